# Optimizing an MI355X kernel written in HIP

```python
import jax, jax.numpy as jnp
from jax import lax
import numpy as np

D_MODEL = 1024
BATCH = 16
SEQ = 256
DEPTH = 4
DEC_BATCH = 4
DEC_SEQ = 2048
PAST_LEN = 512

GRID_W = 64
N_MIXERS = 3
N_A_LAYERS = (DEPTH + 2) // 3
N_B_LAYERS = (DEPTH + 1) // 3
N_MLA_LAYERS = DEPTH // 3
N_GQA_LAYERS = N_A_LAYERS + N_B_LAYERS
N_HEADS = 16
N_KV_HEADS = 4
GROUP = N_HEADS // N_KV_HEADS
HEAD_DIM = 64
Q_BLOCK = 128
WINDOW = 128
MLA_HEADS = 16
Q_RANK = 256
KV_RANK = 128
MLA_NOPE_DIM = 64
MLA_ROPE_DIM = 32
MLA_V_DIM = 64
MLA_SCALE = (MLA_NOPE_DIM + MLA_ROPE_DIM) ** -0.5
GQA_SCALE = HEAD_DIM ** -0.5
N_EXPERTS = 16
EXPERT_FF = 2048
CAPACITY_FACTOR = 2
ROPE_THETA = 10000.0
NORM_EPS = 1e-6
LN_EPS = 1e-5
ALPHA = (2 * DEPTH) ** 0.25
BETA = (8 * DEPTH) ** -0.25

kernel_name = 'hybrid_diffusion_trunk_step'


def layer_norm(x, g, b):
    xf = x.astype(jnp.float32)
    mu = jnp.mean(xf, -1, keepdims=True)
    var = jnp.mean(jnp.square(xf - mu), -1, keepdims=True)
    return ((xf - mu) * lax.rsqrt(var + LN_EPS) * g + b).astype(x.dtype)


def rms_norm(x, g):
    xf = x.astype(jnp.float32)
    return (xf * lax.rsqrt(jnp.mean(jnp.square(xf), -1, keepdims=True) + NORM_EPS) * g).astype(x.dtype)


def adaln(cond, w, b):
    m = jax.nn.silu(cond.reshape(-1, D_MODEL)) @ w + b
    m = m.reshape(m.shape[0], 1, 6, D_MODEL)
    return tuple(m[:, :, k] for k in range(6))


def modulate(x, shift, scale):
    return x * (1 + scale) + shift


def axial_rope(n_tokens, dim):
    n_rows = n_tokens // GRID_W
    rows = jnp.repeat(jnp.arange(n_rows, dtype=jnp.float32), GRID_W)
    cols = jnp.tile(jnp.arange(GRID_W, dtype=jnp.float32), n_rows)
    n_freq = dim // 4
    inv_freq = ROPE_THETA ** (-jnp.arange(n_freq, dtype=jnp.float32) / n_freq)
    ang = jnp.concatenate([rows[:, None] * inv_freq, cols[:, None] * inv_freq], -1)
    return jnp.cos(ang), jnp.sin(ang)


def apply_rope(x, cos, sin):
    xf = x.astype(jnp.float32)
    x1, x2 = jnp.split(xf, 2, axis=-1)
    return jnp.concatenate([x1 * cos - x2 * sin, x2 * cos + x1 * sin], -1).astype(x.dtype)


def split_heads_gqa(h, w_qkv):
    b, t, _ = h.shape
    q, k, v = jnp.split(h @ w_qkv, [N_HEADS * HEAD_DIM, (N_HEADS + N_KV_HEADS) * HEAD_DIM], axis=-1)
    q = q.reshape(b, t, N_KV_HEADS, GROUP, HEAD_DIM).transpose(0, 2, 3, 1, 4)
    k = k.reshape(b, t, N_KV_HEADS, HEAD_DIM).transpose(0, 2, 1, 3)
    v = v.reshape(b, t, N_KV_HEADS, HEAD_DIM).transpose(0, 2, 1, 3)
    return q, k, v


def merge_heads(o):
    b, hk, g, t, d = o.shape
    return o.transpose(0, 3, 1, 2, 4).reshape(b, t, hk * g * d)


def blocked_attention(q, k, v, scale, sink=None):
    b, hk, g, t, dk = q.shape
    nb = t // Q_BLOCK
    qb = jnp.moveaxis(q.reshape(b, hk, g, nb, Q_BLOCK, dk), 3, 0)

    def attend(qblk):
        s = jnp.einsum('bhgqd,bhsd->bhgqs', qblk, k, preferred_element_type=jnp.float32) * scale
        if sink is not None:
            s_sink = jnp.broadcast_to(sink.astype(jnp.float32)[None, :, :, None, None], s.shape[:-1] + (1,))
            p = jax.nn.softmax(jnp.concatenate([s, s_sink], -1), axis=-1)[..., :-1]
        else:
            p = jax.nn.softmax(s, axis=-1)
        return jnp.einsum('bhgqs,bhsd->bhgqd', p.astype(v.dtype), v)

    o = lax.map(attend, qb)
    return jnp.moveaxis(o, 0, 3).reshape(b, hk, g, t, v.shape[-1])


def banded_attention_with_context(q, k, v, k_ctx, v_ctx, sink, scale):
    b, hk, g, t, d = q.shape
    nb = t // Q_BLOCK
    span = Q_BLOCK + 2 * WINDOW
    s_ctx_len = k_ctx.shape[2]
    pad = ((0, 0), (0, 0), (WINDOW, WINDOW), (0, 0))
    kp = jnp.pad(k, pad)
    vp = jnp.pad(v, pad)
    qb = jnp.moveaxis(q.reshape(b, hk, g, nb, Q_BLOCK, d), 3, 0)
    sink_f = sink.astype(jnp.float32)[None, :, :, None, None]

    def attend(args):
        n, qblk = args
        start = n * Q_BLOCK
        kw = lax.dynamic_slice_in_dim(kp, start, span, axis=2)
        vw = lax.dynamic_slice_in_dim(vp, start, span, axis=2)
        qpos = start + jnp.arange(Q_BLOCK)
        kpos = start - WINDOW + jnp.arange(span)
        valid = (jnp.abs(kpos[None, :] - qpos[:, None]) <= WINDOW) & (kpos >= 0)[None, :] & (kpos < t)[None, :]
        s_w = jnp.einsum('bhgqd,bhkd->bhgqk', qblk, kw, preferred_element_type=jnp.float32) * scale
        s_w = jnp.where(valid, s_w, -jnp.inf)
        s_c = jnp.einsum('bhgqd,bhsd->bhgqs', qblk, k_ctx, preferred_element_type=jnp.float32) * scale
        s_sink = jnp.broadcast_to(sink_f, s_c.shape[:-1] + (1,))
        p = jax.nn.softmax(jnp.concatenate([s_w, s_c, s_sink], -1), axis=-1)
        p_w = p[..., :span].astype(v.dtype)
        p_c = p[..., span:span + s_ctx_len].astype(v.dtype)
        return jnp.einsum('bhgqk,bhkd->bhgqd', p_w, vw) + jnp.einsum('bhgqs,bhsd->bhgqd', p_c, v_ctx)

    o = lax.map(attend, (jnp.arange(nb), qb))
    return jnp.moveaxis(o, 0, 3).reshape(b, hk, g, t, d)


def mixer_a_context(h, w_qkv, q_norm, k_norm, w_o):
    q, k, v = split_heads_gqa(h, w_qkv)
    q, k = rms_norm(q, q_norm), rms_norm(k, k_norm)
    o = blocked_attention(q, k, v, GQA_SCALE)
    return merge_heads(o) @ w_o, k, v


def mixer_a_latent(h, k_ctx, v_ctx, w_qkv, q_norm, k_norm, w_o):
    q, k, v = split_heads_gqa(h, w_qkv)
    cos, sin = axial_rope(h.shape[1], HEAD_DIM)
    q = apply_rope(rms_norm(q, q_norm), cos, sin)
    k = apply_rope(rms_norm(k, k_norm), cos, sin)
    k_all = jnp.concatenate([k, k_ctx.astype(k.dtype)], axis=2)
    v_all = jnp.concatenate([v, v_ctx.astype(v.dtype)], axis=2)
    return merge_heads(blocked_attention(q, k_all, v_all, GQA_SCALE)) @ w_o


def mixer_b_context(h, w_qkv, sink, w_o):
    q, k, v = split_heads_gqa(h, w_qkv)
    o = blocked_attention(q, k, v, GQA_SCALE, sink=sink.reshape(N_KV_HEADS, GROUP))
    return merge_heads(o) @ w_o, k, v


def mixer_b_latent(h, k_ctx, v_ctx, w_qkv, sink, w_o):
    q, k, v = split_heads_gqa(h, w_qkv)
    cos, sin = axial_rope(h.shape[1], HEAD_DIM)
    q, k = apply_rope(q, cos, sin), apply_rope(k, cos, sin)
    o = banded_attention_with_context(q, k, v, k_ctx.astype(k.dtype), v_ctx.astype(v.dtype),
                                      sink.reshape(N_KV_HEADS, GROUP), GQA_SCALE)
    return merge_heads(o) @ w_o


def mla_project(h, w_down, q_norm, w_uq, kv_norm):
    b, t, _ = h.shape
    q_a, c_kv, k_pe = jnp.split(h @ w_down, [Q_RANK, Q_RANK + KV_RANK], axis=-1)
    q = (rms_norm(q_a, q_norm) @ w_uq).reshape(b, t, MLA_HEADS, MLA_NOPE_DIM + MLA_ROPE_DIM).transpose(0, 2, 1, 3)
    return q, rms_norm(c_kv, kv_norm), k_pe


def mla_keys_values(c_kv, k_pe, w_ukv):
    b, s, _ = c_kv.shape
    kv = (c_kv @ w_ukv).reshape(b, s, MLA_HEADS, MLA_NOPE_DIM + MLA_V_DIM).transpose(0, 2, 1, 3)
    k_nope, v = jnp.split(kv, [MLA_NOPE_DIM], axis=-1)
    k_rope = jnp.broadcast_to(k_pe[:, None], (b, MLA_HEADS, s, MLA_ROPE_DIM))
    return jnp.concatenate([k_nope, k_rope], -1), v


def mixer_c_context(h, w_down, q_norm, w_uq, kv_norm, w_ukv, w_o):
    q, c_kv, k_pe = mla_project(h, w_down, q_norm, w_uq, kv_norm)
    k, v = mla_keys_values(c_kv, k_pe, w_ukv)
    o = blocked_attention(q[:, :, None], k, v, MLA_SCALE)
    return merge_heads(o) @ w_o, c_kv, k_pe


def mixer_c_latent(h, ckv_ctx, kpe_ctx, w_down, q_norm, w_uq, kv_norm, w_ukv, w_o):
    q, c_kv, k_pe = mla_project(h, w_down, q_norm, w_uq, kv_norm)
    cos, sin = axial_rope(h.shape[1], MLA_ROPE_DIM)
    q = jnp.concatenate([q[..., :MLA_NOPE_DIM], apply_rope(q[..., MLA_NOPE_DIM:], cos, sin)], -1)
    k_pe = apply_rope(k_pe, cos, sin)
    c_all = jnp.concatenate([c_kv, ckv_ctx.astype(c_kv.dtype)], axis=1)
    kpe_all = jnp.concatenate([k_pe, kpe_ctx.astype(k_pe.dtype)], axis=1)
    k, v = mla_keys_values(c_all, kpe_all, w_ukv)
    return merge_heads(blocked_attention(q[:, :, None], k, v, MLA_SCALE)) @ w_o


def ec_moe(h, w_router, w_gate, w_up, w_down):
    b, t, d = h.shape
    xt = h.reshape(b * t, d)
    cap = CAPACITY_FACTOR * (b * t) // N_EXPERTS
    aff = jax.nn.softmax(jnp.einsum('nd,de->ne', xt, w_router, preferred_element_type=jnp.float32), axis=-1)
    gate, idx = lax.top_k(aff.T, cap)
    xe = jnp.take(xt, idx, axis=0)
    hid = jax.nn.silu(jnp.einsum('ecd,edf->ecf', xe, w_gate)) * jnp.einsum('ecd,edf->ecf', xe, w_up)
    ye = jnp.einsum('ecf,efd->ecd', hid, w_down) * gate[..., None].astype(h.dtype)
    out = jnp.zeros_like(xt).at[idx.reshape(-1)].add(ye.reshape(-1, d))
    return out.reshape(b, t, d)


def setup_inputs(seed: int = 0) -> dict:
    key = jax.random.key(seed)
    ks = iter(jax.random.split(key, 48))

    def nrm(shape, scale=1.0):
        return jax.random.normal(next(ks), shape, jnp.float32) * scale

    d = D_MODEL
    qkv_w = (N_HEADS + 2 * N_KV_HEADS) * HEAD_DIM
    attn_w = N_HEADS * HEAD_DIM
    return {
        'x_prompt': nrm((BATCH, SEQ, d)),
        'x_sample': nrm((DEC_BATCH, DEC_SEQ, d)),
        'cache_gqa_k': nrm((DEC_BATCH, N_GQA_LAYERS, N_KV_HEADS, PAST_LEN, HEAD_DIM)),
        'cache_gqa_v': nrm((DEC_BATCH, N_GQA_LAYERS, N_KV_HEADS, PAST_LEN, HEAD_DIM)),
        'cache_mla_ckv': nrm((DEC_BATCH, N_MLA_LAYERS, PAST_LEN, KV_RANK)),
        'cache_mla_kpe': nrm((DEC_BATCH, N_MLA_LAYERS, PAST_LEN, MLA_ROPE_DIM)),
        'c': nrm((DEC_BATCH, d)),
        'c_ctx': nrm((d,)),
        'ada_w': nrm((DEPTH, d, 6 * d), 0.5 * d ** -0.5),
        'ada_b': nrm((DEPTH, 6 * d), 0.02),
        'ln_g': 1.0 + nrm((DEPTH, 2, d), 0.02),
        'ln_b': nrm((DEPTH, 2, d), 0.02),
        'a_w_qkv': nrm((N_A_LAYERS, d, qkv_w), d ** -0.5),
        'a_q_norm': 1.0 + nrm((N_A_LAYERS, HEAD_DIM), 0.02),
        'a_k_norm': 1.0 + nrm((N_A_LAYERS, HEAD_DIM), 0.02),
        'a_w_o': nrm((N_A_LAYERS, attn_w, d), BETA * attn_w ** -0.5),
        'b_w_qkv': nrm((N_B_LAYERS, d, qkv_w), d ** -0.5),
        'b_sink': nrm((N_B_LAYERS, N_HEADS), 0.5),
        'b_w_o': nrm((N_B_LAYERS, attn_w, d), BETA * attn_w ** -0.5),
        'mla_w_down': nrm((N_MLA_LAYERS, d, Q_RANK + KV_RANK + MLA_ROPE_DIM), d ** -0.5),
        'mla_q_norm': 1.0 + nrm((N_MLA_LAYERS, Q_RANK), 0.02),
        'mla_w_uq': nrm((N_MLA_LAYERS, Q_RANK, MLA_HEADS * (MLA_NOPE_DIM + MLA_ROPE_DIM)), Q_RANK ** -0.5),
        'mla_kv_norm': 1.0 + nrm((N_MLA_LAYERS, KV_RANK), 0.02),
        'mla_w_ukv': nrm((N_MLA_LAYERS, KV_RANK, MLA_HEADS * (MLA_NOPE_DIM + MLA_V_DIM)), KV_RANK ** -0.5),
        'mla_w_o': nrm((N_MLA_LAYERS, MLA_HEADS * MLA_V_DIM, d), BETA * (MLA_HEADS * MLA_V_DIM) ** -0.5),
        'moe_w_router': nrm((DEPTH, d, N_EXPERTS), d ** -0.5),
        'moe_w_gate': nrm((DEPTH, N_EXPERTS, d, EXPERT_FF), d ** -0.5),
        'moe_w_up': nrm((DEPTH, N_EXPERTS, d, EXPERT_FF), d ** -0.5),
        'moe_w_down': nrm((DEPTH, N_EXPERTS, EXPERT_FF, d), BETA * EXPERT_FF ** -0.5),
    }


def reference(x_prompt, x_sample, cache_gqa_k, cache_gqa_v, cache_mla_ckv, cache_mla_kpe, c, c_ctx,
              ada_w, ada_b, ln_g, ln_b, a_w_qkv, a_q_norm, a_k_norm, a_w_o, b_w_qkv, b_sink, b_w_o,
              mla_w_down, mla_q_norm, mla_w_uq, mla_kv_norm, mla_w_ukv, mla_w_o,
              moe_w_router, moe_w_gate, moe_w_up, moe_w_down):
    xp = x_prompt
    xs = x_sample
    new_k, new_v, new_ckv, new_kpe = [], [], [], []
    gqa_slot = 0
    for i in range(DEPTH):
        kind, j = i % N_MIXERS, i // N_MIXERS
        mp = adaln(c_ctx, ada_w[i], ada_b[i])
        ms = adaln(c, ada_w[i], ada_b[i])
        hp = modulate(xp, mp[0], mp[1])
        hs = modulate(xs, ms[0], ms[1])
        if kind == 0:
            op, kc, vc = mixer_a_context(hp, a_w_qkv[j], a_q_norm[j], a_k_norm[j], a_w_o[j])
            os_ = mixer_a_latent(hs, cache_gqa_k[:, gqa_slot], cache_gqa_v[:, gqa_slot],
                                 a_w_qkv[j], a_q_norm[j], a_k_norm[j], a_w_o[j])
            new_k.append(kc)
            new_v.append(vc)
            gqa_slot += 1
        elif kind == 1:
            op, kc, vc = mixer_b_context(hp, b_w_qkv[j], b_sink[j], b_w_o[j])
            os_ = mixer_b_latent(hs, cache_gqa_k[:, gqa_slot], cache_gqa_v[:, gqa_slot],
                                 b_w_qkv[j], b_sink[j], b_w_o[j])
            new_k.append(kc)
            new_v.append(vc)
            gqa_slot += 1
        else:
            op, ckv, kpe = mixer_c_context(hp, mla_w_down[j], mla_q_norm[j], mla_w_uq[j],
                                           mla_kv_norm[j], mla_w_ukv[j], mla_w_o[j])
            os_ = mixer_c_latent(hs, cache_mla_ckv[:, j], cache_mla_kpe[:, j], mla_w_down[j], mla_q_norm[j],
                                 mla_w_uq[j], mla_kv_norm[j], mla_w_ukv[j], mla_w_o[j])
            new_ckv.append(ckv)
            new_kpe.append(kpe)
        xp = layer_norm(ALPHA * xp + mp[2] * op, ln_g[i, 0], ln_b[i, 0])
        xs = layer_norm(ALPHA * xs + ms[2] * os_, ln_g[i, 0], ln_b[i, 0])
        hp = modulate(xp, mp[3], mp[4])
        hs = modulate(xs, ms[3], ms[4])
        fp = ec_moe(hp, moe_w_router[i], moe_w_gate[i], moe_w_up[i], moe_w_down[i])
        fs = ec_moe(hs, moe_w_router[i], moe_w_gate[i], moe_w_up[i], moe_w_down[i])
        xp = layer_norm(ALPHA * xp + mp[5] * fp, ln_g[i, 1], ln_b[i, 1])
        xs = layer_norm(ALPHA * xs + ms[5] * fs, ln_g[i, 1], ln_b[i, 1])
    new_gqa_k = jnp.stack(new_k, axis=1)
    new_gqa_v = jnp.stack(new_v, axis=1)
    new_mla_ckv = jnp.stack(new_ckv, axis=1)
    new_mla_kpe = jnp.stack(new_kpe, axis=1)
    return (xp, xs, new_gqa_k, new_gqa_v, new_mla_ckv, new_mla_kpe)
```

```cpp
#include <hip/hip_runtime.h>
#include <cstdio>
#include <cstdint>

#ifndef MK_SPLIT
#define MK_SPLIT 0
#endif
#ifndef MK_REP_ATTN
#define MK_REP_ATTN 1
#endif
#ifndef MK_REP_CONV
#define MK_REP_CONV 1
#endif
#ifndef MK_REP_POST
#define MK_REP_POST 1
#endif
#ifndef MK_REP_GEMM
#define MK_REP_GEMM 1
#endif
#ifndef MK_REP_LN1
#define MK_REP_LN1 1
#endif
#ifndef MK_REP_TOPK
#define MK_REP_TOPK 1
#endif
#ifndef MK_REP_GATH
#define MK_REP_GATH 1
#endif
#ifndef MK_REP_COMB
#define MK_REP_COMB 1
#endif
#ifndef MK_CHECK
#define MK_CHECK 0
#endif

#define LAS __attribute__((address_space(3)))
typedef unsigned short bf16;
typedef unsigned u32x4 __attribute__((ext_vector_type(4)));
typedef unsigned u32x2 __attribute__((ext_vector_type(2)));
typedef float f32x2 __attribute__((ext_vector_type(2)));
typedef float f32x4 __attribute__((ext_vector_type(4)));
typedef float f32x16 __attribute__((ext_vector_type(16)));
typedef short bf16x8 __attribute__((ext_vector_type(8)));
typedef __bf16 bf16x2_t __attribute__((ext_vector_type(2)));

constexpr int D = 1024, NCTX = 4096, NLAT = 8192, NTOK = 12288;
constexpr int NE = 16, FF = 2048, CAPC = 512, CAPL = 1024, ESLOTS = 1536, NSLOTS = 24576;
constexpr float ALPHA = 1.681792830507429f, LOG2E = 1.4426950408889634f;
constexpr float GQA_QS = 0.125f * LOG2E, MLA_QS = 0.10206207261596575f * LOG2E;
constexpr size_t DWN_PART = (size_t)8 << 20;
constexpr int OFF_YP = 0, OFF_NK = 12582912, OFF_NV = OFF_NK + 3145728, OFF_CKV = OFF_NV + 3145728, OFF_KPE = OFF_CKV + 524288;

constexpr size_t MiB = 1u << 20;
constexpr size_t WS_CTL = 0, CTL_BYTES = 1 * MiB;
constexpr size_t WS_ADAP = 1 * MiB, WS_ADA = 9 * MiB, WS_ROPE64 = 10 * MiB, WS_ROPE32 = 10 * MiB + 512 * 1024;
constexpr size_t WS_AFF = 11 * MiB, WS_IDX = 12 * MiB, WS_GATEV = 12 * MiB + 128 * 1024, WS_SLOTMAP = 13 * MiB;
constexpr size_t WS_X = 16 * MiB, WS_H = 64 * MiB, WS_O = 88 * MiB, WS_AO = 112 * MiB, WS_QKV = 160 * MiB, WS_KVRAW = 232 * MiB;
constexpr size_t WS_X1 = 292 * MiB  , WS_KB = 380 * MiB, WS_VT = 428 * MiB, WS_QA = 460 * MiB, WS_CKVA = 466 * MiB;
constexpr size_t WS_XE = 470 * MiB, WS_HID = 518 * MiB, WS_YE = 614 * MiB;
constexpr size_t WS_WQKV = 712 * MiB, WS_WO = 724 * MiB, WS_WDN = 732 * MiB, WS_WUQ = 733 * MiB, WS_WUKV = 734 * MiB;
constexpr size_t WS_WGU = 736 * MiB, WS_WD = 1248 * MiB, WS_END = 1504 * MiB;
constexpr int CW_ERR = 0, CW_BAR = 4096, CW_KV = 8192;

constexpr int LDS_BYTES = 147456, LDS_PH = 256;

__device__ __forceinline__ unsigned cvtpk(float lo, float hi) { f32x2 v = {lo, hi}; bf16x2_t b = __builtin_convertvector(v, bf16x2_t); return __builtin_bit_cast(unsigned, b); }
__device__ __forceinline__ bf16 f2bf(float f) { return (bf16)(cvtpk(f, 0.f) & 0xffffu); }
__device__ __forceinline__ float bf2f(bf16 b) { return __uint_as_float(((unsigned)b) << 16); }
__device__ __forceinline__ unsigned pk4_fp8(float a, float b, float c, float d) { int w = __builtin_amdgcn_cvt_pk_fp8_f32(a, b, 0, false); w = __builtin_amdgcn_cvt_pk_fp8_f32(c, d, w, true); return (unsigned)w; }
constexpr float W8_SCALE = 64.f, H8_SCALE = 8.f;
constexpr float YE8_SCALE = 128.f;
__device__ __forceinline__ float clamp8(float x) { return __builtin_amdgcn_fmed3f(x, -448.f, 448.f); }
__device__ __forceinline__ f32x4 bf4(u32x2 w) { return (f32x4){__uint_as_float(w.x << 16), __uint_as_float(w.x & 0xffff0000u), __uint_as_float(w.y << 16), __uint_as_float(w.y & 0xffff0000u)}; }
__device__ __forceinline__ u32x2 pk4(f32x4 v) { u32x2 w; w.x = cvtpk(v[0], v[1]); w.y = cvtpk(v[2], v[3]); return w; }
template <int CTRL> __device__ __forceinline__ float dppf(float v) { return __uint_as_float((unsigned)__builtin_amdgcn_update_dpp(0, (int)__float_as_uint(v), CTRL, 0xf, 0xf, true)); }
constexpr int DPP_X1 = 0xB1, DPP_X2 = 0x4E, DPP_HMIR = 0x141, DPP_MIR = 0x140, DPP_X8 = 0x128;
__device__ __forceinline__ float xsum16(float a, float b) { const auto r = __builtin_amdgcn_permlane16_swap(__float_as_uint(a), __float_as_uint(b), false, false); return __uint_as_float(r[0]) + __uint_as_float(r[1]); }
__device__ __forceinline__ float xsum32(float a, float b) { const auto r = __builtin_amdgcn_permlane32_swap(__float_as_uint(a), __float_as_uint(b), false, false); return __uint_as_float(r[0]) + __uint_as_float(r[1]); }
__device__ __forceinline__ float xmax16(float a) { const auto r = __builtin_amdgcn_permlane16_swap(__float_as_uint(a), __float_as_uint(a), false, false); return fmaxf(__uint_as_float(r[0]), __uint_as_float(r[1])); }
__device__ __forceinline__ float xmax32(float a) { const auto r = __builtin_amdgcn_permlane32_swap(__float_as_uint(a), __float_as_uint(a), false, false); return fmaxf(__uint_as_float(r[0]), __uint_as_float(r[1])); }
__device__ __forceinline__ float sum16(float v) { v += dppf<DPP_X1>(v); v += dppf<DPP_X2>(v); v += dppf<DPP_HMIR>(v); v += dppf<DPP_MIR>(v); return v; }
__device__ __forceinline__ float wave_sum(float v) { v = sum16(v); v = xsum16(v, v); return xsum32(v, v); }
__device__ __forceinline__ float wave_max(float v) {
    v = fmaxf(v, dppf<DPP_X1>(v)); v = fmaxf(v, dppf<DPP_X2>(v)); v = fmaxf(v, dppf<DPP_HMIR>(v)); v = fmaxf(v, dppf<DPP_MIR>(v)); v = xmax16(v); return xmax32(v);
}
__device__ __forceinline__ int cond_of(int t) { return t < NCTX ? 0 : 1 + ((t - NCTX) >> 11); }
__device__ __forceinline__ unsigned hash_u(unsigned x) { x ^= x >> 16; x *= 0x7feb352dU; x ^= x >> 15; x *= 0x846ca68bU; x ^= x >> 16; return x; }

#define XB_TMO      128
#define XB_XCNT(j)  (256  + 64 * (j))
#define XB_XSUB(j)  (1280 + 64 * (j))
#define XB_XGEN(j)  (2304 + 64 * (j))
#define XB_TOP      3328
#define XB_TOPGEN   3392
#define XCD_BAR_WORDS 3456
#define XB_SPIN_CAP (1u << 18)
__device__ __forceinline__ unsigned xb_ld(unsigned* p)              { return __hip_atomic_load(p, __ATOMIC_RELAXED, __HIP_MEMORY_SCOPE_AGENT); }
__device__ __forceinline__ unsigned xb_add(unsigned* p, unsigned v) { return __hip_atomic_fetch_add(p, v, __ATOMIC_RELAXED, __HIP_MEMORY_SCOPE_AGENT); }
__device__ __forceinline__ unsigned xb_xcc_id() { return (unsigned)__builtin_amdgcn_s_getreg((3 << 11) | 20) & 0xFu; }
#define XB_SPIN(cond, bar) do { unsigned _sp = 0; while (cond) { __builtin_amdgcn_s_sleep(1); \
    if ((++_sp & 255u) == 0u) { if (xb_ld(&(bar)[XB_TMO])) break; if (_sp > XB_SPIN_CAP) { atomicAdd(&(bar)[XB_TMO], 1u); break; } } } } while (0)
struct XcdBarrier { unsigned* bar; unsigned x; volatile LAS unsigned* st; };
__device__ __forceinline__ XcdBarrier xcd_barrier_post(unsigned* bar, volatile LAS unsigned* st) {
    XcdBarrier b; b.bar = bar; b.x = xb_xcc_id(); b.st = st;
    if (threadIdx.x == 0) (void)xb_add(&bar[XB_XCNT(b.x)], 1u);
    return b;
}
__device__ __forceinline__ void xcd_barrier_complete(unsigned* bar, unsigned x, unsigned& nloc, unsigned& nx) {
    const unsigned G = gridDim.x * gridDim.y * gridDim.z;
    unsigned sum, cnt, mine, sp = 0u;
    for (;;) {
        sum = 0u; cnt = 0u; mine = 0u;
#pragma unroll
        for (unsigned j = 0; j < 16; ++j) { const unsigned c = xb_ld(&bar[XB_XCNT(j)]); sum += c; cnt += (c > 0u) ? 1u : 0u; mine = (j == x) ? c : mine; }
        if (sum == G) break;
        __builtin_amdgcn_s_sleep(1);
        if ((++sp & 255u) == 0u) { if (xb_ld(&bar[XB_TMO])) break; if (sp > XB_SPIN_CAP) { atomicAdd(&bar[XB_TMO], 1u); break; } }
    }
    nloc = mine > 0u ? mine : 1u; nx = cnt > 0u ? cnt : 1u;
}
__device__ __forceinline__ void xcd_barrier(const XcdBarrier& b) {
    asm volatile("s_waitcnt vmcnt(0)" ::: "memory");
    __syncthreads();
    if (threadIdx.x == 0) {
        unsigned* bar = b.bar;
        __builtin_amdgcn_s_waitcnt(0);
        unsigned nloc = b.st[0], nx = b.st[1];
        if (nloc == 0u) { xcd_barrier_complete(bar, b.x, nloc, nx); b.st[0] = nloc; b.st[1] = nx; }
        const unsigned old = xb_add(&bar[XB_XSUB(b.x)], 1u);
        const unsigned gen = old / nloc;
        if (old + 1u == (gen + 1u) * nloc) {
            __builtin_amdgcn_fence(__ATOMIC_RELEASE, "agent");
            asm volatile("s_waitcnt vmcnt(0)" ::: "memory");
            const unsigned og = xb_add(&bar[XB_TOP], 1u);
            const unsigned tg = og / nx;
            if (og + 1u == (tg + 1u) * nx) xb_add(&bar[XB_TOPGEN], 1u);
            else XB_SPIN(xb_ld(&bar[XB_TOPGEN]) == tg, bar);
            __builtin_amdgcn_fence(__ATOMIC_ACQUIRE, "agent");
            xb_add(&bar[XB_XGEN(b.x)], 1u);
            asm volatile("s_waitcnt vmcnt(0)" ::: "memory");
        } else {
            XB_SPIN(xb_ld(&bar[XB_XGEN(b.x)]) == gen, bar);
            __builtin_amdgcn_fence(__ATOMIC_ACQUIRE, "agent");
            asm volatile("s_waitcnt vmcnt(0)" ::: "memory");
        }
    }
    __syncthreads();
}

struct Args { const float* in[29]; float* out; unsigned char* ws; int ph_lo, ph_hi; };
struct Frame {
    LAS unsigned char* lds;
    unsigned char* ws; float* out; unsigned* ctl;
    int tid, lane, wave, G, bid, gw, NGW;
};
#if MK_CHECK
#define CHK_FAIL(F, id) do { unsigned _e = 0u; __hip_atomic_compare_exchange_strong((F).ctl + CW_ERR, &_e, (unsigned)(id), __ATOMIC_RELAXED, __ATOMIC_RELAXED, __HIP_MEMORY_SCOPE_AGENT); } while (0)
#endif
__device__ __forceinline__ bool close_enough(float a, float b, float rel, float abs_) { const float d = fabsf(a - b); return d <= rel * fabsf(b) + abs_ && a == a; }

namespace pg8 {
#define PG8_LAS __attribute__((address_space(3)))
typedef unsigned short bf16_t;
typedef short bf16x8 __attribute__((ext_vector_type(8)));
typedef float f32x4 __attribute__((ext_vector_type(4)));
constexpr int BM = 256, BK = 64, HALF = 128, HTB = HALF * BK * 2  , STAGE_BYTES = 8 * HTB, NXCD = 8, WGM = 8;

__host__ __device__ __forceinline__ int lds_byte(int r, int c, int XM = 32) { const int st = (r >> 4) * 2 + (c >> 5), rr = r & 15, cc = c & 31, ob = rr * 64 + cc * 2; return st * 1024 + (ob ^ (((ob >> 9) & 1) * XM)); }
__host__ __device__ __forceinline__ void stage_rc(int b, int& R, int& C, int XM = 32) { const int st = b / 1024, sb = b % 1024, swz = sb ^ (((sb >> 9) & 1) * XM); R = (st >> 1) * 16 + swz / 64; C = (st & 1) * 32 + (swz % 64) / 2; }
__host__ __device__ __forceinline__ int perm32(int rho) { const int n = rho >> 4, i = rho & 15; return 8 * (i >> 2) + 4 * n + (i & 3); }
struct Unit { int pm, pn, kb; };
struct Gemm { const bf16_t* A; const bf16_t* Bt; int K, ld; const int* aidx; };
template <class Epi, class Sched, bool ALIGN_EPI = false, bool SP2 = false, bool GATHER = false, bool F8 = false>
__device__ __forceinline__ void gemm_phase(PG8_LAS unsigned char* lds, const Gemm g, const Sched& S, const Epi& E) {
    int tid_ = threadIdx.x; asm volatile("" : "+v"(tid_));
    const int tid = tid_, wid = __builtin_amdgcn_readfirstlane(tid >> 6), lane = tid & 63, wr = wid >> 2, wc = wid & 3, fr = lane & 15, fq = lane >> 4;
    const int K = g.K, LD = g.ld, nt = K / BK;
    unsigned voffA[2], voffB[2]; int RA[2]; unsigned CA2[2];
#pragma unroll
    for (int i = 0; i < 2; ++i) { int R, C; stage_rc(tid * 16 + i * 8192, R, C, F8 ? 48 : 32); const int Rb = Epi::PERM ? ((R & ~31) + perm32(R & 31)) : R;
        voffA[i] = (unsigned)(R * LD + C) * 2u; voffB[i] = (unsigned)(Rb * LD + C) * 2u; RA[i] = R; CA2[i] = (unsigned)C * 2u; }
    const size_t kstep = (size_t)(BK * 2);
    const size_t hstep = (size_t)HALF * LD * 2;
    const size_t tstep = 2 * hstep;
    const unsigned ldsw = (unsigned)wid * 1024u;
    const int aoff = lds_byte(wr * 64 + fr, F8 ? fq * 16 : fq * 8, F8 ? 48 : 32), boff = lds_byte(wc * 32 + fr, F8 ? fq * 16 : fq * 8, F8 ? 48 : 32);
    const int aoffh = aoff ^ 16, boffh = boff ^ 16;
    typedef int i32x8_t __attribute__((ext_vector_type(8)));
#define PG8_SA(b, h) (((b) * 2 + (h)) * HTB)
#define PG8_SB(b, h) ((4 + (b) * 2 + (h)) * HTB)
#define PG8_STAGE(bufoff, gbase, voff) do { _Pragma("unroll") for (int _i = 0; _i < 2; ++_i) \
        __builtin_amdgcn_global_load_lds((const unsigned*)((const char*)(gbase) + (voff)[_i]), (PG8_LAS unsigned*)(lds + (bufoff) + ldsw + _i * 8192), 16, 0, 0); } while (0)
#define PG8_GOFF(dst, unit) do { _Pragma("unroll") for (int _h = 0; _h < 2; ++_h) _Pragma("unroll") for (int _i = 0; _i < 2; ++_i) dst[_h][_i] = (unsigned)g.aidx[(unit).pm * 256 + _h * 128 + RA[_i]] * (unsigned)(LD * 2) + CA2[_i]; } while (0)
#define PG8_STAGE_A(bufoff, gbase, h, nx) do { if constexpr (GATHER) { unsigned _o[2] = {(nx) ? oN[h][0] : oC[h][0], (nx) ? oN[h][1] : oC[h][1]}; PG8_STAGE(bufoff, gbase, _o); } else { PG8_STAGE(bufoff, (gbase) + (h) * hstep, voffA); } } while (0)
#define PG8_LDA16(dst, b, h) do { _Pragma("unroll") for (int m = 0; m < 4; ++m) _Pragma("unroll") for (int k = 0; k < 2; ++k) dst[m][k] = *(const PG8_LAS bf16x8*)(lds + PG8_SA(b, h) + aoff + m * 2048 + k * 1024); } while (0)
#define PG8_LDB16(dst, b, h) do { _Pragma("unroll") for (int n = 0; n < 2; ++n) _Pragma("unroll") for (int k = 0; k < 2; ++k) dst[n][k] = *(const PG8_LAS bf16x8*)(lds + PG8_SB(b, h) + boff + n * 2048 + k * 1024); } while (0)
#define PG8_MMA16(ai, bj, At, Bt) do { __builtin_amdgcn_s_setprio(1); _Pragma("unroll") for (int m = 0; m < 4; ++m) _Pragma("unroll") for (int n = 0; n < 2; ++n) _Pragma("unroll") for (int k = 0; k < 2; ++k) \
        acc[ai][bj][m][n] = __builtin_amdgcn_mfma_f32_16x16x32_bf16(Bt[n][k], At[m][k], acc[ai][bj][m][n], 0, 0, 0); __builtin_amdgcn_s_setprio(0); } while (0)
#define PG8_LD32(p, lo, hi) __builtin_bit_cast(i32x8_t, __builtin_shufflevector(*(const PG8_LAS bf16x8*)((p) + (lo)), *(const PG8_LAS bf16x8*)((p) + (hi)), 0, 1, 2, 3, 4, 5, 6, 7, 8, 9, 10, 11, 12, 13, 14, 15))
#define PG8_LDA(dst, b, h) do { if constexpr (F8) { _Pragma("unroll") for (int m = 0; m < 4; ++m) dst##8[m] = PG8_LD32(lds + PG8_SA(b, h) + m * 2048, aoff, aoffh); } else { PG8_LDA16(dst, b, h); } } while (0)
#define PG8_LDB(dst, b, h) do { if constexpr (F8) { _Pragma("unroll") for (int n = 0; n < 2; ++n) dst##8[n] = PG8_LD32(lds + PG8_SB(b, h) + n * 2048, boff, boffh); } else { PG8_LDB16(dst, b, h); } } while (0)
#define PG8_MMA(ai, bj, At, Bt) do { if constexpr (F8) { __builtin_amdgcn_s_setprio(1); _Pragma("unroll") for (int m = 0; m < 4; ++m) _Pragma("unroll") for (int n = 0; n < 2; ++n) \
        asm volatile("v_mfma_f32_16x16x128_f8f6f4 %0, %1, %2, %0" : "+v"(acc[ai][bj][m][n]) : "v"(Bt##8[n]), "v"(At##8[m])); __builtin_amdgcn_s_setprio(0); } else { PG8_MMA16(ai, bj, At, Bt); } } while (0)
#define PG8_WAIT_V(n) asm volatile("s_waitcnt vmcnt(" #n ")" ::: "memory")
#define PG8_WAIT_L(n) asm volatile("s_waitcnt lgkmcnt(" #n ")" ::: "memory")
#define PG8_BAR __builtin_amdgcn_s_barrier()
#define PG8_SCHED __builtin_amdgcn_sched_barrier(0)
    Unit cur, nxt; int ui = 0;
    if (!S.next(0, cur)) return;
    unsigned oC[2][2] = {{0u, 0u}, {0u, 0u}}, oN[2][2] = {{0u, 0u}, {0u, 0u}};
    if constexpr (GATHER) PG8_GOFF(oC, cur);
    f32x4 acc[2][2][4][2];
#pragma unroll
    for (int a = 0; a < 2; ++a)
#pragma unroll
        for (int b = 0; b < 2; ++b)
#pragma unroll
            for (int m = 0; m < 4; ++m)
#pragma unroll
                for (int n = 0; n < 2; ++n) acc[a][b][m][n] = (f32x4){0.f, 0.f, 0.f, 0.f};
    bf16x8 At[4][2], B0[2][2], B1[2][2]; i32x8_t At8[4], B08[2], B18[2];
    const char* cA = GATHER ? (const char*)g.A + cur.kb : (const char*)g.A + (size_t)cur.pm * tstep + cur.kb; const char* cB = (const char*)g.Bt + (size_t)cur.pn * tstep + cur.kb;
    S.a_ready(cur);
    if constexpr (SP2) {
        PG8_STAGE(PG8_SB(0, 0), cB, voffB); PG8_STAGE(PG8_SB(0, 1), cB + hstep, voffB); PG8_STAGE_A(PG8_SA(0, 0), cA, 0, false); PG8_STAGE_A(PG8_SA(0, 1), cA, 1, false);
        if (wr == 1) PG8_BAR;
        PG8_WAIT_V(2); PG8_BAR;
        PG8_STAGE(PG8_SB(1, 0), cB + kstep, voffB); PG8_STAGE_A(PG8_SA(1, 0), cA + kstep, 0, false); PG8_STAGE(PG8_SB(1, 1), cB + hstep + kstep, voffB);
        PG8_WAIT_V(6); PG8_BAR;
    } else {
        PG8_STAGE(PG8_SB(0, 0), cB, voffB); PG8_STAGE_A(PG8_SA(0, 0), cA, 0, false); PG8_STAGE(PG8_SB(0, 1), cB + hstep, voffB); PG8_STAGE_A(PG8_SA(0, 1), cA, 1, false);
        if (wr == 1) PG8_BAR;
        PG8_WAIT_V(4); PG8_BAR;
        PG8_STAGE(PG8_SB(1, 0), cB + kstep, voffB); PG8_STAGE_A(PG8_SA(1, 0), cA + kstep, 0, false); PG8_STAGE(PG8_SB(1, 1), cB + hstep + kstep, voffB);
        PG8_WAIT_V(6); PG8_BAR;
    }
    for (;;) {
        const bool has_next = S.next(ui + 1, nxt);
        const char* nA = has_next ? (GATHER ? (const char*)g.A + nxt.kb : (const char*)g.A + (size_t)nxt.pm * tstep + nxt.kb) : cA;
        if constexpr (GATHER) { if (has_next) PG8_GOFF(oN, nxt); } const char* nB = has_next ? (const char*)g.Bt + (size_t)nxt.pn * tstep + nxt.kb : cB;
        for (int t = 0; t < nt; t += 2) {
            const bool last = (t == nt - 2); const bool lastn = last && has_next;
            const char* a1 = cA + (size_t)(t + 1) * kstep;
            const char* a2 = last ? nA : cA + (size_t)(t + 2) * kstep; const char* b2 = last ? nB : cB + (size_t)(t + 2) * kstep;
            const char* a3 = a2 + kstep; const char* b3 = b2 + kstep;
            if (last && has_next) S.a_ready(nxt);
            if constexpr (SP2) {
            PG8_LDB(B0, 0, 0); PG8_LDB(B1, 0, 1); PG8_SCHED; PG8_LDA(At, 0, 0); PG8_STAGE_A(PG8_SA(1, 1), a1, 1, false);
            PG8_WAIT_V(8); PG8_WAIT_L(0); PG8_BAR; PG8_MMA(0, 0, At, B0); PG8_MMA(0, 1, At, B1); PG8_BAR; PG8_SCHED;
            PG8_LDA(At, 0, 1); PG8_STAGE(PG8_SB(0, 0), b2, voffB); PG8_STAGE(PG8_SB(0, 1), b2 + hstep, voffB); PG8_STAGE_A(PG8_SA(0, 0), a2, 0, lastn);
            PG8_WAIT_V(8); PG8_WAIT_L(0); PG8_BAR; PG8_MMA(1, 0, At, B0); PG8_MMA(1, 1, At, B1); PG8_BAR; PG8_SCHED;
            PG8_LDB(B0, 1, 0); PG8_LDB(B1, 1, 1); PG8_SCHED; PG8_LDA(At, 1, 0); PG8_STAGE_A(PG8_SA(0, 1), a2, 1, lastn);
            PG8_WAIT_V(8); PG8_WAIT_L(0); PG8_BAR; PG8_MMA(0, 0, At, B0); PG8_MMA(0, 1, At, B1); PG8_BAR; PG8_SCHED;
            PG8_LDA(At, 1, 1); PG8_STAGE(PG8_SB(1, 0), b3, voffB); PG8_STAGE(PG8_SB(1, 1), b3 + hstep, voffB); PG8_STAGE_A(PG8_SA(1, 0), a3, 0, lastn);
            PG8_WAIT_V(8); PG8_WAIT_L(0); PG8_BAR; PG8_MMA(1, 0, At, B0); PG8_MMA(1, 1, At, B1); PG8_BAR; PG8_SCHED;
            } else {
            PG8_LDB(B0, 0, 0); PG8_SCHED; PG8_LDA(At, 0, 0); PG8_STAGE_A(PG8_SA(1, 1), a1, 1, false);
            PG8_WAIT_L(8); PG8_BAR; PG8_WAIT_L(0); PG8_MMA(0, 0, At, B0); PG8_BAR; PG8_SCHED;
            PG8_LDB(B1, 0, 1); PG8_STAGE(PG8_SB(0, 0), b2, voffB);
            PG8_BAR; PG8_WAIT_L(0); PG8_MMA(0, 1, At, B1); PG8_BAR;
            PG8_LDA(At, 0, 1); PG8_STAGE_A(PG8_SA(0, 0), a2, 0, lastn);
            PG8_BAR; PG8_WAIT_L(0); PG8_MMA(1, 0, At, B0); PG8_BAR; PG8_SCHED;
            PG8_STAGE(PG8_SB(0, 1), b2 + hstep, voffB);
            PG8_WAIT_V(6); PG8_BAR; PG8_MMA(1, 1, At, B1); PG8_BAR;
            PG8_LDB(B0, 1, 0); PG8_SCHED; PG8_LDA(At, 1, 0); PG8_STAGE_A(PG8_SA(0, 1), a2, 1, lastn);
            PG8_WAIT_L(8); PG8_BAR; PG8_WAIT_L(0); PG8_MMA(0, 0, At, B0); PG8_BAR; PG8_SCHED;
            PG8_LDB(B1, 1, 1); PG8_STAGE(PG8_SB(1, 0), b3, voffB);
            PG8_BAR; PG8_WAIT_L(0); PG8_MMA(0, 1, At, B1); PG8_BAR;
            PG8_LDA(At, 1, 1); PG8_STAGE_A(PG8_SA(1, 0), a3, 0, lastn);
            PG8_BAR; PG8_WAIT_L(0); PG8_MMA(1, 0, At, B0); PG8_BAR; PG8_SCHED;
            PG8_STAGE(PG8_SB(1, 1), b3 + hstep, voffB);
            PG8_WAIT_V(6); PG8_BAR; PG8_MMA(1, 1, At, B1); PG8_BAR;
            }
        }
        if constexpr (ALIGN_EPI) { if (wr == 0) PG8_BAR; }
        if constexpr (F8) {
#pragma unroll
            for (int a = 0; a < 2; ++a)
#pragma unroll
                for (int b = 0; b < 2; ++b)
                    asm volatile("s_nop 15\n\ts_nop 7" : "+v"(acc[a][b][0][0]), "+v"(acc[a][b][0][1]), "+v"(acc[a][b][1][0]), "+v"(acc[a][b][1][1]), "+v"(acc[a][b][2][0]), "+v"(acc[a][b][2][1]), "+v"(acc[a][b][3][0]), "+v"(acc[a][b][3][1])); }
        if constexpr (!Epi::AFTER_DRAIN) { E(acc, cur, wr, wc, fr, fq); S.done(cur); }
        if (!has_next) break;
#pragma unroll
        for (int a = 0; a < 2; ++a)
#pragma unroll
            for (int b = 0; b < 2; ++b)
#pragma unroll
                for (int m = 0; m < 4; ++m)
#pragma unroll
                    for (int n = 0; n < 2; ++n) acc[a][b][m][n] = (f32x4){0.f, 0.f, 0.f, 0.f};
        cur = nxt; cA = nA; cB = nB; ++ui;
        if constexpr (GATHER) { oC[0][0] = oN[0][0]; oC[0][1] = oN[0][1]; oC[1][0] = oN[1][0]; oC[1][1] = oN[1][1]; }
        if constexpr (ALIGN_EPI) { if (wr == 1) PG8_BAR; }
    }
    PG8_WAIT_V(0);
    if constexpr (!ALIGN_EPI) { if (wr == 0) PG8_BAR; }
    PG8_BAR;
    if constexpr (Epi::AFTER_DRAIN) { E.fused(acc, cur, wr, wc, fr, fq, lds, wid, lane); S.done(cur); }
#undef PG8_SA
#undef PG8_SB
#undef PG8_STAGE
#undef PG8_STAGE_A
#undef PG8_GOFF
#undef PG8_LDA
#undef PG8_LDA16
#undef PG8_LD32
#undef PG8_LDB16
#undef PG8_MMA16
#undef PG8_LDB
#undef PG8_MMA
#undef PG8_WAIT_V
#undef PG8_WAIT_L
#undef PG8_BAR
#undef PG8_SCHED
}
}
using pg8::Unit; using pg8::Gemm;
struct ChunkMap { int x, loc, nx, chunk;
    __device__ void init(int G, int bid) { if (G % 8 == 0) { nx = 8; chunk = G / 8; x = bid % 8; loc = bid / 8; } else { nx = 1; chunk = G; x = 0; loc = bid; } }
    __device__ __forceinline__ int lin(int i) const { return (i * nx + x) * chunk + loc; } };
struct PlainOrder {
    int nN, total; ChunkMap cm;
    __device__ bool next(int i, Unit& u) const { const int L = cm.lin(i); if (L >= total) return false; u.pm = L / nN; u.pn = L % nN; u.kb = 0; return true; }
    __device__ __forceinline__ void a_ready(const Unit&) const {}
    __device__ __forceinline__ void done(const Unit&) const {}
};
struct QkvOrder { ChunkMap cm;
    __device__ bool next(int i, Unit& u) const { const int L = cm.lin(i); if (L >= 288) return false;
        if (L >= 32 && L < 128) { const int r = L - 32; u.pm = r >> 1; u.pn = 4 + (r & 1); } else { const int r = L < 32 ? L : L - 96; u.pm = r >> 2; u.pn = r & 3; }
        u.kb = 0; return true; }
    __device__ __forceinline__ void a_ready(const Unit&) const {}
    __device__ __forceinline__ void done(const Unit&) const {}
};
struct SplitKOrder {
    int nN, ks, kbytes, total; ChunkMap cm;
    __device__ bool next(int i, Unit& u) const { const int L = cm.lin(i); if (L >= total) return false; const int t = L / ks; u.pm = t / nN; u.pn = t % nN; u.kb = (L % ks) * kbytes; return true; }
    __device__ __forceinline__ void a_ready(const Unit&) const {}
    __device__ __forceinline__ void done(const Unit&) const {}
};
struct GroupedOrder {
    int mt, nt, ks, kbytes; ChunkMap cm;
    __device__ bool next(int i, Unit& u) const { const int L = cm.lin(i), per = mt * nt * ks; if (L >= NE * per) return false; const int e = L / per, r = L % per, m = r / (nt * ks), q = r % (nt * ks);
        u.pm = e * mt + m; u.pn = e * nt + q / ks; u.kb = (q % ks) * kbytes; return true; }
    __device__ __forceinline__ void a_ready(const Unit&) const {}
    __device__ __forceinline__ void done(const Unit&) const {}
};
constexpr int DOWN_FULL_PANELS = 64;
struct DownOrder { int half; ChunkMap cm;
    __device__ bool next(int i, Unit& u) const { const int L = cm.lin(i); if (L >= 256) return false; const int T = half ? 256 + (L >> 1) : L; u.pm = T >> 2; u.pn = (u.pm / 6) * 4 + (T & 3); u.kb = half ? (L & 1) * 1024 : 0; return true; }
    __device__ __forceinline__ void a_ready(const Unit&) const {}
    __device__ __forceinline__ void done(const Unit&) const {}
};
struct EpiF32 { float* C; int ldc; size_t kstride; static constexpr bool PERM = false, AFTER_DRAIN = false;
    __device__ __forceinline__ void operator()(const f32x4 (&acc)[2][2][4][2], const Unit& u, int wr, int wc, int fr, int fq) const {
#pragma unroll
        for (int ai = 0; ai < 2; ++ai)
#pragma unroll
            for (int m = 0; m < 4; ++m) { float* rp = C + (u.kb ? kstride : (size_t)0) + (size_t)(u.pm * 256 + ai * 128 + wr * 64 + m * 16 + fr) * ldc + u.pn * 256 + wc * 32 + 4 * fq;
#pragma unroll
                for (int bj = 0; bj < 2; ++bj)
#pragma unroll
                    for (int n = 0; n < 2; ++n) *(f32x4*)(rp + bj * 128 + n * 16) = acc[ai][bj][m][n]; }
    }
};
struct EpiBf16P { bf16* C; int ldc; static constexpr bool PERM = true, AFTER_DRAIN = false;
    __device__ __forceinline__ void operator()(const f32x4 (&acc)[2][2][4][2], const Unit& u, int wr, int wc, int fr, int fq) const {
#pragma unroll
        for (int ai = 0; ai < 2; ++ai)
#pragma unroll
            for (int m = 0; m < 4; ++m) { bf16* rp = C + (size_t)(u.pm * 256 + ai * 128 + wr * 64 + m * 16 + fr) * ldc + u.pn * 256 + wc * 32 + 8 * fq;
#pragma unroll
                for (int bj = 0; bj < 2; ++bj) { const f32x4 v0 = acc[ai][bj][m][0], v1 = acc[ai][bj][m][1]; u32x4 w; w.x = cvtpk(v0[0], v0[1]); w.y = cvtpk(v0[2], v0[3]); w.z = cvtpk(v1[0], v1[1]); w.w = cvtpk(v1[2], v1[3]);
                    *(u32x4*)(rp + bj * 128) = w; } }
    }
};
__device__ __forceinline__ float silu_f(float x) { return x * __builtin_amdgcn_rcpf(1.f + __builtin_amdgcn_exp2f(-x * LOG2E)); }
struct EpiSwiglu { unsigned char* HID; static constexpr bool PERM = true, AFTER_DRAIN = false;
    __device__ __forceinline__ void operator()(const f32x4 (&acc)[2][2][4][2], const Unit& u, int wr, int wc, int fr, int fq) const {
        const int cb = (u.pn & 15) * 128 + wc * 32 + 8 * fq; constexpr float IS = 1.f / W8_SCALE;
#pragma unroll
        for (int ai = 0; ai < 2; ++ai)
#pragma unroll
            for (int m = 0; m < 4; ++m) { unsigned char* rp = HID + (size_t)(u.pm * 256 + ai * 128 + wr * 64 + m * 16 + fr) * FF + cb; u32x2 w;
#pragma unroll
                for (int n = 0; n < 2; ++n) { const f32x4 g = acc[ai][0][m][n] * IS, up = acc[ai][1][m][n] * (IS * H8_SCALE);
                    const unsigned pk = pk4_fp8(silu_f(g[0]) * up[0], silu_f(g[1]) * up[1], silu_f(g[2]) * up[2], silu_f(g[3]) * up[3]); if (n == 0) w.x = pk; else w.y = pk; }
                *(u32x2*)rp = w; asm volatile("" ::: "memory"); }
    }
};
struct EpiDown { unsigned char* YE; const float* gate; static constexpr bool PERM = true, AFTER_DRAIN = false;
    __device__ __forceinline__ void operator()(const f32x4 (&acc)[2][2][4][2], const Unit& u, int wr, int wc, int fr, int fq) const {
        const int cb = (u.pn & 3) * 256 + wc * 32 + 8 * fq;
#pragma unroll
        for (int ai = 0; ai < 2; ++ai)
#pragma unroll
            for (int m = 0; m < 4; ++m) { const int row = u.pm * 256 + ai * 128 + wr * 64 + m * 16 + fr; const float gv = gate[row] * (YE8_SCALE / (W8_SCALE * H8_SCALE)); unsigned char* rp = YE + (size_t)(u.kb ? NSLOTS : 0) * D + (size_t)row * D + cb;
#pragma unroll
                for (int bj = 0; bj < 2; ++bj) { const f32x4 v0 = acc[ai][bj][m][0] * gv, v1 = acc[ai][bj][m][1] * gv; u32x2 w;
                    w.x = pk4_fp8(clamp8(v0[0]), clamp8(v0[1]), clamp8(v0[2]), clamp8(v0[3])); w.y = pk4_fp8(clamp8(v1[0]), clamp8(v1[1]), clamp8(v1[2]), clamp8(v1[3])); *(u32x2*)(rp + bj * 128) = w; } }
    }
};

#if MK_CHECK
__device__ __forceinline__ float fp8f(const unsigned char* p, int i) { const int w = ((const int*)p)[i >> 2]; const int b = i & 3; return b == 0 ? __builtin_amdgcn_cvt_f32_fp8(w, 0) : b == 1 ? __builtin_amdgcn_cvt_f32_fp8(w, 1) : b == 2 ? __builtin_amdgcn_cvt_f32_fp8(w, 2) : __builtin_amdgcn_cvt_f32_fp8(w, 3); }
__device__ __forceinline__ float dot_fp8(const unsigned char* a, const unsigned char* b, int K, int lane) { float s = 0.f; for (int k = lane; k < K; k += 64) s += fp8f(a, k) * fp8f(b, k); return wave_sum(s); }
__device__ __forceinline__ float dot_bf16(const bf16* a, const bf16* b, int K, int lane) {
    float s = 0.f; for (int k = lane; k < K; k += 64) s += bf2f(a[k]) * bf2f(b[k]); return wave_sum(s);
}
#endif

__constant__ double INVF[16] = {1.0, 0.5623413251903491, 0.31622776601683794, 0.1778279410038923, 0.1, 0.05623413251903491, 0.03162277660168379, 0.01778279410038923,
                                0.01, 0.005623413251903491, 0.0031622776601683794, 0.0017782794100389228, 0.001, 0.0005623413251903491, 0.00031622776601683794, 0.00017782794100389227};
__device__ __forceinline__ void sincos_d(double a, float& s, float& c) {
    const double k = __builtin_rint(a * 0.6366197723675814), r = a - k * 1.5707963267948966, r2 = r * r;
    const double sr = r * (1.0 + r2 * (-1.0 / 6 + r2 * (1.0 / 120 + r2 * (-1.0 / 5040 + r2 * (1.0 / 362880 + r2 * (-1.0 / 39916800 + r2 * (1.0 / 6227020800.0)))))));
    const double cr = 1.0 + r2 * (-0.5 + r2 * (1.0 / 24 + r2 * (-1.0 / 720 + r2 * (1.0 / 40320 + r2 * (-1.0 / 3628800 + r2 * (1.0 / 479001600.0))))));
    const int q = ((int)k) & 3;
    const double ss = (q == 0) ? sr : (q == 1) ? cr : (q == 2) ? -sr : -cr;
    const double cc = (q == 0) ? cr : (q == 1) ? -sr : (q == 2) ? -cr : sr;
    s = (float)ss; c = (float)cc;
}
__device__ __forceinline__ void conv_load(f32x4 (&v)[16], const float* W, int N, int k0, int n0, int lane) {
    const int r4 = lane >> 4, c16 = lane & 15, n = n0 + 4 * c16;
    if (n >= N) return;
    const float* src = W + (size_t)(k0 + 16 * r4) * N + n;
#pragma unroll
    for (int i = 0; i < 16; ++i) v[i] = *(const f32x4*)(src + (size_t)i * N);
}
__device__ __forceinline__ void conv_store(const f32x4 (&v)[16], int N, bf16* WT, size_t rowbase, int ldk, int k0, int n0, int lane) {
    const int r4 = lane >> 4, c16 = lane & 15, n = n0 + 4 * c16;
    if (n >= N) return;
    bf16* dst = WT + (rowbase + 4 * c16) * (size_t)ldk + k0 + 16 * r4;
#pragma unroll
    for (int e = 0; e < 4; ++e) {
        u32x4 lo, hi;
        lo.x = cvtpk(v[0][e], v[1][e]); lo.y = cvtpk(v[2][e], v[3][e]); lo.z = cvtpk(v[4][e], v[5][e]); lo.w = cvtpk(v[6][e], v[7][e]);
        hi.x = cvtpk(v[8][e], v[9][e]); hi.y = cvtpk(v[10][e], v[11][e]); hi.z = cvtpk(v[12][e], v[13][e]); hi.w = cvtpk(v[14][e], v[15][e]);
        *(u32x4*)(dst + (size_t)e * ldk) = lo; *(u32x4*)(dst + (size_t)e * ldk + 8) = hi;
    }
}
__device__ __forceinline__ void conv_item(const float* W, int N, bf16* WT, size_t rowbase, int ldk, int k0, int n0, int lane) {
    f32x4 v[16]; conv_load(v, W, N, k0, n0, lane); conv_store(v, N, WT, rowbase, ldk, k0, n0, lane);
}
__device__ __forceinline__ void glds16(const void* gsrc, unsigned lds_dst) { unsigned keep;
    asm volatile("s_mov_b32 %0, m0\n\ts_mov_b32 m0, %2\n\ts_nop 0\n\tglobal_load_lds_dwordx4 %1, off\n\ts_mov_b32 m0, %0" : "=&s"(keep) : "v"(gsrc), "s"(lds_dst) : "memory"); }
__device__ __forceinline__ void glds16_nt(const void* gsrc, unsigned lds_dst) { unsigned keep;
    asm volatile("s_mov_b32 %0, m0\n\ts_mov_b32 m0, %2\n\ts_nop 0\n\tglobal_load_lds_dwordx4 %1, off nt\n\ts_mov_b32 m0, %0" : "=&s"(keep) : "v"(gsrc), "s"(lds_dst) : "memory"); }
__device__ __forceinline__ void conv_issue8(unsigned lds_scr, const float* W, int N, int k0, int n0, int lane) {
    const float* src = W + (size_t)(k0 + 8 * (lane >> 4)) * N + n0 + 4 * (lane & 15);
#pragma unroll
    for (int i = 0; i < 8; ++i) glds16_nt(src + (size_t)i * N, (unsigned)__builtin_amdgcn_readfirstlane(lds_scr + i * 1024));
}
__device__ __forceinline__ void conv_fetch8(f32x4 (&v)[8], const LAS unsigned char* scr, int lane) {
#pragma unroll
    for (int i = 0; i < 8; ++i) v[i] = *(const LAS f32x4*)(scr + i * 1024 + lane * 16);
}
__device__ __forceinline__ void conv_load8(f32x4 (&v)[8], const float* W, int N, int k0, int n0, int lane) {
    const float* src = W + (size_t)(k0 + 8 * (lane >> 4)) * N + n0 + 4 * (lane & 15);
#pragma unroll
    for (int i = 0; i < 8; ++i) v[i] = __builtin_nontemporal_load((const f32x4*)(src + (size_t)i * N));
}
__device__ __forceinline__ void conv_store8(const f32x4 (&v)[8], unsigned char* WT, size_t rowbase, int ldk, int k0, int lane) {
    unsigned char* dst = WT + (rowbase + 4 * (lane & 15)) * (size_t)ldk + k0 + 8 * (lane >> 4);
#pragma unroll
    for (int e = 0; e < 4; ++e) { u32x2 w; w.x = pk4_fp8(v[0][e] * W8_SCALE, v[1][e] * W8_SCALE, v[2][e] * W8_SCALE, v[3][e] * W8_SCALE); w.y = pk4_fp8(v[4][e] * W8_SCALE, v[5][e] * W8_SCALE, v[6][e] * W8_SCALE, v[7][e] * W8_SCALE);
        *(u32x2*)(dst + (size_t)e * ldk) = w; }
}
struct ConvJob { const float* gate; const float* up; const float* down; unsigned char* wgu; unsigned char* wd; };
constexpr int CV_PER_LAYER = 3 * 16 * 1024, CV_TOTAL = 4 * CV_PER_LAYER;
struct ConvItem { const float* W; unsigned char* WT; size_t rowbase; int N, ldk, k0, n0; };
__device__ __forceinline__ ConvItem cv_decode(const ConvJob& J, int it) {
    ConvItem c; const int L = it / CV_PER_LAYER, r0 = it % CV_PER_LAYER, fam = r0 >> 14, r = r0 & 16383, e = L * 16 + (r >> 10), q = r & 1023;
    if (fam < 2) { c.W = (fam ? J.up : J.gate) + (size_t)e * 1024 * 2048; c.N = 2048; c.k0 = (q >> 5) * 32; c.n0 = (q & 31) * 64; c.WT = J.wgu; c.ldk = 1024; c.rowbase = (size_t)e * 4096 + (c.n0 >> 7) * 256 + (c.n0 & 127) + (fam ? 128 : 0); }
    else { c.W = J.down + (size_t)e * 2048 * 1024; c.N = 1024; c.k0 = (q >> 4) * 32; c.n0 = (q & 15) * 64; c.WT = J.wd; c.ldk = 2048; c.rowbase = (size_t)e * 1024 + c.n0; }
    return c;
}
template <class RowBase>
__device__ __forceinline__ void conv_family(const Frame& F, const float* W, int K, int N, int nmat, bf16* WT, const RowBase& rb) {
    const int nblk = (N + 63) / 64, per = (K / 64) * nblk, total = per * nmat;
    for (int it = F.gw; it < total; it += F.NGW) {
        const int mi = it / per, r = it % per, kb = r / nblk, nb = r % nblk;
        conv_item(W + (size_t)mi * K * N, N, WT, rb(mi, nb * 64), K, kb * 64, nb * 64, F.lane);
    }
}

__device__ __forceinline__ void ada_direct(const Frame& F, const Args& a, int l, int b0) {
    const int cg = F.bid - b0; if (cg < 0 || cg >= 192) return;
    LAS float* sc = (LAS float*)F.lds;
    LAS float* red = (LAS float*)(F.lds + 20480);
    for (int i = F.tid; i < 5 * D; i += 512) { const int c = i >> 10, k = i & 1023; const float x = (c == 0) ? a.in[7][k] : a.in[6][(c - 1) * D + k]; sc[i] = x / (1.f + __expf(-x)); }
    __syncthreads();
    const int col = F.tid & 31, kg = F.tid >> 5, n = cg * 32 + col;
    const float* w = a.in[8] + ((size_t)l * D + kg * 64) * 6144 + n;
    float acc[5] = {0.f, 0.f, 0.f, 0.f, 0.f};
#pragma unroll 16
    for (int k = 0; k < 64; ++k) { const float wv = w[(size_t)k * 6144];
#pragma unroll
        for (int c = 0; c < 5; ++c) acc[c] += sc[c * D + kg * 64 + k] * wv; }
#pragma unroll
    for (int c = 0; c < 5; ++c) red[(kg * 5 + c) * 32 + col] = acc[c];
    __syncthreads();
    if (F.tid < 160) { const int c = F.tid >> 5; float s = a.in[9][l * 6144 + n];
#pragma unroll
        for (int g = 0; g < 16; ++g) s += red[(g * 5 + c) * 32 + col];
        ((float*)(F.ws + WS_ADA))[(size_t)(l * 5 + c) * 6144 + n] = s; }
    __syncthreads();
}
__device__ __forceinline__ void phase_prologue(const Frame& F, const Args& a) {
    ada_direct(F, a, 0, 0);
    {
        float* R64 = (float*)(F.ws + WS_ROPE64); float* R32 = (float*)(F.ws + WS_ROPE32);
        for (int i = F.bid * 512 + F.tid; i < 2048 * 32; i += F.G * 512) { const int pos = i >> 5, j = i & 31; const double ang = (j < 16) ? (double)(pos >> 6) * INVF[j] : (double)(pos & 63) * INVF[j - 16];
            float s, c; sincos_d(ang, s, c); R64[i] = c; R64[2048 * 32 + i] = s; }
        for (int i = F.bid * 512 + F.tid; i < 2048 * 16; i += F.G * 512) { const int pos = i >> 4, j = i & 15; const double ang = (j < 8) ? (double)(pos >> 6) * INVF[2 * j] : (double)(pos & 63) * INVF[2 * (j - 8)];
            float s, c; sincos_d(ang, s, c); R32[i] = c; R32[2048 * 16 + i] = s; }
    }
    __syncthreads();
    for (int rep = 0; rep < MK_REP_CONV; ++rep) {
    bf16* WQKV = (bf16*)(F.ws + WS_WQKV); bf16* WO = (bf16*)(F.ws + WS_WO);
    conv_family(F, a.in[12], 1024, 1536, 2, WQKV, [](int mi, int n0) { return (size_t)(mi == 0 ? 0 : 2) * 1536 + n0; });
    conv_family(F, a.in[16], 1024, 1536, 1, WQKV, [](int mi, int n0) { return (size_t)1536 + n0; });
    conv_family(F, a.in[15], 1024, 1024, 2, WO, [](int mi, int n0) { return (size_t)(mi == 0 ? 0 : 3) * 1024 + n0; });
    conv_family(F, a.in[18], 1024, 1024, 1, WO, [](int mi, int n0) { return (size_t)1024 + n0; });
    conv_family(F, a.in[24], 1024, 1024, 1, WO, [](int mi, int n0) { return (size_t)2048 + n0; });
    conv_family(F, a.in[19], 1024, 416, 1, (bf16*)(F.ws + WS_WDN), [](int mi, int n0) { return (size_t)n0; });
    conv_family(F, a.in[21], 256, 1536, 1, (bf16*)(F.ws + WS_WUQ), [](int mi, int n0) { return (size_t)n0; });
    conv_family(F, a.in[23], 128, 2048, 1, (bf16*)(F.ws + WS_WUKV), [](int mi, int n0) { return (size_t)n0; });
    }
    { u32x4* z = (u32x4*)((bf16*)(F.ws + WS_WDN) + 416 * 1024); for (int i = F.bid * 512 + F.tid; i < 96 * 1024 / 8; i += F.G * 512) z[i] = (u32x4){0u, 0u, 0u, 0u}; }
}
__device__ __forceinline__ void phase_ada_reduce(const Frame& F, const Args& a) {
    const float* ADAP = (const float*)(F.ws + WS_ADAP); float* ADA = (float*)(F.ws + WS_ADA);
    for (int i = F.bid * 512 + F.tid; i < 4 * 5 * 6144; i += F.G * 512) {
        const int l = i / 30720, r = i % 30720, c = r / 6144, n = r % 6144;
        float s = a.in[9][l * 6144 + n];
        for (int kc = 0; kc < 16; ++kc) s += ADAP[((size_t)(kc * 4 + l) * 5 + c) * 6144 + n];
        ADA[i] = s;
    }
}
__device__ __forceinline__ const float* ada_vec(const Frame& F, int l, int c, int k) { return (const float*)(F.ws + WS_ADA) + ((size_t)(l * 5 + c) * 6 + k) * D; }

__device__ __forceinline__ void phase_mod0(const Frame& F, const Args& a) {
    bf16* X = (bf16*)(F.ws + WS_X); bf16* H = (bf16*)(F.ws + WS_H);
    const int RPW = (NTOK + F.NGW - 1) / F.NGW, rbeg = F.gw * RPW, rend = (rbeg + RPW < NTOK) ? rbeg + RPW : NTOK; int ccur = -1;
    f32x4 shv[4], scv[4];
#pragma unroll
    for (int j = 0; j < 4; ++j) { shv[j] = (f32x4){0.f, 0.f, 0.f, 0.f}; scv[j] = shv[j]; }
    for (int row = rbeg; row < rend; ++row) {
        const int c = cond_of(row);
        if (c != ccur) { ccur = c; const f32x4* sh = (const f32x4*)ada_vec(F, 0, c, 0); const f32x4* sc = (const f32x4*)ada_vec(F, 0, c, 1);
#pragma unroll
            for (int j = 0; j < 4; ++j) { shv[j] = sh[F.lane + 64 * j]; scv[j] = sc[F.lane + 64 * j] + 1.f; } }
        const f32x4* xi = (const f32x4*)((row < NCTX) ? a.in[0] + (size_t)row * D : a.in[1] + (size_t)(row - NCTX) * D);
#pragma unroll
        for (int j = 0; j < 4; ++j) { const int q = F.lane + 64 * j; const f32x4 x = xi[q]; ((u32x2*)(X + (size_t)row * D))[q] = pk4(x); ((u32x2*)(H + (size_t)row * D))[q] = pk4(x * scv[j] + shv[j]); }
    }
}

__device__ __forceinline__ size_t kb_off(int HK, int DK, bool lat, int b, int hk) { return lat ? (size_t)16 * HK * 256 * DK + ((size_t)(b * HK + hk) * 2560) * DK : ((size_t)(b * HK + hk) * 256) * DK; }
__device__ __forceinline__ size_t vt_off(int HK, bool lat, int b, int hk) { return lat ? (size_t)16 * HK * 64 * 256 + ((size_t)(b * HK + hk) * 64) * 2560 : ((size_t)(b * HK + hk) * 64) * 256; }
__device__ __forceinline__ int swap23(int k) { return (k & ~12) | ((k & 4) << 1) | ((k & 8) >> 1); }
__device__ __forceinline__ void vt_store(bf16* dst, const float (&vr)[64]) {
#pragma unroll
    for (int q = 0; q < 8; ++q) { const int b = 16 * (q >> 1) + 4 * (q & 1); u32x4 w; w.x = cvtpk(vr[b], vr[b + 1]); w.y = cvtpk(vr[b + 2], vr[b + 3]); w.z = cvtpk(vr[b + 8], vr[b + 9]); w.w = cvtpk(vr[b + 10], vr[b + 11]); ((u32x4*)dst)[q] = w; }
}

__device__ __forceinline__ void phase_kv_post(const Frame& F, const Args& a, int kind, int j, int slot, int gw, int NGW) {
    const bf16* QKV = (const bf16*)(F.ws + WS_QKV); bf16* Kb = (bf16*)(F.ws + WS_KB); bf16* Vt = (bf16*)(F.ws + WS_VT);
    const float* R64 = (const float*)(F.ws + WS_ROPE64);
    int lane_ = F.lane; asm volatile("" : "+v"(lane_)); const int lane = lane_, l16 = lane & 15, hk = lane >> 4;
    for (int it = gw * 64 + lane; it < 16 * 8192; it += NGW * 64) {
        const int bh = it >> 13, q = it & 8191, b = bh >> 2, hc = bh & 3;
        const f32x4 v = *(const f32x4*)(a.in[2] + ((size_t)((b * 3 + slot) * 4 + hc) * 512) * 64 + 4 * q);
        u32x2 w; w.x = cvtpk(v[0], v[1]); w.y = cvtpk(v[2], v[3]);
        *(u32x2*)(Kb + kb_off(4, 64, true, b, hc) + (size_t)2048 * 64 + 4 * q) = w;
    }
    for (int it = gw; it < 4 * 4 * 8; it += NGW) {
        const int b = it >> 5, hv = (it >> 3) & 3, tl = it & 7;
        float vr[64];
#pragma unroll
        for (int i = 0; i < 64; ++i) vr[i] = a.in[3][((size_t)((b * 3 + slot) * 4 + hv) * 512 + tl * 64 + i) * 64 + lane];
        vt_store(Vt + vt_off(4, true, b, hv) + (size_t)lane * 2560 + 2048 + tl * 64, vr);
    }
    f32x4 kn = (f32x4){1.f, 1.f, 1.f, 1.f}; if (kind == 0) kn = *(const f32x4*)(a.in[14] + j * 64 + 4 * l16);
    {
        const int RPW = (NTOK + NGW - 1) / NGW, rbeg = gw * RPW, rend = (rbeg + RPW < NTOK) ? rbeg + RPW : NTOK;
        u32x2 wqn = (u32x2){0u, 0u}; f32x4 cn = (f32x4){0.f, 0.f, 0.f, 0.f}, snn = cn;
        if (rbeg < rend) { wqn = *(const u32x2*)(QKV + (size_t)rbeg * 1536 + 1024 + 4 * lane);
            if (rbeg >= NCTX) { const int s0 = (rbeg - NCTX) & 2047; cn = *(const f32x4*)(R64 + s0 * 32 + 4 * (lane & 7)); snn = *(const f32x4*)(R64 + 2048 * 32 + s0 * 32 + 4 * (lane & 7)); } }
        for (int t = rbeg; t < rend; ++t) {
            const bool lat = t >= NCTX; const int b = lat ? (t - NCTX) >> 11 : t >> 8, s = lat ? (t - NCTX) & 2047 : t & 255;
            const u32x2 wq = wqn; const f32x4 c = cn, sn = snn;
            if (t + 1 < rend) { wqn = *(const u32x2*)(QKV + (size_t)(t + 1) * 1536 + 1024 + 4 * lane);
                if (t + 1 >= NCTX) { const int s1 = (t + 1 - NCTX) & 2047; cn = *(const f32x4*)(R64 + s1 * 32 + 4 * (lane & 7)); snn = *(const f32x4*)(R64 + 2048 * 32 + s1 * 32 + 4 * (lane & 7)); } }
            f32x4 v = bf4(wq);
            if (kind == 0) { float ss = (v[0] * v[0] + v[1] * v[1]) + (v[2] * v[2] + v[3] * v[3]); ss = sum16(ss);
                v = v * (__builtin_amdgcn_rsqf(ss * (1.f / 64.f) + 1e-6f)) * kn; }
            if (lat) { f32x4 p; p[0] = dppf<DPP_X8>(v[0]); p[1] = dppf<DPP_X8>(v[1]); p[2] = dppf<DPP_X8>(v[2]); p[3] = dppf<DPP_X8>(v[3]);
                v = (lane & 8) ? v * c + p * sn : v * c - p * sn; }
            *(u32x2*)(Kb + kb_off(4, 64, lat, b, hk) + (size_t)s * 64 + 4 * l16) = pk4(v);
            if (!lat) *(f32x4*)(F.out + OFF_NK + ((size_t)((b * 3 + slot) * 4 + hk) * 256 + s) * 64 + 4 * l16) = v;
        }
    }
    for (int it = gw; it < (NTOK / 64) * 4; it += NGW) {
        const int tt = it >> 2, hv = it & 3, t0 = tt * 64; const bool lat = t0 >= NCTX; const int b = lat ? (t0 - NCTX) >> 11 : t0 >> 8, s0 = lat ? (t0 - NCTX) & 2047 : t0 & 255;
        float vr[64];
#pragma unroll
        for (int i = 0; i < 64; ++i) vr[i] = bf2f(QKV[(size_t)(t0 + i) * 1536 + 1280 + hv * 64 + lane]);
        vt_store(Vt + vt_off(4, lat, b, hv) + (size_t)lane * (lat ? 2560 : 256) + s0, vr);
        if (!lat) {
#pragma unroll
            for (int i = 0; i < 64; ++i) F.out[OFF_NV + ((size_t)((b * 3 + slot) * 4 + hv) * 256 + s0 + i) * 64 + lane] = vr[i]; }
    }
}

__device__ __forceinline__ void phase_mla_post1(const Frame& F, const Args& a) {
    const float* DWN = (const float*)(F.ws + WS_QKV); bf16* QA = (bf16*)(F.ws + WS_QA); bf16* CKVA = (bf16*)(F.ws + WS_CKVA); bf16* Kb = (bf16*)(F.ws + WS_KB);
    const float* R32 = (const float*)(F.ws + WS_ROPE32);
    int lane_ = F.lane; asm volatile("" : "+v"(lane_)); const int lane = lane_;
    const f32x4 qn = ((const f32x4*)a.in[20])[lane]; const f32x4 kvn = ((const f32x4*)a.in[22])[lane & 31];
    for (int t = F.gw; t < NTOK + 2048; t += F.NGW) {
        if (t < NTOK) {
            const bool lat = t >= NCTX; const int b = lat ? (t - NCTX) >> 11 : t >> 8, s = lat ? (t - NCTX) & 2047 : t & 255;
            const float* row = DWN + (size_t)t * 512;
            { const f32x4 v = ((const f32x4*)row)[lane] + ((const f32x4*)(row + DWN_PART))[lane]; const float ss = wave_sum(v[0] * v[0] + v[1] * v[1] + v[2] * v[2] + v[3] * v[3]); const float r = __builtin_amdgcn_rsqf(ss * (1.f / 256.f) + 1e-6f);
              const f32x4 o = v * r * qn; u32x2 w; w.x = cvtpk(o[0], o[1]); w.y = cvtpk(o[2], o[3]); ((u32x2*)(QA + (size_t)t * 256))[lane] = w; }
            { f32x4 v = (f32x4){0.f, 0.f, 0.f, 0.f}; if (lane < 32) v = ((const f32x4*)(row + 256))[lane] + ((const f32x4*)(row + DWN_PART + 256))[lane];
              const float ss = wave_sum(v[0] * v[0] + v[1] * v[1] + v[2] * v[2] + v[3] * v[3]); const float r = __builtin_amdgcn_rsqf(ss * (1.f / 128.f) + 1e-6f);
              const f32x4 o = v * r * kvn;
              if (lane < 32) { u32x2 w; w.x = cvtpk(o[0], o[1]); w.y = cvtpk(o[2], o[3]); ((u32x2*)(CKVA + (size_t)t * 128))[lane] = w; if (!lat) ((f32x4*)(F.out + OFF_CKV + (size_t)t * 128))[lane] = o; } }
            { float x = (lane < 32) ? row[384 + lane] + row[DWN_PART + 384 + lane] : 0.f;
              if (!lat && lane < 32) F.out[OFF_KPE + (size_t)t * 32 + lane] = x;
              if (lat) { const float p = __shfl_xor(x, 16); const int i = lane & 15; const float c = R32[s * 16 + i], sn = R32[2048 * 16 + s * 16 + i]; x = ((lane & 31) < 16) ? x * c - p * sn : x * c + p * sn; }
              const bf16 xb = f2bf(x);
              if (lane < 32) { for (int h = 0; h < 16; ++h) Kb[kb_off(16, 96, lat, b, h) + (size_t)s * 96 + 64 + lane] = xb; } }
        } else {
            const int r = t - NTOK, b = r >> 9, s = r & 511;
            if (lane < 32) { const f32x4 v = ((const f32x4*)(a.in[4] + (size_t)r * 128))[lane]; u32x2 w; w.x = cvtpk(v[0], v[1]); w.y = cvtpk(v[2], v[3]); ((u32x2*)(CKVA + (size_t)t * 128))[lane] = w;
                const bf16 xb = f2bf(a.in[5][(size_t)r * 32 + lane]);
                for (int h = 0; h < 16; ++h) Kb[kb_off(16, 96, true, b, h) + (size_t)(2048 + s) * 96 + 64 + lane] = xb; }
        }
    }
}
__device__ __forceinline__ void mla_row(int row, bool& lat, int& b, int& s) {
    if (row < NCTX) { lat = false; b = row >> 8; s = row & 255; } else if (row < NTOK) { lat = true; b = (row - NCTX) >> 11; s = (row - NCTX) & 2047; } else { lat = true; b = (row - NTOK) >> 9; s = 2048 + ((row - NTOK) & 511); }
}
struct EpiUkv { bf16* Kb; float* VRAW; static constexpr bool PERM = false, AFTER_DRAIN = false;
    __device__ __forceinline__ void operator()(const f32x4 (&acc)[2][2][4][2], const Unit& u, int wr, int wc, int fr, int fq) const {
#pragma unroll
        for (int ai = 0; ai < 2; ++ai)
#pragma unroll
            for (int m = 0; m < 4; ++m) { const int row = u.pm * 256 + ai * 128 + wr * 64 + m * 16 + fr; bool lat; int b, s; mla_row(row, lat, b, s);
#pragma unroll
                for (int bj = 0; bj < 2; ++bj) { const int h = 2 * u.pn + bj;
                    if (wc < 2) { bf16* kp = Kb + kb_off(16, 96, lat, b, h) + (size_t)s * 96 + wc * 32 + 4 * fq;
#pragma unroll
                        for (int n = 0; n < 2; ++n) { const f32x4 v = acc[ai][bj][m][n]; u32x2 w; w.x = cvtpk(v[0], v[1]); w.y = cvtpk(v[2], v[3]); *(u32x2*)(kp + n * 16) = w; } }
                    else { float* vp = VRAW + (size_t)row * 1024 + h * 64 + (wc - 2) * 32 + 4 * fq;
#pragma unroll
                        for (int n = 0; n < 2; ++n) *(f32x4*)(vp + n * 16) = acc[ai][bj][m][n]; } } }
    }
};
__device__ __forceinline__ void phase_mla_post2(const Frame& F, const Args& a) {
    const float* VRAW = (const float*)(F.ws + WS_KVRAW); bf16* Vt = (bf16*)(F.ws + WS_VT);
    int lane_ = F.lane; asm volatile("" : "+v"(lane_)); const int lane = lane_;
    for (int it = F.gw; it < 224 * 16; it += F.NGW) {
        const int tile = it >> 4, h = it & 15, row0 = tile * 64; bool lat; int b, s0; mla_row(row0, lat, b, s0);
        float vr[64];
#pragma unroll
        for (int i = 0; i < 64; ++i) vr[i] = VRAW[(size_t)(row0 + i) * 1024 + h * 64 + lane];
        vt_store(Vt + vt_off(16, lat, b, h) + (size_t)lane * (lat ? 2560 : 256) + s0, vr);
    }
}

__device__ __forceinline__ int crow(int r, int hi) { return (r & 3) + 8 * (r >> 2) + 4 * hi; }
__device__ __forceinline__ float max3f(float a, float b, float c) { float r; asm("v_max3_f32 %0, %1, %2, %3" : "=v"(r) : "v"(a), "v"(b), "v"(c)); return r; }
constexpr float THRL = 5.f;
template <int DK, int KIND>
__device__ __forceinline__ void attn_phase(const Frame& F, const Args& a, int j, const ConvJob& J, int& cv_it, int cv_need, int cv_cap) {
    constexpr int HK = (DK == 96) ? 16 : 4, CH = (DK == 96) ? 64 : 128, KPB = (DK + 8) * 2, VPB = (CH + 8) * 2, NDS = DK / 16, KCH = DK / 8;
    constexpr int NKC = CH * KCH, NKI = (NKC + 511) / 512, NVI = 64 * (CH / 8) / 512, NSUB = CH / 64;
    constexpr float QS = (DK == 96) ? MLA_QS : GQA_QS;
    const bf16* QRAW = (const bf16*)(F.ws + WS_QKV); const bf16* Kb = (const bf16*)(F.ws + WS_KB); const bf16* Vt = (const bf16*)(F.ws + WS_VT); bf16* O = (bf16*)(F.ws + WS_O);
    LAS unsigned char* Ks = F.lds; LAS unsigned char* Vs = F.lds + 2 * CH * KPB;
    LAS unsigned char* cvs = F.lds + 2 * CH * KPB + 2 * 64 * VPB + F.wave * 8192;
    const unsigned cvs_addr = (unsigned)(uintptr_t)cvs;
    int tid_ = F.tid; asm volatile("" : "+v"(tid_));
    const int tid = tid_, lane = tid & 63, wid = F.wave, r32 = lane & 31, hi = lane >> 5;
    constexpr bool CVP = true;
    int itc = 0;
    for (int un = F.bid; un < 768; un += F.G) {
        bool lat; int b, hq, q0, S, tok0;
        if (un < 512) { lat = true; b = un >> 7; hq = (un >> 3) & 15; q0 = (un & 7) * 256; S = 2560; tok0 = NCTX + b * 2048 + q0; }
        else { const int v = un - 512; lat = false; b = v >> 4; hq = v & 15; q0 = 0; S = 256; tok0 = b * 256; }
        const int hk = (HK == 4) ? (hq >> 2) : hq;
        const bf16* Kg = Kb + kb_off(HK, DK, lat, b, hk); const bf16* Vg = Vt + vt_off(HK, lat, b, hk);
        const int n2 = lat ? 512 / CH : 0; int lo = 0, hiK = lat ? 2048 : 256;
        const bool masked = (KIND == 1) && lat;
        if (masked) { lo = q0 - 128; lo = lo < 0 ? 0 : (lo > 1536 ? 1536 : lo); hiK = lo + 512; }
        const int nch = n2 + (hiK - lo) / CH;
        bf16x8 qf[NDS];
        {
            const bf16* qrow = QRAW + (size_t)(tok0 + wid * 32 + r32) * 1536 + hq * DK + 8 * hi;
            f32x4 v[NDS][2];
#pragma unroll
            for (int ds = 0; ds < NDS; ++ds) { const u32x4 wq = *(const u32x4*)(qrow + 16 * ds);
                v[ds][0] = (f32x4){__uint_as_float(wq.x << 16), __uint_as_float(wq.x & 0xffff0000u), __uint_as_float(wq.y << 16), __uint_as_float(wq.y & 0xffff0000u)};
                v[ds][1] = (f32x4){__uint_as_float(wq.z << 16), __uint_as_float(wq.z & 0xffff0000u), __uint_as_float(wq.w << 16), __uint_as_float(wq.w & 0xffff0000u)}; }
            if (KIND == 0) {
                float ss = 0.f;
#pragma unroll
                for (int ds = 0; ds < NDS; ++ds)
#pragma unroll
                    for (int h2 = 0; h2 < 2; ++h2) ss += (v[ds][h2][0] * v[ds][h2][0] + v[ds][h2][1] * v[ds][h2][1]) + (v[ds][h2][2] * v[ds][h2][2] + v[ds][h2][3] * v[ds][h2][3]);
                ss += __shfl_xor(ss, 32);
                const float r = __builtin_amdgcn_rsqf(ss * (1.f / 64.f) + 1e-6f);
                const float* qn = a.in[13] + j * 64 + 8 * hi;
#pragma unroll
                for (int ds = 0; ds < NDS; ++ds) { v[ds][0] = v[ds][0] * r * *(const f32x4*)(qn + 16 * ds); v[ds][1] = v[ds][1] * r * *(const f32x4*)(qn + 16 * ds + 4); }
            }
            if (lat) {
                const int s = q0 + wid * 32 + r32;
                if (DK == 64) {
                    const float* R64 = (const float*)(F.ws + WS_ROPE64);
#pragma unroll
                    for (int ds = 0; ds < 2; ++ds)
#pragma unroll
                        for (int h2 = 0; h2 < 2; ++h2) { const int idx = s * 32 + 16 * ds + 8 * hi + 4 * h2; const f32x4 c = *(const f32x4*)(R64 + idx), sn = *(const f32x4*)(R64 + 2048 * 32 + idx);
                            const f32x4 xa = v[ds][h2], xb = v[ds + 2][h2]; v[ds][h2] = xa * c - xb * sn; v[ds + 2][h2] = xb * c + xa * sn; }
                } else {
                    const float* R32 = (const float*)(F.ws + WS_ROPE32);
#pragma unroll
                    for (int h2 = 0; h2 < 2; ++h2) { const int idx = s * 16 + 8 * hi + 4 * h2; const f32x4 c = *(const f32x4*)(R32 + idx), sn = *(const f32x4*)(R32 + 2048 * 16 + idx);
                        const f32x4 xa = v[NDS - 2][h2], xb = v[NDS - 1][h2]; v[NDS - 2][h2] = xa * c - xb * sn; v[NDS - 1][h2] = xb * c + xa * sn; }
                }
            }
#pragma unroll
            for (int ds = 0; ds < NDS; ++ds) { u32x4 w; w.x = cvtpk(v[ds][0][0] * QS, v[ds][0][1] * QS); w.y = cvtpk(v[ds][0][2] * QS, v[ds][0][3] * QS); w.z = cvtpk(v[ds][1][0] * QS, v[ds][1][1] * QS); w.w = cvtpk(v[ds][1][2] * QS, v[ds][1][3] * QS);
                qf[ds] = __builtin_bit_cast(bf16x8, w); }
        }
        const int qw0 = q0 + wid * 32, qpos = qw0 + r32;
        float mhat = 0.f, l_run = 0.f; bool first = true; f32x16 o0, o1, negm;
#pragma unroll
        for (int r = 0; r < 16; ++r) { o0[r] = 0.f; o1[r] = 0.f; negm[r] = 0.f; }
        u32x4 kreg[NKI], vreg[NVI];
#define ATT_KEY0(c) ((c) < n2 ? 2048 + CH * (c) : lo + CH * ((c) - n2))
#define ATT_LOAD(c) do { const int k0_ = ATT_KEY0(c); \
            _Pragma("unroll") for (int i_ = 0; i_ < NKI; ++i_) { const int cc_ = tid + 512 * i_; if (NKC % 512 == 0 || cc_ < NKC) kreg[i_] = *(const u32x4*)(Kg + (size_t)(k0_ + cc_ / KCH) * DK + (cc_ % KCH) * 8); } \
            _Pragma("unroll") for (int i_ = 0; i_ < NVI; ++i_) { const int cc_ = tid + 512 * i_; vreg[i_] = *(const u32x4*)(Vg + (size_t)(cc_ / (CH / 8)) * S + k0_ + (cc_ % (CH / 8)) * 8); } } while (0)
#define ATT_STORE(buf) do { \
            _Pragma("unroll") for (int i_ = 0; i_ < NKI; ++i_) { const int cc_ = tid + 512 * i_; if (NKC % 512 == 0 || cc_ < NKC) *(LAS u32x4*)(Ks + (buf) * CH * KPB + (cc_ / KCH) * KPB + (cc_ % KCH) * 16) = kreg[i_]; } \
            _Pragma("unroll") for (int i_ = 0; i_ < NVI; ++i_) { const int cc_ = tid + 512 * i_; *(LAS u32x4*)(Vs + (buf) * 64 * VPB + (cc_ / (CH / 8)) * VPB + (cc_ % (CH / 8)) * 16) = vreg[i_]; } } while (0)
        ATT_LOAD(0);
        __syncthreads();
        ATT_STORE(0);
        __syncthreads();
        for (int c = 0; c < nch; ++c) {
            const int cur = c & 1;
            if (c + 1 < nch) ATT_LOAD(c + 1);
            const bool cv = CVP && ((CH == 128) || ((itc++ & 1) == 0)) && cv_it < cv_cap;
            if (cv) { const ConvItem ci = cv_decode(J, cv_it); conv_issue8(cvs_addr, ci.W, ci.N, ci.k0, ci.n0, lane); }
            const int key0c = ATT_KEY0(c);
            for (int sub = 0; sub < NSUB; ++sub) {
                const int key0 = key0c + 64 * sub;
                if (masked && c >= n2 && (key0 > qw0 + 159 || key0 + 63 < qw0 - 128)) continue;
                f32x16 p0, p1;
                const LAS unsigned char* kb_ = Ks + cur * CH * KPB + (sub * 64 + r32) * KPB + hi * 16;
                const LAS unsigned char* vb_ = Vs + cur * 64 * VPB + r32 * VPB + sub * 128 + hi * 16;
                bf16x8 kf[2 * NDS], vf[8];
#pragma unroll
                for (int ds = 0; ds < NDS; ++ds) { kf[2 * ds] = *(const LAS bf16x8*)(kb_ + ds * 32); kf[2 * ds + 1] = *(const LAS bf16x8*)(kb_ + 32 * KPB + ds * 32); }
#pragma unroll
                for (int s = 0; s < 4; ++s) { vf[2 * s] = *(const LAS bf16x8*)(vb_ + s * 32); vf[2 * s + 1] = *(const LAS bf16x8*)(vb_ + 32 * VPB + s * 32); }
                __builtin_amdgcn_sched_barrier(0);
#pragma unroll
                for (int ds = 0; ds < NDS; ++ds) {
                    if (ds == 0) { p0 = __builtin_amdgcn_mfma_f32_32x32x16_bf16(kf[0], qf[0], negm, 0, 0, 0); p1 = __builtin_amdgcn_mfma_f32_32x32x16_bf16(kf[1], qf[0], negm, 0, 0, 0); }
                    else { p0 = __builtin_amdgcn_mfma_f32_32x32x16_bf16(kf[2 * ds], qf[ds], p0, 0, 0, 0); p1 = __builtin_amdgcn_mfma_f32_32x32x16_bf16(kf[2 * ds + 1], qf[ds], p1, 0, 0, 0); }
                }
                if (masked && c >= n2) {
                    const int kbase = key0 - qpos;
#pragma unroll
                    for (int r = 0; r < 16; ++r) { const int d0 = kbase + crow(r, hi), d1 = d0 + 32;
                        if (d0 > 128 || d0 < -128) p0[r] = -INFINITY;
                        if (d1 > 128 || d1 < -128) p1[r] = -INFINITY; }
                }
                float rm;
                { float ma = max3f(p0[0], p0[1], p1[0]), mb = max3f(p0[2], p0[3], p1[1]); ma = max3f(ma, p1[2], p1[3]);
#pragma unroll
                  for (int r = 4; r < 16; r += 4) { ma = max3f(ma, p0[r], p0[r + 1]); mb = max3f(mb, p0[r + 2], p0[r + 3]); ma = max3f(ma, p1[r], p1[r + 1]); mb = max3f(mb, p1[r + 2], p1[r + 3]); }
                  const float m2 = max3f(ma, mb, mb);
                  auto rr = __builtin_amdgcn_permlane32_swap(__float_as_uint(m2), __float_as_uint(m2), false, false);
                  rm = max3f(__uint_as_float(rr[0]), __uint_as_float(rr[1]), m2); }
                if (first || __any(rm > THRL)) {
                    const float dl = first ? rm : fmaxf(rm, 0.f);
                    mhat += dl;
#pragma unroll
                    for (int r = 0; r < 16; ++r) { p0[r] -= dl; p1[r] -= dl; }
                    if (!first) { const float sc = __builtin_amdgcn_exp2f(-dl); l_run *= sc;
#pragma unroll
                        for (int r = 0; r < 16; ++r) { o0[r] *= sc; o1[r] *= sc; } }
#pragma unroll
                    for (int r = 0; r < 16; ++r) negm[r] = -mhat;
                    first = false;
                }
                float ls0 = 0.f, ls1 = 0.f;
#pragma unroll
                for (int r = 0; r < 16; ++r) { p0[r] = __builtin_amdgcn_exp2f(p0[r]); p1[r] = __builtin_amdgcn_exp2f(p1[r]); ls0 += p0[r]; ls1 += p1[r]; }
                l_run += ls0 + ls1;
                bf16x8 pb[4];
#pragma unroll
                for (int s = 0; s < 4; ++s) { u32x4 w;
                    if (s < 2) { w.x = cvtpk(p0[8 * s], p0[8 * s + 1]); w.y = cvtpk(p0[8 * s + 2], p0[8 * s + 3]); w.z = cvtpk(p0[8 * s + 4], p0[8 * s + 5]); w.w = cvtpk(p0[8 * s + 6], p0[8 * s + 7]); }
                    else { const int q = s - 2; w.x = cvtpk(p1[8 * q], p1[8 * q + 1]); w.y = cvtpk(p1[8 * q + 2], p1[8 * q + 3]); w.z = cvtpk(p1[8 * q + 4], p1[8 * q + 5]); w.w = cvtpk(p1[8 * q + 6], p1[8 * q + 7]); }
                    pb[s] = __builtin_bit_cast(bf16x8, w); }
#pragma unroll
                for (int s = 0; s < 4; ++s) {
                    o0 = __builtin_amdgcn_mfma_f32_32x32x16_bf16(vf[2 * s], pb[s], o0, 0, 0, 0);
                    o1 = __builtin_amdgcn_mfma_f32_32x32x16_bf16(vf[2 * s + 1], pb[s], o1, 0, 0, 0);
                }
            }
            if (c + 1 < nch) ATT_STORE(cur ^ 1);
            if (cv) { asm volatile("s_waitcnt vmcnt(0)" ::: "memory"); f32x4 cvv[8]; conv_fetch8(cvv, cvs, lane); const ConvItem ci = cv_decode(J, cv_it); conv_store8(cvv, ci.WT, ci.rowbase, ci.ldk, ci.k0, lane); cv_it += F.NGW; }
            __syncthreads();
        }
#undef ATT_KEY0
#undef ATT_LOAD
#undef ATT_STORE
        float l = l_run + __shfl_xor(l_run, 32);
        if (KIND == 1) l += __builtin_amdgcn_exp2f(a.in[17][hq] * LOG2E - mhat);
        const float inv = 1.f / l;
        bf16* op = O + (size_t)(tok0 + wid * 32 + r32) * 1024 + hq * 64 + 4 * hi;
#pragma unroll
        for (int g = 0; g < 4; ++g) {
            u32x2 w0, w1; w0.x = cvtpk(o0[4 * g] * inv, o0[4 * g + 1] * inv); w0.y = cvtpk(o0[4 * g + 2] * inv, o0[4 * g + 3] * inv);
            w1.x = cvtpk(o1[4 * g] * inv, o1[4 * g + 1] * inv); w1.y = cvtpk(o1[4 * g + 2] * inv, o1[4 * g + 3] * inv);
            *(u32x2*)(op + 8 * g) = w0; *(u32x2*)(op + 32 + 8 * g) = w1;
        }
    }
    for (; cv_it < cv_need; cv_it += 2 * F.NGW) {
        f32x4 v0[8], v1[8]; const ConvItem c0 = cv_decode(J, cv_it); conv_load8(v0, c0.W, c0.N, c0.k0, c0.n0, lane);
        const bool two = cv_it + F.NGW < CV_TOTAL; ConvItem c1 = c0; if (two) { c1 = cv_decode(J, cv_it + F.NGW); conv_load8(v1, c1.W, c1.N, c1.k0, c1.n0, lane); }
        conv_store8(v0, c0.WT, c0.rowbase, c0.ldk, c0.k0, lane); if (two) conv_store8(v1, c1.WT, c1.rowbase, c1.ldk, c1.k0, lane); }
}
#if MK_CHECK
template <int DK, int KIND>
__device__ __forceinline__ void check_attn(const Frame& F, const Args& a, int j, int id) {
    constexpr int HK = (DK == 96) ? 16 : 4; constexpr float QS = (DK == 96) ? MLA_QS : GQA_QS;
    const bf16* QRAW = (const bf16*)(F.ws + WS_QKV); const bf16* Kb = (const bf16*)(F.ws + WS_KB); const bf16* Vt = (const bf16*)(F.ws + WS_VT); const bf16* O = (const bf16*)(F.ws + WS_O);
    LAS float* scs = (LAS float*)(F.lds + F.wave * 12288); LAS float* qs = scs + 2560;
    const int lane = F.lane;
    const unsigned hsh = hash_u(F.gw * 2654435761u + id);
    const int t = (F.gw & 1) ? (hsh % NCTX) : NCTX + (hsh % NLAT), hq = (hsh >> 16) & 15;
    const bool lat = t >= NCTX; const int b = lat ? (t - NCTX) >> 11 : t >> 8, s = lat ? (t - NCTX) & 2047 : t & 255, S = lat ? 2560 : 256;
    const int hk = (HK == 4) ? (hq >> 2) : hq;
    const bf16* Kg = Kb + kb_off(HK, DK, lat, b, hk); const bf16* Vg = Vt + vt_off(HK, lat, b, hk); const bf16* q = QRAW + (size_t)t * 1536 + hq * DK;
    {
        float x = bf2f(q[lane]);
        if (KIND == 0) { const float ss = wave_sum(x * x); x = x * __builtin_amdgcn_rsqf(ss * (1.f / 64.f) + 1e-6f) * a.in[13][j * 64 + lane]; }
        if (DK == 64 && lat) { const float* R64 = (const float*)(F.ws + WS_ROPE64); const float p = __shfl_xor(x, 32); const int i = lane & 31; const float c = R64[s * 32 + i], sn = R64[2048 * 32 + s * 32 + i]; x = (lane < 32) ? x * c - p * sn : x * c + p * sn; }
        qs[lane] = bf2f(f2bf(x * QS));
        if (DK == 96) { float y = (lane < 32) ? bf2f(q[64 + lane]) : 0.f;
            if (lat) { const float* R32 = (const float*)(F.ws + WS_ROPE32); const float p = __shfl_xor(y, 16); const int i = lane & 15; const float c = R32[s * 16 + i], sn = R32[2048 * 16 + s * 16 + i]; y = ((lane & 31) < 16) ? y * c - p * sn : y * c + p * sn; }
            if (lane < 32) qs[64 + lane] = bf2f(f2bf(y * QS)); }
        asm volatile("s_waitcnt lgkmcnt(0)" ::: "memory");
    }
    float mx = -1e30f;
    for (int jk = lane; jk < S; jk += 64) {
        float sc = 0.f; for (int d = 0; d < DK; ++d) sc += qs[d] * bf2f(Kg[(size_t)jk * DK + d]);
        if (KIND == 1 && lat && jk < 2048 && (jk - s > 128 || jk - s < -128)) sc = -INFINITY;
        scs[jk] = sc; mx = fmaxf(mx, sc);
    }
    mx = wave_max(mx);
    asm volatile("s_waitcnt lgkmcnt(0)" ::: "memory");
    float l = 0.f, o = 0.f;
    for (int jk = 0; jk < S; ++jk) { const float p = __builtin_amdgcn_exp2f(scs[jk] - mx); l += p; o += bf2f(f2bf(p)) * bf2f(Vg[(size_t)lane * S + swap23(jk)]); }
    if (KIND == 1) l += __builtin_amdgcn_exp2f(a.in[17][hq] * LOG2E - mx);
    o /= l;
    const float got = bf2f(O[(size_t)t * 1024 + hq * 64 + lane]);
    if (!close_enough(got, o, 0.03f, 0.01f)) CHK_FAIL(F, id);
    asm volatile("s_waitcnt lgkmcnt(0)" ::: "memory");
}
template <class Fn>
__device__ __forceinline__ void check_gemm_f32(const Frame& F, const bf16* A, const bf16* Bt, int M, int N, int K, const float* C, int ldc, int id) {
    for (int sidx = 0; sidx < 2; ++sidx) {
        const unsigned h = hash_u((F.gw * 2 + sidx) * 2654435761u + id * 97u);
        const int row = h % M, col = (h >> 12) % N;
        const float ref = dot_bf16(A + (size_t)row * K, Bt + (size_t)col * K, K, F.lane);
        if (!close_enough(C[(size_t)row * ldc + col], ref, 0.01f, 0.01f)) CHK_FAIL(F, id);
    }
}
template <class Fn>
__device__ __forceinline__ void check_gemm_bf16(const Frame& F, const bf16* A, const bf16* Bt, int M, int N, int K, const bf16* C, int ldc, int id) {
    for (int sidx = 0; sidx < 2; ++sidx) {
        const unsigned h = hash_u((F.gw * 2 + sidx) * 2654435761u + id * 97u);
        const int row = h % M, col = (h >> 12) % N;
        const float ref = dot_bf16(A + (size_t)row * K, Bt + (size_t)col * K, K, F.lane);
        if (!close_enough(bf2f(C[(size_t)row * ldc + col]), ref, 0.02f, 0.02f)) CHK_FAIL(F, id);
    }
}
#endif

__device__ __forceinline__ void phase_ln1_router(const Frame& F, const Args& a, int l) {
    const bf16* X = (const bf16*)(F.ws + WS_X); bf16* X1 = (bf16*)(F.ws + WS_X1); const bf16* AO = (const bf16*)(F.ws + WS_AO); unsigned char* H8 = F.ws + WS_XE; float* AFF = (float*)(F.ws + WS_AFF);
    constexpr int RP = 1032, RB = 6;
    LAS bf16* Wb = (LAS bf16*)F.lds;
    LAS bf16* Hs = (LAS bf16*)(F.lds + 16 * RP * 2) + F.wave * (RB * RP);
    const float* wr = a.in[25] + (size_t)l * D * NE;
    for (int i = F.tid; i < D * NE; i += 512) Wb[(i & 15) * RP + (i >> 4)] = f2bf(wr[i]);
    __syncthreads();
    int lane_ = F.lane; asm volatile("" : "+v"(lane_)); const int lane = lane_;
    const f32x4* lg = (const f32x4*)(a.in[10] + (size_t)(l * 2 + 0) * D); const f32x4* lb = (const f32x4*)(a.in[11] + (size_t)(l * 2 + 0) * D);
    const int RPW = (NTOK + F.NGW - 1) / F.NGW, rbeg = F.gw * RPW, rend = (rbeg + RPW < NTOK) ? rbeg + RPW : NTOK;
    f32x4 lgv[4], lbv[4], g1v[4], sh2v[4], sc2v[4]; int ccur = -1;
#pragma unroll
    for (int j = 0; j < 4; ++j) { lgv[j] = lg[lane + 64 * j]; lbv[j] = lb[lane + 64 * j]; g1v[j] = lgv[j]; sh2v[j] = lgv[j]; sc2v[j] = lgv[j]; }
    u32x2 xc[4], ac[4], xd[4], ad[4];
    { const int r0 = rbeg < rend ? rbeg : NTOK - 1, r1 = rbeg + 1 < rend ? rbeg + 1 : r0;
#pragma unroll
      for (int j = 0; j < 4; ++j) { xc[j] = ((const u32x2*)(X + (size_t)r0 * D))[lane + 64 * j]; ac[j] = ((const u32x2*)(AO + (size_t)r0 * D))[lane + 64 * j];
          xd[j] = ((const u32x2*)(X + (size_t)r1 * D))[lane + 64 * j]; ad[j] = ((const u32x2*)(AO + (size_t)r1 * D))[lane + 64 * j]; } }
    for (int row = rbeg; row < rend; ++row) {
        const int c = cond_of(row);
        if (c != ccur) { ccur = c; const f32x4* g1 = (const f32x4*)ada_vec(F, l, c, 2); const f32x4* sh2 = (const f32x4*)ada_vec(F, l, c, 3); const f32x4* sc2 = (const f32x4*)ada_vec(F, l, c, 4);
#pragma unroll
            for (int j = 0; j < 4; ++j) { g1v[j] = g1[lane + 64 * j]; sh2v[j] = sh2[lane + 64 * j]; sc2v[j] = sc2[lane + 64 * j] + 1.f; } }
        f32x4 y[4]; float s = 0.f, s2 = 0.f;
#pragma unroll
        for (int j = 0; j < 4; ++j) { const f32x4 av = (f32x4){__uint_as_float(ac[j].x << 16), __uint_as_float(ac[j].x & 0xffff0000u), __uint_as_float(ac[j].y << 16), __uint_as_float(ac[j].y & 0xffff0000u)}; y[j] = bf4(xc[j]) * ALPHA + g1v[j] * av; s += (y[j][0] + y[j][1]) + (y[j][2] + y[j][3]); s2 += (y[j][0] * y[j][0] + y[j][1] * y[j][1]) + (y[j][2] * y[j][2] + y[j][3] * y[j][3]); }
        { const int nr = row + 2 < rend ? row + 2 : row;
#pragma unroll
          for (int j = 0; j < 4; ++j) { xc[j] = xd[j]; ac[j] = ad[j]; xd[j] = ((const u32x2*)(X + (size_t)nr * D))[lane + 64 * j]; ad[j] = ((const u32x2*)(AO + (size_t)nr * D))[lane + 64 * j]; } }
        s = wave_sum(s); s2 = wave_sum(s2);
        const float mean = s * (1.f / D), var = fmaxf(s2 * (1.f / D) - mean * mean, 0.f);
        const float rstd = 1.f / sqrtf(var + 1e-5f);
        f32x4 h[4];
#pragma unroll
        for (int j = 0; j < 4; ++j) { const int q = lane + 64 * j; const f32x4 xn = (y[j] - mean) * rstd * lgv[j] + lbv[j]; ((u32x2*)(X1 + (size_t)row * D))[q] = pk4(xn);
            h[j] = xn * sc2v[j] + sh2v[j]; ((unsigned*)(H8 + (size_t)row * D))[q] = pk4_fp8(h[j][0], h[j][1], h[j][2], h[j][3]); }
        const int br = (row - rbeg) % RB;
#pragma unroll
        for (int j = 0; j < 4; ++j) { u32x2 w; w.x = cvtpk(h[j][0], h[j][1]); w.y = cvtpk(h[j][2], h[j][3]); *(LAS u32x2*)(Hs + br * RP + 4 * (lane + 64 * j)) = w; }
        if (br == RB - 1 || row == rend - 1) {
            const int nrows = br + 1, row0 = row - br, n = lane & 15, kq = lane >> 4, nn = n < nrows ? n : 0;
            const LAS bf16* wp = Wb + n * RP + 8 * kq; const LAS bf16* hp = Hs + nn * RP + 8 * kq;
            f32x4 l0 = (f32x4){0.f, 0.f, 0.f, 0.f}, l1 = l0;
#pragma unroll 4
            for (int st = 0; st < 32; st += 2) {
                l0 = __builtin_amdgcn_mfma_f32_16x16x32_bf16(*(const LAS bf16x8*)(wp + 32 * st), *(const LAS bf16x8*)(hp + 32 * st), l0, 0, 0, 0);
                l1 = __builtin_amdgcn_mfma_f32_16x16x32_bf16(*(const LAS bf16x8*)(wp + 32 * st + 32), *(const LAS bf16x8*)(hp + 32 * st + 32), l1, 0, 0, 0); }
            const f32x4 lg4 = l0 + l1;
            float mx = fmaxf(fmaxf(lg4[0], lg4[1]), fmaxf(lg4[2], lg4[3])); mx = xmax16(mx); mx = xmax32(mx);
            f32x4 ex; ex[0] = __expf(lg4[0] - mx); ex[1] = __expf(lg4[1] - mx); ex[2] = __expf(lg4[2] - mx); ex[3] = __expf(lg4[3] - mx);
            float den = (ex[0] + ex[1]) + (ex[2] + ex[3]); den = xsum16(den, den); den = xsum32(den, den);
            const float inv = 1.f / den;
            if (n < nrows) {
#pragma unroll
                for (int i = 0; i < 4; ++i) AFF[(size_t)(4 * kq + i) * NTOK + row0 + n] = ex[i] * inv; }
        }
    }
    __syncthreads();
}

__device__ __forceinline__ int block_excl_scan(int v, LAS int* wsum, int lane, int wid, int& total) {
    int inc = v;
#pragma unroll
    for (int o = 1; o < 64; o <<= 1) { const int t = __shfl_up(inc, o); if (lane >= o) inc += t; }
    if (lane == 63) wsum[wid] = inc;
    __syncthreads();
    int off = 0, tot = 0;
#pragma unroll
    for (int w = 0; w < 8; ++w) { const int s = wsum[w]; if (w < wid) off += s; tot += s; }
    __syncthreads();
    total = tot; return off + inc - v;
}
__device__ __forceinline__ void phase_topk(const Frame& F) {
    const float* AFFT = (const float*)(F.ws + WS_AFF); int* IDX = (int*)(F.ws + WS_IDX); float* GATEV = (float*)(F.ws + WS_GATEV); int* SLOTMAP = (int*)(F.ws + WS_SLOTMAP);
    LAS int* hist = (LAS int*)F.lds;
    LAS int* wsum = (LAS int*)(F.lds + 1024);
    LAS unsigned* shv = (LAS unsigned*)(F.lds + 1024 + 64);
    const int tid = F.tid, lane = F.lane;
    for (int pr = F.bid; pr < 32; pr += F.G) {
        const int stream = pr >> 4, e = pr & 15, tok0 = stream ? NCTX : 0, cap = stream ? CAPL : CAPC, sbase = e * ESLOTS + (stream ? CAPC : 0);
        const int C = stream ? 16 : 8, i0 = tid * C;
        unsigned k[16];
        { const u32x4* src = (const u32x4*)(AFFT + (size_t)e * NTOK + tok0 + i0);
#pragma unroll
          for (int q = 0; q < 4; ++q) { u32x4 v = (u32x4){0u, 0u, 0u, 0u}; if (q * 4 < C) v = src[q]; k[4 * q] = v.x; k[4 * q + 1] = v.y; k[4 * q + 2] = v.z; k[4 * q + 3] = v.w; } }
        unsigned prefix = 0u; int remaining = cap;
        __syncthreads();
        for (int pass = 0; pass < 4; ++pass) {
            const int shift = 24 - 8 * pass;
            if (tid < 256) hist[tid] = 0;
            __syncthreads();
#pragma unroll
            for (int i = 0; i < 16; ++i) if (i < C) { const unsigned kk = k[i]; if (pass == 0 || (kk >> (shift + 8)) == prefix) __hip_atomic_fetch_add(&hist[(kk >> shift) & 255u], 1, __ATOMIC_RELAXED, __HIP_MEMORY_SCOPE_WORKGROUP); }
            __syncthreads();
            if (tid < 64) {
                const int h0 = hist[4 * lane], h1 = hist[4 * lane + 1], h2 = hist[4 * lane + 2], h3 = hist[4 * lane + 3], c = h0 + h1 + h2 + h3;
                int inc = c;
#pragma unroll
                for (int o = 1; o < 64; o <<= 1) { const int t = __shfl_down(inc, o); if (lane + o < 64) inc += t; }
                const int above = inc - c;
                if (above < remaining && remaining <= inc) {
                    int cum = above, sel;
                    if (cum + h3 >= remaining) sel = 3; else { cum += h3; if (cum + h2 >= remaining) sel = 2; else { cum += h2; if (cum + h1 >= remaining) sel = 1; else { cum += h1; sel = 0; } } }
                    shv[0] = (prefix << 8) | (unsigned)(4 * lane + sel); shv[1] = (unsigned)(remaining - cum);
                }
            }
            __syncthreads();
            prefix = shv[0]; remaining = (int)shv[1];
        }
        const unsigned thr = prefix; const int need = remaining;
        int ceq = 0;
#pragma unroll
        for (int i = 0; i < 16; ++i) if (i < C) ceq += (k[i] == thr) ? 1 : 0;
        int tot; const int eq_rank = block_excl_scan(ceq, wsum, F.lane, F.wave, tot);
        int csel = 0; { int er = eq_rank;
#pragma unroll
            for (int i = 0; i < 16; ++i) if (i < C) { if (k[i] > thr) ++csel; else if (k[i] == thr) { if (er < need) ++csel; ++er; } } }
        int slot = block_excl_scan(csel, wsum, F.lane, F.wave, tot);
#if MK_CHECK
        if (tid == 0 && tot != cap) CHK_FAIL(F, 60);
#endif
        { int er = eq_rank; int sm[16];
#pragma unroll
            for (int i = 0; i < 16; ++i) { sm[i] = -1; if (i < C) { bool sel = false; if (k[i] > thr) sel = true; else if (k[i] == thr) { sel = er < need; ++er; }
                const int tok = tok0 + i0 + i;
                if (sel) { const int r = sbase + slot; IDX[r] = tok; GATEV[r] = __uint_as_float(k[i]); sm[i] = r; ++slot; } } }
            u32x4* dst = (u32x4*)(SLOTMAP + (size_t)e * NTOK + tok0 + i0);
#pragma unroll
            for (int q = 0; q < 4; ++q) if (q * 4 < C) dst[q] = (u32x4){(unsigned)sm[4 * q], (unsigned)sm[4 * q + 1], (unsigned)sm[4 * q + 2], (unsigned)sm[4 * q + 3]}; }
    }
    __syncthreads();
}
__device__ __forceinline__ void phase_gather(const Frame& F) {
    const int* IDX = (const int*)(F.ws + WS_IDX);
#if MK_CHECK
    {
        const int* SLOTMAP = (const int*)(F.ws + WS_SLOTMAP); const float* GATEV = (const float*)(F.ws + WS_GATEV); const float* AFF = (const float*)(F.ws + WS_AFF);
        for (int r = F.gw * 64 + F.lane; r < NSLOTS; r += F.NGW * 64) { const int tok = IDX[r], e = r / ESLOTS; const bool latslot = (r % ESLOTS) >= CAPC;
            bool ok = tok >= 0 && tok < NTOK && ((tok >= NCTX) == latslot);
            if (ok) ok = SLOTMAP[(size_t)e * NTOK + tok] == r && GATEV[r] == AFF[(size_t)e * NTOK + tok];
            if (ok) { const unsigned h = hash_u(r * 7919u + 13u); const int t2 = latslot ? NCTX + (h % NLAT) : (h % NCTX); if (SLOTMAP[(size_t)e * NTOK + t2] < 0 && AFF[(size_t)e * NTOK + t2] > GATEV[r]) ok = false; }
            if (!ok) CHK_FAIL(F, 61); }
    }
#endif
}

__device__ __forceinline__ void ye_acc(f32x4& f, unsigned w) {
    const auto lo = __builtin_amdgcn_cvt_pk_f32_fp8((int)w, false), hi = __builtin_amdgcn_cvt_pk_f32_fp8((int)w, true); f[0] += lo[0]; f[1] += lo[1]; f[2] += hi[0]; f[3] += hi[1];
}
__device__ __forceinline__ void ye_add(f32x4 (&f)[4], const unsigned char* YE, int r, int lane) {
    const bool two = (r >> 8) >= DOWN_FULL_PANELS;
    unsigned w[4], w2[4];
#pragma unroll
    for (int j = 0; j < 4; ++j) { w[j] = ((const unsigned*)(YE + (size_t)r * D))[lane + 64 * j]; w2[j] = 0u; if (two) w2[j] = ((const unsigned*)(YE + (size_t)(NSLOTS + r) * D))[lane + 64 * j]; }
#pragma unroll
    for (int j = 0; j < 4; ++j) { ye_acc(f[j], w[j]); ye_acc(f[j], w2[j]); }
}
__device__ __forceinline__ void ye_add2(f32x4 (&f)[4], const unsigned char* YE, int r, int rb, int lane) {
    const bool two = (r >> 8) >= DOWN_FULL_PANELS, twob = (rb >> 8) >= DOWN_FULL_PANELS;
    unsigned w[4], w2[4], v[4], v2[4];
#pragma unroll
    for (int j = 0; j < 4; ++j) { w[j] = ((const unsigned*)(YE + (size_t)r * D))[lane + 64 * j]; w2[j] = 0u; if (two) w2[j] = ((const unsigned*)(YE + (size_t)(NSLOTS + r) * D))[lane + 64 * j];
        v[j] = ((const unsigned*)(YE + (size_t)rb * D))[lane + 64 * j]; v2[j] = 0u; if (twob) v2[j] = ((const unsigned*)(YE + (size_t)(NSLOTS + rb) * D))[lane + 64 * j]; }
#pragma unroll
    for (int j = 0; j < 4; ++j) { ye_acc(f[j], w[j]); ye_acc(f[j], w2[j]); ye_acc(f[j], v[j]); ye_acc(f[j], v2[j]); }
}
__device__ __forceinline__ void phase_combine(const Frame& F, const Args& a, int l) {
    bf16* X = (bf16*)(F.ws + WS_X); const bf16* X1 = (const bf16*)(F.ws + WS_X1); bf16* H = (bf16*)(F.ws + WS_H); const unsigned char* YE = F.ws + WS_YE; const int* SLOTMAP = (const int*)(F.ws + WS_SLOTMAP);
    int lane_ = F.lane; asm volatile("" : "+v"(lane_)); const int lane = lane_;
    const f32x4* lg = (const f32x4*)(a.in[10] + (size_t)(l * 2 + 1) * D); const f32x4* lb = (const f32x4*)(a.in[11] + (size_t)(l * 2 + 1) * D);
#if MK_CHECK
    const unsigned err = __hip_atomic_load(F.ctl + CW_ERR, __ATOMIC_RELAXED, __HIP_MEMORY_SCOPE_AGENT);
    const unsigned tmo = __hip_atomic_load(F.ctl + CW_BAR + XB_TMO, __ATOMIC_RELAXED, __HIP_MEMORY_SCOPE_AGENT);
#endif
    const int RPW = (NTOK + F.NGW - 1) / F.NGW, rbeg = F.gw * RPW, rend = (rbeg + RPW < NTOK) ? rbeg + RPW : NTOK;
    f32x4 lgv[4], lbv[4], g2v[4], shv[4], scv[4]; int ccur = -1;
#pragma unroll
    for (int j = 0; j < 4; ++j) { lgv[j] = lg[lane + 64 * j]; lbv[j] = lb[lane + 64 * j]; g2v[j] = lgv[j]; shv[j] = lgv[j]; scv[j] = lgv[j]; }
    int sm = -1; if (rbeg < rend && lane < 16) sm = SLOTMAP[(size_t)lane * NTOK + rbeg];
    for (int row = rbeg; row < rend; ++row) {
        const int c = cond_of(row);
        if (c != ccur) { ccur = c; const f32x4* g2 = (const f32x4*)ada_vec(F, l, c, 5);
#pragma unroll
            for (int j = 0; j < 4; ++j) g2v[j] = g2[lane + 64 * j];
            if (l < 3) { const f32x4* sh = (const f32x4*)ada_vec(F, l + 1, c, 0); const f32x4* sc = (const f32x4*)ada_vec(F, l + 1, c, 1);
#pragma unroll
                for (int j = 0; j < 4; ++j) { shv[j] = sh[lane + 64 * j]; scv[j] = sc[lane + 64 * j] + 1.f; } } }
        f32x4 x1[4];
#pragma unroll
        for (int j = 0; j < 4; ++j) x1[j] = bf4(((const u32x2*)(X1 + (size_t)row * D))[lane + 64 * j]);
        unsigned mask = (unsigned)__ballot(sm >= 0) & 0xffffu;
        const int smc = sm;
        { const int nr = row + 1; sm = -1; if (nr < rend && lane < 16) sm = SLOTMAP[(size_t)lane * NTOK + nr]; }
        f32x4 f[4];
#pragma unroll
        for (int j = 0; j < 4; ++j) f[j] = (f32x4){0.f, 0.f, 0.f, 0.f};
        while (mask) {
            const int e0 = __builtin_ctz(mask); mask &= mask - 1; const int r0 = __builtin_amdgcn_readlane(smc, e0);
            if (mask) { const int e1 = __builtin_ctz(mask); mask &= mask - 1; const int r1 = __builtin_amdgcn_readlane(smc, e1); ye_add2(f, YE, r0, r1, lane); }
            else ye_add(f, YE, r0, lane);
        }
        f32x4 y[4]; float s = 0.f, s2 = 0.f;
#pragma unroll
        for (int j = 0; j < 4; ++j) { y[j] = x1[j] * ALPHA + g2v[j] * f[j] * (1.f / YE8_SCALE); s += (y[j][0] + y[j][1]) + (y[j][2] + y[j][3]); s2 += (y[j][0] * y[j][0] + y[j][1] * y[j][1]) + (y[j][2] * y[j][2] + y[j][3] * y[j][3]); }
        s = wave_sum(s); s2 = wave_sum(s2);
        const float mean = s * (1.f / D), var = fmaxf(s2 * (1.f / D) - mean * mean, 0.f);
        const float rstd = 1.f / sqrtf(var + 1e-5f);
        if (l < 3) {
#pragma unroll
            for (int j = 0; j < 4; ++j) { const int q = lane + 64 * j; const f32x4 xn = (y[j] - mean) * rstd * lgv[j] + lbv[j]; ((u32x2*)(X + (size_t)row * D))[q] = pk4(xn);
                const f32x4 h = xn * scv[j] + shv[j]; u32x2 w; w.x = cvtpk(h[0], h[1]); w.y = cvtpk(h[2], h[3]); ((u32x2*)(H + (size_t)row * D))[q] = w; }
        } else {
#pragma unroll
            for (int j = 0; j < 4; ++j) { const int q = lane + 64 * j; f32x4 xn = (y[j] - mean) * rstd * lgv[j] + lbv[j];
#if MK_CHECK
                if (row == 0 && q == 0) { if (err) xn[0] = 100.f * (float)err; else if (tmo) xn[0] = 9900.f; }
#endif
                ((f32x4*)(F.out + (size_t)row * D))[q] = xn; }
        }
    }
}

#if !MK_SPLIT
#define GRID_BAR() xcd_barrier(bar)
#else
#define GRID_BAR() do { } while (0)
#endif
#define IN(k) (lo <= (k) && (k) < hi)
#define GEMM_PHASE(EPI, SCHED) do { for (int rep_ = 0; rep_ < MK_REP_GEMM; ++rep_) pg8::gemm_phase<EPI, SCHED, true, true>(F.lds, g, S, E); } while (0)
template <int KIND>
__device__ __forceinline__ void run_mixer(const Frame& F, const Args& a, const XcdBarrier& bar, int lo, int hi, int l, int j, int slot, int& cv_it) {
    const int base = 3 + 12 * l;
    const bf16* Hb = (const bf16*)(F.ws + WS_H);
    ChunkMap cm; cm.init(F.G, F.bid);
    const ConvJob J{a.in[26], a.in[27], a.in[28], F.ws + WS_WGU, F.ws + WS_WD};
    const int cv_cap = (l == 0 ? 32 : l == 1 ? 48 : l == 2 ? 82 : 96) * (CV_PER_LAYER / 24);
    if (KIND != 2) {
        const bf16* Wq = (const bf16*)(F.ws + WS_WQKV) + (size_t)slot * 1536 * 1024;
        if (IN(base + 0)) {
            unsigned* cnt = F.ctl + CW_KV + 16 * l;
            Gemm g{Hb, Wq, 1024, 1024}; QkvOrder S{cm}; EpiBf16P E{(bf16*)(F.ws + WS_QKV), 1536};
            GEMM_PHASE(EpiBf16P, QkvOrder);
            int nkv = 0; { Unit u; for (int i = 0; S.next(i, u); ++i) nkv += (u.pn >= 4) ? 1 : 0; }
            if (nkv && F.tid == 0) { __builtin_amdgcn_fence(__ATOMIC_RELEASE, "agent"); (void)__hip_atomic_fetch_add(cnt, (unsigned)nkv, __ATOMIC_RELAXED, __HIP_MEMORY_SCOPE_AGENT); }
            const int idx = cm.x * cm.chunk + cm.loc; int skip = 288 - F.G; if (skip < 0 || skip >= F.G) skip = 0;
            if (idx >= skip) {
                if (F.tid == 0) { while (__hip_atomic_load(cnt, __ATOMIC_RELAXED, __HIP_MEMORY_SCOPE_AGENT) < 96u) __builtin_amdgcn_s_sleep(2); __builtin_amdgcn_fence(__ATOMIC_ACQUIRE, "agent"); }
                __syncthreads();
                for (int rep = 0; rep < MK_REP_POST; ++rep) phase_kv_post(F, a, KIND, j, slot, (idx - skip) * 8 + F.wave, (F.G - skip) * 8);
            }
            GRID_BAR();
        }
#if MK_CHECK
        if (IN(base + 3)) check_gemm_bf16<int>(F, Hb, Wq, NTOK, 1536, 1024, (const bf16*)(F.ws + WS_QKV), 1536, 10 + l);
#endif
        if (IN(base + 4)) {
            for (int rep = 0; rep < MK_REP_ATTN; ++rep) { if (KIND == 0) attn_phase<64, 0>(F, a, j, J, cv_it, (l + 1) * CV_PER_LAYER, cv_cap); else attn_phase<64, 1>(F, a, j, J, cv_it, (l + 1) * CV_PER_LAYER, cv_cap); }
            GRID_BAR();
        }
    } else {
        if (IN(base + 0)) {
            Gemm g{Hb, (const bf16*)(F.ws + WS_WDN), 512, 1024}; SplitKOrder S{2, 2, 1024, 48 * 2 * 2, cm}; EpiF32 E{(float*)(F.ws + WS_QKV), 512, DWN_PART};
            GEMM_PHASE(EpiF32, SplitKOrder); GRID_BAR();
        }
        if (IN(base + 1)) {
#if MK_CHECK
            for (int sidx = 0; sidx < 2; ++sidx) { const unsigned h = hash_u((F.gw * 2 + sidx) * 2654435761u + (10 + l) * 97u); const int row = h % NTOK, col = (h >> 12) % 512;
                const float ref = dot_bf16(Hb + (size_t)row * 1024, (const bf16*)(F.ws + WS_WDN) + (size_t)col * 1024, 1024, F.lane); const float* dq = (const float*)(F.ws + WS_QKV) + (size_t)row * 512 + col;
                if (!close_enough(dq[0] + dq[DWN_PART], ref, 0.01f, 0.01f)) CHK_FAIL(F, 10 + l); }
#endif
            phase_mla_post1(F, a); GRID_BAR();
        }
        if (IN(base + 2)) {
            { Gemm g{(const bf16*)(F.ws + WS_QA), (const bf16*)(F.ws + WS_WUQ), 256, 256}; PlainOrder S{6, 48 * 6, cm}; EpiBf16P E{(bf16*)(F.ws + WS_QKV), 1536}; GEMM_PHASE(EpiBf16P, PlainOrder); }
            { Gemm g{(const bf16*)(F.ws + WS_CKVA), (const bf16*)(F.ws + WS_WUKV), 128, 128}; PlainOrder S{8, 56 * 8, cm}; EpiUkv E{(bf16*)(F.ws + WS_KB), (float*)(F.ws + WS_KVRAW)}; GEMM_PHASE(EpiUkv, PlainOrder); }
            GRID_BAR();
        }
        if (IN(base + 3)) {
#if MK_CHECK
            check_gemm_bf16<int>(F, (const bf16*)(F.ws + WS_QA), (const bf16*)(F.ws + WS_WUQ), NTOK, 1536, 256, (const bf16*)(F.ws + WS_QKV), 1536, 14);
            for (int sidx = 0; sidx < 2; ++sidx) {
                const unsigned h = hash_u((F.gw * 2 + sidx) * 2654435761u + 15u * 97u); const int row = h % 14336, col = (h >> 12) % 2048, hh = col >> 7, ii = col & 127;
                const float ref = dot_bf16((const bf16*)(F.ws + WS_CKVA) + (size_t)row * 128, (const bf16*)(F.ws + WS_WUKV) + (size_t)col * 128, 128, F.lane);
                bool lat; int b, s; mla_row(row, lat, b, s);
                const float got = (ii < 64) ? bf2f(((const bf16*)(F.ws + WS_KB))[kb_off(16, 96, lat, b, hh) + (size_t)s * 96 + ii]) : ((const float*)(F.ws + WS_KVRAW))[(size_t)row * 1024 + hh * 64 + ii - 64];
                if (!close_enough(got, ref, 0.02f, 0.02f)) CHK_FAIL(F, 15);
            }
#endif
            for (int rep = 0; rep < MK_REP_POST; ++rep) phase_mla_post2(F, a); GRID_BAR();
        }
        if (IN(base + 4)) { for (int rep = 0; rep < MK_REP_ATTN; ++rep) attn_phase<96, 2>(F, a, j, J, cv_it, (l + 1) * CV_PER_LAYER, cv_cap); GRID_BAR(); }
    }
}
__device__ __forceinline__ void run_moe(const Frame& F, const Args& a, const XcdBarrier& bar, int lo, int hi, int l, int kind) {
    const int base = 3 + 12 * l;
    ChunkMap cm; cm.init(F.G, F.bid);
    const bf16* Wo = (const bf16*)(F.ws + WS_WO) + (size_t)l * 1024 * 1024;
    if (IN(base + 5)) {
#if MK_CHECK
        if (kind == 0) check_attn<64, 0>(F, a, l / 3, 20 + l); else if (kind == 1) check_attn<64, 1>(F, a, 0, 20 + l); else check_attn<96, 2>(F, a, 0, 20 + l);
        __syncthreads();
#endif
        Gemm g{(const bf16*)(F.ws + WS_O), Wo, 1024, 1024}; PlainOrder S{4, 48 * 4, cm}; EpiBf16P E{(bf16*)(F.ws + WS_AO), 1024};
        GEMM_PHASE(EpiBf16P, PlainOrder); GRID_BAR();
    }
    if (IN(base + 6)) {
#if MK_CHECK
        check_gemm_bf16<int>(F, (const bf16*)(F.ws + WS_O), Wo, NTOK, 1024, 1024, (const bf16*)(F.ws + WS_AO), 1024, 30 + l);
#endif
        for (int rep = 0; rep < MK_REP_LN1; ++rep) phase_ln1_router(F, a, l); GRID_BAR();
    }
#if MK_CHECK
    if (IN(base + 7)) {
        const unsigned hsh = hash_u(F.gw * 2654435761u + 991u * l + 17u); const int row = hsh % NTOK, c = cond_of(row);
        const bf16* X1c = (const bf16*)(F.ws + WS_X1); const float* sh2 = ada_vec(F, l, c, 3); const float* sc2 = ada_vec(F, l, c, 4); const float* wrc = a.in[25] + (size_t)l * D * NE; const float* AFFc = (const float*)(F.ws + WS_AFF);
        float lgt[16];
#pragma unroll
        for (int e = 0; e < 16; ++e) { float sacc = 0.f; for (int k = F.lane; k < D; k += 64) { const float hh = bf2f(X1c[(size_t)row * D + k]) * (sc2[k] + 1.f) + sh2[k]; sacc += hh * wrc[k * NE + e]; } lgt[e] = wave_sum(sacc); }
        float mxc = lgt[0];
#pragma unroll
        for (int e = 1; e < 16; ++e) mxc = fmaxf(mxc, lgt[e]);
        float denc = 0.f;
#pragma unroll
        for (int e = 0; e < 16; ++e) denc += __expf(lgt[e] - mxc);
#pragma unroll
        for (int e = 0; e < 16; ++e) { const float ref = __expf(lgt[e] - mxc) / denc, got = AFFc[(size_t)e * NTOK + row]; if (!close_enough(got, ref, 0.03f, 2e-4f)) CHK_FAIL(F, 62); }
    }
#endif
    if (IN(base + 7)) { for (int rep = 0; rep < MK_REP_TOPK; ++rep) phase_topk(F); if (l < 3) ada_direct(F, a, l + 1, 32); GRID_BAR(); }
#if MK_CHECK
    if (IN(base + 8)) { phase_gather(F); GRID_BAR(); }
#endif
    const unsigned char* Wgu = F.ws + WS_WGU + (size_t)l * 16 * 4096 * 1024; const unsigned char* Wd = F.ws + WS_WD + (size_t)l * 16 * 1024 * 2048;
    if (IN(base + 9)) {
#if MK_CHECK
        for (int sidx = 0; sidx < 16; ++sidx) {
            const unsigned h = hash_u((F.gw * 16 + sidx) * 2654435761u + 71u * l + 3u); const int idx = h & 63, e = (h >> 6) & 15, kk = (h >> 10) & 1023, nn = (h >> 20) & 2047;
            const int k = kk + ((idx & 1) ? 1024 * ((h >> 31) & 1) : 0);
            float src, got;
            if (idx & 1) { const int n = nn & 1023; src = a.in[28][((size_t)(l * 16 + e) * 2048 + k) * 1024 + n]; got = fp8f(Wd + ((size_t)e * 1024 + n) * 2048, k); }
            else { const bool up = (idx & 2) != 0; src = (up ? a.in[27] : a.in[26])[((size_t)(l * 16 + e) * 1024 + kk) * 2048 + nn]; got = fp8f(Wgu + ((size_t)e * 4096 + (nn >> 7) * 256 + (up ? 128 : 0) + (nn & 127)) * 1024, kk); }
            { const unsigned pk = pk4_fp8(src * W8_SCALE, 0.f, 0.f, 0.f); if (F.lane == 0 && got != __builtin_amdgcn_cvt_f32_fp8((int)pk, 0)) CHK_FAIL(F, 70 + l); }
        }
#endif
        Gemm g{(const bf16*)(F.ws + WS_XE), (const bf16*)Wgu, 512, 512, (const int*)(F.ws + WS_IDX)}; GroupedOrder S{6, 16, 1, 0, cm}; EpiSwiglu E{F.ws + WS_HID};
        pg8::gemm_phase<EpiSwiglu, GroupedOrder, true, true, true, true>(F.lds, g, S, E); GRID_BAR();
    }
    if (IN(base + 10)) {
#if MK_CHECK
        for (int sidx = 0; sidx < 2; ++sidx) {
            const unsigned h = hash_u((F.gw * 2 + sidx) * 2654435761u + 977u * l); const int row = h % NSLOTS, cc = (h >> 12) % FF, e = row / ESLOTS;
            const unsigned char* xr = F.ws + WS_XE + (size_t)((const int*)(F.ws + WS_IDX))[row] * D; const unsigned char* wg = Wgu + ((size_t)e * 4096 + (cc >> 7) * 256 + (cc & 127)) * 1024;
            const float gd = dot_fp8(xr, wg, 1024, F.lane) * (1.f / W8_SCALE), ud = dot_fp8(xr, wg + 128 * 1024, 1024, F.lane) * (1.f / W8_SCALE);
            const float ref = gd / (1.f + __expf(-gd)) * ud, got = fp8f(F.ws + WS_HID + (size_t)row * FF, cc) * (1.f / H8_SCALE);
            if (!close_enough(got, ref, 0.08f, 0.01f)) CHK_FAIL(F, 40 + l);
        }
#endif
        EpiDown E{F.ws + WS_YE, (const float*)(F.ws + WS_GATEV)};
        { Gemm g{(const bf16*)(F.ws + WS_HID), (const bf16*)Wd, 1024, 1024, nullptr}; DownOrder S{0, cm}; pg8::gemm_phase<EpiDown, DownOrder, true, true, false, true>(F.lds, g, S, E); }
        { Gemm g{(const bf16*)(F.ws + WS_HID), (const bf16*)Wd, 512, 1024, nullptr}; DownOrder S{1, cm}; pg8::gemm_phase<EpiDown, DownOrder, true, true, false, true>(F.lds, g, S, E); }
        GRID_BAR();
    }
    if (IN(base + 11)) {
#if MK_CHECK
        for (int sidx = 0; sidx < 2; ++sidx) {
            const unsigned h = hash_u((F.gw * 2 + sidx) * 2654435761u + 577u * l + 5u); const int row = h % NSLOTS, cc = (h >> 12) % D, e = row / ESLOTS;
            const float dd = dot_fp8(F.ws + WS_HID + (size_t)row * FF, Wd + ((size_t)e * 1024 + cc) * 2048, 2048, F.lane) * (1.f / (W8_SCALE * H8_SCALE));
            const float ref = dd * ((const float*)(F.ws + WS_GATEV))[row], p1 = fp8f(F.ws + WS_YE + (size_t)row * D, cc) * (1.f / YE8_SCALE), p2 = ((row >> 8) >= DOWN_FULL_PANELS) ? fp8f(F.ws + WS_YE + (size_t)(NSLOTS + row) * D, cc) * (1.f / YE8_SCALE) : 0.f;
            if (!(fabsf(p1 + p2 - ref) <= 0.07f * (fabsf(p1) + fabsf(p2)) + 0.0005f)) CHK_FAIL(F, 50 + l);
        }
#endif
        for (int rep = 0; rep < MK_REP_COMB; ++rep) phase_combine(F, a, l); if (l < 3) GRID_BAR();
    }
}
#undef IN

constexpr int N_PHASES = 3 + 4 * 12;
__global__ void __launch_bounds__(512, 2) mk_fwd(Args a) {
    extern __shared__ __attribute__((aligned(16))) unsigned char lds_raw[];
    LAS unsigned char* lds0 = (LAS unsigned char*)lds_raw;
    Frame F;
    F.lds = lds0 + LDS_PH; F.ws = a.ws; F.out = a.out; F.ctl = (unsigned*)(a.ws + WS_CTL);
    F.tid = threadIdx.x; F.lane = F.tid & 63; F.wave = __builtin_amdgcn_readfirstlane(F.tid >> 6); F.G = gridDim.x; F.bid = blockIdx.x; F.gw = F.bid * 8 + F.wave; F.NGW = F.G * 8;
    if (F.tid < LDS_PH / 4) ((LAS unsigned*)lds0)[F.tid] = 0u;
    __syncthreads();
#if !MK_SPLIT
    XcdBarrier bar = xcd_barrier_post(F.ctl + CW_BAR, (volatile LAS unsigned*)lds0);
#else
    XcdBarrier bar; bar.bar = F.ctl + CW_BAR; bar.x = 0; bar.st = (volatile LAS unsigned*)lds0;
#endif
    const int lo = a.ph_lo, hi = a.ph_hi;
#define IN(k) (lo <= (k) && (k) < hi)
    if (IN(0)) { phase_prologue(F, a); GRID_BAR(); }
    if (IN(2)) { phase_mod0(F, a); GRID_BAR(); }
    int cv_it = F.gw;
    run_mixer<0>(F, a, bar, lo, hi, 0, 0, 0, cv_it);
    run_moe(F, a, bar, lo, hi, 0, 0);
    run_mixer<1>(F, a, bar, lo, hi, 1, 0, 1, cv_it);
    run_moe(F, a, bar, lo, hi, 1, 1);
    run_mixer<2>(F, a, bar, lo, hi, 2, 0, 0, cv_it);
    run_moe(F, a, bar, lo, hi, 2, 2);
    run_mixer<0>(F, a, bar, lo, hi, 3, 1, 2, cv_it);
    run_moe(F, a, bar, lo, hi, 3, 0);
#undef IN
}

extern "C" void kernel_launch(void* const* d_in, const int* in_sizes, int n_in, void* d_out, int out_size, void* d_ws, size_t ws_size, hipStream_t stream) {
    static int grid = 0;
    if (grid == 0) {
        if (n_in != 29 || out_size != 19529728 || ws_size < WS_END) { fprintf(stderr, "kernel_launch: unexpected sizes n_in %d out %d ws %zu\n", n_in, out_size, ws_size); grid = -1; return; }
        int dev = 0, cus = 0, per_cu = 0;
        if (hipGetDevice(&dev) != hipSuccess || hipDeviceGetAttribute(&cus, hipDeviceAttributeMultiprocessorCount, dev) != hipSuccess) { grid = -1; return; }
        if (hipFuncSetAttribute((const void*)mk_fwd, hipFuncAttributeMaxDynamicSharedMemorySize, LDS_BYTES) != hipSuccess) { fprintf(stderr, "kernel_launch: hipFuncSetAttribute failed\n"); grid = -1; return; }
        if (hipOccupancyMaxActiveBlocksPerMultiprocessor(&per_cu, (const void*)mk_fwd, 512, LDS_BYTES) != hipSuccess || per_cu < 1) fprintf(stderr, "kernel_launch: occupancy query says %d\n", per_cu);
        (void)hipGetLastError();
        grid = cus;
    }
    if (grid < 0) return;
    (void)hipMemsetAsync((char*)d_ws + WS_CTL, 0, CTL_BYTES, stream);
    Args a{};
    for (int i = 0; i < 29; ++i) a.in[i] = (const float*)d_in[i];
    a.out = (float*)d_out; a.ws = (unsigned char*)d_ws;
#if MK_SPLIT
    for (int p = 0; p < N_PHASES; ++p) {
        const int r = (p - 3) % 12, l = (p - 3) / 12;
        if (p >= 3) { const bool mla = (l % 3) == 2; if (!mla && (r == 1 || r == 2)) continue; }
        a.ph_lo = p; a.ph_hi = p + 1;
        hipLaunchKernelGGL(mk_fwd, dim3(grid), dim3(512), LDS_BYTES, stream, a);
    }
#else
    a.ph_lo = 0; a.ph_hi = N_PHASES;
    hipLaunchKernelGGL(mk_fwd, dim3(grid), dim3(512), LDS_BYTES, stream, a);
#endif
}
```

```cpp
#include <hip/hip_runtime.h>
#include <cstdio>
#include <cstdint>

#ifndef MK_SPLIT
#define MK_SPLIT 0
#endif
#ifndef MK_REP_ATTN
#define MK_REP_ATTN 1
#endif
#ifndef MK_REP_CONV
#define MK_REP_CONV 1
#endif
#ifndef MK_REP_POST
#define MK_REP_POST 1
#endif
#ifndef MK_REP_GEMM
#define MK_REP_GEMM 1
#endif
#ifndef MK_REP_LN1
#define MK_REP_LN1 1
#endif
#ifndef MK_REP_TOPK
#define MK_REP_TOPK 1
#endif
#ifndef MK_REP_GATH
#define MK_REP_GATH 1
#endif
#ifndef MK_REP_COMB
#define MK_REP_COMB 1
#endif
#ifndef MK_CHECK
#define MK_CHECK 0
#endif

#define LAS __attribute__((address_space(3)))
typedef unsigned short bf16;
typedef unsigned u32x4 __attribute__((ext_vector_type(4)));
typedef unsigned u32x2 __attribute__((ext_vector_type(2)));
typedef float f32x2 __attribute__((ext_vector_type(2)));
typedef float f32x4 __attribute__((ext_vector_type(4)));
typedef float f32x16 __attribute__((ext_vector_type(16)));
typedef short bf16x8 __attribute__((ext_vector_type(8)));
typedef __bf16 bf16x2_t __attribute__((ext_vector_type(2)));

constexpr int D = 1024, NCTX = 4096, NLAT = 8192, NTOK = 12288;
constexpr int NE = 16, FF = 2048, CAPC = 512, CAPL = 1024, ESLOTS = 1536, NSLOTS = 24576;
constexpr float ALPHA = 1.681792830507429f, LOG2E = 1.4426950408889634f;
constexpr float GQA_QS = 0.125f * LOG2E, MLA_QS = 0.10206207261596575f * LOG2E;
constexpr size_t DWN_PART = (size_t)8 << 20;
constexpr int OFF_YP = 0, OFF_NK = 12582912, OFF_NV = OFF_NK + 3145728, OFF_CKV = OFF_NV + 3145728, OFF_KPE = OFF_CKV + 524288;

constexpr size_t MiB = 1u << 20;
constexpr size_t WS_CTL = 0, CTL_BYTES = 1 * MiB;
constexpr size_t WS_ADAP = 1 * MiB, WS_ADA = 9 * MiB, WS_ROPE64 = 10 * MiB, WS_ROPE32 = 10 * MiB + 512 * 1024;
constexpr size_t WS_AFF = 11 * MiB, WS_IDX = 12 * MiB, WS_GATEV = 12 * MiB + 128 * 1024, WS_SLOTMAP = 13 * MiB;
constexpr size_t WS_X = 16 * MiB, WS_H = 64 * MiB, WS_O = 88 * MiB, WS_AO = 112 * MiB, WS_QKV = 160 * MiB, WS_KVRAW = 232 * MiB;
constexpr size_t WS_X1 = 292 * MiB  , WS_KB = 380 * MiB, WS_VT = 428 * MiB, WS_QA = 460 * MiB, WS_CKVA = 466 * MiB;
constexpr size_t WS_XE = 470 * MiB, WS_HID = 518 * MiB, WS_YE = 614 * MiB;
constexpr size_t WS_WQKV = 712 * MiB, WS_WO = 724 * MiB, WS_WDN = 732 * MiB, WS_WUQ = 733 * MiB, WS_WUKV = 734 * MiB;
constexpr size_t WS_WGU = 736 * MiB, WS_WD = 1248 * MiB, WS_END = 1504 * MiB;
constexpr int CW_ERR = 0, CW_BAR = 4096, CW_KV = 8192;

constexpr int LDS_BYTES = 147456, LDS_PH = 256;

__device__ __forceinline__ unsigned cvtpk(float lo, float hi) { f32x2 v = {lo, hi}; bf16x2_t b = __builtin_convertvector(v, bf16x2_t); return __builtin_bit_cast(unsigned, b); }
__device__ __forceinline__ bf16 f2bf(float f) { return (bf16)(cvtpk(f, 0.f) & 0xffffu); }
__device__ __forceinline__ float bf2f(bf16 b) { return __uint_as_float(((unsigned)b) << 16); }
__device__ __forceinline__ unsigned pk4_fp8(float a, float b, float c, float d) { int w = __builtin_amdgcn_cvt_pk_fp8_f32(a, b, 0, false); w = __builtin_amdgcn_cvt_pk_fp8_f32(c, d, w, true); return (unsigned)w; }
constexpr float W8_SCALE = 64.f, H8_SCALE = 8.f;
constexpr float YE8_SCALE = 128.f;
__device__ __forceinline__ float clamp8(float x) { return __builtin_amdgcn_fmed3f(x, -448.f, 448.f); }
__device__ __forceinline__ f32x4 bf4(u32x2 w) { return (f32x4){__uint_as_float(w.x << 16), __uint_as_float(w.x & 0xffff0000u), __uint_as_float(w.y << 16), __uint_as_float(w.y & 0xffff0000u)}; }
__device__ __forceinline__ u32x2 pk4(f32x4 v) { u32x2 w; w.x = cvtpk(v[0], v[1]); w.y = cvtpk(v[2], v[3]); return w; }
template <int CTRL> __device__ __forceinline__ float dppf(float v) { return __uint_as_float((unsigned)__builtin_amdgcn_update_dpp(0, (int)__float_as_uint(v), CTRL, 0xf, 0xf, true)); }
constexpr int DPP_X1 = 0xB1, DPP_X2 = 0x4E, DPP_HMIR = 0x141, DPP_MIR = 0x140, DPP_X8 = 0x128;
__device__ __forceinline__ float xsum16(float a, float b) { const auto r = __builtin_amdgcn_permlane16_swap(__float_as_uint(a), __float_as_uint(b), false, false); return __uint_as_float(r[0]) + __uint_as_float(r[1]); }
__device__ __forceinline__ float xsum32(float a, float b) { const auto r = __builtin_amdgcn_permlane32_swap(__float_as_uint(a), __float_as_uint(b), false, false); return __uint_as_float(r[0]) + __uint_as_float(r[1]); }
__device__ __forceinline__ float xmax16(float a) { const auto r = __builtin_amdgcn_permlane16_swap(__float_as_uint(a), __float_as_uint(a), false, false); return fmaxf(__uint_as_float(r[0]), __uint_as_float(r[1])); }
__device__ __forceinline__ float xmax32(float a) { const auto r = __builtin_amdgcn_permlane32_swap(__float_as_uint(a), __float_as_uint(a), false, false); return fmaxf(__uint_as_float(r[0]), __uint_as_float(r[1])); }
__device__ __forceinline__ float sum16(float v) { v += dppf<DPP_X1>(v); v += dppf<DPP_X2>(v); v += dppf<DPP_HMIR>(v); v += dppf<DPP_MIR>(v); return v; }
__device__ __forceinline__ float wave_sum(float v) { v = sum16(v); v = xsum16(v, v); return xsum32(v, v); }
__device__ __forceinline__ float wave_max(float v) {
    v = fmaxf(v, dppf<DPP_X1>(v)); v = fmaxf(v, dppf<DPP_X2>(v)); v = fmaxf(v, dppf<DPP_HMIR>(v)); v = fmaxf(v, dppf<DPP_MIR>(v)); v = xmax16(v); return xmax32(v);
}
__device__ __forceinline__ int cond_of(int t) { return t < NCTX ? 0 : 1 + ((t - NCTX) >> 11); }
__device__ __forceinline__ unsigned hash_u(unsigned x) { x ^= x >> 16; x *= 0x7feb352dU; x ^= x >> 15; x *= 0x846ca68bU; x ^= x >> 16; return x; }

#define XB_TMO      128
#define XB_XCNT(j)  (256  + 64 * (j))
#define XB_XSUB(j)  (1280 + 64 * (j))
#define XB_XGEN(j)  (2304 + 64 * (j))
#define XB_TOP      3328
#define XB_TOPGEN   3392
#define XCD_BAR_WORDS 3456
#define XB_SPIN_CAP (1u << 18)
__device__ __forceinline__ unsigned xb_ld(unsigned* p)              { return __hip_atomic_load(p, __ATOMIC_RELAXED, __HIP_MEMORY_SCOPE_AGENT); }
__device__ __forceinline__ unsigned xb_add(unsigned* p, unsigned v) { return __hip_atomic_fetch_add(p, v, __ATOMIC_RELAXED, __HIP_MEMORY_SCOPE_AGENT); }
__device__ __forceinline__ unsigned xb_xcc_id() { return (unsigned)__builtin_amdgcn_s_getreg((3 << 11) | 20) & 0xFu; }
#define XB_SPIN(cond, bar) do { unsigned _sp = 0; while (cond) { __builtin_amdgcn_s_sleep(1); \
    if ((++_sp & 255u) == 0u) { if (xb_ld(&(bar)[XB_TMO])) break; if (_sp > XB_SPIN_CAP) { atomicAdd(&(bar)[XB_TMO], 1u); break; } } } } while (0)
struct XcdBarrier { unsigned* bar; unsigned x; volatile LAS unsigned* st; };
__device__ __forceinline__ XcdBarrier xcd_barrier_post(unsigned* bar, volatile LAS unsigned* st) {
    XcdBarrier b; b.bar = bar; b.x = xb_xcc_id(); b.st = st;
    if (threadIdx.x == 0) (void)xb_add(&bar[XB_XCNT(b.x)], 1u);
    return b;
}
__device__ __forceinline__ void xcd_barrier_complete(unsigned* bar, unsigned x, unsigned& nloc, unsigned& nx) {
    const unsigned G = gridDim.x * gridDim.y * gridDim.z;
    unsigned sum, cnt, mine, sp = 0u;
    for (;;) {
        sum = 0u; cnt = 0u; mine = 0u;
#pragma unroll
        for (unsigned j = 0; j < 16; ++j) { const unsigned c = xb_ld(&bar[XB_XCNT(j)]); sum += c; cnt += (c > 0u) ? 1u : 0u; mine = (j == x) ? c : mine; }
        if (sum == G) break;
        __builtin_amdgcn_s_sleep(1);
        if ((++sp & 255u) == 0u) { if (xb_ld(&bar[XB_TMO])) break; if (sp > XB_SPIN_CAP) { atomicAdd(&bar[XB_TMO], 1u); break; } }
    }
    nloc = mine > 0u ? mine : 1u; nx = cnt > 0u ? cnt : 1u;
}
__device__ __forceinline__ void xcd_barrier(const XcdBarrier& b) {
    asm volatile("s_waitcnt vmcnt(0)" ::: "memory");
    __syncthreads();
    if (threadIdx.x == 0) {
        unsigned* bar = b.bar;
        __builtin_amdgcn_s_waitcnt(0);
        unsigned nloc = b.st[0], nx = b.st[1];
        if (nloc == 0u) { xcd_barrier_complete(bar, b.x, nloc, nx); b.st[0] = nloc; b.st[1] = nx; }
        const unsigned old = xb_add(&bar[XB_XSUB(b.x)], 1u);
        const unsigned gen = old / nloc;
        if (old + 1u == (gen + 1u) * nloc) {
            __builtin_amdgcn_fence(__ATOMIC_RELEASE, "agent");
            asm volatile("s_waitcnt vmcnt(0)" ::: "memory");
            const unsigned og = xb_add(&bar[XB_TOP], 1u);
            const unsigned tg = og / nx;
            if (og + 1u == (tg + 1u) * nx) xb_add(&bar[XB_TOPGEN], 1u);
            else XB_SPIN(xb_ld(&bar[XB_TOPGEN]) == tg, bar);
            __builtin_amdgcn_fence(__ATOMIC_ACQUIRE, "agent");
            xb_add(&bar[XB_XGEN(b.x)], 1u);
            asm volatile("s_waitcnt vmcnt(0)" ::: "memory");
        } else {
            XB_SPIN(xb_ld(&bar[XB_XGEN(b.x)]) == gen, bar);
            __builtin_amdgcn_fence(__ATOMIC_ACQUIRE, "agent");
            asm volatile("s_waitcnt vmcnt(0)" ::: "memory");
        }
    }
    __syncthreads();
}

struct Args { const float* in[29]; float* out; unsigned char* ws; int ph_lo, ph_hi; };
struct Frame {
    LAS unsigned char* lds;
    unsigned char* ws; float* out; unsigned* ctl;
    int tid, lane, wave, G, bid, gw, NGW;
};
#if MK_CHECK
#define CHK_FAIL(F, id) do { unsigned _e = 0u; __hip_atomic_compare_exchange_strong((F).ctl + CW_ERR, &_e, (unsigned)(id), __ATOMIC_RELAXED, __ATOMIC_RELAXED, __HIP_MEMORY_SCOPE_AGENT); } while (0)
#endif
__device__ __forceinline__ bool close_enough(float a, float b, float rel, float abs_) { const float d = fabsf(a - b); return d <= rel * fabsf(b) + abs_ && a == a; }

namespace pg8 {
#define PG8_LAS __attribute__((address_space(3)))
typedef unsigned short bf16_t;
typedef short bf16x8 __attribute__((ext_vector_type(8)));
typedef float f32x4 __attribute__((ext_vector_type(4)));
constexpr int BM = 256, BK = 64, HALF = 128, HTB = HALF * BK * 2  , STAGE_BYTES = 8 * HTB, NXCD = 8, WGM = 8;

__host__ __device__ __forceinline__ int lds_byte(int r, int c, int XM = 32) { const int st = (r >> 4) * 2 + (c >> 5), rr = r & 15, cc = c & 31, ob = rr * 64 + cc * 2; return st * 1024 + (ob ^ (((ob >> 9) & 1) * XM)); }
__host__ __device__ __forceinline__ void stage_rc(int b, int& R, int& C, int XM = 32) { const int st = b / 1024, sb = b % 1024, swz = sb ^ (((sb >> 9) & 1) * XM); R = (st >> 1) * 16 + swz / 64; C = (st & 1) * 32 + (swz % 64) / 2; }
__host__ __device__ __forceinline__ int perm32(int rho) { const int n = rho >> 4, i = rho & 15; return 8 * (i >> 2) + 4 * n + (i & 3); }
struct Unit { int pm, pn, kb; };
struct Gemm { const bf16_t* A; const bf16_t* Bt; int K, ld; const int* aidx; };
template <class Epi, class Sched, bool ALIGN_EPI = false, bool SP2 = false, bool GATHER = false, bool F8 = false>
__device__ __forceinline__ void gemm_phase(PG8_LAS unsigned char* lds, const Gemm g, const Sched& S, const Epi& E) {
    int tid_ = threadIdx.x; asm volatile("" : "+v"(tid_));
    const int tid = tid_, wid = __builtin_amdgcn_readfirstlane(tid >> 6), lane = tid & 63, wr = wid >> 2, wc = wid & 3, fr = lane & 15, fq = lane >> 4;
    const int K = g.K, LD = g.ld, nt = K / BK;
    unsigned voffA[2], voffB[2]; int RA[2]; unsigned CA2[2];
#pragma unroll
    for (int i = 0; i < 2; ++i) { int R, C; stage_rc(tid * 16 + i * 8192, R, C, F8 ? 48 : 32); const int Rb = Epi::PERM ? ((R & ~31) + perm32(R & 31)) : R;
        voffA[i] = (unsigned)(R * LD + C) * 2u; voffB[i] = (unsigned)(Rb * LD + C) * 2u; RA[i] = R; CA2[i] = (unsigned)C * 2u; }
    const size_t kstep = (size_t)(BK * 2);
    const size_t hstep = (size_t)HALF * LD * 2;
    const size_t tstep = 2 * hstep;
    const unsigned ldsw = (unsigned)wid * 1024u;
    const int aoff = lds_byte(wr * 64 + fr, F8 ? fq * 16 : fq * 8, F8 ? 48 : 32), boff = lds_byte(wc * 32 + fr, F8 ? fq * 16 : fq * 8, F8 ? 48 : 32);
    const int aoffh = aoff ^ 16, boffh = boff ^ 16;
    typedef int i32x8_t __attribute__((ext_vector_type(8)));
#define PG8_SA(b, h) (((b) * 2 + (h)) * HTB)
#define PG8_SB(b, h) ((4 + (b) * 2 + (h)) * HTB)
#define PG8_STAGE(bufoff, gbase, voff) do { _Pragma("unroll") for (int _i = 0; _i < 2; ++_i) \
        __builtin_amdgcn_global_load_lds((const unsigned*)((const char*)(gbase) + (voff)[_i]), (PG8_LAS unsigned*)(lds + (bufoff) + ldsw + _i * 8192), 16, 0, 0); } while (0)
#define PG8_GOFF(dst, unit) do { _Pragma("unroll") for (int _h = 0; _h < 2; ++_h) _Pragma("unroll") for (int _i = 0; _i < 2; ++_i) dst[_h][_i] = (unsigned)g.aidx[(unit).pm * 256 + _h * 128 + RA[_i]] * (unsigned)(LD * 2) + CA2[_i]; } while (0)
#define PG8_STAGE_A(bufoff, gbase, h, nx) do { if constexpr (GATHER) { unsigned _o[2] = {(nx) ? oN[h][0] : oC[h][0], (nx) ? oN[h][1] : oC[h][1]}; PG8_STAGE(bufoff, gbase, _o); } else { PG8_STAGE(bufoff, (gbase) + (h) * hstep, voffA); } } while (0)
#define PG8_LDA16(dst, b, h) do { _Pragma("unroll") for (int m = 0; m < 4; ++m) _Pragma("unroll") for (int k = 0; k < 2; ++k) dst[m][k] = *(const PG8_LAS bf16x8*)(lds + PG8_SA(b, h) + aoff + m * 2048 + k * 1024); } while (0)
#define PG8_LDB16(dst, b, h) do { _Pragma("unroll") for (int n = 0; n < 2; ++n) _Pragma("unroll") for (int k = 0; k < 2; ++k) dst[n][k] = *(const PG8_LAS bf16x8*)(lds + PG8_SB(b, h) + boff + n * 2048 + k * 1024); } while (0)
#define PG8_MMA16(ai, bj, At, Bt) do { __builtin_amdgcn_s_setprio(1); _Pragma("unroll") for (int m = 0; m < 4; ++m) _Pragma("unroll") for (int n = 0; n < 2; ++n) _Pragma("unroll") for (int k = 0; k < 2; ++k) \
        acc[ai][bj][m][n] = __builtin_amdgcn_mfma_f32_16x16x32_bf16(Bt[n][k], At[m][k], acc[ai][bj][m][n], 0, 0, 0); __builtin_amdgcn_s_setprio(0); } while (0)
#define PG8_LD32(p, lo, hi) __builtin_bit_cast(i32x8_t, __builtin_shufflevector(*(const PG8_LAS bf16x8*)((p) + (lo)), *(const PG8_LAS bf16x8*)((p) + (hi)), 0, 1, 2, 3, 4, 5, 6, 7, 8, 9, 10, 11, 12, 13, 14, 15))
#define PG8_LDA(dst, b, h) do { if constexpr (F8) { _Pragma("unroll") for (int m = 0; m < 4; ++m) dst##8[m] = PG8_LD32(lds + PG8_SA(b, h) + m * 2048, aoff, aoffh); } else { PG8_LDA16(dst, b, h); } } while (0)
#define PG8_LDB(dst, b, h) do { if constexpr (F8) { _Pragma("unroll") for (int n = 0; n < 2; ++n) dst##8[n] = PG8_LD32(lds + PG8_SB(b, h) + n * 2048, boff, boffh); } else { PG8_LDB16(dst, b, h); } } while (0)
#define PG8_MMA(ai, bj, At, Bt) do { if constexpr (F8) { __builtin_amdgcn_s_setprio(1); _Pragma("unroll") for (int m = 0; m < 4; ++m) _Pragma("unroll") for (int n = 0; n < 2; ++n) \
        asm volatile("v_mfma_f32_16x16x128_f8f6f4 %0, %1, %2, %0" : "+v"(acc[ai][bj][m][n]) : "v"(Bt##8[n]), "v"(At##8[m])); __builtin_amdgcn_s_setprio(0); } else { PG8_MMA16(ai, bj, At, Bt); } } while (0)
#define PG8_WAIT_V(n) asm volatile("s_waitcnt vmcnt(" #n ")" ::: "memory")
#define PG8_WAIT_L(n) asm volatile("s_waitcnt lgkmcnt(" #n ")" ::: "memory")
#define PG8_BAR __builtin_amdgcn_s_barrier()
#define PG8_SCHED __builtin_amdgcn_sched_barrier(0)
    Unit cur, nxt; int ui = 0;
    if (!S.next(0, cur)) return;
    unsigned oC[2][2] = {{0u, 0u}, {0u, 0u}}, oN[2][2] = {{0u, 0u}, {0u, 0u}};
    if constexpr (GATHER) PG8_GOFF(oC, cur);
    f32x4 acc[2][2][4][2];
#pragma unroll
    for (int a = 0; a < 2; ++a)
#pragma unroll
        for (int b = 0; b < 2; ++b)
#pragma unroll
            for (int m = 0; m < 4; ++m)
#pragma unroll
                for (int n = 0; n < 2; ++n) acc[a][b][m][n] = (f32x4){0.f, 0.f, 0.f, 0.f};
    bf16x8 At[4][2], B0[2][2], B1[2][2]; i32x8_t At8[4], B08[2], B18[2];
    const char* cA = GATHER ? (const char*)g.A + cur.kb : (const char*)g.A + (size_t)cur.pm * tstep + cur.kb; const char* cB = (const char*)g.Bt + (size_t)cur.pn * tstep + cur.kb;
    S.a_ready(cur);
    if constexpr (SP2) {
        PG8_STAGE(PG8_SB(0, 0), cB, voffB); PG8_STAGE(PG8_SB(0, 1), cB + hstep, voffB); PG8_STAGE_A(PG8_SA(0, 0), cA, 0, false); PG8_STAGE_A(PG8_SA(0, 1), cA, 1, false);
        if (wr == 1) PG8_BAR;
        PG8_WAIT_V(2); PG8_BAR;
        PG8_STAGE(PG8_SB(1, 0), cB + kstep, voffB); PG8_STAGE_A(PG8_SA(1, 0), cA + kstep, 0, false); PG8_STAGE(PG8_SB(1, 1), cB + hstep + kstep, voffB);
        PG8_WAIT_V(6); PG8_BAR;
    } else {
        PG8_STAGE(PG8_SB(0, 0), cB, voffB); PG8_STAGE_A(PG8_SA(0, 0), cA, 0, false); PG8_STAGE(PG8_SB(0, 1), cB + hstep, voffB); PG8_STAGE_A(PG8_SA(0, 1), cA, 1, false);
        if (wr == 1) PG8_BAR;
        PG8_WAIT_V(4); PG8_BAR;
        PG8_STAGE(PG8_SB(1, 0), cB + kstep, voffB); PG8_STAGE_A(PG8_SA(1, 0), cA + kstep, 0, false); PG8_STAGE(PG8_SB(1, 1), cB + hstep + kstep, voffB);
        PG8_WAIT_V(6); PG8_BAR;
    }
    for (;;) {
        const bool has_next = S.next(ui + 1, nxt);
        const char* nA = has_next ? (GATHER ? (const char*)g.A + nxt.kb : (const char*)g.A + (size_t)nxt.pm * tstep + nxt.kb) : cA;
        if constexpr (GATHER) { if (has_next) PG8_GOFF(oN, nxt); } const char* nB = has_next ? (const char*)g.Bt + (size_t)nxt.pn * tstep + nxt.kb : cB;
        for (int t = 0; t < nt; t += 2) {
            const bool last = (t == nt - 2); const bool lastn = last && has_next;
            const char* a1 = cA + (size_t)(t + 1) * kstep;
            const char* a2 = last ? nA : cA + (size_t)(t + 2) * kstep; const char* b2 = last ? nB : cB + (size_t)(t + 2) * kstep;
            const char* a3 = a2 + kstep; const char* b3 = b2 + kstep;
            if (last && has_next) S.a_ready(nxt);
            if constexpr (SP2) {
            PG8_LDB(B0, 0, 0); PG8_LDB(B1, 0, 1); PG8_SCHED; PG8_LDA(At, 0, 0); PG8_STAGE_A(PG8_SA(1, 1), a1, 1, false);
            PG8_WAIT_V(8); PG8_WAIT_L(0); PG8_BAR; PG8_MMA(0, 0, At, B0); PG8_MMA(0, 1, At, B1); PG8_BAR; PG8_SCHED;
            PG8_LDA(At, 0, 1); PG8_STAGE(PG8_SB(0, 0), b2, voffB); PG8_STAGE(PG8_SB(0, 1), b2 + hstep, voffB); PG8_STAGE_A(PG8_SA(0, 0), a2, 0, lastn);
            PG8_WAIT_V(8); PG8_WAIT_L(0); PG8_BAR; PG8_MMA(1, 0, At, B0); PG8_MMA(1, 1, At, B1); PG8_BAR; PG8_SCHED;
            PG8_LDB(B0, 1, 0); PG8_LDB(B1, 1, 1); PG8_SCHED; PG8_LDA(At, 1, 0); PG8_STAGE_A(PG8_SA(0, 1), a2, 1, lastn);
            PG8_WAIT_V(8); PG8_WAIT_L(0); PG8_BAR; PG8_MMA(0, 0, At, B0); PG8_MMA(0, 1, At, B1); PG8_BAR; PG8_SCHED;
            PG8_LDA(At, 1, 1); PG8_STAGE(PG8_SB(1, 0), b3, voffB); PG8_STAGE(PG8_SB(1, 1), b3 + hstep, voffB); PG8_STAGE_A(PG8_SA(1, 0), a3, 0, lastn);
            PG8_WAIT_V(8); PG8_WAIT_L(0); PG8_BAR; PG8_MMA(1, 0, At, B0); PG8_MMA(1, 1, At, B1); PG8_BAR; PG8_SCHED;
            } else {
            PG8_LDB(B0, 0, 0); PG8_SCHED; PG8_LDA(At, 0, 0); PG8_STAGE_A(PG8_SA(1, 1), a1, 1, false);
            PG8_WAIT_L(8); PG8_BAR; PG8_WAIT_L(0); PG8_MMA(0, 0, At, B0); PG8_BAR; PG8_SCHED;
            PG8_LDB(B1, 0, 1); PG8_STAGE(PG8_SB(0, 0), b2, voffB);
            PG8_BAR; PG8_WAIT_L(0); PG8_MMA(0, 1, At, B1); PG8_BAR;
            PG8_LDA(At, 0, 1); PG8_STAGE_A(PG8_SA(0, 0), a2, 0, lastn);
            PG8_BAR; PG8_WAIT_L(0); PG8_MMA(1, 0, At, B0); PG8_BAR; PG8_SCHED;
            PG8_STAGE(PG8_SB(0, 1), b2 + hstep, voffB);
            PG8_WAIT_V(6); PG8_BAR; PG8_MMA(1, 1, At, B1); PG8_BAR;
            PG8_LDB(B0, 1, 0); PG8_SCHED; PG8_LDA(At, 1, 0); PG8_STAGE_A(PG8_SA(0, 1), a2, 1, lastn);
            PG8_WAIT_L(8); PG8_BAR; PG8_WAIT_L(0); PG8_MMA(0, 0, At, B0); PG8_BAR; PG8_SCHED;
            PG8_LDB(B1, 1, 1); PG8_STAGE(PG8_SB(1, 0), b3, voffB);
            PG8_BAR; PG8_WAIT_L(0); PG8_MMA(0, 1, At, B1); PG8_BAR;
            PG8_LDA(At, 1, 1); PG8_STAGE_A(PG8_SA(1, 0), a3, 0, lastn);
            PG8_BAR; PG8_WAIT_L(0); PG8_MMA(1, 0, At, B0); PG8_BAR; PG8_SCHED;
            PG8_STAGE(PG8_SB(1, 1), b3 + hstep, voffB);
            PG8_WAIT_V(6); PG8_BAR; PG8_MMA(1, 1, At, B1); PG8_BAR;
            }
        }
        if constexpr (ALIGN_EPI) { if (wr == 0) PG8_BAR; }
        if constexpr (F8) {
#pragma unroll
            for (int a = 0; a < 2; ++a)
#pragma unroll
                for (int b = 0; b < 2; ++b)
                    asm volatile("s_nop 15\n\ts_nop 7" : "+v"(acc[a][b][0][0]), "+v"(acc[a][b][0][1]), "+v"(acc[a][b][1][0]), "+v"(acc[a][b][1][1]), "+v"(acc[a][b][2][0]), "+v"(acc[a][b][2][1]), "+v"(acc[a][b][3][0]), "+v"(acc[a][b][3][1])); }
        if constexpr (!Epi::AFTER_DRAIN) { E(acc, cur, wr, wc, fr, fq); S.done(cur); }
        if (!has_next) break;
#pragma unroll
        for (int a = 0; a < 2; ++a)
#pragma unroll
            for (int b = 0; b < 2; ++b)
#pragma unroll
                for (int m = 0; m < 4; ++m)
#pragma unroll
                    for (int n = 0; n < 2; ++n) acc[a][b][m][n] = (f32x4){0.f, 0.f, 0.f, 0.f};
        cur = nxt; cA = nA; cB = nB; ++ui;
        if constexpr (GATHER) { oC[0][0] = oN[0][0]; oC[0][1] = oN[0][1]; oC[1][0] = oN[1][0]; oC[1][1] = oN[1][1]; }
        if constexpr (ALIGN_EPI) { if (wr == 1) PG8_BAR; }
    }
    PG8_WAIT_V(0);
    if constexpr (!ALIGN_EPI) { if (wr == 0) PG8_BAR; }
    PG8_BAR;
    if constexpr (Epi::AFTER_DRAIN) { E.fused(acc, cur, wr, wc, fr, fq, lds, wid, lane); S.done(cur); }
#undef PG8_SA
#undef PG8_SB
#undef PG8_STAGE
#undef PG8_STAGE_A
#undef PG8_GOFF
#undef PG8_LDA
#undef PG8_LDA16
#undef PG8_LD32
#undef PG8_LDB16
#undef PG8_MMA16
#undef PG8_LDB
#undef PG8_MMA
#undef PG8_WAIT_V
#undef PG8_WAIT_L
#undef PG8_BAR
#undef PG8_SCHED
}
}
using pg8::Unit; using pg8::Gemm;
struct ChunkMap { int x, loc, nx, chunk;
    __device__ void init(int G, int bid) { if (G % 8 == 0) { nx = 8; chunk = G / 8; x = bid % 8; loc = bid / 8; } else { nx = 1; chunk = G; x = 0; loc = bid; } }
    __device__ __forceinline__ int lin(int i) const { return (i * nx + x) * chunk + loc; } };
struct PlainOrder {
    int nN, total; ChunkMap cm;
    __device__ bool next(int i, Unit& u) const { const int L = cm.lin(i); if (L >= total) return false; u.pm = L / nN; u.pn = L % nN; u.kb = 0; return true; }
    __device__ __forceinline__ void a_ready(const Unit&) const {}
    __device__ __forceinline__ void done(const Unit&) const {}
};
struct QkvOrder { ChunkMap cm;
    __device__ bool next(int i, Unit& u) const { const int L = cm.lin(i); if (L >= 288) return false;
        if (L >= 32 && L < 128) { const int r = L - 32; u.pm = r >> 1; u.pn = 4 + (r & 1); } else { const int r = L < 32 ? L : L - 96; u.pm = r >> 2; u.pn = r & 3; }
        u.kb = 0; return true; }
    __device__ __forceinline__ void a_ready(const Unit&) const {}
    __device__ __forceinline__ void done(const Unit&) const {}
};
struct SplitKOrder {
    int nN, ks, kbytes, total; ChunkMap cm;
    __device__ bool next(int i, Unit& u) const { const int L = cm.lin(i); if (L >= total) return false; const int t = L / ks; u.pm = t / nN; u.pn = t % nN; u.kb = (L % ks) * kbytes; return true; }
    __device__ __forceinline__ void a_ready(const Unit&) const {}
    __device__ __forceinline__ void done(const Unit&) const {}
};
struct GroupedOrder {
    int mt, nt, ks, kbytes; ChunkMap cm;
    __device__ bool next(int i, Unit& u) const { const int L = cm.lin(i), per = mt * nt * ks; if (L >= NE * per) return false; const int e = L / per, r = L % per, m = r / (nt * ks), q = r % (nt * ks);
        u.pm = e * mt + m; u.pn = e * nt + q / ks; u.kb = (q % ks) * kbytes; return true; }
    __device__ __forceinline__ void a_ready(const Unit&) const {}
    __device__ __forceinline__ void done(const Unit&) const {}
};
constexpr int DOWN_FULL_PANELS = 64;
struct DownOrder { int half; ChunkMap cm;
    __device__ bool next(int i, Unit& u) const { const int L = cm.lin(i); if (L >= 256) return false; const int T = half ? 256 + (L >> 1) : L; u.pm = T >> 2; u.pn = (u.pm / 6) * 4 + (T & 3); u.kb = half ? (L & 1) * 1024 : 0; return true; }
    __device__ __forceinline__ void a_ready(const Unit&) const {}
    __device__ __forceinline__ void done(const Unit&) const {}
};
struct EpiF32 { float* C; int ldc; size_t kstride; static constexpr bool PERM = false, AFTER_DRAIN = false;
    __device__ __forceinline__ void operator()(const f32x4 (&acc)[2][2][4][2], const Unit& u, int wr, int wc, int fr, int fq) const {
#pragma unroll
        for (int ai = 0; ai < 2; ++ai)
#pragma unroll
            for (int m = 0; m < 4; ++m) { float* rp = C + (u.kb ? kstride : (size_t)0) + (size_t)(u.pm * 256 + ai * 128 + wr * 64 + m * 16 + fr) * ldc + u.pn * 256 + wc * 32 + 4 * fq;
#pragma unroll
                for (int bj = 0; bj < 2; ++bj)
#pragma unroll
                    for (int n = 0; n < 2; ++n) *(f32x4*)(rp + bj * 128 + n * 16) = acc[ai][bj][m][n]; }
    }
};
struct EpiBf16P { bf16* C; int ldc; static constexpr bool PERM = true, AFTER_DRAIN = false;
    __device__ __forceinline__ void operator()(const f32x4 (&acc)[2][2][4][2], const Unit& u, int wr, int wc, int fr, int fq) const {
#pragma unroll
        for (int ai = 0; ai < 2; ++ai)
#pragma unroll
            for (int m = 0; m < 4; ++m) { bf16* rp = C + (size_t)(u.pm * 256 + ai * 128 + wr * 64 + m * 16 + fr) * ldc + u.pn * 256 + wc * 32 + 8 * fq;
#pragma unroll
                for (int bj = 0; bj < 2; ++bj) { const f32x4 v0 = acc[ai][bj][m][0], v1 = acc[ai][bj][m][1]; u32x4 w; w.x = cvtpk(v0[0], v0[1]); w.y = cvtpk(v0[2], v0[3]); w.z = cvtpk(v1[0], v1[1]); w.w = cvtpk(v1[2], v1[3]);
                    *(u32x4*)(rp + bj * 128) = w; } }
    }
};
__device__ __forceinline__ float silu_f(float x) { return x * __builtin_amdgcn_rcpf(1.f + __builtin_amdgcn_exp2f(-x * LOG2E)); }
struct EpiSwiglu { unsigned char* HID; static constexpr bool PERM = true, AFTER_DRAIN = false;
    __device__ __forceinline__ void operator()(const f32x4 (&acc)[2][2][4][2], const Unit& u, int wr, int wc, int fr, int fq) const {
        const int cb = (u.pn & 15) * 128 + wc * 32 + 8 * fq; constexpr float IS = 1.f / W8_SCALE;
#pragma unroll
        for (int ai = 0; ai < 2; ++ai)
#pragma unroll
            for (int m = 0; m < 4; ++m) { unsigned char* rp = HID + (size_t)(u.pm * 256 + ai * 128 + wr * 64 + m * 16 + fr) * FF + cb; u32x2 w;
#pragma unroll
                for (int n = 0; n < 2; ++n) { const f32x4 g = acc[ai][0][m][n] * IS, up = acc[ai][1][m][n] * (IS * H8_SCALE);
                    const unsigned pk = pk4_fp8(silu_f(g[0]) * up[0], silu_f(g[1]) * up[1], silu_f(g[2]) * up[2], silu_f(g[3]) * up[3]); if (n == 0) w.x = pk; else w.y = pk; }
                *(u32x2*)rp = w; asm volatile("" ::: "memory"); }
    }
};
struct EpiDown { unsigned char* YE; const float* gate; static constexpr bool PERM = true, AFTER_DRAIN = false;
    __device__ __forceinline__ void operator()(const f32x4 (&acc)[2][2][4][2], const Unit& u, int wr, int wc, int fr, int fq) const {
        const int cb = (u.pn & 3) * 256 + wc * 32 + 8 * fq;
#pragma unroll
        for (int ai = 0; ai < 2; ++ai)
#pragma unroll
            for (int m = 0; m < 4; ++m) { const int row = u.pm * 256 + ai * 128 + wr * 64 + m * 16 + fr; const float gv = gate[row] * (YE8_SCALE / (W8_SCALE * H8_SCALE)); unsigned char* rp = YE + (size_t)(u.kb ? NSLOTS : 0) * D + (size_t)row * D + cb;
#pragma unroll
                for (int bj = 0; bj < 2; ++bj) { const f32x4 v0 = acc[ai][bj][m][0] * gv, v1 = acc[ai][bj][m][1] * gv; u32x2 w;
                    w.x = pk4_fp8(clamp8(v0[0]), clamp8(v0[1]), clamp8(v0[2]), clamp8(v0[3])); w.y = pk4_fp8(clamp8(v1[0]), clamp8(v1[1]), clamp8(v1[2]), clamp8(v1[3])); *(u32x2*)(rp + bj * 128) = w; } }
    }
};

#if MK_CHECK
__device__ __forceinline__ float fp8f(const unsigned char* p, int i) { const int w = ((const int*)p)[i >> 2]; const int b = i & 3; return b == 0 ? __builtin_amdgcn_cvt_f32_fp8(w, 0) : b == 1 ? __builtin_amdgcn_cvt_f32_fp8(w, 1) : b == 2 ? __builtin_amdgcn_cvt_f32_fp8(w, 2) : __builtin_amdgcn_cvt_f32_fp8(w, 3); }
__device__ __forceinline__ float dot_fp8(const unsigned char* a, const unsigned char* b, int K, int lane) { float s = 0.f; for (int k = lane; k < K; k += 64) s += fp8f(a, k) * fp8f(b, k); return wave_sum(s); }
__device__ __forceinline__ float dot_bf16(const bf16* a, const bf16* b, int K, int lane) {
    float s = 0.f; for (int k = lane; k < K; k += 64) s += bf2f(a[k]) * bf2f(b[k]); return wave_sum(s);
}
#endif

__constant__ double INVF[16] = {1.0, 0.5623413251903491, 0.31622776601683794, 0.1778279410038923, 0.1, 0.05623413251903491, 0.03162277660168379, 0.01778279410038923,
                                0.01, 0.005623413251903491, 0.0031622776601683794, 0.0017782794100389228, 0.001, 0.0005623413251903491, 0.00031622776601683794, 0.00017782794100389227};
__device__ __forceinline__ void sincos_d(double a, float& s, float& c) {
    const double k = __builtin_rint(a * 0.6366197723675814), r = a - k * 1.5707963267948966, r2 = r * r;
    const double sr = r * (1.0 + r2 * (-1.0 / 6 + r2 * (1.0 / 120 + r2 * (-1.0 / 5040 + r2 * (1.0 / 362880 + r2 * (-1.0 / 39916800 + r2 * (1.0 / 6227020800.0)))))));
    const double cr = 1.0 + r2 * (-0.5 + r2 * (1.0 / 24 + r2 * (-1.0 / 720 + r2 * (1.0 / 40320 + r2 * (-1.0 / 3628800 + r2 * (1.0 / 479001600.0))))));
    const int q = ((int)k) & 3;
    const double ss = (q == 0) ? sr : (q == 1) ? cr : (q == 2) ? -sr : -cr;
    const double cc = (q == 0) ? cr : (q == 1) ? -sr : (q == 2) ? -cr : sr;
    s = (float)ss; c = (float)cc;
}
__device__ __forceinline__ void conv_load(f32x4 (&v)[16], const float* W, int N, int k0, int n0, int lane) {
    const int r4 = lane >> 4, c16 = lane & 15, n = n0 + 4 * c16;
    if (n >= N) return;
    const float* src = W + (size_t)(k0 + 16 * r4) * N + n;
#pragma unroll
    for (int i = 0; i < 16; ++i) v[i] = *(const f32x4*)(src + (size_t)i * N);
}
__device__ __forceinline__ void conv_store(const f32x4 (&v)[16], int N, bf16* WT, size_t rowbase, int ldk, int k0, int n0, int lane) {
    const int r4 = lane >> 4, c16 = lane & 15, n = n0 + 4 * c16;
    if (n >= N) return;
    bf16* dst = WT + (rowbase + 4 * c16) * (size_t)ldk + k0 + 16 * r4;
#pragma unroll
    for (int e = 0; e < 4; ++e) {
        u32x4 lo, hi;
        lo.x = cvtpk(v[0][e], v[1][e]); lo.y = cvtpk(v[2][e], v[3][e]); lo.z = cvtpk(v[4][e], v[5][e]); lo.w = cvtpk(v[6][e], v[7][e]);
        hi.x = cvtpk(v[8][e], v[9][e]); hi.y = cvtpk(v[10][e], v[11][e]); hi.z = cvtpk(v[12][e], v[13][e]); hi.w = cvtpk(v[14][e], v[15][e]);
        *(u32x4*)(dst + (size_t)e * ldk) = lo; *(u32x4*)(dst + (size_t)e * ldk + 8) = hi;
    }
}
__device__ __forceinline__ void conv_item(const float* W, int N, bf16* WT, size_t rowbase, int ldk, int k0, int n0, int lane) {
    f32x4 v[16]; conv_load(v, W, N, k0, n0, lane); conv_store(v, N, WT, rowbase, ldk, k0, n0, lane);
}
__device__ __forceinline__ void glds16(const void* gsrc, unsigned lds_dst) { unsigned keep;
    asm volatile("s_mov_b32 %0, m0\n\ts_mov_b32 m0, %2\n\ts_nop 0\n\tglobal_load_lds_dwordx4 %1, off\n\ts_mov_b32 m0, %0" : "=&s"(keep) : "v"(gsrc), "s"(lds_dst) : "memory"); }
__device__ __forceinline__ void glds16_nt(const void* gsrc, unsigned lds_dst) { unsigned keep;
    asm volatile("s_mov_b32 %0, m0\n\ts_mov_b32 m0, %2\n\ts_nop 0\n\tglobal_load_lds_dwordx4 %1, off nt\n\ts_mov_b32 m0, %0" : "=&s"(keep) : "v"(gsrc), "s"(lds_dst) : "memory"); }
__device__ __forceinline__ void conv_issue8(unsigned lds_scr, const float* W, int N, int k0, int n0, int lane) {
    const float* src = W + (size_t)(k0 + 8 * (lane >> 4)) * N + n0 + 4 * (lane & 15);
#pragma unroll
    for (int i = 0; i < 8; ++i) glds16_nt(src + (size_t)i * N, (unsigned)__builtin_amdgcn_readfirstlane(lds_scr + i * 1024));
}
__device__ __forceinline__ void conv_fetch8(f32x4 (&v)[8], const LAS unsigned char* scr, int lane) {
#pragma unroll
    for (int i = 0; i < 8; ++i) v[i] = *(const LAS f32x4*)(scr + i * 1024 + lane * 16);
}
__device__ __forceinline__ void conv_load8(f32x4 (&v)[8], const float* W, int N, int k0, int n0, int lane) {
    const float* src = W + (size_t)(k0 + 8 * (lane >> 4)) * N + n0 + 4 * (lane & 15);
#pragma unroll
    for (int i = 0; i < 8; ++i) v[i] = __builtin_nontemporal_load((const f32x4*)(src + (size_t)i * N));
}
__device__ __forceinline__ void conv_store8(const f32x4 (&v)[8], unsigned char* WT, size_t rowbase, int ldk, int k0, int lane) {
    unsigned char* dst = WT + (rowbase + 4 * (lane & 15)) * (size_t)ldk + k0 + 8 * (lane >> 4);
#pragma unroll
    for (int e = 0; e < 4; ++e) { u32x2 w; w.x = pk4_fp8(v[0][e] * W8_SCALE, v[1][e] * W8_SCALE, v[2][e] * W8_SCALE, v[3][e] * W8_SCALE); w.y = pk4_fp8(v[4][e] * W8_SCALE, v[5][e] * W8_SCALE, v[6][e] * W8_SCALE, v[7][e] * W8_SCALE);
        *(u32x2*)(dst + (size_t)e * ldk) = w; }
}
struct ConvJob { const float* gate; const float* up; const float* down; unsigned char* wgu; unsigned char* wd; };
constexpr int CV_PER_LAYER = 3 * 16 * 1024, CV_TOTAL = 4 * CV_PER_LAYER;
struct ConvItem { const float* W; unsigned char* WT; size_t rowbase; int N, ldk, k0, n0; };
__device__ __forceinline__ ConvItem cv_decode(const ConvJob& J, int it) {
    ConvItem c; const int L = it / CV_PER_LAYER, r0 = it % CV_PER_LAYER, fam = r0 >> 14, r = r0 & 16383, e = L * 16 + (r >> 10), q = r & 1023;
    if (fam < 2) { c.W = (fam ? J.up : J.gate) + (size_t)e * 1024 * 2048; c.N = 2048; c.k0 = (q >> 5) * 32; c.n0 = (q & 31) * 64; c.WT = J.wgu; c.ldk = 1024; c.rowbase = (size_t)e * 4096 + (c.n0 >> 7) * 256 + (c.n0 & 127) + (fam ? 128 : 0); }
    else { c.W = J.down + (size_t)e * 2048 * 1024; c.N = 1024; c.k0 = (q >> 4) * 32; c.n0 = (q & 15) * 64; c.WT = J.wd; c.ldk = 2048; c.rowbase = (size_t)e * 1024 + c.n0; }
    return c;
}
template <class RowBase>
__device__ __forceinline__ void conv_family(const Frame& F, const float* W, int K, int N, int nmat, bf16* WT, const RowBase& rb) {
    const int nblk = (N + 63) / 64, per = (K / 64) * nblk, total = per * nmat;
    for (int it = F.gw; it < total; it += F.NGW) {
        const int mi = it / per, r = it % per, kb = r / nblk, nb = r % nblk;
        conv_item(W + (size_t)mi * K * N, N, WT, rb(mi, nb * 64), K, kb * 64, nb * 64, F.lane);
    }
}

__device__ __forceinline__ void ada_direct(const Frame& F, const Args& a, int l, int b0) {
    const int cg = F.bid - b0; if (cg < 0 || cg >= 192) return;
    LAS float* sc = (LAS float*)F.lds;
    LAS float* red = (LAS float*)(F.lds + 20480);
    for (int i = F.tid; i < 5 * D; i += 512) { const int c = i >> 10, k = i & 1023; const float x = (c == 0) ? a.in[7][k] : a.in[6][(c - 1) * D + k]; sc[i] = x / (1.f + __expf(-x)); }
    __syncthreads();
    const int col = F.tid & 31, kg = F.tid >> 5, n = cg * 32 + col;
    const float* w = a.in[8] + ((size_t)l * D + kg * 64) * 6144 + n;
    float acc[5] = {0.f, 0.f, 0.f, 0.f, 0.f};
#pragma unroll 16
    for (int k = 0; k < 64; ++k) { const float wv = w[(size_t)k * 6144];
#pragma unroll
        for (int c = 0; c < 5; ++c) acc[c] += sc[c * D + kg * 64 + k] * wv; }
#pragma unroll
    for (int c = 0; c < 5; ++c) red[(kg * 5 + c) * 32 + col] = acc[c];
    __syncthreads();
    if (F.tid < 160) { const int c = F.tid >> 5; float s = a.in[9][l * 6144 + n];
#pragma unroll
        for (int g = 0; g < 16; ++g) s += red[(g * 5 + c) * 32 + col];
        ((float*)(F.ws + WS_ADA))[(size_t)(l * 5 + c) * 6144 + n] = s; }
    __syncthreads();
}
__device__ __forceinline__ void phase_prologue(const Frame& F, const Args& a) {
    ada_direct(F, a, 0, 0);
    {
        float* R64 = (float*)(F.ws + WS_ROPE64); float* R32 = (float*)(F.ws + WS_ROPE32);
        for (int i = F.bid * 512 + F.tid; i < 2048 * 32; i += F.G * 512) { const int pos = i >> 5, j = i & 31; const double ang = (j < 16) ? (double)(pos >> 6) * INVF[j] : (double)(pos & 63) * INVF[j - 16];
            float s, c; sincos_d(ang, s, c); R64[i] = c; R64[2048 * 32 + i] = s; }
        for (int i = F.bid * 512 + F.tid; i < 2048 * 16; i += F.G * 512) { const int pos = i >> 4, j = i & 15; const double ang = (j < 8) ? (double)(pos >> 6) * INVF[2 * j] : (double)(pos & 63) * INVF[2 * (j - 8)];
            float s, c; sincos_d(ang, s, c); R32[i] = c; R32[2048 * 16 + i] = s; }
    }
    __syncthreads();
    for (int rep = 0; rep < MK_REP_CONV; ++rep) {
    bf16* WQKV = (bf16*)(F.ws + WS_WQKV); bf16* WO = (bf16*)(F.ws + WS_WO);
    conv_family(F, a.in[12], 1024, 1536, 2, WQKV, [](int mi, int n0) { return (size_t)(mi == 0 ? 0 : 2) * 1536 + n0; });
    conv_family(F, a.in[16], 1024, 1536, 1, WQKV, [](int mi, int n0) { return (size_t)1536 + n0; });
    conv_family(F, a.in[15], 1024, 1024, 2, WO, [](int mi, int n0) { return (size_t)(mi == 0 ? 0 : 3) * 1024 + n0; });
    conv_family(F, a.in[18], 1024, 1024, 1, WO, [](int mi, int n0) { return (size_t)1024 + n0; });
    conv_family(F, a.in[24], 1024, 1024, 1, WO, [](int mi, int n0) { return (size_t)2048 + n0; });
    conv_family(F, a.in[19], 1024, 416, 1, (bf16*)(F.ws + WS_WDN), [](int mi, int n0) { return (size_t)n0; });
    conv_family(F, a.in[21], 256, 1536, 1, (bf16*)(F.ws + WS_WUQ), [](int mi, int n0) { return (size_t)n0; });
    conv_family(F, a.in[23], 128, 2048, 1, (bf16*)(F.ws + WS_WUKV), [](int mi, int n0) { return (size_t)n0; });
    }
    { u32x4* z = (u32x4*)((bf16*)(F.ws + WS_WDN) + 416 * 1024); for (int i = F.bid * 512 + F.tid; i < 96 * 1024 / 8; i += F.G * 512) z[i] = (u32x4){0u, 0u, 0u, 0u}; }
}
__device__ __forceinline__ void phase_ada_reduce(const Frame& F, const Args& a) {
    const float* ADAP = (const float*)(F.ws + WS_ADAP); float* ADA = (float*)(F.ws + WS_ADA);
    for (int i = F.bid * 512 + F.tid; i < 4 * 5 * 6144; i += F.G * 512) {
        const int l = i / 30720, r = i % 30720, c = r / 6144, n = r % 6144;
        float s = a.in[9][l * 6144 + n];
        for (int kc = 0; kc < 16; ++kc) s += ADAP[((size_t)(kc * 4 + l) * 5 + c) * 6144 + n];
        ADA[i] = s;
    }
}
__device__ __forceinline__ const float* ada_vec(const Frame& F, int l, int c, int k) { return (const float*)(F.ws + WS_ADA) + ((size_t)(l * 5 + c) * 6 + k) * D; }

__device__ __forceinline__ void phase_mod0(const Frame& F, const Args& a) {
    bf16* X = (bf16*)(F.ws + WS_X); bf16* H = (bf16*)(F.ws + WS_H);
    const int RPW = (NTOK + F.NGW - 1) / F.NGW, rbeg = F.gw * RPW, rend = (rbeg + RPW < NTOK) ? rbeg + RPW : NTOK; int ccur = -1;
    f32x4 shv[4], scv[4];
#pragma unroll
    for (int j = 0; j < 4; ++j) { shv[j] = (f32x4){0.f, 0.f, 0.f, 0.f}; scv[j] = shv[j]; }
    for (int row = rbeg; row < rend; ++row) {
        const int c = cond_of(row);
        if (c != ccur) { ccur = c; const f32x4* sh = (const f32x4*)ada_vec(F, 0, c, 0); const f32x4* sc = (const f32x4*)ada_vec(F, 0, c, 1);
#pragma unroll
            for (int j = 0; j < 4; ++j) { shv[j] = sh[F.lane + 64 * j]; scv[j] = sc[F.lane + 64 * j] + 1.f; } }
        const f32x4* xi = (const f32x4*)((row < NCTX) ? a.in[0] + (size_t)row * D : a.in[1] + (size_t)(row - NCTX) * D);
#pragma unroll
        for (int j = 0; j < 4; ++j) { const int q = F.lane + 64 * j; const f32x4 x = xi[q]; ((u32x2*)(X + (size_t)row * D))[q] = pk4(x); ((u32x2*)(H + (size_t)row * D))[q] = pk4(x * scv[j] + shv[j]); }
    }
}

__device__ __forceinline__ size_t kb_off(int HK, int DK, bool lat, int b, int hk) { return lat ? (size_t)16 * HK * 256 * DK + ((size_t)(b * HK + hk) * 2560) * DK : ((size_t)(b * HK + hk) * 256) * DK; }
__device__ __forceinline__ size_t vt_off(int HK, bool lat, int b, int hk) { return lat ? (size_t)16 * HK * 64 * 256 + ((size_t)(b * HK + hk) * 64) * 2560 : ((size_t)(b * HK + hk) * 64) * 256; }
__device__ __forceinline__ int swap23(int k) { return (k & ~12) | ((k & 4) << 1) | ((k & 8) >> 1); }
__device__ __forceinline__ void vt_store(bf16* dst, const float (&vr)[64]) {
#pragma unroll
    for (int q = 0; q < 8; ++q) { const int b = 16 * (q >> 1) + 4 * (q & 1); u32x4 w; w.x = cvtpk(vr[b], vr[b + 1]); w.y = cvtpk(vr[b + 2], vr[b + 3]); w.z = cvtpk(vr[b + 8], vr[b + 9]); w.w = cvtpk(vr[b + 10], vr[b + 11]); ((u32x4*)dst)[q] = w; }
}

__device__ __forceinline__ void phase_kv_post(const Frame& F, const Args& a, int kind, int j, int slot, int gw, int NGW) {
    const bf16* QKV = (const bf16*)(F.ws + WS_QKV); bf16* Kb = (bf16*)(F.ws + WS_KB); bf16* Vt = (bf16*)(F.ws + WS_VT);
    const float* R64 = (const float*)(F.ws + WS_ROPE64);
    int lane_ = F.lane; asm volatile("" : "+v"(lane_)); const int lane = lane_, l16 = lane & 15, hk = lane >> 4;
    for (int it = gw * 64 + lane; it < 16 * 8192; it += NGW * 64) {
        const int bh = it >> 13, q = it & 8191, b = bh >> 2, hc = bh & 3;
        const f32x4 v = *(const f32x4*)(a.in[2] + ((size_t)((b * 3 + slot) * 4 + hc) * 512) * 64 + 4 * q);
        u32x2 w; w.x = cvtpk(v[0], v[1]); w.y = cvtpk(v[2], v[3]);
        *(u32x2*)(Kb + kb_off(4, 64, true, b, hc) + (size_t)2048 * 64 + 4 * q) = w;
    }
    for (int it = gw; it < 4 * 4 * 8; it += NGW) {
        const int b = it >> 5, hv = (it >> 3) & 3, tl = it & 7;
        float vr[64];
#pragma unroll
        for (int i = 0; i < 64; ++i) vr[i] = a.in[3][((size_t)((b * 3 + slot) * 4 + hv) * 512 + tl * 64 + i) * 64 + lane];
        vt_store(Vt + vt_off(4, true, b, hv) + (size_t)lane * 2560 + 2048 + tl * 64, vr);
    }
    f32x4 kn = (f32x4){1.f, 1.f, 1.f, 1.f}; if (kind == 0) kn = *(const f32x4*)(a.in[14] + j * 64 + 4 * l16);
    {
        const int RPW = (NTOK + NGW - 1) / NGW, rbeg = gw * RPW, rend = (rbeg + RPW < NTOK) ? rbeg + RPW : NTOK;
        u32x2 wqn = (u32x2){0u, 0u}; f32x4 cn = (f32x4){0.f, 0.f, 0.f, 0.f}, snn = cn;
        if (rbeg < rend) { wqn = *(const u32x2*)(QKV + (size_t)rbeg * 1536 + 1024 + 4 * lane);
            if (rbeg >= NCTX) { const int s0 = (rbeg - NCTX) & 2047; cn = *(const f32x4*)(R64 + s0 * 32 + 4 * (lane & 7)); snn = *(const f32x4*)(R64 + 2048 * 32 + s0 * 32 + 4 * (lane & 7)); } }
        for (int t = rbeg; t < rend; ++t) {
            const bool lat = t >= NCTX; const int b = lat ? (t - NCTX) >> 11 : t >> 8, s = lat ? (t - NCTX) & 2047 : t & 255;
            const u32x2 wq = wqn; const f32x4 c = cn, sn = snn;
            if (t + 1 < rend) { wqn = *(const u32x2*)(QKV + (size_t)(t + 1) * 1536 + 1024 + 4 * lane);
                if (t + 1 >= NCTX) { const int s1 = (t + 1 - NCTX) & 2047; cn = *(const f32x4*)(R64 + s1 * 32 + 4 * (lane & 7)); snn = *(const f32x4*)(R64 + 2048 * 32 + s1 * 32 + 4 * (lane & 7)); } }
            f32x4 v = bf4(wq);
            if (kind == 0) { float ss = (v[0] * v[0] + v[1] * v[1]) + (v[2] * v[2] + v[3] * v[3]); ss = sum16(ss);
                v = v * (__builtin_amdgcn_rsqf(ss * (1.f / 64.f) + 1e-6f)) * kn; }
            if (lat) { f32x4 p; p[0] = dppf<DPP_X8>(v[0]); p[1] = dppf<DPP_X8>(v[1]); p[2] = dppf<DPP_X8>(v[2]); p[3] = dppf<DPP_X8>(v[3]);
                v = (lane & 8) ? v * c + p * sn : v * c - p * sn; }
            *(u32x2*)(Kb + kb_off(4, 64, lat, b, hk) + (size_t)s * 64 + 4 * l16) = pk4(v);
            if (!lat) *(f32x4*)(F.out + OFF_NK + ((size_t)((b * 3 + slot) * 4 + hk) * 256 + s) * 64 + 4 * l16) = v;
        }
    }
    for (int it = gw; it < (NTOK / 64) * 4; it += NGW) {
        const int tt = it >> 2, hv = it & 3, t0 = tt * 64; const bool lat = t0 >= NCTX; const int b = lat ? (t0 - NCTX) >> 11 : t0 >> 8, s0 = lat ? (t0 - NCTX) & 2047 : t0 & 255;
        float vr[64];
#pragma unroll
        for (int i = 0; i < 64; ++i) vr[i] = bf2f(QKV[(size_t)(t0 + i) * 1536 + 1280 + hv * 64 + lane]);
        vt_store(Vt + vt_off(4, lat, b, hv) + (size_t)lane * (lat ? 2560 : 256) + s0, vr);
        if (!lat) {
#pragma unroll
            for (int i = 0; i < 64; ++i) F.out[OFF_NV + ((size_t)((b * 3 + slot) * 4 + hv) * 256 + s0 + i) * 64 + lane] = vr[i]; }
    }
}

__device__ __forceinline__ void phase_mla_post1(const Frame& F, const Args& a) {
    const float* DWN = (const float*)(F.ws + WS_QKV); bf16* QA = (bf16*)(F.ws + WS_QA); bf16* CKVA = (bf16*)(F.ws + WS_CKVA); bf16* Kb = (bf16*)(F.ws + WS_KB);
    const float* R32 = (const float*)(F.ws + WS_ROPE32);
    int lane_ = F.lane; asm volatile("" : "+v"(lane_)); const int lane = lane_;
    const f32x4 qn = ((const f32x4*)a.in[20])[lane]; const f32x4 kvn = ((const f32x4*)a.in[22])[lane & 31];
    for (int t = F.gw; t < NTOK + 2048; t += F.NGW) {
        if (t < NTOK) {
            const bool lat = t >= NCTX; const int b = lat ? (t - NCTX) >> 11 : t >> 8, s = lat ? (t - NCTX) & 2047 : t & 255;
            const float* row = DWN + (size_t)t * 512;
            { const f32x4 v = ((const f32x4*)row)[lane] + ((const f32x4*)(row + DWN_PART))[lane]; const float ss = wave_sum(v[0] * v[0] + v[1] * v[1] + v[2] * v[2] + v[3] * v[3]); const float r = __builtin_amdgcn_rsqf(ss * (1.f / 256.f) + 1e-6f);
              const f32x4 o = v * r * qn; u32x2 w; w.x = cvtpk(o[0], o[1]); w.y = cvtpk(o[2], o[3]); ((u32x2*)(QA + (size_t)t * 256))[lane] = w; }
            { f32x4 v = (f32x4){0.f, 0.f, 0.f, 0.f}; if (lane < 32) v = ((const f32x4*)(row + 256))[lane] + ((const f32x4*)(row + DWN_PART + 256))[lane];
              const float ss = wave_sum(v[0] * v[0] + v[1] * v[1] + v[2] * v[2] + v[3] * v[3]); const float r = __builtin_amdgcn_rsqf(ss * (1.f / 128.f) + 1e-6f);
              const f32x4 o = v * r * kvn;
              if (lane < 32) { u32x2 w; w.x = cvtpk(o[0], o[1]); w.y = cvtpk(o[2], o[3]); ((u32x2*)(CKVA + (size_t)t * 128))[lane] = w; if (!lat) ((f32x4*)(F.out + OFF_CKV + (size_t)t * 128))[lane] = o; } }
            { float x = (lane < 32) ? row[384 + lane] + row[DWN_PART + 384 + lane] : 0.f;
              if (!lat && lane < 32) F.out[OFF_KPE + (size_t)t * 32 + lane] = x;
              if (lat) { const float p = __shfl_xor(x, 16); const int i = lane & 15; const float c = R32[s * 16 + i], sn = R32[2048 * 16 + s * 16 + i]; x = ((lane & 31) < 16) ? x * c - p * sn : x * c + p * sn; }
              const bf16 xb = f2bf(x);
              if (lane < 32) { for (int h = 0; h < 16; ++h) Kb[kb_off(16, 96, lat, b, h) + (size_t)s * 96 + 64 + lane] = xb; } }
        } else {
            const int r = t - NTOK, b = r >> 9, s = r & 511;
            if (lane < 32) { const f32x4 v = ((const f32x4*)(a.in[4] + (size_t)r * 128))[lane]; u32x2 w; w.x = cvtpk(v[0], v[1]); w.y = cvtpk(v[2], v[3]); ((u32x2*)(CKVA + (size_t)t * 128))[lane] = w;
                const bf16 xb = f2bf(a.in[5][(size_t)r * 32 + lane]);
                for (int h = 0; h < 16; ++h) Kb[kb_off(16, 96, true, b, h) + (size_t)(2048 + s) * 96 + 64 + lane] = xb; }
        }
    }
}
__device__ __forceinline__ void mla_row(int row, bool& lat, int& b, int& s) {
    if (row < NCTX) { lat = false; b = row >> 8; s = row & 255; } else if (row < NTOK) { lat = true; b = (row - NCTX) >> 11; s = (row - NCTX) & 2047; } else { lat = true; b = (row - NTOK) >> 9; s = 2048 + ((row - NTOK) & 511); }
}
struct EpiUkv { bf16* Kb; float* VRAW; static constexpr bool PERM = false, AFTER_DRAIN = false;
    __device__ __forceinline__ void operator()(const f32x4 (&acc)[2][2][4][2], const Unit& u, int wr, int wc, int fr, int fq) const {
#pragma unroll
        for (int ai = 0; ai < 2; ++ai)
#pragma unroll
            for (int m = 0; m < 4; ++m) { const int row = u.pm * 256 + ai * 128 + wr * 64 + m * 16 + fr; bool lat; int b, s; mla_row(row, lat, b, s);
#pragma unroll
                for (int bj = 0; bj < 2; ++bj) { const int h = 2 * u.pn + bj;
                    if (wc < 2) { bf16* kp = Kb + kb_off(16, 96, lat, b, h) + (size_t)s * 96 + wc * 32 + 4 * fq;
#pragma unroll
                        for (int n = 0; n < 2; ++n) { const f32x4 v = acc[ai][bj][m][n]; u32x2 w; w.x = cvtpk(v[0], v[1]); w.y = cvtpk(v[2], v[3]); *(u32x2*)(kp + n * 16) = w; } }
                    else { float* vp = VRAW + (size_t)row * 1024 + h * 64 + (wc - 2) * 32 + 4 * fq;
#pragma unroll
                        for (int n = 0; n < 2; ++n) *(f32x4*)(vp + n * 16) = acc[ai][bj][m][n]; } } }
    }
};
__device__ __forceinline__ void phase_mla_post2(const Frame& F, const Args& a) {
    const float* VRAW = (const float*)(F.ws + WS_KVRAW); bf16* Vt = (bf16*)(F.ws + WS_VT);
    int lane_ = F.lane; asm volatile("" : "+v"(lane_)); const int lane = lane_;
    for (int it = F.gw; it < 224 * 16; it += F.NGW) {
        const int tile = it >> 4, h = it & 15, row0 = tile * 64; bool lat; int b, s0; mla_row(row0, lat, b, s0);
        float vr[64];
#pragma unroll
        for (int i = 0; i < 64; ++i) vr[i] = VRAW[(size_t)(row0 + i) * 1024 + h * 64 + lane];
        vt_store(Vt + vt_off(16, lat, b, h) + (size_t)lane * (lat ? 2560 : 256) + s0, vr);
    }
}

__device__ __forceinline__ int crow(int r, int hi) { return (r & 3) + 8 * (r >> 2) + 4 * hi; }
__device__ __forceinline__ float max3f(float a, float b, float c) { float r; asm("v_max3_f32 %0, %1, %2, %3" : "=v"(r) : "v"(a), "v"(b), "v"(c)); return r; }
constexpr float THRL = 5.f;
template <int DK, int KIND>
__device__ __forceinline__ void attn_phase(const Frame& F, const Args& a, int j, const ConvJob& J, int& cv_it, int cv_need, int cv_cap) {
    constexpr int HK = (DK == 96) ? 16 : 4, CH = (DK == 96) ? 64 : 128, KPB = (DK + 8) * 2, VPB = (CH + 8) * 2, NDS = DK / 16, KCH = DK / 8;
    constexpr int NKC = CH * KCH, NKI = (NKC + 511) / 512, NVI = 64 * (CH / 8) / 512, NSUB = CH / 64;
    constexpr float QS = (DK == 96) ? MLA_QS : GQA_QS;
    const bf16* QRAW = (const bf16*)(F.ws + WS_QKV); const bf16* Kb = (const bf16*)(F.ws + WS_KB); const bf16* Vt = (const bf16*)(F.ws + WS_VT); bf16* O = (bf16*)(F.ws + WS_O);
    LAS unsigned char* Ks = F.lds; LAS unsigned char* Vs = F.lds + 2 * CH * KPB;
    LAS unsigned char* cvs = F.lds + 2 * CH * KPB + 2 * 64 * VPB + F.wave * 8192;
    const unsigned cvs_addr = (unsigned)(uintptr_t)cvs;
    int tid_ = F.tid; asm volatile("" : "+v"(tid_));
    const int tid = tid_, lane = tid & 63, wid = F.wave, r32 = lane & 31, hi = lane >> 5;
    constexpr bool CVP = true;
    int itc = 0;
    for (int un = F.bid; un < 768; un += F.G) {
        bool lat; int b, hq, q0, S, tok0;
        if (un < 512) { lat = true; b = un >> 7; hq = (un >> 3) & 15; q0 = (un & 7) * 256; S = 2560; tok0 = NCTX + b * 2048 + q0; }
        else { const int v = un - 512; lat = false; b = v >> 4; hq = v & 15; q0 = 0; S = 256; tok0 = b * 256; }
        const int hk = (HK == 4) ? (hq >> 2) : hq;
        const bf16* Kg = Kb + kb_off(HK, DK, lat, b, hk); const bf16* Vg = Vt + vt_off(HK, lat, b, hk);
        const int n2 = lat ? 512 / CH : 0; int lo = 0, hiK = lat ? 2048 : 256;
        const bool masked = (KIND == 1) && lat;
        if (masked) { lo = q0 - 128; lo = lo < 0 ? 0 : (lo > 1536 ? 1536 : lo); hiK = lo + 512; }
        const int nch = n2 + (hiK - lo) / CH;
        bf16x8 qf[NDS];
        {
            const bf16* qrow = QRAW + (size_t)(tok0 + wid * 32 + r32) * 1536 + hq * DK + 8 * hi;
            f32x4 v[NDS][2];
#pragma unroll
            for (int ds = 0; ds < NDS; ++ds) { const u32x4 wq = *(const u32x4*)(qrow + 16 * ds);
                v[ds][0] = (f32x4){__uint_as_float(wq.x << 16), __uint_as_float(wq.x & 0xffff0000u), __uint_as_float(wq.y << 16), __uint_as_float(wq.y & 0xffff0000u)};
                v[ds][1] = (f32x4){__uint_as_float(wq.z << 16), __uint_as_float(wq.z & 0xffff0000u), __uint_as_float(wq.w << 16), __uint_as_float(wq.w & 0xffff0000u)}; }
            if (KIND == 0) {
                float ss = 0.f;
#pragma unroll
                for (int ds = 0; ds < NDS; ++ds)
#pragma unroll
                    for (int h2 = 0; h2 < 2; ++h2) ss += (v[ds][h2][0] * v[ds][h2][0] + v[ds][h2][1] * v[ds][h2][1]) + (v[ds][h2][2] * v[ds][h2][2] + v[ds][h2][3] * v[ds][h2][3]);
                ss += __shfl_xor(ss, 32);
                const float r = __builtin_amdgcn_rsqf(ss * (1.f / 64.f) + 1e-6f);
                const float* qn = a.in[13] + j * 64 + 8 * hi;
#pragma unroll
                for (int ds = 0; ds < NDS; ++ds) { v[ds][0] = v[ds][0] * r * *(const f32x4*)(qn + 16 * ds); v[ds][1] = v[ds][1] * r * *(const f32x4*)(qn + 16 * ds + 4); }
            }
            if (lat) {
                const int s = q0 + wid * 32 + r32;
                if (DK == 64) {
                    const float* R64 = (const float*)(F.ws + WS_ROPE64);
#pragma unroll
                    for (int ds = 0; ds < 2; ++ds)
#pragma unroll
                        for (int h2 = 0; h2 < 2; ++h2) { const int idx = s * 32 + 16 * ds + 8 * hi + 4 * h2; const f32x4 c = *(const f32x4*)(R64 + idx), sn = *(const f32x4*)(R64 + 2048 * 32 + idx);
                            const f32x4 xa = v[ds][h2], xb = v[ds + 2][h2]; v[ds][h2] = xa * c - xb * sn; v[ds + 2][h2] = xb * c + xa * sn; }
                } else {
                    const float* R32 = (const float*)(F.ws + WS_ROPE32);
#pragma unroll
                    for (int h2 = 0; h2 < 2; ++h2) { const int idx = s * 16 + 8 * hi + 4 * h2; const f32x4 c = *(const f32x4*)(R32 + idx), sn = *(const f32x4*)(R32 + 2048 * 16 + idx);
                        const f32x4 xa = v[NDS - 2][h2], xb = v[NDS - 1][h2]; v[NDS - 2][h2] = xa * c - xb * sn; v[NDS - 1][h2] = xb * c + xa * sn; }
                }
            }
#pragma unroll
            for (int ds = 0; ds < NDS; ++ds) { u32x4 w; w.x = cvtpk(v[ds][0][0] * QS, v[ds][0][1] * QS); w.y = cvtpk(v[ds][0][2] * QS, v[ds][0][3] * QS); w.z = cvtpk(v[ds][1][0] * QS, v[ds][1][1] * QS); w.w = cvtpk(v[ds][1][2] * QS, v[ds][1][3] * QS);
                qf[ds] = __builtin_bit_cast(bf16x8, w); }
        }
        const int qw0 = q0 + wid * 32, qpos = qw0 + r32;
        float mhat = 0.f, l_run = 0.f; bool first = true; f32x16 o0, o1, negm;
#pragma unroll
        for (int r = 0; r < 16; ++r) { o0[r] = 0.f; o1[r] = 0.f; negm[r] = 0.f; }
        u32x4 kreg[NKI], vreg[NVI];
#define ATT_KEY0(c) ((c) < n2 ? 2048 + CH * (c) : lo + CH * ((c) - n2))
#define ATT_LOAD(c) do { const int k0_ = ATT_KEY0(c); \
            _Pragma("unroll") for (int i_ = 0; i_ < NKI; ++i_) { const int cc_ = tid + 512 * i_; if (NKC % 512 == 0 || cc_ < NKC) kreg[i_] = *(const u32x4*)(Kg + (size_t)(k0_ + cc_ / KCH) * DK + (cc_ % KCH) * 8); } \
            _Pragma("unroll") for (int i_ = 0; i_ < NVI; ++i_) { const int cc_ = tid + 512 * i_; vreg[i_] = *(const u32x4*)(Vg + (size_t)(cc_ / (CH / 8)) * S + k0_ + (cc_ % (CH / 8)) * 8); } } while (0)
#define ATT_STORE(buf) do { \
            _Pragma("unroll") for (int i_ = 0; i_ < NKI; ++i_) { const int cc_ = tid + 512 * i_; if (NKC % 512 == 0 || cc_ < NKC) *(LAS u32x4*)(Ks + (buf) * CH * KPB + (cc_ / KCH) * KPB + (cc_ % KCH) * 16) = kreg[i_]; } \
            _Pragma("unroll") for (int i_ = 0; i_ < NVI; ++i_) { const int cc_ = tid + 512 * i_; *(LAS u32x4*)(Vs + (buf) * 64 * VPB + (cc_ / (CH / 8)) * VPB + (cc_ % (CH / 8)) * 16) = vreg[i_]; } } while (0)
        ATT_LOAD(0);
        __syncthreads();
        ATT_STORE(0);
        __syncthreads();
        for (int c = 0; c < nch; ++c) {
            const int cur = c & 1;
            if (c + 1 < nch) ATT_LOAD(c + 1);
            const bool cv = CVP && ((CH == 128) || ((itc++ & 1) == 0)) && cv_it < cv_cap;
            if (cv) { const ConvItem ci = cv_decode(J, cv_it); conv_issue8(cvs_addr, ci.W, ci.N, ci.k0, ci.n0, lane); }
            const int key0c = ATT_KEY0(c);
            for (int sub = 0; sub < NSUB; ++sub) {
                const int key0 = key0c + 64 * sub;
                if (masked && c >= n2 && (key0 > qw0 + 159 || key0 + 63 < qw0 - 128)) continue;
                f32x16 p0, p1;
                const LAS unsigned char* kb_ = Ks + cur * CH * KPB + (sub * 64 + r32) * KPB + hi * 16;
                const LAS unsigned char* vb_ = Vs + cur * 64 * VPB + r32 * VPB + sub * 128 + hi * 16;
                bf16x8 kf[2 * NDS], vf[8];
#pragma unroll
                for (int ds = 0; ds < NDS; ++ds) { kf[2 * ds] = *(const LAS bf16x8*)(kb_ + ds * 32); kf[2 * ds + 1] = *(const LAS bf16x8*)(kb_ + 32 * KPB + ds * 32); }
#pragma unroll
                for (int s = 0; s < 4; ++s) { vf[2 * s] = *(const LAS bf16x8*)(vb_ + s * 32); vf[2 * s + 1] = *(const LAS bf16x8*)(vb_ + 32 * VPB + s * 32); }
                __builtin_amdgcn_sched_barrier(0);
#pragma unroll
                for (int ds = 0; ds < NDS; ++ds) {
                    if (ds == 0) { p0 = __builtin_amdgcn_mfma_f32_32x32x16_bf16(kf[0], qf[0], negm, 0, 0, 0); p1 = __builtin_amdgcn_mfma_f32_32x32x16_bf16(kf[1], qf[0], negm, 0, 0, 0); }
                    else { p0 = __builtin_amdgcn_mfma_f32_32x32x16_bf16(kf[2 * ds], qf[ds], p0, 0, 0, 0); p1 = __builtin_amdgcn_mfma_f32_32x32x16_bf16(kf[2 * ds + 1], qf[ds], p1, 0, 0, 0); }
                }
                if (masked && c >= n2) {
                    const int kbase = key0 - qpos;
#pragma unroll
                    for (int r = 0; r < 16; ++r) { const int d0 = kbase + crow(r, hi), d1 = d0 + 32;
                        if (d0 > 128 || d0 < -128) p0[r] = -INFINITY;
                        if (d1 > 128 || d1 < -128) p1[r] = -INFINITY; }
                }
                float rm;
                { float ma = max3f(p0[0], p0[1], p1[0]), mb = max3f(p0[2], p0[3], p1[1]); ma = max3f(ma, p1[2], p1[3]);
#pragma unroll
                  for (int r = 4; r < 16; r += 4) { ma = max3f(ma, p0[r], p0[r + 1]); mb = max3f(mb, p0[r + 2], p0[r + 3]); ma = max3f(ma, p1[r], p1[r + 1]); mb = max3f(mb, p1[r + 2], p1[r + 3]); }
                  const float m2 = max3f(ma, mb, mb);
                  auto rr = __builtin_amdgcn_permlane32_swap(__float_as_uint(m2), __float_as_uint(m2), false, false);
                  rm = max3f(__uint_as_float(rr[0]), __uint_as_float(rr[1]), m2); }
                if (first || __any(rm > THRL)) {
                    const float dl = first ? rm : fmaxf(rm, 0.f);
                    mhat += dl;
#pragma unroll
                    for (int r = 0; r < 16; ++r) { p0[r] -= dl; p1[r] -= dl; }
                    if (!first) { const float sc = __builtin_amdgcn_exp2f(-dl); l_run *= sc;
#pragma unroll
                        for (int r = 0; r < 16; ++r) { o0[r] *= sc; o1[r] *= sc; } }
#pragma unroll
                    for (int r = 0; r < 16; ++r) negm[r] = -mhat;
                    first = false;
                }
                float ls0 = 0.f, ls1 = 0.f;
#pragma unroll
                for (int r = 0; r < 16; ++r) { p0[r] = __builtin_amdgcn_exp2f(p0[r]); p1[r] = __builtin_amdgcn_exp2f(p1[r]); ls0 += p0[r]; ls1 += p1[r]; }
                l_run += ls0 + ls1;
                bf16x8 pb[4];
#pragma unroll
                for (int s = 0; s < 4; ++s) { u32x4 w;
                    if (s < 2) { w.x = cvtpk(p0[8 * s], p0[8 * s + 1]); w.y = cvtpk(p0[8 * s + 2], p0[8 * s + 3]); w.z = cvtpk(p0[8 * s + 4], p0[8 * s + 5]); w.w = cvtpk(p0[8 * s + 6], p0[8 * s + 7]); }
                    else { const int q = s - 2; w.x = cvtpk(p1[8 * q], p1[8 * q + 1]); w.y = cvtpk(p1[8 * q + 2], p1[8 * q + 3]); w.z = cvtpk(p1[8 * q + 4], p1[8 * q + 5]); w.w = cvtpk(p1[8 * q + 6], p1[8 * q + 7]); }
                    pb[s] = __builtin_bit_cast(bf16x8, w); }
#pragma unroll
                for (int s = 0; s < 4; ++s) {
                    o0 = __builtin_amdgcn_mfma_f32_32x32x16_bf16(vf[2 * s], pb[s], o0, 0, 0, 0);
                    o1 = __builtin_amdgcn_mfma_f32_32x32x16_bf16(vf[2 * s + 1], pb[s], o1, 0, 0, 0);
                }
            }
            if (c + 1 < nch) ATT_STORE(cur ^ 1);
            if (cv) { asm volatile("s_waitcnt vmcnt(0)" ::: "memory"); f32x4 cvv[8]; conv_fetch8(cvv, cvs, lane); const ConvItem ci = cv_decode(J, cv_it); conv_store8(cvv, ci.WT, ci.rowbase, ci.ldk, ci.k0, lane); cv_it += F.NGW; }
            __syncthreads();
        }
#undef ATT_KEY0
#undef ATT_LOAD
#undef ATT_STORE
        float l = l_run + __shfl_xor(l_run, 32);
        if (KIND == 1) l += __builtin_amdgcn_exp2f(a.in[17][hq] * LOG2E - mhat);
        const float inv = 1.f / l;
        bf16* op = O + (size_t)(tok0 + wid * 32 + r32) * 1024 + hq * 64 + 4 * hi;
#pragma unroll
        for (int g = 0; g < 4; ++g) {
            u32x2 w0, w1; w0.x = cvtpk(o0[4 * g] * inv, o0[4 * g + 1] * inv); w0.y = cvtpk(o0[4 * g + 2] * inv, o0[4 * g + 3] * inv);
            w1.x = cvtpk(o1[4 * g] * inv, o1[4 * g + 1] * inv); w1.y = cvtpk(o1[4 * g + 2] * inv, o1[4 * g + 3] * inv);
            *(u32x2*)(op + 8 * g) = w0; *(u32x2*)(op + 32 + 8 * g) = w1;
        }
    }
    for (; cv_it < cv_need; cv_it += 2 * F.NGW) {
        f32x4 v0[8], v1[8]; const ConvItem c0 = cv_decode(J, cv_it); conv_load8(v0, c0.W, c0.N, c0.k0, c0.n0, lane);
        const bool two = cv_it + F.NGW < CV_TOTAL; ConvItem c1 = c0; if (two) { c1 = cv_decode(J, cv_it + F.NGW); conv_load8(v1, c1.W, c1.N, c1.k0, c1.n0, lane); }
        conv_store8(v0, c0.WT, c0.rowbase, c0.ldk, c0.k0, lane); if (two) conv_store8(v1, c1.WT, c1.rowbase, c1.ldk, c1.k0, lane); }
}
#if MK_CHECK
template <int DK, int KIND>
__device__ __forceinline__ void check_attn(const Frame& F, const Args& a, int j, int id) {
    constexpr int HK = (DK == 96) ? 16 : 4; constexpr float QS = (DK == 96) ? MLA_QS : GQA_QS;
    const bf16* QRAW = (const bf16*)(F.ws + WS_QKV); const bf16* Kb = (const bf16*)(F.ws + WS_KB); const bf16* Vt = (const bf16*)(F.ws + WS_VT); const bf16* O = (const bf16*)(F.ws + WS_O);
    LAS float* scs = (LAS float*)(F.lds + F.wave * 12288); LAS float* qs = scs + 2560;
    const int lane = F.lane;
    const unsigned hsh = hash_u(F.gw * 2654435761u + id);
    const int t = (F.gw & 1) ? (hsh % NCTX) : NCTX + (hsh % NLAT), hq = (hsh >> 16) & 15;
    const bool lat = t >= NCTX; const int b = lat ? (t - NCTX) >> 11 : t >> 8, s = lat ? (t - NCTX) & 2047 : t & 255, S = lat ? 2560 : 256;
    const int hk = (HK == 4) ? (hq >> 2) : hq;
    const bf16* Kg = Kb + kb_off(HK, DK, lat, b, hk); const bf16* Vg = Vt + vt_off(HK, lat, b, hk); const bf16* q = QRAW + (size_t)t * 1536 + hq * DK;
    {
        float x = bf2f(q[lane]);
        if (KIND == 0) { const float ss = wave_sum(x * x); x = x * __builtin_amdgcn_rsqf(ss * (1.f / 64.f) + 1e-6f) * a.in[13][j * 64 + lane]; }
        if (DK == 64 && lat) { const float* R64 = (const float*)(F.ws + WS_ROPE64); const float p = __shfl_xor(x, 32); const int i = lane & 31; const float c = R64[s * 32 + i], sn = R64[2048 * 32 + s * 32 + i]; x = (lane < 32) ? x * c - p * sn : x * c + p * sn; }
        qs[lane] = bf2f(f2bf(x * QS));
        if (DK == 96) { float y = (lane < 32) ? bf2f(q[64 + lane]) : 0.f;
            if (lat) { const float* R32 = (const float*)(F.ws + WS_ROPE32); const float p = __shfl_xor(y, 16); const int i = lane & 15; const float c = R32[s * 16 + i], sn = R32[2048 * 16 + s * 16 + i]; y = ((lane & 31) < 16) ? y * c - p * sn : y * c + p * sn; }
            if (lane < 32) qs[64 + lane] = bf2f(f2bf(y * QS)); }
        asm volatile("s_waitcnt lgkmcnt(0)" ::: "memory");
    }
    float mx = -1e30f;
    for (int jk = lane; jk < S; jk += 64) {
        float sc = 0.f; for (int d = 0; d < DK; ++d) sc += qs[d] * bf2f(Kg[(size_t)jk * DK + d]);
        if (KIND == 1 && lat && jk < 2048 && (jk - s > 128 || jk - s < -128)) sc = -INFINITY;
        scs[jk] = sc; mx = fmaxf(mx, sc);
    }
    mx = wave_max(mx);
    asm volatile("s_waitcnt lgkmcnt(0)" ::: "memory");
    float l = 0.f, o = 0.f;
    for (int jk = 0; jk < S; ++jk) { const float p = __builtin_amdgcn_exp2f(scs[jk] - mx); l += p; o += bf2f(f2bf(p)) * bf2f(Vg[(size_t)lane * S + swap23(jk)]); }
    if (KIND == 1) l += __builtin_amdgcn_exp2f(a.in[17][hq] * LOG2E - mx);
    o /= l;
    const float got = bf2f(O[(size_t)t * 1024 + hq * 64 + lane]);
    if (!close_enough(got, o, 0.03f, 0.01f)) CHK_FAIL(F, id);
    asm volatile("s_waitcnt lgkmcnt(0)" ::: "memory");
}
template <class Fn>
__device__ __forceinline__ void check_gemm_f32(const Frame& F, const bf16* A, const bf16* Bt, int M, int N, int K, const float* C, int ldc, int id) {
    for (int sidx = 0; sidx < 2; ++sidx) {
        const unsigned h = hash_u((F.gw * 2 + sidx) * 2654435761u + id * 97u);
        const int row = h % M, col = (h >> 12) % N;
        const float ref = dot_bf16(A + (size_t)row * K, Bt + (size_t)col * K, K, F.lane);
        if (!close_enough(C[(size_t)row * ldc + col], ref, 0.01f, 0.01f)) CHK_FAIL(F, id);
    }
}
template <class Fn>
__device__ __forceinline__ void check_gemm_bf16(const Frame& F, const bf16* A, const bf16* Bt, int M, int N, int K, const bf16* C, int ldc, int id) {
    for (int sidx = 0; sidx < 2; ++sidx) {
        const unsigned h = hash_u((F.gw * 2 + sidx) * 2654435761u + id * 97u);
        const int row = h % M, col = (h >> 12) % N;
        const float ref = dot_bf16(A + (size_t)row * K, Bt + (size_t)col * K, K, F.lane);
        if (!close_enough(bf2f(C[(size_t)row * ldc + col]), ref, 0.02f, 0.02f)) CHK_FAIL(F, id);
    }
}
#endif

__device__ __forceinline__ void phase_ln1_router(const Frame& F, const Args& a, int l) {
    const bf16* X = (const bf16*)(F.ws + WS_X); bf16* X1 = (bf16*)(F.ws + WS_X1); const bf16* AO = (const bf16*)(F.ws + WS_AO); unsigned char* H8 = F.ws + WS_XE; float* AFF = (float*)(F.ws + WS_AFF);
    constexpr int RP = 1032, RB = 6;
    LAS bf16* Wb = (LAS bf16*)F.lds;
    LAS bf16* Hs = (LAS bf16*)(F.lds + 16 * RP * 2) + F.wave * (RB * RP);
    const float* wr = a.in[25] + (size_t)l * D * NE;
    for (int i = F.tid; i < D * NE; i += 512) Wb[(i & 15) * RP + (i >> 4)] = f2bf(wr[i]);
    __syncthreads();
    int lane_ = F.lane; asm volatile("" : "+v"(lane_)); const int lane = lane_;
    const f32x4* lg = (const f32x4*)(a.in[10] + (size_t)(l * 2 + 0) * D); const f32x4* lb = (const f32x4*)(a.in[11] + (size_t)(l * 2 + 0) * D);
    const int RPW = (NTOK + F.NGW - 1) / F.NGW, rbeg = F.gw * RPW, rend = (rbeg + RPW < NTOK) ? rbeg + RPW : NTOK;
    f32x4 lgv[4], lbv[4], g1v[4], sh2v[4], sc2v[4]; int ccur = -1;
#pragma unroll
    for (int j = 0; j < 4; ++j) { lgv[j] = lg[lane + 64 * j]; lbv[j] = lb[lane + 64 * j]; g1v[j] = lgv[j]; sh2v[j] = lgv[j]; sc2v[j] = lgv[j]; }
    u32x2 xc[4], ac[4], xd[4], ad[4];
    { const int r0 = rbeg < rend ? rbeg : NTOK - 1, r1 = rbeg + 1 < rend ? rbeg + 1 : r0;
#pragma unroll
      for (int j = 0; j < 4; ++j) { xc[j] = ((const u32x2*)(X + (size_t)r0 * D))[lane + 64 * j]; ac[j] = ((const u32x2*)(AO + (size_t)r0 * D))[lane + 64 * j];
          xd[j] = ((const u32x2*)(X + (size_t)r1 * D))[lane + 64 * j]; ad[j] = ((const u32x2*)(AO + (size_t)r1 * D))[lane + 64 * j]; } }
    for (int row = rbeg; row < rend; ++row) {
        const int c = cond_of(row);
        if (c != ccur) { ccur = c; const f32x4* g1 = (const f32x4*)ada_vec(F, l, c, 2); const f32x4* sh2 = (const f32x4*)ada_vec(F, l, c, 3); const f32x4* sc2 = (const f32x4*)ada_vec(F, l, c, 4);
#pragma unroll
            for (int j = 0; j < 4; ++j) { g1v[j] = g1[lane + 64 * j]; sh2v[j] = sh2[lane + 64 * j]; sc2v[j] = sc2[lane + 64 * j] + 1.f; } }
        f32x4 y[4]; float s = 0.f, s2 = 0.f;
#pragma unroll
        for (int j = 0; j < 4; ++j) { const f32x4 av = (f32x4){__uint_as_float(ac[j].x << 16), __uint_as_float(ac[j].x & 0xffff0000u), __uint_as_float(ac[j].y << 16), __uint_as_float(ac[j].y & 0xffff0000u)}; y[j] = bf4(xc[j]) * ALPHA + g1v[j] * av; s += (y[j][0] + y[j][1]) + (y[j][2] + y[j][3]); s2 += (y[j][0] * y[j][0] + y[j][1] * y[j][1]) + (y[j][2] * y[j][2] + y[j][3] * y[j][3]); }
        { const int nr = row + 2 < rend ? row + 2 : row;
#pragma unroll
          for (int j = 0; j < 4; ++j) { xc[j] = xd[j]; ac[j] = ad[j]; xd[j] = ((const u32x2*)(X + (size_t)nr * D))[lane + 64 * j]; ad[j] = ((const u32x2*)(AO + (size_t)nr * D))[lane + 64 * j]; } }
        s = wave_sum(s); s2 = wave_sum(s2);
        const float mean = s * (1.f / D), var = fmaxf(s2 * (1.f / D) - mean * mean, 0.f);
        const float rstd = 1.f / sqrtf(var + 1e-5f);
        f32x4 h[4];
#pragma unroll
        for (int j = 0; j < 4; ++j) { const int q = lane + 64 * j; const f32x4 xn = (y[j] - mean) * rstd * lgv[j] + lbv[j]; ((u32x2*)(X1 + (size_t)row * D))[q] = pk4(xn);
            h[j] = xn * sc2v[j] + sh2v[j]; ((unsigned*)(H8 + (size_t)row * D))[q] = pk4_fp8(h[j][0], h[j][1], h[j][2], h[j][3]); }
        const int br = (row - rbeg) % RB;
#pragma unroll
        for (int j = 0; j < 4; ++j) { u32x2 w; w.x = cvtpk(h[j][0], h[j][1]); w.y = cvtpk(h[j][2], h[j][3]); *(LAS u32x2*)(Hs + br * RP + 4 * (lane + 64 * j)) = w; }
        if (br == RB - 1 || row == rend - 1) {
            const int nrows = br + 1, row0 = row - br, n = lane & 15, kq = lane >> 4, nn = n < nrows ? n : 0;
            const LAS bf16* wp = Wb + n * RP + 8 * kq; const LAS bf16* hp = Hs + nn * RP + 8 * kq;
            f32x4 l0 = (f32x4){0.f, 0.f, 0.f, 0.f}, l1 = l0;
#pragma unroll 4
            for (int st = 0; st < 32; st += 2) {
                l0 = __builtin_amdgcn_mfma_f32_16x16x32_bf16(*(const LAS bf16x8*)(wp + 32 * st), *(const LAS bf16x8*)(hp + 32 * st), l0, 0, 0, 0);
                l1 = __builtin_amdgcn_mfma_f32_16x16x32_bf16(*(const LAS bf16x8*)(wp + 32 * st + 32), *(const LAS bf16x8*)(hp + 32 * st + 32), l1, 0, 0, 0); }
            const f32x4 lg4 = l0 + l1;
            float mx = fmaxf(fmaxf(lg4[0], lg4[1]), fmaxf(lg4[2], lg4[3])); mx = xmax16(mx); mx = xmax32(mx);
            f32x4 ex; ex[0] = __expf(lg4[0] - mx); ex[1] = __expf(lg4[1] - mx); ex[2] = __expf(lg4[2] - mx); ex[3] = __expf(lg4[3] - mx);
            float den = (ex[0] + ex[1]) + (ex[2] + ex[3]); den = xsum16(den, den); den = xsum32(den, den);
            const float inv = 1.f / den;
            if (n < nrows) {
#pragma unroll
                for (int i = 0; i < 4; ++i) AFF[(size_t)(4 * kq + i) * NTOK + row0 + n] = ex[i] * inv; }
        }
    }
    __syncthreads();
}

__device__ __forceinline__ int block_excl_scan(int v, LAS int* wsum, int lane, int wid, int& total) {
    int inc = v;
#pragma unroll
    for (int o = 1; o < 64; o <<= 1) { const int t = __shfl_up(inc, o); if (lane >= o) inc += t; }
    if (lane == 63) wsum[wid] = inc;
    __syncthreads();
    int off = 0, tot = 0;
#pragma unroll
    for (int w = 0; w < 8; ++w) { const int s = wsum[w]; if (w < wid) off += s; tot += s; }
    __syncthreads();
    total = tot; return off + inc - v;
}
__device__ __forceinline__ void phase_topk(const Frame& F) {
    const float* AFFT = (const float*)(F.ws + WS_AFF); int* IDX = (int*)(F.ws + WS_IDX); float* GATEV = (float*)(F.ws + WS_GATEV); int* SLOTMAP = (int*)(F.ws + WS_SLOTMAP);
    LAS int* hist = (LAS int*)F.lds;
    LAS int* wsum = (LAS int*)(F.lds + 1024);
    LAS unsigned* shv = (LAS unsigned*)(F.lds + 1024 + 64);
    const int tid = F.tid, lane = F.lane;
    for (int pr = F.bid; pr < 32; pr += F.G) {
        const int stream = pr >> 4, e = pr & 15, tok0 = stream ? NCTX : 0, cap = stream ? CAPL : CAPC, sbase = e * ESLOTS + (stream ? CAPC : 0);
        const int C = stream ? 16 : 8, i0 = tid * C;
        unsigned k[16];
        { const u32x4* src = (const u32x4*)(AFFT + (size_t)e * NTOK + tok0 + i0);
#pragma unroll
          for (int q = 0; q < 4; ++q) { u32x4 v = (u32x4){0u, 0u, 0u, 0u}; if (q * 4 < C) v = src[q]; k[4 * q] = v.x; k[4 * q + 1] = v.y; k[4 * q + 2] = v.z; k[4 * q + 3] = v.w; } }
        unsigned prefix = 0u; int remaining = cap;
        __syncthreads();
        for (int pass = 0; pass < 4; ++pass) {
            const int shift = 24 - 8 * pass;
            if (tid < 256) hist[tid] = 0;
            __syncthreads();
#pragma unroll
            for (int i = 0; i < 16; ++i) if (i < C) { const unsigned kk = k[i]; if (pass == 0 || (kk >> (shift + 8)) == prefix) __hip_atomic_fetch_add(&hist[(kk >> shift) & 255u], 1, __ATOMIC_RELAXED, __HIP_MEMORY_SCOPE_WORKGROUP); }
            __syncthreads();
            if (tid < 64) {
                const int h0 = hist[4 * lane], h1 = hist[4 * lane + 1], h2 = hist[4 * lane + 2], h3 = hist[4 * lane + 3], c = h0 + h1 + h2 + h3;
                int inc = c;
#pragma unroll
                for (int o = 1; o < 64; o <<= 1) { const int t = __shfl_down(inc, o); if (lane + o < 64) inc += t; }
                const int above = inc - c;
                if (above < remaining && remaining <= inc) {
                    int cum = above, sel;
                    if (cum + h3 >= remaining) sel = 3; else { cum += h3; if (cum + h2 >= remaining) sel = 2; else { cum += h2; if (cum + h1 >= remaining) sel = 1; else { cum += h1; sel = 0; } } }
                    shv[0] = (prefix << 8) | (unsigned)(4 * lane + sel); shv[1] = (unsigned)(remaining - cum);
                }
            }
            __syncthreads();
            prefix = shv[0]; remaining = (int)shv[1];
        }
        const unsigned thr = prefix; const int need = remaining;
        int ceq = 0;
#pragma unroll
        for (int i = 0; i < 16; ++i) if (i < C) ceq += (k[i] == thr) ? 1 : 0;
        int tot; const int eq_rank = block_excl_scan(ceq, wsum, F.lane, F.wave, tot);
        int csel = 0; { int er = eq_rank;
#pragma unroll
            for (int i = 0; i < 16; ++i) if (i < C) { if (k[i] > thr) ++csel; else if (k[i] == thr) { if (er < need) ++csel; ++er; } } }
        int slot = block_excl_scan(csel, wsum, F.lane, F.wave, tot);
#if MK_CHECK
        if (tid == 0 && tot != cap) CHK_FAIL(F, 60);
#endif
        { int er = eq_rank; int sm[16];
#pragma unroll
            for (int i = 0; i < 16; ++i) { sm[i] = -1; if (i < C) { bool sel = false; if (k[i] > thr) sel = true; else if (k[i] == thr) { sel = er < need; ++er; }
                const int tok = tok0 + i0 + i;
                if (sel) { const int r = sbase + slot; IDX[r] = tok; GATEV[r] = __uint_as_float(k[i]); sm[i] = r; ++slot; } } }
            u32x4* dst = (u32x4*)(SLOTMAP + (size_t)e * NTOK + tok0 + i0);
#pragma unroll
            for (int q = 0; q < 4; ++q) if (q * 4 < C) dst[q] = (u32x4){(unsigned)sm[4 * q], (unsigned)sm[4 * q + 1], (unsigned)sm[4 * q + 2], (unsigned)sm[4 * q + 3]}; }
    }
    __syncthreads();
}
__device__ __forceinline__ void phase_gather(const Frame& F) {
    const int* IDX = (const int*)(F.ws + WS_IDX);
#if MK_CHECK
    {
        const int* SLOTMAP = (const int*)(F.ws + WS_SLOTMAP); const float* GATEV = (const float*)(F.ws + WS_GATEV); const float* AFF = (const float*)(F.ws + WS_AFF);
        for (int r = F.gw * 64 + F.lane; r < NSLOTS; r += F.NGW * 64) { const int tok = IDX[r], e = r / ESLOTS; const bool latslot = (r % ESLOTS) >= CAPC;
            bool ok = tok >= 0 && tok < NTOK && ((tok >= NCTX) == latslot);
            if (ok) ok = SLOTMAP[(size_t)e * NTOK + tok] == r && GATEV[r] == AFF[(size_t)e * NTOK + tok];
            if (ok) { const unsigned h = hash_u(r * 7919u + 13u); const int t2 = latslot ? NCTX + (h % NLAT) : (h % NCTX); if (SLOTMAP[(size_t)e * NTOK + t2] < 0 && AFF[(size_t)e * NTOK + t2] > GATEV[r]) ok = false; }
            if (!ok) CHK_FAIL(F, 61); }
    }
#endif
}

__device__ __forceinline__ void ye_acc(f32x4& f, unsigned w) {
    const auto lo = __builtin_amdgcn_cvt_pk_f32_fp8((int)w, false), hi = __builtin_amdgcn_cvt_pk_f32_fp8((int)w, true); f[0] += lo[0]; f[1] += lo[1]; f[2] += hi[0]; f[3] += hi[1];
}
__device__ __forceinline__ void ye_add(f32x4 (&f)[4], const unsigned char* YE, int r, int lane) {
    const bool two = (r >> 8) >= DOWN_FULL_PANELS;
    unsigned w[4], w2[4];
#pragma unroll
    for (int j = 0; j < 4; ++j) { w[j] = ((const unsigned*)(YE + (size_t)r * D))[lane + 64 * j]; w2[j] = 0u; if (two) w2[j] = ((const unsigned*)(YE + (size_t)(NSLOTS + r) * D))[lane + 64 * j]; }
#pragma unroll
    for (int j = 0; j < 4; ++j) { ye_acc(f[j], w[j]); ye_acc(f[j], w2[j]); }
}
__device__ __forceinline__ void ye_add2(f32x4 (&f)[4], const unsigned char* YE, int r, int rb, int lane) {
    const bool two = (r >> 8) >= DOWN_FULL_PANELS, twob = (rb >> 8) >= DOWN_FULL_PANELS;
    unsigned w[4], w2[4], v[4], v2[4];
#pragma unroll
    for (int j = 0; j < 4; ++j) { w[j] = ((const unsigned*)(YE + (size_t)r * D))[lane + 64 * j]; w2[j] = 0u; if (two) w2[j] = ((const unsigned*)(YE + (size_t)(NSLOTS + r) * D))[lane + 64 * j];
        v[j] = ((const unsigned*)(YE + (size_t)rb * D))[lane + 64 * j]; v2[j] = 0u; if (twob) v2[j] = ((const unsigned*)(YE + (size_t)(NSLOTS + rb) * D))[lane + 64 * j]; }
#pragma unroll
    for (int j = 0; j < 4; ++j) { ye_acc(f[j], w[j]); ye_acc(f[j], w2[j]); ye_acc(f[j], v[j]); ye_acc(f[j], v2[j]); }
}
__device__ __forceinline__ void phase_combine(const Frame& F, const Args& a, int l) {
    bf16* X = (bf16*)(F.ws + WS_X); const bf16* X1 = (const bf16*)(F.ws + WS_X1); bf16* H = (bf16*)(F.ws + WS_H); const unsigned char* YE = F.ws + WS_YE; const int* SLOTMAP = (const int*)(F.ws + WS_SLOTMAP);
    int lane_ = F.lane; asm volatile("" : "+v"(lane_)); const int lane = lane_;
    const f32x4* lg = (const f32x4*)(a.in[10] + (size_t)(l * 2 + 1) * D); const f32x4* lb = (const f32x4*)(a.in[11] + (size_t)(l * 2 + 1) * D);
#if MK_CHECK
    const unsigned err = __hip_atomic_load(F.ctl + CW_ERR, __ATOMIC_RELAXED, __HIP_MEMORY_SCOPE_AGENT);
    const unsigned tmo = __hip_atomic_load(F.ctl + CW_BAR + XB_TMO, __ATOMIC_RELAXED, __HIP_MEMORY_SCOPE_AGENT);
#endif
    const int RPW = (NTOK + F.NGW - 1) / F.NGW, rbeg = F.gw * RPW, rend = (rbeg + RPW < NTOK) ? rbeg + RPW : NTOK;
    f32x4 lgv[4], lbv[4], g2v[4], shv[4], scv[4]; int ccur = -1;
#pragma unroll
    for (int j = 0; j < 4; ++j) { lgv[j] = lg[lane + 64 * j]; lbv[j] = lb[lane + 64 * j]; g2v[j] = lgv[j]; shv[j] = lgv[j]; scv[j] = lgv[j]; }
    auto ld_sm = [&](int r) { int v = -1; if (r < rend && lane < 16) v = SLOTMAP[(size_t)lane * NTOK + r]; return v; };
    u32x2 x1n[4]; unsigned pw[4], pw2[4], pv[4], pv2[4]; unsigned restn = 0u; int smn_keep = -1;
    auto issue = [&](int r, int smv) {
        unsigned mask = (unsigned)__ballot(smv >= 0) & 0xffffu; int r0 = -1, r1 = -1;
        if (mask) { const int e0 = __builtin_ctz(mask); mask &= mask - 1; r0 = __builtin_amdgcn_readlane(smv, e0); }
        if (mask) { const int e1 = __builtin_ctz(mask); mask &= mask - 1; r1 = __builtin_amdgcn_readlane(smv, e1); }
        restn = mask; smn_keep = smv;
        const int rr = r < rend ? r : rend - 1;
#pragma unroll
        for (int j = 0; j < 4; ++j) { x1n[j] = ((const u32x2*)(X1 + (size_t)rr * D))[lane + 64 * j]; pw[j] = 0u; pw2[j] = 0u; pv[j] = 0u; pv2[j] = 0u; }
        if (r0 >= 0) {
#pragma unroll
            for (int j = 0; j < 4; ++j) { pw[j] = ((const unsigned*)(YE + (size_t)r0 * D))[lane + 64 * j]; if ((r0 >> 8) >= DOWN_FULL_PANELS) pw2[j] = ((const unsigned*)(YE + (size_t)(NSLOTS + r0) * D))[lane + 64 * j]; } }
        if (r1 >= 0) {
#pragma unroll
            for (int j = 0; j < 4; ++j) { pv[j] = ((const unsigned*)(YE + (size_t)r1 * D))[lane + 64 * j]; if ((r1 >> 8) >= DOWN_FULL_PANELS) pv2[j] = ((const unsigned*)(YE + (size_t)(NSLOTS + r1) * D))[lane + 64 * j]; } }
    };
    int sm1 = ld_sm(rbeg + 1);
    if (rbeg < rend) issue(rbeg, ld_sm(rbeg));
    for (int row = rbeg; row < rend; ++row) {
        const int c = cond_of(row);
        if (c != ccur) { ccur = c; const f32x4* g2 = (const f32x4*)ada_vec(F, l, c, 5);
#pragma unroll
            for (int j = 0; j < 4; ++j) g2v[j] = g2[lane + 64 * j];
            if (l < 3) { const f32x4* sh = (const f32x4*)ada_vec(F, l + 1, c, 0); const f32x4* sc = (const f32x4*)ada_vec(F, l + 1, c, 1);
#pragma unroll
                for (int j = 0; j < 4; ++j) { shv[j] = sh[lane + 64 * j]; scv[j] = sc[lane + 64 * j] + 1.f; } } }
        f32x4 x1[4], f[4]; unsigned mask = restn; const int smc = smn_keep;
#pragma unroll
        for (int j = 0; j < 4; ++j) { x1[j] = bf4(x1n[j]); f[j] = (f32x4){0.f, 0.f, 0.f, 0.f}; ye_acc(f[j], pw[j]); ye_acc(f[j], pw2[j]); ye_acc(f[j], pv[j]); ye_acc(f[j], pv2[j]); }
        if (row + 1 < rend) { const int smv = sm1; sm1 = ld_sm(row + 2); issue(row + 1, smv); }
        while (mask) {
            const int e0 = __builtin_ctz(mask); mask &= mask - 1; const int r0 = __builtin_amdgcn_readlane(smc, e0);
            if (mask) { const int e1 = __builtin_ctz(mask); mask &= mask - 1; const int r1 = __builtin_amdgcn_readlane(smc, e1); ye_add2(f, YE, r0, r1, lane); }
            else ye_add(f, YE, r0, lane);
        }
        f32x4 y[4]; float s = 0.f, s2 = 0.f;
#pragma unroll
        for (int j = 0; j < 4; ++j) { y[j] = x1[j] * ALPHA + g2v[j] * f[j] * (1.f / YE8_SCALE); s += (y[j][0] + y[j][1]) + (y[j][2] + y[j][3]); s2 += (y[j][0] * y[j][0] + y[j][1] * y[j][1]) + (y[j][2] * y[j][2] + y[j][3] * y[j][3]); }
        s = wave_sum(s); s2 = wave_sum(s2);
        const float mean = s * (1.f / D), var = fmaxf(s2 * (1.f / D) - mean * mean, 0.f);
        const float rstd = 1.f / sqrtf(var + 1e-5f);
        if (l < 3) {
#pragma unroll
            for (int j = 0; j < 4; ++j) { const int q = lane + 64 * j; const f32x4 xn = (y[j] - mean) * rstd * lgv[j] + lbv[j]; ((u32x2*)(X + (size_t)row * D))[q] = pk4(xn);
                const f32x4 h = xn * scv[j] + shv[j]; u32x2 w; w.x = cvtpk(h[0], h[1]); w.y = cvtpk(h[2], h[3]); ((u32x2*)(H + (size_t)row * D))[q] = w; }
        } else {
#pragma unroll
            for (int j = 0; j < 4; ++j) { const int q = lane + 64 * j; f32x4 xn = (y[j] - mean) * rstd * lgv[j] + lbv[j];
#if MK_CHECK
                if (row == 0 && q == 0) { if (err) xn[0] = 100.f * (float)err; else if (tmo) xn[0] = 9900.f; }
#endif
                ((f32x4*)(F.out + (size_t)row * D))[q] = xn; }
        }
    }
}

#if !MK_SPLIT
#define GRID_BAR() xcd_barrier(bar)
#else
#define GRID_BAR() do { } while (0)
#endif
#define IN(k) (lo <= (k) && (k) < hi)
#define GEMM_PHASE(EPI, SCHED) do { for (int rep_ = 0; rep_ < MK_REP_GEMM; ++rep_) pg8::gemm_phase<EPI, SCHED, true, true>(F.lds, g, S, E); } while (0)
template <int KIND>
__device__ __forceinline__ void run_mixer(const Frame& F, const Args& a, const XcdBarrier& bar, int lo, int hi, int l, int j, int slot, int& cv_it) {
    const int base = 3 + 12 * l;
    const bf16* Hb = (const bf16*)(F.ws + WS_H);
    ChunkMap cm; cm.init(F.G, F.bid);
    const ConvJob J{a.in[26], a.in[27], a.in[28], F.ws + WS_WGU, F.ws + WS_WD};
    const int cv_cap = (l == 0 ? 32 : l == 1 ? 48 : l == 2 ? 82 : 96) * (CV_PER_LAYER / 24);
    if (KIND != 2) {
        const bf16* Wq = (const bf16*)(F.ws + WS_WQKV) + (size_t)slot * 1536 * 1024;
        if (IN(base + 0)) {
            unsigned* cnt = F.ctl + CW_KV + 16 * l;
            Gemm g{Hb, Wq, 1024, 1024}; QkvOrder S{cm}; EpiBf16P E{(bf16*)(F.ws + WS_QKV), 1536};
            GEMM_PHASE(EpiBf16P, QkvOrder);
            int nkv = 0; { Unit u; for (int i = 0; S.next(i, u); ++i) nkv += (u.pn >= 4) ? 1 : 0; }
            if (nkv && F.tid == 0) { __builtin_amdgcn_fence(__ATOMIC_RELEASE, "agent"); (void)__hip_atomic_fetch_add(cnt, (unsigned)nkv, __ATOMIC_RELAXED, __HIP_MEMORY_SCOPE_AGENT); }
            const int idx = cm.x * cm.chunk + cm.loc; int skip = 288 - F.G; if (skip < 0 || skip >= F.G) skip = 0;
            if (idx >= skip) {
                if (F.tid == 0) { while (__hip_atomic_load(cnt, __ATOMIC_RELAXED, __HIP_MEMORY_SCOPE_AGENT) < 96u) __builtin_amdgcn_s_sleep(2); __builtin_amdgcn_fence(__ATOMIC_ACQUIRE, "agent"); }
                __syncthreads();
                for (int rep = 0; rep < MK_REP_POST; ++rep) phase_kv_post(F, a, KIND, j, slot, (idx - skip) * 8 + F.wave, (F.G - skip) * 8);
            }
            GRID_BAR();
        }
#if MK_CHECK
        if (IN(base + 3)) check_gemm_bf16<int>(F, Hb, Wq, NTOK, 1536, 1024, (const bf16*)(F.ws + WS_QKV), 1536, 10 + l);
#endif
        if (IN(base + 4)) {
            for (int rep = 0; rep < MK_REP_ATTN; ++rep) { if (KIND == 0) attn_phase<64, 0>(F, a, j, J, cv_it, (l + 1) * CV_PER_LAYER, cv_cap); else attn_phase<64, 1>(F, a, j, J, cv_it, (l + 1) * CV_PER_LAYER, cv_cap); }
            GRID_BAR();
        }
    } else {
        if (IN(base + 0)) {
            Gemm g{Hb, (const bf16*)(F.ws + WS_WDN), 512, 1024}; SplitKOrder S{2, 2, 1024, 48 * 2 * 2, cm}; EpiF32 E{(float*)(F.ws + WS_QKV), 512, DWN_PART};
            GEMM_PHASE(EpiF32, SplitKOrder); GRID_BAR();
        }
        if (IN(base + 1)) {
#if MK_CHECK
            for (int sidx = 0; sidx < 2; ++sidx) { const unsigned h = hash_u((F.gw * 2 + sidx) * 2654435761u + (10 + l) * 97u); const int row = h % NTOK, col = (h >> 12) % 512;
                const float ref = dot_bf16(Hb + (size_t)row * 1024, (const bf16*)(F.ws + WS_WDN) + (size_t)col * 1024, 1024, F.lane); const float* dq = (const float*)(F.ws + WS_QKV) + (size_t)row * 512 + col;
                if (!close_enough(dq[0] + dq[DWN_PART], ref, 0.01f, 0.01f)) CHK_FAIL(F, 10 + l); }
#endif
            phase_mla_post1(F, a); GRID_BAR();
        }
        if (IN(base + 2)) {
            { Gemm g{(const bf16*)(F.ws + WS_QA), (const bf16*)(F.ws + WS_WUQ), 256, 256}; PlainOrder S{6, 48 * 6, cm}; EpiBf16P E{(bf16*)(F.ws + WS_QKV), 1536}; GEMM_PHASE(EpiBf16P, PlainOrder); }
            { Gemm g{(const bf16*)(F.ws + WS_CKVA), (const bf16*)(F.ws + WS_WUKV), 128, 128}; PlainOrder S{8, 56 * 8, cm}; EpiUkv E{(bf16*)(F.ws + WS_KB), (float*)(F.ws + WS_KVRAW)}; GEMM_PHASE(EpiUkv, PlainOrder); }
            GRID_BAR();
        }
        if (IN(base + 3)) {
#if MK_CHECK
            check_gemm_bf16<int>(F, (const bf16*)(F.ws + WS_QA), (const bf16*)(F.ws + WS_WUQ), NTOK, 1536, 256, (const bf16*)(F.ws + WS_QKV), 1536, 14);
            for (int sidx = 0; sidx < 2; ++sidx) {
                const unsigned h = hash_u((F.gw * 2 + sidx) * 2654435761u + 15u * 97u); const int row = h % 14336, col = (h >> 12) % 2048, hh = col >> 7, ii = col & 127;
                const float ref = dot_bf16((const bf16*)(F.ws + WS_CKVA) + (size_t)row * 128, (const bf16*)(F.ws + WS_WUKV) + (size_t)col * 128, 128, F.lane);
                bool lat; int b, s; mla_row(row, lat, b, s);
                const float got = (ii < 64) ? bf2f(((const bf16*)(F.ws + WS_KB))[kb_off(16, 96, lat, b, hh) + (size_t)s * 96 + ii]) : ((const float*)(F.ws + WS_KVRAW))[(size_t)row * 1024 + hh * 64 + ii - 64];
                if (!close_enough(got, ref, 0.02f, 0.02f)) CHK_FAIL(F, 15);
            }
#endif
            for (int rep = 0; rep < MK_REP_POST; ++rep) phase_mla_post2(F, a); GRID_BAR();
        }
        if (IN(base + 4)) { for (int rep = 0; rep < MK_REP_ATTN; ++rep) attn_phase<96, 2>(F, a, j, J, cv_it, (l + 1) * CV_PER_LAYER, cv_cap); GRID_BAR(); }
    }
}
__device__ __forceinline__ void run_moe(const Frame& F, const Args& a, const XcdBarrier& bar, int lo, int hi, int l, int kind) {
    const int base = 3 + 12 * l;
    ChunkMap cm; cm.init(F.G, F.bid);
    const bf16* Wo = (const bf16*)(F.ws + WS_WO) + (size_t)l * 1024 * 1024;
    if (IN(base + 5)) {
#if MK_CHECK
        if (kind == 0) check_attn<64, 0>(F, a, l / 3, 20 + l); else if (kind == 1) check_attn<64, 1>(F, a, 0, 20 + l); else check_attn<96, 2>(F, a, 0, 20 + l);
        __syncthreads();
#endif
        Gemm g{(const bf16*)(F.ws + WS_O), Wo, 1024, 1024}; PlainOrder S{4, 48 * 4, cm}; EpiBf16P E{(bf16*)(F.ws + WS_AO), 1024};
        GEMM_PHASE(EpiBf16P, PlainOrder); GRID_BAR();
    }
    if (IN(base + 6)) {
#if MK_CHECK
        check_gemm_bf16<int>(F, (const bf16*)(F.ws + WS_O), Wo, NTOK, 1024, 1024, (const bf16*)(F.ws + WS_AO), 1024, 30 + l);
#endif
        for (int rep = 0; rep < MK_REP_LN1; ++rep) phase_ln1_router(F, a, l); GRID_BAR();
    }
#if MK_CHECK
    if (IN(base + 7)) {
        const unsigned hsh = hash_u(F.gw * 2654435761u + 991u * l + 17u); const int row = hsh % NTOK, c = cond_of(row);
        const bf16* X1c = (const bf16*)(F.ws + WS_X1); const float* sh2 = ada_vec(F, l, c, 3); const float* sc2 = ada_vec(F, l, c, 4); const float* wrc = a.in[25] + (size_t)l * D * NE; const float* AFFc = (const float*)(F.ws + WS_AFF);
        float lgt[16];
#pragma unroll
        for (int e = 0; e < 16; ++e) { float sacc = 0.f; for (int k = F.lane; k < D; k += 64) { const float hh = bf2f(X1c[(size_t)row * D + k]) * (sc2[k] + 1.f) + sh2[k]; sacc += hh * wrc[k * NE + e]; } lgt[e] = wave_sum(sacc); }
        float mxc = lgt[0];
#pragma unroll
        for (int e = 1; e < 16; ++e) mxc = fmaxf(mxc, lgt[e]);
        float denc = 0.f;
#pragma unroll
        for (int e = 0; e < 16; ++e) denc += __expf(lgt[e] - mxc);
#pragma unroll
        for (int e = 0; e < 16; ++e) { const float ref = __expf(lgt[e] - mxc) / denc, got = AFFc[(size_t)e * NTOK + row]; if (!close_enough(got, ref, 0.03f, 2e-4f)) CHK_FAIL(F, 62); }
    }
#endif
    if (IN(base + 7)) { for (int rep = 0; rep < MK_REP_TOPK; ++rep) phase_topk(F); if (l < 3) ada_direct(F, a, l + 1, 32); GRID_BAR(); }
#if MK_CHECK
    if (IN(base + 8)) { phase_gather(F); GRID_BAR(); }
#endif
    const unsigned char* Wgu = F.ws + WS_WGU + (size_t)l * 16 * 4096 * 1024; const unsigned char* Wd = F.ws + WS_WD + (size_t)l * 16 * 1024 * 2048;
    if (IN(base + 9)) {
#if MK_CHECK
        for (int sidx = 0; sidx < 16; ++sidx) {
            const unsigned h = hash_u((F.gw * 16 + sidx) * 2654435761u + 71u * l + 3u); const int idx = h & 63, e = (h >> 6) & 15, kk = (h >> 10) & 1023, nn = (h >> 20) & 2047;
            const int k = kk + ((idx & 1) ? 1024 * ((h >> 31) & 1) : 0);
            float src, got;
            if (idx & 1) { const int n = nn & 1023; src = a.in[28][((size_t)(l * 16 + e) * 2048 + k) * 1024 + n]; got = fp8f(Wd + ((size_t)e * 1024 + n) * 2048, k); }
            else { const bool up = (idx & 2) != 0; src = (up ? a.in[27] : a.in[26])[((size_t)(l * 16 + e) * 1024 + kk) * 2048 + nn]; got = fp8f(Wgu + ((size_t)e * 4096 + (nn >> 7) * 256 + (up ? 128 : 0) + (nn & 127)) * 1024, kk); }
            { const unsigned pk = pk4_fp8(src * W8_SCALE, 0.f, 0.f, 0.f); if (F.lane == 0 && got != __builtin_amdgcn_cvt_f32_fp8((int)pk, 0)) CHK_FAIL(F, 70 + l); }
        }
#endif
        Gemm g{(const bf16*)(F.ws + WS_XE), (const bf16*)Wgu, 512, 512, (const int*)(F.ws + WS_IDX)}; GroupedOrder S{6, 16, 1, 0, cm}; EpiSwiglu E{F.ws + WS_HID};
        pg8::gemm_phase<EpiSwiglu, GroupedOrder, true, true, true, true>(F.lds, g, S, E); GRID_BAR();
    }
    if (IN(base + 10)) {
#if MK_CHECK
        for (int sidx = 0; sidx < 2; ++sidx) {
            const unsigned h = hash_u((F.gw * 2 + sidx) * 2654435761u + 977u * l); const int row = h % NSLOTS, cc = (h >> 12) % FF, e = row / ESLOTS;
            const unsigned char* xr = F.ws + WS_XE + (size_t)((const int*)(F.ws + WS_IDX))[row] * D; const unsigned char* wg = Wgu + ((size_t)e * 4096 + (cc >> 7) * 256 + (cc & 127)) * 1024;
            const float gd = dot_fp8(xr, wg, 1024, F.lane) * (1.f / W8_SCALE), ud = dot_fp8(xr, wg + 128 * 1024, 1024, F.lane) * (1.f / W8_SCALE);
            const float ref = gd / (1.f + __expf(-gd)) * ud, got = fp8f(F.ws + WS_HID + (size_t)row * FF, cc) * (1.f / H8_SCALE);
            if (!close_enough(got, ref, 0.08f, 0.01f)) CHK_FAIL(F, 40 + l);
        }
#endif
        EpiDown E{F.ws + WS_YE, (const float*)(F.ws + WS_GATEV)};
        { Gemm g{(const bf16*)(F.ws + WS_HID), (const bf16*)Wd, 1024, 1024, nullptr}; DownOrder S{0, cm}; pg8::gemm_phase<EpiDown, DownOrder, true, true, false, true>(F.lds, g, S, E); }
        { Gemm g{(const bf16*)(F.ws + WS_HID), (const bf16*)Wd, 512, 1024, nullptr}; DownOrder S{1, cm}; pg8::gemm_phase<EpiDown, DownOrder, true, true, false, true>(F.lds, g, S, E); }
        GRID_BAR();
    }
    if (IN(base + 11)) {
#if MK_CHECK
        for (int sidx = 0; sidx < 2; ++sidx) {
            const unsigned h = hash_u((F.gw * 2 + sidx) * 2654435761u + 577u * l + 5u); const int row = h % NSLOTS, cc = (h >> 12) % D, e = row / ESLOTS;
            const float dd = dot_fp8(F.ws + WS_HID + (size_t)row * FF, Wd + ((size_t)e * 1024 + cc) * 2048, 2048, F.lane) * (1.f / (W8_SCALE * H8_SCALE));
            const float ref = dd * ((const float*)(F.ws + WS_GATEV))[row], p1 = fp8f(F.ws + WS_YE + (size_t)row * D, cc) * (1.f / YE8_SCALE), p2 = ((row >> 8) >= DOWN_FULL_PANELS) ? fp8f(F.ws + WS_YE + (size_t)(NSLOTS + row) * D, cc) * (1.f / YE8_SCALE) : 0.f;
            if (!(fabsf(p1 + p2 - ref) <= 0.07f * (fabsf(p1) + fabsf(p2)) + 0.0005f)) CHK_FAIL(F, 50 + l);
        }
#endif
        for (int rep = 0; rep < MK_REP_COMB; ++rep) phase_combine(F, a, l); if (l < 3) GRID_BAR();
    }
}
#undef IN

constexpr int N_PHASES = 3 + 4 * 12;
__global__ void __launch_bounds__(512, 2) mk_fwd(Args a) {
    extern __shared__ __attribute__((aligned(16))) unsigned char lds_raw[];
    LAS unsigned char* lds0 = (LAS unsigned char*)lds_raw;
    Frame F;
    F.lds = lds0 + LDS_PH; F.ws = a.ws; F.out = a.out; F.ctl = (unsigned*)(a.ws + WS_CTL);
    F.tid = threadIdx.x; F.lane = F.tid & 63; F.wave = __builtin_amdgcn_readfirstlane(F.tid >> 6); F.G = gridDim.x; F.bid = blockIdx.x; F.gw = F.bid * 8 + F.wave; F.NGW = F.G * 8;
    if (F.tid < LDS_PH / 4) ((LAS unsigned*)lds0)[F.tid] = 0u;
    __syncthreads();
#if !MK_SPLIT
    XcdBarrier bar = xcd_barrier_post(F.ctl + CW_BAR, (volatile LAS unsigned*)lds0);
#else
    XcdBarrier bar; bar.bar = F.ctl + CW_BAR; bar.x = 0; bar.st = (volatile LAS unsigned*)lds0;
#endif
    const int lo = a.ph_lo, hi = a.ph_hi;
#define IN(k) (lo <= (k) && (k) < hi)
    if (IN(0)) { phase_prologue(F, a); GRID_BAR(); }
    if (IN(2)) { phase_mod0(F, a); GRID_BAR(); }
    int cv_it = F.gw;
    run_mixer<0>(F, a, bar, lo, hi, 0, 0, 0, cv_it);
    run_moe(F, a, bar, lo, hi, 0, 0);
    run_mixer<1>(F, a, bar, lo, hi, 1, 0, 1, cv_it);
    run_moe(F, a, bar, lo, hi, 1, 1);
    run_mixer<2>(F, a, bar, lo, hi, 2, 0, 0, cv_it);
    run_moe(F, a, bar, lo, hi, 2, 2);
    run_mixer<0>(F, a, bar, lo, hi, 3, 1, 2, cv_it);
    run_moe(F, a, bar, lo, hi, 3, 0);
#undef IN
}

extern "C" void kernel_launch(void* const* d_in, const int* in_sizes, int n_in, void* d_out, int out_size, void* d_ws, size_t ws_size, hipStream_t stream) {
    static int grid = 0;
    if (grid == 0) {
        if (n_in != 29 || out_size != 19529728 || ws_size < WS_END) { fprintf(stderr, "kernel_launch: unexpected sizes n_in %d out %d ws %zu\n", n_in, out_size, ws_size); grid = -1; return; }
        int dev = 0, cus = 0, per_cu = 0;
        if (hipGetDevice(&dev) != hipSuccess || hipDeviceGetAttribute(&cus, hipDeviceAttributeMultiprocessorCount, dev) != hipSuccess) { grid = -1; return; }
        if (hipFuncSetAttribute((const void*)mk_fwd, hipFuncAttributeMaxDynamicSharedMemorySize, LDS_BYTES) != hipSuccess) { fprintf(stderr, "kernel_launch: hipFuncSetAttribute failed\n"); grid = -1; return; }
        if (hipOccupancyMaxActiveBlocksPerMultiprocessor(&per_cu, (const void*)mk_fwd, 512, LDS_BYTES) != hipSuccess || per_cu < 1) fprintf(stderr, "kernel_launch: occupancy query says %d\n", per_cu);
        (void)hipGetLastError();
        grid = cus;
    }
    if (grid < 0) return;
    (void)hipMemsetAsync((char*)d_ws + WS_CTL, 0, CTL_BYTES, stream);
    Args a{};
    for (int i = 0; i < 29; ++i) a.in[i] = (const float*)d_in[i];
    a.out = (float*)d_out; a.ws = (unsigned char*)d_ws;
#if MK_SPLIT
    for (int p = 0; p < N_PHASES; ++p) {
        const int r = (p - 3) % 12, l = (p - 3) / 12;
        if (p >= 3) { const bool mla = (l % 3) == 2; if (!mla && (r == 1 || r == 2)) continue; }
        a.ph_lo = p; a.ph_hi = p + 1;
        hipLaunchKernelGGL(mk_fwd, dim3(grid), dim3(512), LDS_BYTES, stream, a);
    }
#else
    a.ph_lo = 0; a.ph_hi = N_PHASES;
    hipLaunchKernelGGL(mk_fwd, dim3(grid), dim3(512), LDS_BYTES, stream, a);
#endif
}
```

```cpp
#include <hip/hip_runtime.h>
#include <cstdio>
#include <cstdint>

#ifndef MK_SPLIT
#define MK_SPLIT 0
#endif
#ifndef MK_REP_ATTN
#define MK_REP_ATTN 1
#endif
#ifndef MK_REP_CONV
#define MK_REP_CONV 1
#endif
#ifndef MK_REP_POST
#define MK_REP_POST 1
#endif
#ifndef MK_REP_GEMM
#define MK_REP_GEMM 1
#endif
#ifndef MK_REP_LN1
#define MK_REP_LN1 1
#endif
#ifndef MK_REP_TOPK
#define MK_REP_TOPK 1
#endif
#ifndef MK_REP_GATH
#define MK_REP_GATH 1
#endif
#ifndef MK_REP_COMB
#define MK_REP_COMB 1
#endif
#ifndef MK_CHECK
#define MK_CHECK 0
#endif

#define LAS __attribute__((address_space(3)))
typedef unsigned short bf16;
typedef unsigned u32x4 __attribute__((ext_vector_type(4)));
typedef unsigned u32x2 __attribute__((ext_vector_type(2)));
typedef float f32x2 __attribute__((ext_vector_type(2)));
typedef float f32x4 __attribute__((ext_vector_type(4)));
typedef float f32x16 __attribute__((ext_vector_type(16)));
typedef short bf16x8 __attribute__((ext_vector_type(8)));
typedef __bf16 bf16x2_t __attribute__((ext_vector_type(2)));

constexpr int D = 1024, NCTX = 4096, NLAT = 8192, NTOK = 12288;
constexpr int NE = 16, FF = 2048, CAPC = 512, CAPL = 1024, ESLOTS = 1536, NSLOTS = 24576;
constexpr float ALPHA = 1.681792830507429f, LOG2E = 1.4426950408889634f;
constexpr float GQA_QS = 0.125f * LOG2E, MLA_QS = 0.10206207261596575f * LOG2E;
constexpr size_t DWN_PART = (size_t)8 << 20;
constexpr int OFF_YP = 0, OFF_NK = 12582912, OFF_NV = OFF_NK + 3145728, OFF_CKV = OFF_NV + 3145728, OFF_KPE = OFF_CKV + 524288;

constexpr size_t MiB = 1u << 20;
constexpr size_t WS_CTL = 0, CTL_BYTES = 1 * MiB;
constexpr size_t WS_ADAP = 1 * MiB, WS_ADA = 9 * MiB, WS_ROPE64 = 10 * MiB, WS_ROPE32 = 10 * MiB + 512 * 1024;
constexpr size_t WS_AFF = 11 * MiB, WS_IDX = 12 * MiB, WS_GATEV = 12 * MiB + 128 * 1024, WS_SLOTMAP = 13 * MiB;
constexpr size_t WS_X = 16 * MiB, WS_H = 64 * MiB, WS_O = 88 * MiB, WS_AO = 112 * MiB, WS_QKV = 160 * MiB, WS_KVRAW = 232 * MiB;
constexpr size_t WS_X1 = 292 * MiB  , WS_KB = 380 * MiB, WS_VT = 428 * MiB, WS_QA = 460 * MiB, WS_CKVA = 466 * MiB;
constexpr size_t WS_XE = 470 * MiB, WS_HID = 518 * MiB, WS_YE = 614 * MiB;
constexpr size_t WS_WQKV = 712 * MiB, WS_WO = 724 * MiB, WS_WDN = 732 * MiB, WS_WUQ = 733 * MiB, WS_WUKV = 734 * MiB;
constexpr size_t WS_WGU = 736 * MiB, WS_WD = 1248 * MiB, WS_END = 1504 * MiB;
constexpr int CW_ERR = 0, CW_BAR = 4096, CW_KV = 8192;

constexpr int LDS_BYTES = 147456, LDS_PH = 256;

__device__ __forceinline__ unsigned cvtpk(float lo, float hi) { f32x2 v = {lo, hi}; bf16x2_t b = __builtin_convertvector(v, bf16x2_t); return __builtin_bit_cast(unsigned, b); }
__device__ __forceinline__ bf16 f2bf(float f) { return (bf16)(cvtpk(f, 0.f) & 0xffffu); }
__device__ __forceinline__ float bf2f(bf16 b) { return __uint_as_float(((unsigned)b) << 16); }
__device__ __forceinline__ unsigned pk4_fp8(float a, float b, float c, float d) { int w = __builtin_amdgcn_cvt_pk_fp8_f32(a, b, 0, false); w = __builtin_amdgcn_cvt_pk_fp8_f32(c, d, w, true); return (unsigned)w; }
constexpr float W8_SCALE = 64.f, H8_SCALE = 8.f;
constexpr float YE8_SCALE = 128.f;
__device__ __forceinline__ float clamp8(float x) { return __builtin_amdgcn_fmed3f(x, -448.f, 448.f); }
__device__ __forceinline__ f32x4 bf4(u32x2 w) { return (f32x4){__uint_as_float(w.x << 16), __uint_as_float(w.x & 0xffff0000u), __uint_as_float(w.y << 16), __uint_as_float(w.y & 0xffff0000u)}; }
__device__ __forceinline__ u32x2 pk4(f32x4 v) { u32x2 w; w.x = cvtpk(v[0], v[1]); w.y = cvtpk(v[2], v[3]); return w; }
template <int CTRL> __device__ __forceinline__ float dppf(float v) { return __uint_as_float((unsigned)__builtin_amdgcn_update_dpp(0, (int)__float_as_uint(v), CTRL, 0xf, 0xf, true)); }
constexpr int DPP_X1 = 0xB1, DPP_X2 = 0x4E, DPP_HMIR = 0x141, DPP_MIR = 0x140, DPP_X8 = 0x128;
__device__ __forceinline__ float xsum16(float a, float b) { const auto r = __builtin_amdgcn_permlane16_swap(__float_as_uint(a), __float_as_uint(b), false, false); return __uint_as_float(r[0]) + __uint_as_float(r[1]); }
__device__ __forceinline__ float xsum32(float a, float b) { const auto r = __builtin_amdgcn_permlane32_swap(__float_as_uint(a), __float_as_uint(b), false, false); return __uint_as_float(r[0]) + __uint_as_float(r[1]); }
__device__ __forceinline__ float xmax16(float a) { const auto r = __builtin_amdgcn_permlane16_swap(__float_as_uint(a), __float_as_uint(a), false, false); return fmaxf(__uint_as_float(r[0]), __uint_as_float(r[1])); }
__device__ __forceinline__ float xmax32(float a) { const auto r = __builtin_amdgcn_permlane32_swap(__float_as_uint(a), __float_as_uint(a), false, false); return fmaxf(__uint_as_float(r[0]), __uint_as_float(r[1])); }
__device__ __forceinline__ float sum16(float v) { v += dppf<DPP_X1>(v); v += dppf<DPP_X2>(v); v += dppf<DPP_HMIR>(v); v += dppf<DPP_MIR>(v); return v; }
__device__ __forceinline__ float wave_sum(float v) { v = sum16(v); v = xsum16(v, v); return xsum32(v, v); }
__device__ __forceinline__ float wave_max(float v) {
    v = fmaxf(v, dppf<DPP_X1>(v)); v = fmaxf(v, dppf<DPP_X2>(v)); v = fmaxf(v, dppf<DPP_HMIR>(v)); v = fmaxf(v, dppf<DPP_MIR>(v)); v = xmax16(v); return xmax32(v);
}
__device__ __forceinline__ int cond_of(int t) { return t < NCTX ? 0 : 1 + ((t - NCTX) >> 11); }
__device__ __forceinline__ unsigned hash_u(unsigned x) { x ^= x >> 16; x *= 0x7feb352dU; x ^= x >> 15; x *= 0x846ca68bU; x ^= x >> 16; return x; }

#define XB_TMO      128
#define XB_XCNT(j)  (256  + 64 * (j))
#define XB_XSUB(j)  (1280 + 64 * (j))
#define XB_XGEN(j)  (2304 + 64 * (j))
#define XB_TOP      3328
#define XB_TOPGEN   3392
#define XCD_BAR_WORDS 3456
#define XB_SPIN_CAP (1u << 18)
__device__ __forceinline__ unsigned xb_ld(unsigned* p)              { return __hip_atomic_load(p, __ATOMIC_RELAXED, __HIP_MEMORY_SCOPE_AGENT); }
__device__ __forceinline__ unsigned xb_add(unsigned* p, unsigned v) { return __hip_atomic_fetch_add(p, v, __ATOMIC_RELAXED, __HIP_MEMORY_SCOPE_AGENT); }
__device__ __forceinline__ unsigned xb_xcc_id() { return (unsigned)__builtin_amdgcn_s_getreg((3 << 11) | 20) & 0xFu; }
#define XB_SPIN(cond, bar) do { unsigned _sp = 0; while (cond) { __builtin_amdgcn_s_sleep(1); \
    if ((++_sp & 255u) == 0u) { if (xb_ld(&(bar)[XB_TMO])) break; if (_sp > XB_SPIN_CAP) { atomicAdd(&(bar)[XB_TMO], 1u); break; } } } } while (0)
struct XcdBarrier { unsigned* bar; unsigned x; volatile LAS unsigned* st; };
__device__ __forceinline__ XcdBarrier xcd_barrier_post(unsigned* bar, volatile LAS unsigned* st) {
    XcdBarrier b; b.bar = bar; b.x = xb_xcc_id(); b.st = st;
    if (threadIdx.x == 0) (void)xb_add(&bar[XB_XCNT(b.x)], 1u);
    return b;
}
__device__ __forceinline__ void xcd_barrier_complete(unsigned* bar, unsigned x, unsigned& nloc, unsigned& nx) {
    const unsigned G = gridDim.x * gridDim.y * gridDim.z;
    unsigned sum, cnt, mine, sp = 0u;
    for (;;) {
        sum = 0u; cnt = 0u; mine = 0u;
#pragma unroll
        for (unsigned j = 0; j < 16; ++j) { const unsigned c = xb_ld(&bar[XB_XCNT(j)]); sum += c; cnt += (c > 0u) ? 1u : 0u; mine = (j == x) ? c : mine; }
        if (sum == G) break;
        __builtin_amdgcn_s_sleep(1);
        if ((++sp & 255u) == 0u) { if (xb_ld(&bar[XB_TMO])) break; if (sp > XB_SPIN_CAP) { atomicAdd(&bar[XB_TMO], 1u); break; } }
    }
    nloc = mine > 0u ? mine : 1u; nx = cnt > 0u ? cnt : 1u;
}
__device__ __forceinline__ void xcd_barrier(const XcdBarrier& b) {
    asm volatile("s_waitcnt vmcnt(0)" ::: "memory");
    __syncthreads();
    if (threadIdx.x == 0) {
        unsigned* bar = b.bar;
        __builtin_amdgcn_s_waitcnt(0);
        unsigned nloc = b.st[0], nx = b.st[1];
        if (nloc == 0u) { xcd_barrier_complete(bar, b.x, nloc, nx); b.st[0] = nloc; b.st[1] = nx; }
        const unsigned old = xb_add(&bar[XB_XSUB(b.x)], 1u);
        const unsigned gen = old / nloc;
        if (old + 1u == (gen + 1u) * nloc) {
            __builtin_amdgcn_fence(__ATOMIC_RELEASE, "agent");
            asm volatile("s_waitcnt vmcnt(0)" ::: "memory");
            const unsigned og = xb_add(&bar[XB_TOP], 1u);
            const unsigned tg = og / nx;
            if (og + 1u == (tg + 1u) * nx) xb_add(&bar[XB_TOPGEN], 1u);
            else XB_SPIN(xb_ld(&bar[XB_TOPGEN]) == tg, bar);
            __builtin_amdgcn_fence(__ATOMIC_ACQUIRE, "agent");
            xb_add(&bar[XB_XGEN(b.x)], 1u);
            asm volatile("s_waitcnt vmcnt(0)" ::: "memory");
        } else {
            XB_SPIN(xb_ld(&bar[XB_XGEN(b.x)]) == gen, bar);
            __builtin_amdgcn_fence(__ATOMIC_ACQUIRE, "agent");
            asm volatile("s_waitcnt vmcnt(0)" ::: "memory");
        }
    }
    __syncthreads();
}

struct Args { const float* in[29]; float* out; unsigned char* ws; int ph_lo, ph_hi; };
struct Frame {
    LAS unsigned char* lds;
    unsigned char* ws; float* out; unsigned* ctl;
    int tid, lane, wave, G, bid, gw, NGW;
};
#if MK_CHECK
#define CHK_FAIL(F, id) do { unsigned _e = 0u; __hip_atomic_compare_exchange_strong((F).ctl + CW_ERR, &_e, (unsigned)(id), __ATOMIC_RELAXED, __ATOMIC_RELAXED, __HIP_MEMORY_SCOPE_AGENT); } while (0)
#endif
__device__ __forceinline__ bool close_enough(float a, float b, float rel, float abs_) { const float d = fabsf(a - b); return d <= rel * fabsf(b) + abs_ && a == a; }

namespace pg8 {
#define PG8_LAS __attribute__((address_space(3)))
typedef unsigned short bf16_t;
typedef short bf16x8 __attribute__((ext_vector_type(8)));
typedef float f32x4 __attribute__((ext_vector_type(4)));
constexpr int BM = 256, BK = 64, HALF = 128, HTB = HALF * BK * 2  , STAGE_BYTES = 8 * HTB, NXCD = 8, WGM = 8;

__host__ __device__ __forceinline__ int lds_byte(int r, int c, int XM = 32) { const int st = (r >> 4) * 2 + (c >> 5), rr = r & 15, cc = c & 31, ob = rr * 64 + cc * 2; return st * 1024 + (ob ^ (((ob >> 9) & 1) * XM)); }
__host__ __device__ __forceinline__ void stage_rc(int b, int& R, int& C, int XM = 32) { const int st = b / 1024, sb = b % 1024, swz = sb ^ (((sb >> 9) & 1) * XM); R = (st >> 1) * 16 + swz / 64; C = (st & 1) * 32 + (swz % 64) / 2; }
__host__ __device__ __forceinline__ int perm32(int rho) { const int n = rho >> 4, i = rho & 15; return 8 * (i >> 2) + 4 * n + (i & 3); }
struct Unit { int pm, pn, kb; };
struct Gemm { const bf16_t* A; const bf16_t* Bt; int K, ld; const int* aidx; };
template <class Epi, class Sched, bool ALIGN_EPI = false, bool SP2 = false, bool GATHER = false, bool F8 = false>
__device__ __forceinline__ void gemm_phase(PG8_LAS unsigned char* lds, const Gemm g, const Sched& S, const Epi& E) {
    int tid_ = threadIdx.x; asm volatile("" : "+v"(tid_));
    const int tid = tid_, wid = __builtin_amdgcn_readfirstlane(tid >> 6), lane = tid & 63, wr = wid >> 2, wc = wid & 3, fr = lane & 15, fq = lane >> 4;
    const int K = g.K, LD = g.ld, nt = K / BK;
    unsigned voffA[2], voffB[2]; int RA[2]; unsigned CA2[2];
#pragma unroll
    for (int i = 0; i < 2; ++i) { int R, C; stage_rc(tid * 16 + i * 8192, R, C, F8 ? 48 : 32); const int Rb = Epi::PERM ? ((R & ~31) + perm32(R & 31)) : R;
        voffA[i] = (unsigned)(R * LD + C) * 2u; voffB[i] = (unsigned)(Rb * LD + C) * 2u; RA[i] = R; CA2[i] = (unsigned)C * 2u; }
    const size_t kstep = (size_t)(BK * 2);
    const size_t hstep = (size_t)HALF * LD * 2;
    const size_t tstep = 2 * hstep;
    const unsigned ldsw = (unsigned)wid * 1024u;
    const int aoff = lds_byte(wr * 64 + fr, F8 ? fq * 16 : fq * 8, F8 ? 48 : 32), boff = lds_byte(wc * 32 + fr, F8 ? fq * 16 : fq * 8, F8 ? 48 : 32);
    const int aoffh = aoff ^ 16, boffh = boff ^ 16;
    typedef int i32x8_t __attribute__((ext_vector_type(8)));
#define PG8_SA(b, h) (((b) * 2 + (h)) * HTB)
#define PG8_SB(b, h) ((4 + (b) * 2 + (h)) * HTB)
#define PG8_STAGE(bufoff, gbase, voff) do { _Pragma("unroll") for (int _i = 0; _i < 2; ++_i) \
        __builtin_amdgcn_global_load_lds((const unsigned*)((const char*)(gbase) + (voff)[_i]), (PG8_LAS unsigned*)(lds + (bufoff) + ldsw + _i * 8192), 16, 0, 0); } while (0)
#define PG8_GOFF(dst, unit) do { _Pragma("unroll") for (int _h = 0; _h < 2; ++_h) _Pragma("unroll") for (int _i = 0; _i < 2; ++_i) dst[_h][_i] = (unsigned)g.aidx[(unit).pm * 256 + _h * 128 + RA[_i]] * (unsigned)(LD * 2) + CA2[_i]; } while (0)
#define PG8_STAGE_A(bufoff, gbase, h, nx) do { if constexpr (GATHER) { unsigned _o[2] = {(nx) ? oN[h][0] : oC[h][0], (nx) ? oN[h][1] : oC[h][1]}; PG8_STAGE(bufoff, gbase, _o); } else { PG8_STAGE(bufoff, (gbase) + (h) * hstep, voffA); } } while (0)
#define PG8_LDA16(dst, b, h) do { _Pragma("unroll") for (int m = 0; m < 4; ++m) _Pragma("unroll") for (int k = 0; k < 2; ++k) dst[m][k] = *(const PG8_LAS bf16x8*)(lds + PG8_SA(b, h) + aoff + m * 2048 + k * 1024); } while (0)
#define PG8_LDB16(dst, b, h) do { _Pragma("unroll") for (int n = 0; n < 2; ++n) _Pragma("unroll") for (int k = 0; k < 2; ++k) dst[n][k] = *(const PG8_LAS bf16x8*)(lds + PG8_SB(b, h) + boff + n * 2048 + k * 1024); } while (0)
#define PG8_MMA16(ai, bj, At, Bt) do { __builtin_amdgcn_s_setprio(1); _Pragma("unroll") for (int m = 0; m < 4; ++m) _Pragma("unroll") for (int n = 0; n < 2; ++n) _Pragma("unroll") for (int k = 0; k < 2; ++k) \
        acc[ai][bj][m][n] = __builtin_amdgcn_mfma_f32_16x16x32_bf16(Bt[n][k], At[m][k], acc[ai][bj][m][n], 0, 0, 0); __builtin_amdgcn_s_setprio(0); } while (0)
#define PG8_LD32(p, lo, hi) __builtin_bit_cast(i32x8_t, __builtin_shufflevector(*(const PG8_LAS bf16x8*)((p) + (lo)), *(const PG8_LAS bf16x8*)((p) + (hi)), 0, 1, 2, 3, 4, 5, 6, 7, 8, 9, 10, 11, 12, 13, 14, 15))
#define PG8_LDA(dst, b, h) do { if constexpr (F8) { _Pragma("unroll") for (int m = 0; m < 4; ++m) dst##8[m] = PG8_LD32(lds + PG8_SA(b, h) + m * 2048, aoff, aoffh); } else { PG8_LDA16(dst, b, h); } } while (0)
#define PG8_LDB(dst, b, h) do { if constexpr (F8) { _Pragma("unroll") for (int n = 0; n < 2; ++n) dst##8[n] = PG8_LD32(lds + PG8_SB(b, h) + n * 2048, boff, boffh); } else { PG8_LDB16(dst, b, h); } } while (0)
#define PG8_MMA(ai, bj, At, Bt) do { if constexpr (F8) { __builtin_amdgcn_s_setprio(1); _Pragma("unroll") for (int m = 0; m < 4; ++m) _Pragma("unroll") for (int n = 0; n < 2; ++n) \
        asm volatile("v_mfma_f32_16x16x128_f8f6f4 %0, %1, %2, %0" : "+v"(acc[ai][bj][m][n]) : "v"(Bt##8[n]), "v"(At##8[m])); __builtin_amdgcn_s_setprio(0); } else { PG8_MMA16(ai, bj, At, Bt); } } while (0)
#define PG8_WAIT_V(n) asm volatile("s_waitcnt vmcnt(" #n ")" ::: "memory")
#define PG8_WAIT_L(n) asm volatile("s_waitcnt lgkmcnt(" #n ")" ::: "memory")
#define PG8_BAR __builtin_amdgcn_s_barrier()
#define PG8_SCHED __builtin_amdgcn_sched_barrier(0)
    Unit cur, nxt; int ui = 0;
    if (!S.next(0, cur)) return;
    unsigned oC[2][2] = {{0u, 0u}, {0u, 0u}}, oN[2][2] = {{0u, 0u}, {0u, 0u}};
    if constexpr (GATHER) PG8_GOFF(oC, cur);
    f32x4 acc[2][2][4][2];
#pragma unroll
    for (int a = 0; a < 2; ++a)
#pragma unroll
        for (int b = 0; b < 2; ++b)
#pragma unroll
            for (int m = 0; m < 4; ++m)
#pragma unroll
                for (int n = 0; n < 2; ++n) acc[a][b][m][n] = (f32x4){0.f, 0.f, 0.f, 0.f};
    bf16x8 At[4][2], B0[2][2], B1[2][2]; i32x8_t At8[4], B08[2], B18[2];
    const char* cA = GATHER ? (const char*)g.A + cur.kb : (const char*)g.A + (size_t)cur.pm * tstep + cur.kb; const char* cB = (const char*)g.Bt + (size_t)cur.pn * tstep + cur.kb;
    S.a_ready(cur);
    if constexpr (SP2) {
        PG8_STAGE(PG8_SB(0, 0), cB, voffB); PG8_STAGE(PG8_SB(0, 1), cB + hstep, voffB); PG8_STAGE_A(PG8_SA(0, 0), cA, 0, false); PG8_STAGE_A(PG8_SA(0, 1), cA, 1, false);
        if (wr == 1) PG8_BAR;
        PG8_WAIT_V(2); PG8_BAR;
        PG8_STAGE(PG8_SB(1, 0), cB + kstep, voffB); PG8_STAGE_A(PG8_SA(1, 0), cA + kstep, 0, false); PG8_STAGE(PG8_SB(1, 1), cB + hstep + kstep, voffB);
        PG8_WAIT_V(6); PG8_BAR;
    } else {
        PG8_STAGE(PG8_SB(0, 0), cB, voffB); PG8_STAGE_A(PG8_SA(0, 0), cA, 0, false); PG8_STAGE(PG8_SB(0, 1), cB + hstep, voffB); PG8_STAGE_A(PG8_SA(0, 1), cA, 1, false);
        if (wr == 1) PG8_BAR;
        PG8_WAIT_V(4); PG8_BAR;
        PG8_STAGE(PG8_SB(1, 0), cB + kstep, voffB); PG8_STAGE_A(PG8_SA(1, 0), cA + kstep, 0, false); PG8_STAGE(PG8_SB(1, 1), cB + hstep + kstep, voffB);
        PG8_WAIT_V(6); PG8_BAR;
    }
    for (;;) {
        const bool has_next = S.next(ui + 1, nxt);
        const char* nA = has_next ? (GATHER ? (const char*)g.A + nxt.kb : (const char*)g.A + (size_t)nxt.pm * tstep + nxt.kb) : cA;
        if constexpr (GATHER) { if (has_next) PG8_GOFF(oN, nxt); } const char* nB = has_next ? (const char*)g.Bt + (size_t)nxt.pn * tstep + nxt.kb : cB;
        for (int t = 0; t < nt; t += 2) {
            const bool last = (t == nt - 2); const bool lastn = last && has_next;
            const char* a1 = cA + (size_t)(t + 1) * kstep;
            const char* a2 = last ? nA : cA + (size_t)(t + 2) * kstep; const char* b2 = last ? nB : cB + (size_t)(t + 2) * kstep;
            const char* a3 = a2 + kstep; const char* b3 = b2 + kstep;
            if (last && has_next) S.a_ready(nxt);
            if constexpr (SP2) {
            PG8_LDB(B0, 0, 0); PG8_LDB(B1, 0, 1); PG8_SCHED; PG8_LDA(At, 0, 0); PG8_STAGE_A(PG8_SA(1, 1), a1, 1, false);
            PG8_WAIT_V(8); PG8_WAIT_L(0); PG8_BAR; PG8_MMA(0, 0, At, B0); PG8_MMA(0, 1, At, B1); PG8_BAR; PG8_SCHED;
            PG8_LDA(At, 0, 1); PG8_STAGE(PG8_SB(0, 0), b2, voffB); PG8_STAGE(PG8_SB(0, 1), b2 + hstep, voffB); PG8_STAGE_A(PG8_SA(0, 0), a2, 0, lastn);
            PG8_WAIT_V(8); PG8_WAIT_L(0); PG8_BAR; PG8_MMA(1, 0, At, B0); PG8_MMA(1, 1, At, B1); PG8_BAR; PG8_SCHED;
            PG8_LDB(B0, 1, 0); PG8_LDB(B1, 1, 1); PG8_SCHED; PG8_LDA(At, 1, 0); PG8_STAGE_A(PG8_SA(0, 1), a2, 1, lastn);
            PG8_WAIT_V(8); PG8_WAIT_L(0); PG8_BAR; PG8_MMA(0, 0, At, B0); PG8_MMA(0, 1, At, B1); PG8_BAR; PG8_SCHED;
            PG8_LDA(At, 1, 1); PG8_STAGE(PG8_SB(1, 0), b3, voffB); PG8_STAGE(PG8_SB(1, 1), b3 + hstep, voffB); PG8_STAGE_A(PG8_SA(1, 0), a3, 0, lastn);
            PG8_WAIT_V(8); PG8_WAIT_L(0); PG8_BAR; PG8_MMA(1, 0, At, B0); PG8_MMA(1, 1, At, B1); PG8_BAR; PG8_SCHED;
            } else {
            PG8_LDB(B0, 0, 0); PG8_SCHED; PG8_LDA(At, 0, 0); PG8_STAGE_A(PG8_SA(1, 1), a1, 1, false);
            PG8_WAIT_L(8); PG8_BAR; PG8_WAIT_L(0); PG8_MMA(0, 0, At, B0); PG8_BAR; PG8_SCHED;
            PG8_LDB(B1, 0, 1); PG8_STAGE(PG8_SB(0, 0), b2, voffB);
            PG8_BAR; PG8_WAIT_L(0); PG8_MMA(0, 1, At, B1); PG8_BAR;
            PG8_LDA(At, 0, 1); PG8_STAGE_A(PG8_SA(0, 0), a2, 0, lastn);
            PG8_BAR; PG8_WAIT_L(0); PG8_MMA(1, 0, At, B0); PG8_BAR; PG8_SCHED;
            PG8_STAGE(PG8_SB(0, 1), b2 + hstep, voffB);
            PG8_WAIT_V(6); PG8_BAR; PG8_MMA(1, 1, At, B1); PG8_BAR;
            PG8_LDB(B0, 1, 0); PG8_SCHED; PG8_LDA(At, 1, 0); PG8_STAGE_A(PG8_SA(0, 1), a2, 1, lastn);
            PG8_WAIT_L(8); PG8_BAR; PG8_WAIT_L(0); PG8_MMA(0, 0, At, B0); PG8_BAR; PG8_SCHED;
            PG8_LDB(B1, 1, 1); PG8_STAGE(PG8_SB(1, 0), b3, voffB);
            PG8_BAR; PG8_WAIT_L(0); PG8_MMA(0, 1, At, B1); PG8_BAR;
            PG8_LDA(At, 1, 1); PG8_STAGE_A(PG8_SA(1, 0), a3, 0, lastn);
            PG8_BAR; PG8_WAIT_L(0); PG8_MMA(1, 0, At, B0); PG8_BAR; PG8_SCHED;
            PG8_STAGE(PG8_SB(1, 1), b3 + hstep, voffB);
            PG8_WAIT_V(6); PG8_BAR; PG8_MMA(1, 1, At, B1); PG8_BAR;
            }
        }
        if constexpr (ALIGN_EPI) { if (wr == 0) PG8_BAR; }
        if constexpr (F8) {
#pragma unroll
            for (int a = 0; a < 2; ++a)
#pragma unroll
                for (int b = 0; b < 2; ++b)
                    asm volatile("s_nop 15\n\ts_nop 7" : "+v"(acc[a][b][0][0]), "+v"(acc[a][b][0][1]), "+v"(acc[a][b][1][0]), "+v"(acc[a][b][1][1]), "+v"(acc[a][b][2][0]), "+v"(acc[a][b][2][1]), "+v"(acc[a][b][3][0]), "+v"(acc[a][b][3][1])); }
        if constexpr (!Epi::AFTER_DRAIN) { E(acc, cur, wr, wc, fr, fq); S.done(cur); }
        if (!has_next) break;
#pragma unroll
        for (int a = 0; a < 2; ++a)
#pragma unroll
            for (int b = 0; b < 2; ++b)
#pragma unroll
                for (int m = 0; m < 4; ++m)
#pragma unroll
                    for (int n = 0; n < 2; ++n) acc[a][b][m][n] = (f32x4){0.f, 0.f, 0.f, 0.f};
        cur = nxt; cA = nA; cB = nB; ++ui;
        if constexpr (GATHER) { oC[0][0] = oN[0][0]; oC[0][1] = oN[0][1]; oC[1][0] = oN[1][0]; oC[1][1] = oN[1][1]; }
        if constexpr (ALIGN_EPI) { if (wr == 1) PG8_BAR; }
    }
    PG8_WAIT_V(0);
    if constexpr (!ALIGN_EPI) { if (wr == 0) PG8_BAR; }
    PG8_BAR;
    if constexpr (Epi::AFTER_DRAIN) { E.fused(acc, cur, wr, wc, fr, fq, lds, wid, lane); S.done(cur); }
#undef PG8_SA
#undef PG8_SB
#undef PG8_STAGE
#undef PG8_STAGE_A
#undef PG8_GOFF
#undef PG8_LDA
#undef PG8_LDA16
#undef PG8_LD32
#undef PG8_LDB16
#undef PG8_MMA16
#undef PG8_LDB
#undef PG8_MMA
#undef PG8_WAIT_V
#undef PG8_WAIT_L
#undef PG8_BAR
#undef PG8_SCHED
}
}
using pg8::Unit; using pg8::Gemm;
struct ChunkMap { int x, loc, nx, chunk;
    __device__ void init(int G, int bid) { if (G % 8 == 0) { nx = 8; chunk = G / 8; x = bid % 8; loc = bid / 8; } else { nx = 1; chunk = G; x = 0; loc = bid; } }
    __device__ __forceinline__ int lin(int i) const { return (i * nx + x) * chunk + loc; } };
struct PlainOrder {
    int nN, total; ChunkMap cm;
    __device__ bool next(int i, Unit& u) const { const int L = cm.lin(i); if (L >= total) return false; u.pm = L / nN; u.pn = L % nN; u.kb = 0; return true; }
    __device__ __forceinline__ void a_ready(const Unit&) const {}
    __device__ __forceinline__ void done(const Unit&) const {}
};
struct QkvOrder { ChunkMap cm;
    __device__ bool next(int i, Unit& u) const { const int L = cm.lin(i); if (L >= 288) return false;
        if (L >= 32 && L < 128) { const int r = L - 32; u.pm = r >> 1; u.pn = 4 + (r & 1); } else { const int r = L < 32 ? L : L - 96; u.pm = r >> 2; u.pn = r & 3; }
        u.kb = 0; return true; }
    __device__ __forceinline__ void a_ready(const Unit&) const {}
    __device__ __forceinline__ void done(const Unit&) const {}
};
struct SplitKOrder {
    int nN, ks, kbytes, total; ChunkMap cm;
    __device__ bool next(int i, Unit& u) const { const int L = cm.lin(i); if (L >= total) return false; const int t = L / ks; u.pm = t / nN; u.pn = t % nN; u.kb = (L % ks) * kbytes; return true; }
    __device__ __forceinline__ void a_ready(const Unit&) const {}
    __device__ __forceinline__ void done(const Unit&) const {}
};
struct GroupedOrder {
    int mt, nt, ks, kbytes; ChunkMap cm;
    __device__ bool next(int i, Unit& u) const { const int L = cm.lin(i), per = mt * nt * ks; if (L >= NE * per) return false; const int e = L / per, r = L % per, m = r / (nt * ks), q = r % (nt * ks);
        u.pm = e * mt + m; u.pn = e * nt + q / ks; u.kb = (q % ks) * kbytes; return true; }
    __device__ __forceinline__ void a_ready(const Unit&) const {}
    __device__ __forceinline__ void done(const Unit&) const {}
};
constexpr int DOWN_FULL_PANELS = 64;
struct DownOrder { int half; ChunkMap cm;
    __device__ bool next(int i, Unit& u) const { const int L = cm.lin(i); if (L >= 256) return false; const int T = half ? 256 + (L >> 1) : L; u.pm = T >> 2; u.pn = (u.pm / 6) * 4 + (T & 3); u.kb = half ? (L & 1) * 1024 : 0; return true; }
    __device__ __forceinline__ void a_ready(const Unit&) const {}
    __device__ __forceinline__ void done(const Unit&) const {}
};
struct EpiF32 { float* C; int ldc; size_t kstride; static constexpr bool PERM = false, AFTER_DRAIN = false;
    __device__ __forceinline__ void operator()(const f32x4 (&acc)[2][2][4][2], const Unit& u, int wr, int wc, int fr, int fq) const {
#pragma unroll
        for (int ai = 0; ai < 2; ++ai)
#pragma unroll
            for (int m = 0; m < 4; ++m) { float* rp = C + (u.kb ? kstride : (size_t)0) + (size_t)(u.pm * 256 + ai * 128 + wr * 64 + m * 16 + fr) * ldc + u.pn * 256 + wc * 32 + 4 * fq;
#pragma unroll
                for (int bj = 0; bj < 2; ++bj)
#pragma unroll
                    for (int n = 0; n < 2; ++n) *(f32x4*)(rp + bj * 128 + n * 16) = acc[ai][bj][m][n]; }
    }
};
struct EpiBf16P { bf16* C; int ldc; static constexpr bool PERM = true, AFTER_DRAIN = false;
    __device__ __forceinline__ void operator()(const f32x4 (&acc)[2][2][4][2], const Unit& u, int wr, int wc, int fr, int fq) const {
#pragma unroll
        for (int ai = 0; ai < 2; ++ai)
#pragma unroll
            for (int m = 0; m < 4; ++m) { bf16* rp = C + (size_t)(u.pm * 256 + ai * 128 + wr * 64 + m * 16 + fr) * ldc + u.pn * 256 + wc * 32 + 8 * fq;
#pragma unroll
                for (int bj = 0; bj < 2; ++bj) { const f32x4 v0 = acc[ai][bj][m][0], v1 = acc[ai][bj][m][1]; u32x4 w; w.x = cvtpk(v0[0], v0[1]); w.y = cvtpk(v0[2], v0[3]); w.z = cvtpk(v1[0], v1[1]); w.w = cvtpk(v1[2], v1[3]);
                    *(u32x4*)(rp + bj * 128) = w; } }
    }
};
__device__ __forceinline__ float silu_f(float x) { return x * __builtin_amdgcn_rcpf(1.f + __builtin_amdgcn_exp2f(-x * LOG2E)); }
struct EpiSwiglu { unsigned char* HID; static constexpr bool PERM = true, AFTER_DRAIN = false;
    __device__ __forceinline__ void operator()(const f32x4 (&acc)[2][2][4][2], const Unit& u, int wr, int wc, int fr, int fq) const {
        const int cb = (u.pn & 15) * 128 + wc * 32 + 8 * fq; constexpr float IS = 1.f / W8_SCALE;
#pragma unroll
        for (int ai = 0; ai < 2; ++ai)
#pragma unroll
            for (int m = 0; m < 4; ++m) { unsigned char* rp = HID + (size_t)(u.pm * 256 + ai * 128 + wr * 64 + m * 16 + fr) * FF + cb; u32x2 w;
#pragma unroll
                for (int n = 0; n < 2; ++n) { const f32x4 g = acc[ai][0][m][n] * IS, up = acc[ai][1][m][n] * (IS * H8_SCALE);
                    const unsigned pk = pk4_fp8(silu_f(g[0]) * up[0], silu_f(g[1]) * up[1], silu_f(g[2]) * up[2], silu_f(g[3]) * up[3]); if (n == 0) w.x = pk; else w.y = pk; }
                *(u32x2*)rp = w; asm volatile("" ::: "memory"); }
    }
};
struct EpiDown { unsigned char* YE; const float* gate; static constexpr bool PERM = true, AFTER_DRAIN = false;
    __device__ __forceinline__ void operator()(const f32x4 (&acc)[2][2][4][2], const Unit& u, int wr, int wc, int fr, int fq) const {
        const int cb = (u.pn & 3) * 256 + wc * 32 + 8 * fq;
#pragma unroll
        for (int ai = 0; ai < 2; ++ai)
#pragma unroll
            for (int m = 0; m < 4; ++m) { const int row = u.pm * 256 + ai * 128 + wr * 64 + m * 16 + fr; const float gv = gate[row] * (YE8_SCALE / (W8_SCALE * H8_SCALE)); unsigned char* rp = YE + (size_t)(u.kb ? NSLOTS : 0) * D + (size_t)row * D + cb;
#pragma unroll
                for (int bj = 0; bj < 2; ++bj) { const f32x4 v0 = acc[ai][bj][m][0] * gv, v1 = acc[ai][bj][m][1] * gv; u32x2 w;
                    w.x = pk4_fp8(clamp8(v0[0]), clamp8(v0[1]), clamp8(v0[2]), clamp8(v0[3])); w.y = pk4_fp8(clamp8(v1[0]), clamp8(v1[1]), clamp8(v1[2]), clamp8(v1[3])); *(u32x2*)(rp + bj * 128) = w; } }
    }
};

#if MK_CHECK
__device__ __forceinline__ float fp8f(const unsigned char* p, int i) { const int w = ((const int*)p)[i >> 2]; const int b = i & 3; return b == 0 ? __builtin_amdgcn_cvt_f32_fp8(w, 0) : b == 1 ? __builtin_amdgcn_cvt_f32_fp8(w, 1) : b == 2 ? __builtin_amdgcn_cvt_f32_fp8(w, 2) : __builtin_amdgcn_cvt_f32_fp8(w, 3); }
__device__ __forceinline__ float dot_fp8(const unsigned char* a, const unsigned char* b, int K, int lane) { float s = 0.f; for (int k = lane; k < K; k += 64) s += fp8f(a, k) * fp8f(b, k); return wave_sum(s); }
__device__ __forceinline__ float dot_bf16(const bf16* a, const bf16* b, int K, int lane) {
    float s = 0.f; for (int k = lane; k < K; k += 64) s += bf2f(a[k]) * bf2f(b[k]); return wave_sum(s);
}
#endif

__constant__ double INVF[16] = {1.0, 0.5623413251903491, 0.31622776601683794, 0.1778279410038923, 0.1, 0.05623413251903491, 0.03162277660168379, 0.01778279410038923,
                                0.01, 0.005623413251903491, 0.0031622776601683794, 0.0017782794100389228, 0.001, 0.0005623413251903491, 0.00031622776601683794, 0.00017782794100389227};
__device__ __forceinline__ void sincos_d(double a, float& s, float& c) {
    const double k = __builtin_rint(a * 0.6366197723675814), r = a - k * 1.5707963267948966, r2 = r * r;
    const double sr = r * (1.0 + r2 * (-1.0 / 6 + r2 * (1.0 / 120 + r2 * (-1.0 / 5040 + r2 * (1.0 / 362880 + r2 * (-1.0 / 39916800 + r2 * (1.0 / 6227020800.0)))))));
    const double cr = 1.0 + r2 * (-0.5 + r2 * (1.0 / 24 + r2 * (-1.0 / 720 + r2 * (1.0 / 40320 + r2 * (-1.0 / 3628800 + r2 * (1.0 / 479001600.0))))));
    const int q = ((int)k) & 3;
    const double ss = (q == 0) ? sr : (q == 1) ? cr : (q == 2) ? -sr : -cr;
    const double cc = (q == 0) ? cr : (q == 1) ? -sr : (q == 2) ? -cr : sr;
    s = (float)ss; c = (float)cc;
}
__device__ __forceinline__ void conv_load(f32x4 (&v)[16], const float* W, int N, int k0, int n0, int lane) {
    const int r4 = lane >> 4, c16 = lane & 15, n = n0 + 4 * c16;
    if (n >= N) return;
    const float* src = W + (size_t)(k0 + 16 * r4) * N + n;
#pragma unroll
    for (int i = 0; i < 16; ++i) v[i] = *(const f32x4*)(src + (size_t)i * N);
}
__device__ __forceinline__ void conv_store(const f32x4 (&v)[16], int N, bf16* WT, size_t rowbase, int ldk, int k0, int n0, int lane) {
    const int r4 = lane >> 4, c16 = lane & 15, n = n0 + 4 * c16;
    if (n >= N) return;
    bf16* dst = WT + (rowbase + 4 * c16) * (size_t)ldk + k0 + 16 * r4;
#pragma unroll
    for (int e = 0; e < 4; ++e) {
        u32x4 lo, hi;
        lo.x = cvtpk(v[0][e], v[1][e]); lo.y = cvtpk(v[2][e], v[3][e]); lo.z = cvtpk(v[4][e], v[5][e]); lo.w = cvtpk(v[6][e], v[7][e]);
        hi.x = cvtpk(v[8][e], v[9][e]); hi.y = cvtpk(v[10][e], v[11][e]); hi.z = cvtpk(v[12][e], v[13][e]); hi.w = cvtpk(v[14][e], v[15][e]);
        *(u32x4*)(dst + (size_t)e * ldk) = lo; *(u32x4*)(dst + (size_t)e * ldk + 8) = hi;
    }
}
__device__ __forceinline__ void conv_item(const float* W, int N, bf16* WT, size_t rowbase, int ldk, int k0, int n0, int lane) {
    f32x4 v[16]; conv_load(v, W, N, k0, n0, lane); conv_store(v, N, WT, rowbase, ldk, k0, n0, lane);
}
__device__ __forceinline__ void glds16(const void* gsrc, unsigned lds_dst) { unsigned keep;
    asm volatile("s_mov_b32 %0, m0\n\ts_mov_b32 m0, %2\n\ts_nop 0\n\tglobal_load_lds_dwordx4 %1, off\n\ts_mov_b32 m0, %0" : "=&s"(keep) : "v"(gsrc), "s"(lds_dst) : "memory"); }
__device__ __forceinline__ void glds16_nt(const void* gsrc, unsigned lds_dst) { unsigned keep;
    asm volatile("s_mov_b32 %0, m0\n\ts_mov_b32 m0, %2\n\ts_nop 0\n\tglobal_load_lds_dwordx4 %1, off nt\n\ts_mov_b32 m0, %0" : "=&s"(keep) : "v"(gsrc), "s"(lds_dst) : "memory"); }
__device__ __forceinline__ void conv_issue8(unsigned lds_scr, const float* W, int N, int k0, int n0, int lane) {
    const float* src = W + (size_t)(k0 + 8 * (lane >> 4)) * N + n0 + 4 * (lane & 15);
#pragma unroll
    for (int i = 0; i < 8; ++i) glds16_nt(src + (size_t)i * N, (unsigned)__builtin_amdgcn_readfirstlane(lds_scr + i * 1024));
}
__device__ __forceinline__ void conv_fetch8(f32x4 (&v)[8], const LAS unsigned char* scr, int lane) {
#pragma unroll
    for (int i = 0; i < 8; ++i) v[i] = *(const LAS f32x4*)(scr + i * 1024 + lane * 16);
}
__device__ __forceinline__ void conv_load8(f32x4 (&v)[8], const float* W, int N, int k0, int n0, int lane) {
    const float* src = W + (size_t)(k0 + 8 * (lane >> 4)) * N + n0 + 4 * (lane & 15);
#pragma unroll
    for (int i = 0; i < 8; ++i) v[i] = __builtin_nontemporal_load((const f32x4*)(src + (size_t)i * N));
}
__device__ __forceinline__ void conv_store8(const f32x4 (&v)[8], unsigned char* WT, size_t rowbase, int ldk, int k0, int lane) {
    unsigned char* dst = WT + (rowbase + 4 * (lane & 15)) * (size_t)ldk + k0 + 8 * (lane >> 4);
#pragma unroll
    for (int e = 0; e < 4; ++e) { u32x2 w; w.x = pk4_fp8(v[0][e] * W8_SCALE, v[1][e] * W8_SCALE, v[2][e] * W8_SCALE, v[3][e] * W8_SCALE); w.y = pk4_fp8(v[4][e] * W8_SCALE, v[5][e] * W8_SCALE, v[6][e] * W8_SCALE, v[7][e] * W8_SCALE);
        *(u32x2*)(dst + (size_t)e * ldk) = w; }
}
struct ConvJob { const float* gate; const float* up; const float* down; unsigned char* wgu; unsigned char* wd; };
constexpr int CV_PER_LAYER = 3 * 16 * 1024, CV_TOTAL = 4 * CV_PER_LAYER;
struct ConvItem { const float* W; unsigned char* WT; size_t rowbase; int N, ldk, k0, n0; };
__device__ __forceinline__ ConvItem cv_decode(const ConvJob& J, int it) {
    ConvItem c; const int L = it / CV_PER_LAYER, r0 = it % CV_PER_LAYER, fam = r0 >> 14, r = r0 & 16383, e = L * 16 + (r >> 10), q = r & 1023;
    if (fam < 2) { c.W = (fam ? J.up : J.gate) + (size_t)e * 1024 * 2048; c.N = 2048; c.k0 = (q >> 5) * 32; c.n0 = (q & 31) * 64; c.WT = J.wgu; c.ldk = 1024; c.rowbase = (size_t)e * 4096 + (c.n0 >> 7) * 256 + (c.n0 & 127) + (fam ? 128 : 0); }
    else { c.W = J.down + (size_t)e * 2048 * 1024; c.N = 1024; c.k0 = (q >> 4) * 32; c.n0 = (q & 15) * 64; c.WT = J.wd; c.ldk = 2048; c.rowbase = (size_t)e * 1024 + c.n0; }
    return c;
}
template <class RowBase>
__device__ __forceinline__ void conv_family(const Frame& F, const float* W, int K, int N, int nmat, bf16* WT, const RowBase& rb, int& base) {
    const int nblk = (N + 63) / 64, per = (K / 64) * nblk, total = per * nmat;
    const int gwr = F.G > 192 ? (F.gw + F.NGW - 192 * 8) % F.NGW : F.gw;
    const int first = (gwr + F.NGW - base % F.NGW) % F.NGW; base += total;
    for (int it = first; it < total; it += F.NGW) {
        const int mi = it / per, r = it % per, kb = r / nblk, nb = r % nblk;
        conv_item(W + (size_t)mi * K * N, N, WT, rb(mi, nb * 64), K, kb * 64, nb * 64, F.lane);
    }
}

__device__ __forceinline__ void ada_direct(const Frame& F, const Args& a, int l, int b0) {
    const int cg = F.bid - b0; if (cg < 0 || cg >= 192) return;
    LAS float* sc = (LAS float*)F.lds;
    LAS float* red = (LAS float*)(F.lds + 20480);
    for (int i = F.tid; i < 5 * D; i += 512) { const int c = i >> 10, k = i & 1023; const float x = (c == 0) ? a.in[7][k] : a.in[6][(c - 1) * D + k]; sc[i] = x / (1.f + __expf(-x)); }
    __syncthreads();
    const int col = F.tid & 31, kg = F.tid >> 5, n = cg * 32 + col;
    const float* w = a.in[8] + ((size_t)l * D + kg * 64) * 6144 + n;
    float acc[5] = {0.f, 0.f, 0.f, 0.f, 0.f};
#pragma unroll 16
    for (int k = 0; k < 64; ++k) { const float wv = w[(size_t)k * 6144];
#pragma unroll
        for (int c = 0; c < 5; ++c) acc[c] += sc[c * D + kg * 64 + k] * wv; }
#pragma unroll
    for (int c = 0; c < 5; ++c) red[(kg * 5 + c) * 32 + col] = acc[c];
    __syncthreads();
    if (F.tid < 160) { const int c = F.tid >> 5; float s = a.in[9][l * 6144 + n];
#pragma unroll
        for (int g = 0; g < 16; ++g) s += red[(g * 5 + c) * 32 + col];
        ((float*)(F.ws + WS_ADA))[(size_t)(l * 5 + c) * 6144 + n] = s; }
    __syncthreads();
}
__device__ __forceinline__ void phase_prologue(const Frame& F, const Args& a) {
    ada_direct(F, a, 0, 0);
    {
        float* R64 = (float*)(F.ws + WS_ROPE64); float* R32 = (float*)(F.ws + WS_ROPE32);
        for (int i = F.bid * 512 + F.tid; i < 2048 * 32; i += F.G * 512) { const int pos = i >> 5, j = i & 31; const double ang = (j < 16) ? (double)(pos >> 6) * INVF[j] : (double)(pos & 63) * INVF[j - 16];
            float s, c; sincos_d(ang, s, c); R64[i] = c; R64[2048 * 32 + i] = s; }
        for (int i = F.bid * 512 + F.tid; i < 2048 * 16; i += F.G * 512) { const int pos = i >> 4, j = i & 15; const double ang = (j < 8) ? (double)(pos >> 6) * INVF[2 * j] : (double)(pos & 63) * INVF[2 * (j - 8)];
            float s, c; sincos_d(ang, s, c); R32[i] = c; R32[2048 * 16 + i] = s; }
    }
    __syncthreads();
    for (int rep = 0; rep < MK_REP_CONV; ++rep) {
    bf16* WQKV = (bf16*)(F.ws + WS_WQKV); bf16* WO = (bf16*)(F.ws + WS_WO);
    int cvb = 0;
    conv_family(F, a.in[12], 1024, 1536, 2, WQKV, [](int mi, int n0) { return (size_t)(mi == 0 ? 0 : 2) * 1536 + n0; }, cvb);
    conv_family(F, a.in[16], 1024, 1536, 1, WQKV, [](int mi, int n0) { return (size_t)1536 + n0; }, cvb);
    conv_family(F, a.in[15], 1024, 1024, 2, WO, [](int mi, int n0) { return (size_t)(mi == 0 ? 0 : 3) * 1024 + n0; }, cvb);
    conv_family(F, a.in[18], 1024, 1024, 1, WO, [](int mi, int n0) { return (size_t)1024 + n0; }, cvb);
    conv_family(F, a.in[24], 1024, 1024, 1, WO, [](int mi, int n0) { return (size_t)2048 + n0; }, cvb);
    conv_family(F, a.in[19], 1024, 416, 1, (bf16*)(F.ws + WS_WDN), [](int mi, int n0) { return (size_t)n0; }, cvb);
    conv_family(F, a.in[21], 256, 1536, 1, (bf16*)(F.ws + WS_WUQ), [](int mi, int n0) { return (size_t)n0; }, cvb);
    conv_family(F, a.in[23], 128, 2048, 1, (bf16*)(F.ws + WS_WUKV), [](int mi, int n0) { return (size_t)n0; }, cvb);
    }
    { u32x4* z = (u32x4*)((bf16*)(F.ws + WS_WDN) + 416 * 1024); for (int i = F.bid * 512 + F.tid; i < 96 * 1024 / 8; i += F.G * 512) z[i] = (u32x4){0u, 0u, 0u, 0u}; }
}
__device__ __forceinline__ void phase_ada_reduce(const Frame& F, const Args& a) {
    const float* ADAP = (const float*)(F.ws + WS_ADAP); float* ADA = (float*)(F.ws + WS_ADA);
    for (int i = F.bid * 512 + F.tid; i < 4 * 5 * 6144; i += F.G * 512) {
        const int l = i / 30720, r = i % 30720, c = r / 6144, n = r % 6144;
        float s = a.in[9][l * 6144 + n];
        for (int kc = 0; kc < 16; ++kc) s += ADAP[((size_t)(kc * 4 + l) * 5 + c) * 6144 + n];
        ADA[i] = s;
    }
}
__device__ __forceinline__ const float* ada_vec(const Frame& F, int l, int c, int k) { return (const float*)(F.ws + WS_ADA) + ((size_t)(l * 5 + c) * 6 + k) * D; }

__device__ __forceinline__ void phase_mod0(const Frame& F, const Args& a) {
    bf16* X = (bf16*)(F.ws + WS_X); bf16* H = (bf16*)(F.ws + WS_H);
    const int RPW = (NTOK + F.NGW - 1) / F.NGW, rbeg = F.gw * RPW, rend = (rbeg + RPW < NTOK) ? rbeg + RPW : NTOK; int ccur = -1;
    f32x4 shv[4], scv[4];
#pragma unroll
    for (int j = 0; j < 4; ++j) { shv[j] = (f32x4){0.f, 0.f, 0.f, 0.f}; scv[j] = shv[j]; }
    for (int row = rbeg; row < rend; ++row) {
        const int c = cond_of(row);
        if (c != ccur) { ccur = c; const f32x4* sh = (const f32x4*)ada_vec(F, 0, c, 0); const f32x4* sc = (const f32x4*)ada_vec(F, 0, c, 1);
#pragma unroll
            for (int j = 0; j < 4; ++j) { shv[j] = sh[F.lane + 64 * j]; scv[j] = sc[F.lane + 64 * j] + 1.f; } }
        const f32x4* xi = (const f32x4*)((row < NCTX) ? a.in[0] + (size_t)row * D : a.in[1] + (size_t)(row - NCTX) * D);
#pragma unroll
        for (int j = 0; j < 4; ++j) { const int q = F.lane + 64 * j; const f32x4 x = xi[q]; ((u32x2*)(X + (size_t)row * D))[q] = pk4(x); ((u32x2*)(H + (size_t)row * D))[q] = pk4(x * scv[j] + shv[j]); }
    }
}

__device__ __forceinline__ size_t kb_off(int HK, int DK, bool lat, int b, int hk) { return lat ? (size_t)16 * HK * 256 * DK + ((size_t)(b * HK + hk) * 2560) * DK : ((size_t)(b * HK + hk) * 256) * DK; }
__device__ __forceinline__ size_t vt_off(int HK, bool lat, int b, int hk) { return lat ? (size_t)16 * HK * 64 * 256 + ((size_t)(b * HK + hk) * 64) * 2560 : ((size_t)(b * HK + hk) * 64) * 256; }
__device__ __forceinline__ int swap23(int k) { return (k & ~12) | ((k & 4) << 1) | ((k & 8) >> 1); }
__device__ __forceinline__ void vt_store(bf16* dst, const float (&vr)[64]) {
#pragma unroll
    for (int q = 0; q < 8; ++q) { const int b = 16 * (q >> 1) + 4 * (q & 1); u32x4 w; w.x = cvtpk(vr[b], vr[b + 1]); w.y = cvtpk(vr[b + 2], vr[b + 3]); w.z = cvtpk(vr[b + 8], vr[b + 9]); w.w = cvtpk(vr[b + 10], vr[b + 11]); ((u32x4*)dst)[q] = w; }
}

__device__ __forceinline__ void phase_kv_post(const Frame& F, const Args& a, int kind, int j, int slot, int gw, int NGW) {
    const bf16* QKV = (const bf16*)(F.ws + WS_QKV); bf16* Kb = (bf16*)(F.ws + WS_KB); bf16* Vt = (bf16*)(F.ws + WS_VT);
    const float* R64 = (const float*)(F.ws + WS_ROPE64);
    int lane_ = F.lane; asm volatile("" : "+v"(lane_)); const int lane = lane_, l16 = lane & 15, hk = lane >> 4;
    for (int it = gw * 64 + lane; it < 16 * 8192; it += NGW * 64) {
        const int bh = it >> 13, q = it & 8191, b = bh >> 2, hc = bh & 3;
        const f32x4 v = *(const f32x4*)(a.in[2] + ((size_t)((b * 3 + slot) * 4 + hc) * 512) * 64 + 4 * q);
        u32x2 w; w.x = cvtpk(v[0], v[1]); w.y = cvtpk(v[2], v[3]);
        *(u32x2*)(Kb + kb_off(4, 64, true, b, hc) + (size_t)2048 * 64 + 4 * q) = w;
    }
    for (int it = gw; it < 4 * 4 * 8; it += NGW) {
        const int b = it >> 5, hv = (it >> 3) & 3, tl = it & 7;
        float vr[64];
#pragma unroll
        for (int i = 0; i < 64; ++i) vr[i] = a.in[3][((size_t)((b * 3 + slot) * 4 + hv) * 512 + tl * 64 + i) * 64 + lane];
        vt_store(Vt + vt_off(4, true, b, hv) + (size_t)lane * 2560 + 2048 + tl * 64, vr);
    }
    f32x4 kn = (f32x4){1.f, 1.f, 1.f, 1.f}; if (kind == 0) kn = *(const f32x4*)(a.in[14] + j * 64 + 4 * l16);
    {
        const int RPW = (NTOK + NGW - 1) / NGW, rbeg = gw * RPW, rend = (rbeg + RPW < NTOK) ? rbeg + RPW : NTOK;
        u32x2 wqn = (u32x2){0u, 0u}; f32x4 cn = (f32x4){0.f, 0.f, 0.f, 0.f}, snn = cn;
        if (rbeg < rend) { wqn = *(const u32x2*)(QKV + (size_t)rbeg * 1536 + 1024 + 4 * lane);
            if (rbeg >= NCTX) { const int s0 = (rbeg - NCTX) & 2047; cn = *(const f32x4*)(R64 + s0 * 32 + 4 * (lane & 7)); snn = *(const f32x4*)(R64 + 2048 * 32 + s0 * 32 + 4 * (lane & 7)); } }
        for (int t = rbeg; t < rend; ++t) {
            const bool lat = t >= NCTX; const int b = lat ? (t - NCTX) >> 11 : t >> 8, s = lat ? (t - NCTX) & 2047 : t & 255;
            const u32x2 wq = wqn; const f32x4 c = cn, sn = snn;
            if (t + 1 < rend) { wqn = *(const u32x2*)(QKV + (size_t)(t + 1) * 1536 + 1024 + 4 * lane);
                if (t + 1 >= NCTX) { const int s1 = (t + 1 - NCTX) & 2047; cn = *(const f32x4*)(R64 + s1 * 32 + 4 * (lane & 7)); snn = *(const f32x4*)(R64 + 2048 * 32 + s1 * 32 + 4 * (lane & 7)); } }
            f32x4 v = bf4(wq);
            if (kind == 0) { float ss = (v[0] * v[0] + v[1] * v[1]) + (v[2] * v[2] + v[3] * v[3]); ss = sum16(ss);
                v = v * (__builtin_amdgcn_rsqf(ss * (1.f / 64.f) + 1e-6f)) * kn; }
            if (lat) { f32x4 p; p[0] = dppf<DPP_X8>(v[0]); p[1] = dppf<DPP_X8>(v[1]); p[2] = dppf<DPP_X8>(v[2]); p[3] = dppf<DPP_X8>(v[3]);
                v = (lane & 8) ? v * c + p * sn : v * c - p * sn; }
            *(u32x2*)(Kb + kb_off(4, 64, lat, b, hk) + (size_t)s * 64 + 4 * l16) = pk4(v);
            if (!lat) *(f32x4*)(F.out + OFF_NK + ((size_t)((b * 3 + slot) * 4 + hk) * 256 + s) * 64 + 4 * l16) = v;
        }
    }
    for (int it = gw; it < (NTOK / 64) * 4; it += NGW) {
        const int tt = it >> 2, hv = it & 3, t0 = tt * 64; const bool lat = t0 >= NCTX; const int b = lat ? (t0 - NCTX) >> 11 : t0 >> 8, s0 = lat ? (t0 - NCTX) & 2047 : t0 & 255;
        float vr[64];
#pragma unroll
        for (int i = 0; i < 64; ++i) vr[i] = bf2f(QKV[(size_t)(t0 + i) * 1536 + 1280 + hv * 64 + lane]);
        vt_store(Vt + vt_off(4, lat, b, hv) + (size_t)lane * (lat ? 2560 : 256) + s0, vr);
        if (!lat) {
#pragma unroll
            for (int i = 0; i < 64; ++i) F.out[OFF_NV + ((size_t)((b * 3 + slot) * 4 + hv) * 256 + s0 + i) * 64 + lane] = vr[i]; }
    }
}

__device__ __forceinline__ void phase_mla_post1(const Frame& F, const Args& a) {
    const float* DWN = (const float*)(F.ws + WS_QKV); bf16* QA = (bf16*)(F.ws + WS_QA); bf16* CKVA = (bf16*)(F.ws + WS_CKVA); bf16* Kb = (bf16*)(F.ws + WS_KB);
    const float* R32 = (const float*)(F.ws + WS_ROPE32);
    int lane_ = F.lane; asm volatile("" : "+v"(lane_)); const int lane = lane_;
    const f32x4 qn = ((const f32x4*)a.in[20])[lane]; const f32x4 kvn = ((const f32x4*)a.in[22])[lane & 31];
    for (int t = F.gw; t < NTOK + 2048; t += F.NGW) {
        if (t < NTOK) {
            const bool lat = t >= NCTX; const int b = lat ? (t - NCTX) >> 11 : t >> 8, s = lat ? (t - NCTX) & 2047 : t & 255;
            const float* row = DWN + (size_t)t * 512;
            { const f32x4 v = ((const f32x4*)row)[lane] + ((const f32x4*)(row + DWN_PART))[lane]; const float ss = wave_sum(v[0] * v[0] + v[1] * v[1] + v[2] * v[2] + v[3] * v[3]); const float r = __builtin_amdgcn_rsqf(ss * (1.f / 256.f) + 1e-6f);
              const f32x4 o = v * r * qn; u32x2 w; w.x = cvtpk(o[0], o[1]); w.y = cvtpk(o[2], o[3]); ((u32x2*)(QA + (size_t)t * 256))[lane] = w; }
            { f32x4 v = (f32x4){0.f, 0.f, 0.f, 0.f}; if (lane < 32) v = ((const f32x4*)(row + 256))[lane] + ((const f32x4*)(row + DWN_PART + 256))[lane];
              const float ss = wave_sum(v[0] * v[0] + v[1] * v[1] + v[2] * v[2] + v[3] * v[3]); const float r = __builtin_amdgcn_rsqf(ss * (1.f / 128.f) + 1e-6f);
              const f32x4 o = v * r * kvn;
              if (lane < 32) { u32x2 w; w.x = cvtpk(o[0], o[1]); w.y = cvtpk(o[2], o[3]); ((u32x2*)(CKVA + (size_t)t * 128))[lane] = w; if (!lat) ((f32x4*)(F.out + OFF_CKV + (size_t)t * 128))[lane] = o; } }
            { float x = (lane < 32) ? row[384 + lane] + row[DWN_PART + 384 + lane] : 0.f;
              if (!lat && lane < 32) F.out[OFF_KPE + (size_t)t * 32 + lane] = x;
              if (lat) { const float p = __shfl_xor(x, 16); const int i = lane & 15; const float c = R32[s * 16 + i], sn = R32[2048 * 16 + s * 16 + i]; x = ((lane & 31) < 16) ? x * c - p * sn : x * c + p * sn; }
              const bf16 xb = f2bf(x);
              if (lane < 32) { for (int h = 0; h < 16; ++h) Kb[kb_off(16, 96, lat, b, h) + (size_t)s * 96 + 64 + lane] = xb; } }
        } else {
            const int r = t - NTOK, b = r >> 9, s = r & 511;
            if (lane < 32) { const f32x4 v = ((const f32x4*)(a.in[4] + (size_t)r * 128))[lane]; u32x2 w; w.x = cvtpk(v[0], v[1]); w.y = cvtpk(v[2], v[3]); ((u32x2*)(CKVA + (size_t)t * 128))[lane] = w;
                const bf16 xb = f2bf(a.in[5][(size_t)r * 32 + lane]);
                for (int h = 0; h < 16; ++h) Kb[kb_off(16, 96, true, b, h) + (size_t)(2048 + s) * 96 + 64 + lane] = xb; }
        }
    }
}
__device__ __forceinline__ void mla_row(int row, bool& lat, int& b, int& s) {
    if (row < NCTX) { lat = false; b = row >> 8; s = row & 255; } else if (row < NTOK) { lat = true; b = (row - NCTX) >> 11; s = (row - NCTX) & 2047; } else { lat = true; b = (row - NTOK) >> 9; s = 2048 + ((row - NTOK) & 511); }
}
struct EpiUkv { bf16* Kb; float* VRAW; static constexpr bool PERM = false, AFTER_DRAIN = false;
    __device__ __forceinline__ void operator()(const f32x4 (&acc)[2][2][4][2], const Unit& u, int wr, int wc, int fr, int fq) const {
#pragma unroll
        for (int ai = 0; ai < 2; ++ai)
#pragma unroll
            for (int m = 0; m < 4; ++m) { const int row = u.pm * 256 + ai * 128 + wr * 64 + m * 16 + fr; bool lat; int b, s; mla_row(row, lat, b, s);
#pragma unroll
                for (int bj = 0; bj < 2; ++bj) { const int h = 2 * u.pn + bj;
                    if (wc < 2) { bf16* kp = Kb + kb_off(16, 96, lat, b, h) + (size_t)s * 96 + wc * 32 + 4 * fq;
#pragma unroll
                        for (int n = 0; n < 2; ++n) { const f32x4 v = acc[ai][bj][m][n]; u32x2 w; w.x = cvtpk(v[0], v[1]); w.y = cvtpk(v[2], v[3]); *(u32x2*)(kp + n * 16) = w; } }
                    else { float* vp = VRAW + (size_t)row * 1024 + h * 64 + (wc - 2) * 32 + 4 * fq;
#pragma unroll
                        for (int n = 0; n < 2; ++n) *(f32x4*)(vp + n * 16) = acc[ai][bj][m][n]; } } }
    }
};
__device__ __forceinline__ void phase_mla_post2(const Frame& F, const Args& a) {
    const float* VRAW = (const float*)(F.ws + WS_KVRAW); bf16* Vt = (bf16*)(F.ws + WS_VT);
    int lane_ = F.lane; asm volatile("" : "+v"(lane_)); const int lane = lane_;
    for (int it = F.gw; it < 224 * 16; it += F.NGW) {
        const int tile = it >> 4, h = it & 15, row0 = tile * 64; bool lat; int b, s0; mla_row(row0, lat, b, s0);
        float vr[64];
#pragma unroll
        for (int i = 0; i < 64; ++i) vr[i] = VRAW[(size_t)(row0 + i) * 1024 + h * 64 + lane];
        vt_store(Vt + vt_off(16, lat, b, h) + (size_t)lane * (lat ? 2560 : 256) + s0, vr);
    }
}

__device__ __forceinline__ int crow(int r, int hi) { return (r & 3) + 8 * (r >> 2) + 4 * hi; }
__device__ __forceinline__ float max3f(float a, float b, float c) { float r; asm("v_max3_f32 %0, %1, %2, %3" : "=v"(r) : "v"(a), "v"(b), "v"(c)); return r; }
constexpr float THRL = 5.f;
template <int DK, int KIND>
__device__ __forceinline__ void attn_phase(const Frame& F, const Args& a, int j, const ConvJob& J, int& cv_it, int cv_need, int cv_cap) {
    constexpr int HK = (DK == 96) ? 16 : 4, CH = (DK == 96) ? 64 : 128, KPB = (DK + 8) * 2, VPB = (CH + 8) * 2, NDS = DK / 16, KCH = DK / 8;
    constexpr int NKC = CH * KCH, NKI = (NKC + 511) / 512, NVI = 64 * (CH / 8) / 512, NSUB = CH / 64;
    constexpr float QS = (DK == 96) ? MLA_QS : GQA_QS;
    const bf16* QRAW = (const bf16*)(F.ws + WS_QKV); const bf16* Kb = (const bf16*)(F.ws + WS_KB); const bf16* Vt = (const bf16*)(F.ws + WS_VT); bf16* O = (bf16*)(F.ws + WS_O);
    LAS unsigned char* Ks = F.lds; LAS unsigned char* Vs = F.lds + 2 * CH * KPB;
    LAS unsigned char* cvs = F.lds + 2 * CH * KPB + 2 * 64 * VPB + F.wave * 8192;
    const unsigned cvs_addr = (unsigned)(uintptr_t)cvs;
    int tid_ = F.tid; asm volatile("" : "+v"(tid_));
    const int tid = tid_, lane = tid & 63, wid = F.wave, r32 = lane & 31, hi = lane >> 5;
    constexpr bool CVP = true;
    int itc = 0;
    for (int un = F.bid; un < 768; un += F.G) {
        bool lat; int b, hq, q0, S, tok0;
        if (un < 512) { lat = true; b = un >> 7; hq = (un >> 3) & 15; q0 = (un & 7) * 256; S = 2560; tok0 = NCTX + b * 2048 + q0; }
        else { const int v = un - 512; lat = false; b = v >> 4; hq = v & 15; q0 = 0; S = 256; tok0 = b * 256; }
        const int hk = (HK == 4) ? (hq >> 2) : hq;
        const bf16* Kg = Kb + kb_off(HK, DK, lat, b, hk); const bf16* Vg = Vt + vt_off(HK, lat, b, hk);
        const int n2 = lat ? 512 / CH : 0; int lo = 0, hiK = lat ? 2048 : 256;
        const bool masked = (KIND == 1) && lat;
        if (masked) { lo = q0 - 128; lo = lo < 0 ? 0 : (lo > 1536 ? 1536 : lo); hiK = lo + 512; }
        const int nch = n2 + (hiK - lo) / CH;
        bf16x8 qf[NDS];
        {
            const bf16* qrow = QRAW + (size_t)(tok0 + wid * 32 + r32) * 1536 + hq * DK + 8 * hi;
            f32x4 v[NDS][2];
#pragma unroll
            for (int ds = 0; ds < NDS; ++ds) { const u32x4 wq = *(const u32x4*)(qrow + 16 * ds);
                v[ds][0] = (f32x4){__uint_as_float(wq.x << 16), __uint_as_float(wq.x & 0xffff0000u), __uint_as_float(wq.y << 16), __uint_as_float(wq.y & 0xffff0000u)};
                v[ds][1] = (f32x4){__uint_as_float(wq.z << 16), __uint_as_float(wq.z & 0xffff0000u), __uint_as_float(wq.w << 16), __uint_as_float(wq.w & 0xffff0000u)}; }
            if (KIND == 0) {
                float ss = 0.f;
#pragma unroll
                for (int ds = 0; ds < NDS; ++ds)
#pragma unroll
                    for (int h2 = 0; h2 < 2; ++h2) ss += (v[ds][h2][0] * v[ds][h2][0] + v[ds][h2][1] * v[ds][h2][1]) + (v[ds][h2][2] * v[ds][h2][2] + v[ds][h2][3] * v[ds][h2][3]);
                ss += __shfl_xor(ss, 32);
                const float r = __builtin_amdgcn_rsqf(ss * (1.f / 64.f) + 1e-6f);
                const float* qn = a.in[13] + j * 64 + 8 * hi;
#pragma unroll
                for (int ds = 0; ds < NDS; ++ds) { v[ds][0] = v[ds][0] * r * *(const f32x4*)(qn + 16 * ds); v[ds][1] = v[ds][1] * r * *(const f32x4*)(qn + 16 * ds + 4); }
            }
            if (lat) {
                const int s = q0 + wid * 32 + r32;
                if (DK == 64) {
                    const float* R64 = (const float*)(F.ws + WS_ROPE64);
#pragma unroll
                    for (int ds = 0; ds < 2; ++ds)
#pragma unroll
                        for (int h2 = 0; h2 < 2; ++h2) { const int idx = s * 32 + 16 * ds + 8 * hi + 4 * h2; const f32x4 c = *(const f32x4*)(R64 + idx), sn = *(const f32x4*)(R64 + 2048 * 32 + idx);
                            const f32x4 xa = v[ds][h2], xb = v[ds + 2][h2]; v[ds][h2] = xa * c - xb * sn; v[ds + 2][h2] = xb * c + xa * sn; }
                } else {
                    const float* R32 = (const float*)(F.ws + WS_ROPE32);
#pragma unroll
                    for (int h2 = 0; h2 < 2; ++h2) { const int idx = s * 16 + 8 * hi + 4 * h2; const f32x4 c = *(const f32x4*)(R32 + idx), sn = *(const f32x4*)(R32 + 2048 * 16 + idx);
                        const f32x4 xa = v[NDS - 2][h2], xb = v[NDS - 1][h2]; v[NDS - 2][h2] = xa * c - xb * sn; v[NDS - 1][h2] = xb * c + xa * sn; }
                }
            }
#pragma unroll
            for (int ds = 0; ds < NDS; ++ds) { u32x4 w; w.x = cvtpk(v[ds][0][0] * QS, v[ds][0][1] * QS); w.y = cvtpk(v[ds][0][2] * QS, v[ds][0][3] * QS); w.z = cvtpk(v[ds][1][0] * QS, v[ds][1][1] * QS); w.w = cvtpk(v[ds][1][2] * QS, v[ds][1][3] * QS);
                qf[ds] = __builtin_bit_cast(bf16x8, w); }
        }
        const int qw0 = q0 + wid * 32, qpos = qw0 + r32;
        float mhat = 0.f, l_run = 0.f; bool first = true; f32x16 o0, o1, negm;
#pragma unroll
        for (int r = 0; r < 16; ++r) { o0[r] = 0.f; o1[r] = 0.f; negm[r] = 0.f; }
        u32x4 kreg[NKI], vreg[NVI];
#define ATT_KEY0(c) ((c) < n2 ? 2048 + CH * (c) : lo + CH * ((c) - n2))
#define ATT_LOAD(c) do { const int k0_ = ATT_KEY0(c); \
            _Pragma("unroll") for (int i_ = 0; i_ < NKI; ++i_) { const int cc_ = tid + 512 * i_; if (NKC % 512 == 0 || cc_ < NKC) kreg[i_] = *(const u32x4*)(Kg + (size_t)(k0_ + cc_ / KCH) * DK + (cc_ % KCH) * 8); } \
            _Pragma("unroll") for (int i_ = 0; i_ < NVI; ++i_) { const int cc_ = tid + 512 * i_; vreg[i_] = *(const u32x4*)(Vg + (size_t)(cc_ / (CH / 8)) * S + k0_ + (cc_ % (CH / 8)) * 8); } } while (0)
#define ATT_STORE(buf) do { \
            _Pragma("unroll") for (int i_ = 0; i_ < NKI; ++i_) { const int cc_ = tid + 512 * i_; if (NKC % 512 == 0 || cc_ < NKC) *(LAS u32x4*)(Ks + (buf) * CH * KPB + (cc_ / KCH) * KPB + (cc_ % KCH) * 16) = kreg[i_]; } \
            _Pragma("unroll") for (int i_ = 0; i_ < NVI; ++i_) { const int cc_ = tid + 512 * i_; *(LAS u32x4*)(Vs + (buf) * 64 * VPB + (cc_ / (CH / 8)) * VPB + (cc_ % (CH / 8)) * 16) = vreg[i_]; } } while (0)
        ATT_LOAD(0);
        __syncthreads();
        ATT_STORE(0);
        __syncthreads();
        for (int c = 0; c < nch; ++c) {
            const int cur = c & 1;
            if (c + 1 < nch) ATT_LOAD(c + 1);
            const bool cv = CVP && ((CH == 128) || ((itc++ & 1) == 0)) && cv_it < cv_cap;
            if (cv) { const ConvItem ci = cv_decode(J, cv_it); conv_issue8(cvs_addr, ci.W, ci.N, ci.k0, ci.n0, lane); }
            const int key0c = ATT_KEY0(c);
            for (int sub = 0; sub < NSUB; ++sub) {
                const int key0 = key0c + 64 * sub;
                if (masked && c >= n2 && (key0 > qw0 + 159 || key0 + 63 < qw0 - 128)) continue;
                f32x16 p0, p1;
                const LAS unsigned char* kb_ = Ks + cur * CH * KPB + (sub * 64 + r32) * KPB + hi * 16;
                const LAS unsigned char* vb_ = Vs + cur * 64 * VPB + r32 * VPB + sub * 128 + hi * 16;
                bf16x8 kf[2 * NDS], vf[8];
#pragma unroll
                for (int ds = 0; ds < NDS; ++ds) { kf[2 * ds] = *(const LAS bf16x8*)(kb_ + ds * 32); kf[2 * ds + 1] = *(const LAS bf16x8*)(kb_ + 32 * KPB + ds * 32); }
#pragma unroll
                for (int s = 0; s < 4; ++s) { vf[2 * s] = *(const LAS bf16x8*)(vb_ + s * 32); vf[2 * s + 1] = *(const LAS bf16x8*)(vb_ + 32 * VPB + s * 32); }
                __builtin_amdgcn_sched_barrier(0);
#pragma unroll
                for (int ds = 0; ds < NDS; ++ds) {
                    if (ds == 0) { p0 = __builtin_amdgcn_mfma_f32_32x32x16_bf16(kf[0], qf[0], negm, 0, 0, 0); p1 = __builtin_amdgcn_mfma_f32_32x32x16_bf16(kf[1], qf[0], negm, 0, 0, 0); }
                    else { p0 = __builtin_amdgcn_mfma_f32_32x32x16_bf16(kf[2 * ds], qf[ds], p0, 0, 0, 0); p1 = __builtin_amdgcn_mfma_f32_32x32x16_bf16(kf[2 * ds + 1], qf[ds], p1, 0, 0, 0); }
                }
                if (masked && c >= n2) {
                    const int kbase = key0 - qpos;
#pragma unroll
                    for (int r = 0; r < 16; ++r) { const int d0 = kbase + crow(r, hi), d1 = d0 + 32;
                        if (d0 > 128 || d0 < -128) p0[r] = -INFINITY;
                        if (d1 > 128 || d1 < -128) p1[r] = -INFINITY; }
                }
                float rm;
                { float ma = max3f(p0[0], p0[1], p1[0]), mb = max3f(p0[2], p0[3], p1[1]); ma = max3f(ma, p1[2], p1[3]);
#pragma unroll
                  for (int r = 4; r < 16; r += 4) { ma = max3f(ma, p0[r], p0[r + 1]); mb = max3f(mb, p0[r + 2], p0[r + 3]); ma = max3f(ma, p1[r], p1[r + 1]); mb = max3f(mb, p1[r + 2], p1[r + 3]); }
                  const float m2 = max3f(ma, mb, mb);
                  auto rr = __builtin_amdgcn_permlane32_swap(__float_as_uint(m2), __float_as_uint(m2), false, false);
                  rm = max3f(__uint_as_float(rr[0]), __uint_as_float(rr[1]), m2); }
                if (first || __any(rm > THRL)) {
                    const float dl = first ? rm : fmaxf(rm, 0.f);
                    mhat += dl;
#pragma unroll
                    for (int r = 0; r < 16; ++r) { p0[r] -= dl; p1[r] -= dl; }
                    if (!first) { const float sc = __builtin_amdgcn_exp2f(-dl); l_run *= sc;
#pragma unroll
                        for (int r = 0; r < 16; ++r) { o0[r] *= sc; o1[r] *= sc; } }
#pragma unroll
                    for (int r = 0; r < 16; ++r) negm[r] = -mhat;
                    first = false;
                }
                float ls0 = 0.f, ls1 = 0.f;
#pragma unroll
                for (int r = 0; r < 16; ++r) { p0[r] = __builtin_amdgcn_exp2f(p0[r]); p1[r] = __builtin_amdgcn_exp2f(p1[r]); ls0 += p0[r]; ls1 += p1[r]; }
                l_run += ls0 + ls1;
                bf16x8 pb[4];
#pragma unroll
                for (int s = 0; s < 4; ++s) { u32x4 w;
                    if (s < 2) { w.x = cvtpk(p0[8 * s], p0[8 * s + 1]); w.y = cvtpk(p0[8 * s + 2], p0[8 * s + 3]); w.z = cvtpk(p0[8 * s + 4], p0[8 * s + 5]); w.w = cvtpk(p0[8 * s + 6], p0[8 * s + 7]); }
                    else { const int q = s - 2; w.x = cvtpk(p1[8 * q], p1[8 * q + 1]); w.y = cvtpk(p1[8 * q + 2], p1[8 * q + 3]); w.z = cvtpk(p1[8 * q + 4], p1[8 * q + 5]); w.w = cvtpk(p1[8 * q + 6], p1[8 * q + 7]); }
                    pb[s] = __builtin_bit_cast(bf16x8, w); }
#pragma unroll
                for (int s = 0; s < 4; ++s) {
                    o0 = __builtin_amdgcn_mfma_f32_32x32x16_bf16(vf[2 * s], pb[s], o0, 0, 0, 0);
                    o1 = __builtin_amdgcn_mfma_f32_32x32x16_bf16(vf[2 * s + 1], pb[s], o1, 0, 0, 0);
                }
            }
            if (c + 1 < nch) ATT_STORE(cur ^ 1);
            if (cv) { asm volatile("s_waitcnt vmcnt(0)" ::: "memory"); f32x4 cvv[8]; conv_fetch8(cvv, cvs, lane); const ConvItem ci = cv_decode(J, cv_it); conv_store8(cvv, ci.WT, ci.rowbase, ci.ldk, ci.k0, lane); cv_it += F.NGW; }
            __syncthreads();
        }
#undef ATT_KEY0
#undef ATT_LOAD
#undef ATT_STORE
        float l = l_run + __shfl_xor(l_run, 32);
        if (KIND == 1) l += __builtin_amdgcn_exp2f(a.in[17][hq] * LOG2E - mhat);
        const float inv = 1.f / l;
        bf16* op = O + (size_t)(tok0 + wid * 32 + r32) * 1024 + hq * 64 + 4 * hi;
#pragma unroll
        for (int g = 0; g < 4; ++g) {
            u32x2 w0, w1; w0.x = cvtpk(o0[4 * g] * inv, o0[4 * g + 1] * inv); w0.y = cvtpk(o0[4 * g + 2] * inv, o0[4 * g + 3] * inv);
            w1.x = cvtpk(o1[4 * g] * inv, o1[4 * g + 1] * inv); w1.y = cvtpk(o1[4 * g + 2] * inv, o1[4 * g + 3] * inv);
            *(u32x2*)(op + 8 * g) = w0; *(u32x2*)(op + 32 + 8 * g) = w1;
        }
    }
    for (; cv_it < cv_need; cv_it += 2 * F.NGW) {
        f32x4 v0[8], v1[8]; const ConvItem c0 = cv_decode(J, cv_it); conv_load8(v0, c0.W, c0.N, c0.k0, c0.n0, lane);
        const bool two = cv_it + F.NGW < CV_TOTAL; ConvItem c1 = c0; if (two) { c1 = cv_decode(J, cv_it + F.NGW); conv_load8(v1, c1.W, c1.N, c1.k0, c1.n0, lane); }
        conv_store8(v0, c0.WT, c0.rowbase, c0.ldk, c0.k0, lane); if (two) conv_store8(v1, c1.WT, c1.rowbase, c1.ldk, c1.k0, lane); }
}
#if MK_CHECK
template <int DK, int KIND>
__device__ __forceinline__ void check_attn(const Frame& F, const Args& a, int j, int id) {
    constexpr int HK = (DK == 96) ? 16 : 4; constexpr float QS = (DK == 96) ? MLA_QS : GQA_QS;
    const bf16* QRAW = (const bf16*)(F.ws + WS_QKV); const bf16* Kb = (const bf16*)(F.ws + WS_KB); const bf16* Vt = (const bf16*)(F.ws + WS_VT); const bf16* O = (const bf16*)(F.ws + WS_O);
    LAS float* scs = (LAS float*)(F.lds + F.wave * 12288); LAS float* qs = scs + 2560;
    const int lane = F.lane;
    const unsigned hsh = hash_u(F.gw * 2654435761u + id);
    const int t = (F.gw & 1) ? (hsh % NCTX) : NCTX + (hsh % NLAT), hq = (hsh >> 16) & 15;
    const bool lat = t >= NCTX; const int b = lat ? (t - NCTX) >> 11 : t >> 8, s = lat ? (t - NCTX) & 2047 : t & 255, S = lat ? 2560 : 256;
    const int hk = (HK == 4) ? (hq >> 2) : hq;
    const bf16* Kg = Kb + kb_off(HK, DK, lat, b, hk); const bf16* Vg = Vt + vt_off(HK, lat, b, hk); const bf16* q = QRAW + (size_t)t * 1536 + hq * DK;
    {
        float x = bf2f(q[lane]);
        if (KIND == 0) { const float ss = wave_sum(x * x); x = x * __builtin_amdgcn_rsqf(ss * (1.f / 64.f) + 1e-6f) * a.in[13][j * 64 + lane]; }
        if (DK == 64 && lat) { const float* R64 = (const float*)(F.ws + WS_ROPE64); const float p = __shfl_xor(x, 32); const int i = lane & 31; const float c = R64[s * 32 + i], sn = R64[2048 * 32 + s * 32 + i]; x = (lane < 32) ? x * c - p * sn : x * c + p * sn; }
        qs[lane] = bf2f(f2bf(x * QS));
        if (DK == 96) { float y = (lane < 32) ? bf2f(q[64 + lane]) : 0.f;
            if (lat) { const float* R32 = (const float*)(F.ws + WS_ROPE32); const float p = __shfl_xor(y, 16); const int i = lane & 15; const float c = R32[s * 16 + i], sn = R32[2048 * 16 + s * 16 + i]; y = ((lane & 31) < 16) ? y * c - p * sn : y * c + p * sn; }
            if (lane < 32) qs[64 + lane] = bf2f(f2bf(y * QS)); }
        asm volatile("s_waitcnt lgkmcnt(0)" ::: "memory");
    }
    float mx = -1e30f;
    for (int jk = lane; jk < S; jk += 64) {
        float sc = 0.f; for (int d = 0; d < DK; ++d) sc += qs[d] * bf2f(Kg[(size_t)jk * DK + d]);
        if (KIND == 1 && lat && jk < 2048 && (jk - s > 128 || jk - s < -128)) sc = -INFINITY;
        scs[jk] = sc; mx = fmaxf(mx, sc);
    }
    mx = wave_max(mx);
    asm volatile("s_waitcnt lgkmcnt(0)" ::: "memory");
    float l = 0.f, o = 0.f;
    for (int jk = 0; jk < S; ++jk) { const float p = __builtin_amdgcn_exp2f(scs[jk] - mx); l += p; o += bf2f(f2bf(p)) * bf2f(Vg[(size_t)lane * S + swap23(jk)]); }
    if (KIND == 1) l += __builtin_amdgcn_exp2f(a.in[17][hq] * LOG2E - mx);
    o /= l;
    const float got = bf2f(O[(size_t)t * 1024 + hq * 64 + lane]);
    if (!close_enough(got, o, 0.03f, 0.01f)) CHK_FAIL(F, id);
    asm volatile("s_waitcnt lgkmcnt(0)" ::: "memory");
}
template <class Fn>
__device__ __forceinline__ void check_gemm_f32(const Frame& F, const bf16* A, const bf16* Bt, int M, int N, int K, const float* C, int ldc, int id) {
    for (int sidx = 0; sidx < 2; ++sidx) {
        const unsigned h = hash_u((F.gw * 2 + sidx) * 2654435761u + id * 97u);
        const int row = h % M, col = (h >> 12) % N;
        const float ref = dot_bf16(A + (size_t)row * K, Bt + (size_t)col * K, K, F.lane);
        if (!close_enough(C[(size_t)row * ldc + col], ref, 0.01f, 0.01f)) CHK_FAIL(F, id);
    }
}
template <class Fn>
__device__ __forceinline__ void check_gemm_bf16(const Frame& F, const bf16* A, const bf16* Bt, int M, int N, int K, const bf16* C, int ldc, int id) {
    for (int sidx = 0; sidx < 2; ++sidx) {
        const unsigned h = hash_u((F.gw * 2 + sidx) * 2654435761u + id * 97u);
        const int row = h % M, col = (h >> 12) % N;
        const float ref = dot_bf16(A + (size_t)row * K, Bt + (size_t)col * K, K, F.lane);
        if (!close_enough(bf2f(C[(size_t)row * ldc + col]), ref, 0.02f, 0.02f)) CHK_FAIL(F, id);
    }
}
#endif

__device__ __forceinline__ void phase_ln1_router(const Frame& F, const Args& a, int l) {
    const bf16* X = (const bf16*)(F.ws + WS_X); bf16* X1 = (bf16*)(F.ws + WS_X1); const bf16* AO = (const bf16*)(F.ws + WS_AO); unsigned char* H8 = F.ws + WS_XE; float* AFF = (float*)(F.ws + WS_AFF);
    constexpr int RP = 1032, RB = 6;
    LAS bf16* Wb = (LAS bf16*)F.lds;
    LAS bf16* Hs = (LAS bf16*)(F.lds + 16 * RP * 2) + F.wave * (RB * RP);
    const float* wr = a.in[25] + (size_t)l * D * NE;
    for (int i = F.tid; i < D * NE; i += 512) Wb[(i & 15) * RP + (i >> 4)] = f2bf(wr[i]);
    __syncthreads();
    int lane_ = F.lane; asm volatile("" : "+v"(lane_)); const int lane = lane_;
    const f32x4* lg = (const f32x4*)(a.in[10] + (size_t)(l * 2 + 0) * D); const f32x4* lb = (const f32x4*)(a.in[11] + (size_t)(l * 2 + 0) * D);
    const int RPW = (NTOK + F.NGW - 1) / F.NGW, rbeg = F.gw * RPW, rend = (rbeg + RPW < NTOK) ? rbeg + RPW : NTOK;
    f32x4 lgv[4], lbv[4], g1v[4], sh2v[4], sc2v[4]; int ccur = -1;
#pragma unroll
    for (int j = 0; j < 4; ++j) { lgv[j] = lg[lane + 64 * j]; lbv[j] = lb[lane + 64 * j]; g1v[j] = lgv[j]; sh2v[j] = lgv[j]; sc2v[j] = lgv[j]; }
    u32x2 xc[4], ac[4], xd[4], ad[4];
    { const int r0 = rbeg < rend ? rbeg : NTOK - 1, r1 = rbeg + 1 < rend ? rbeg + 1 : r0;
#pragma unroll
      for (int j = 0; j < 4; ++j) { xc[j] = ((const u32x2*)(X + (size_t)r0 * D))[lane + 64 * j]; ac[j] = ((const u32x2*)(AO + (size_t)r0 * D))[lane + 64 * j];
          xd[j] = ((const u32x2*)(X + (size_t)r1 * D))[lane + 64 * j]; ad[j] = ((const u32x2*)(AO + (size_t)r1 * D))[lane + 64 * j]; } }
    for (int row = rbeg; row < rend; ++row) {
        const int c = cond_of(row);
        if (c != ccur) { ccur = c; const f32x4* g1 = (const f32x4*)ada_vec(F, l, c, 2); const f32x4* sh2 = (const f32x4*)ada_vec(F, l, c, 3); const f32x4* sc2 = (const f32x4*)ada_vec(F, l, c, 4);
#pragma unroll
            for (int j = 0; j < 4; ++j) { g1v[j] = g1[lane + 64 * j]; sh2v[j] = sh2[lane + 64 * j]; sc2v[j] = sc2[lane + 64 * j] + 1.f; } }
        f32x4 y[4]; float s = 0.f, s2 = 0.f;
#pragma unroll
        for (int j = 0; j < 4; ++j) { const f32x4 av = (f32x4){__uint_as_float(ac[j].x << 16), __uint_as_float(ac[j].x & 0xffff0000u), __uint_as_float(ac[j].y << 16), __uint_as_float(ac[j].y & 0xffff0000u)}; y[j] = bf4(xc[j]) * ALPHA + g1v[j] * av; s += (y[j][0] + y[j][1]) + (y[j][2] + y[j][3]); s2 += (y[j][0] * y[j][0] + y[j][1] * y[j][1]) + (y[j][2] * y[j][2] + y[j][3] * y[j][3]); }
        { const int nr = row + 2 < rend ? row + 2 : row;
#pragma unroll
          for (int j = 0; j < 4; ++j) { xc[j] = xd[j]; ac[j] = ad[j]; xd[j] = ((const u32x2*)(X + (size_t)nr * D))[lane + 64 * j]; ad[j] = ((const u32x2*)(AO + (size_t)nr * D))[lane + 64 * j]; } }
        s = wave_sum(s); s2 = wave_sum(s2);
        const float mean = s * (1.f / D), var = fmaxf(s2 * (1.f / D) - mean * mean, 0.f);
        const float rstd = 1.f / sqrtf(var + 1e-5f);
        f32x4 h[4];
#pragma unroll
        for (int j = 0; j < 4; ++j) { const int q = lane + 64 * j; const f32x4 xn = (y[j] - mean) * rstd * lgv[j] + lbv[j]; ((u32x2*)(X1 + (size_t)row * D))[q] = pk4(xn);
            h[j] = xn * sc2v[j] + sh2v[j]; ((unsigned*)(H8 + (size_t)row * D))[q] = pk4_fp8(h[j][0], h[j][1], h[j][2], h[j][3]); }
        const int br = (row - rbeg) % RB;
#pragma unroll
        for (int j = 0; j < 4; ++j) { u32x2 w; w.x = cvtpk(h[j][0], h[j][1]); w.y = cvtpk(h[j][2], h[j][3]); *(LAS u32x2*)(Hs + br * RP + 4 * (lane + 64 * j)) = w; }
        if (br == RB - 1 || row == rend - 1) {
            const int nrows = br + 1, row0 = row - br, n = lane & 15, kq = lane >> 4, nn = n < nrows ? n : 0;
            const LAS bf16* wp = Wb + n * RP + 8 * kq; const LAS bf16* hp = Hs + nn * RP + 8 * kq;
            f32x4 l0 = (f32x4){0.f, 0.f, 0.f, 0.f}, l1 = l0;
#pragma unroll 4
            for (int st = 0; st < 32; st += 2) {
                l0 = __builtin_amdgcn_mfma_f32_16x16x32_bf16(*(const LAS bf16x8*)(wp + 32 * st), *(const LAS bf16x8*)(hp + 32 * st), l0, 0, 0, 0);
                l1 = __builtin_amdgcn_mfma_f32_16x16x32_bf16(*(const LAS bf16x8*)(wp + 32 * st + 32), *(const LAS bf16x8*)(hp + 32 * st + 32), l1, 0, 0, 0); }
            const f32x4 lg4 = l0 + l1;
            float mx = fmaxf(fmaxf(lg4[0], lg4[1]), fmaxf(lg4[2], lg4[3])); mx = xmax16(mx); mx = xmax32(mx);
            f32x4 ex; ex[0] = __expf(lg4[0] - mx); ex[1] = __expf(lg4[1] - mx); ex[2] = __expf(lg4[2] - mx); ex[3] = __expf(lg4[3] - mx);
            float den = (ex[0] + ex[1]) + (ex[2] + ex[3]); den = xsum16(den, den); den = xsum32(den, den);
            const float inv = 1.f / den;
            if (n < nrows) {
#pragma unroll
                for (int i = 0; i < 4; ++i) AFF[(size_t)(4 * kq + i) * NTOK + row0 + n] = ex[i] * inv; }
        }
    }
    __syncthreads();
}

__device__ __forceinline__ int block_excl_scan(int v, LAS int* wsum, int lane, int wid, int& total) {
    int inc = v;
#pragma unroll
    for (int o = 1; o < 64; o <<= 1) { const int t = __shfl_up(inc, o); if (lane >= o) inc += t; }
    if (lane == 63) wsum[wid] = inc;
    __syncthreads();
    int off = 0, tot = 0;
#pragma unroll
    for (int w = 0; w < 8; ++w) { const int s = wsum[w]; if (w < wid) off += s; tot += s; }
    __syncthreads();
    total = tot; return off + inc - v;
}
__device__ __forceinline__ void phase_topk(const Frame& F) {
    const float* AFFT = (const float*)(F.ws + WS_AFF); int* IDX = (int*)(F.ws + WS_IDX); float* GATEV = (float*)(F.ws + WS_GATEV); int* SLOTMAP = (int*)(F.ws + WS_SLOTMAP);
    LAS int* hist = (LAS int*)F.lds;
    LAS int* wsum = (LAS int*)(F.lds + 1024);
    LAS unsigned* shv = (LAS unsigned*)(F.lds + 1024 + 64);
    const int tid = F.tid, lane = F.lane;
    for (int pr = F.bid; pr < 32; pr += F.G) {
        const int stream = pr >> 4, e = pr & 15, tok0 = stream ? NCTX : 0, cap = stream ? CAPL : CAPC, sbase = e * ESLOTS + (stream ? CAPC : 0);
        const int C = stream ? 16 : 8, i0 = tid * C;
        unsigned k[16];
        { const u32x4* src = (const u32x4*)(AFFT + (size_t)e * NTOK + tok0 + i0);
#pragma unroll
          for (int q = 0; q < 4; ++q) { u32x4 v = (u32x4){0u, 0u, 0u, 0u}; if (q * 4 < C) v = src[q]; k[4 * q] = v.x; k[4 * q + 1] = v.y; k[4 * q + 2] = v.z; k[4 * q + 3] = v.w; } }
        unsigned prefix = 0u; int remaining = cap;
        __syncthreads();
        for (int pass = 0; pass < 4; ++pass) {
            const int shift = 24 - 8 * pass;
            if (tid < 256) hist[tid] = 0;
            __syncthreads();
#pragma unroll
            for (int i = 0; i < 16; ++i) if (i < C) { const unsigned kk = k[i]; if (pass == 0 || (kk >> (shift + 8)) == prefix) __hip_atomic_fetch_add(&hist[(kk >> shift) & 255u], 1, __ATOMIC_RELAXED, __HIP_MEMORY_SCOPE_WORKGROUP); }
            __syncthreads();
            if (tid < 64) {
                const int h0 = hist[4 * lane], h1 = hist[4 * lane + 1], h2 = hist[4 * lane + 2], h3 = hist[4 * lane + 3], c = h0 + h1 + h2 + h3;
                int inc = c;
#pragma unroll
                for (int o = 1; o < 64; o <<= 1) { const int t = __shfl_down(inc, o); if (lane + o < 64) inc += t; }
                const int above = inc - c;
                if (above < remaining && remaining <= inc) {
                    int cum = above, sel;
                    if (cum + h3 >= remaining) sel = 3; else { cum += h3; if (cum + h2 >= remaining) sel = 2; else { cum += h2; if (cum + h1 >= remaining) sel = 1; else { cum += h1; sel = 0; } } }
                    shv[0] = (prefix << 8) | (unsigned)(4 * lane + sel); shv[1] = (unsigned)(remaining - cum);
                }
            }
            __syncthreads();
            prefix = shv[0]; remaining = (int)shv[1];
        }
        const unsigned thr = prefix; const int need = remaining;
        int ceq = 0;
#pragma unroll
        for (int i = 0; i < 16; ++i) if (i < C) ceq += (k[i] == thr) ? 1 : 0;
        int tot; const int eq_rank = block_excl_scan(ceq, wsum, F.lane, F.wave, tot);
        int csel = 0; { int er = eq_rank;
#pragma unroll
            for (int i = 0; i < 16; ++i) if (i < C) { if (k[i] > thr) ++csel; else if (k[i] == thr) { if (er < need) ++csel; ++er; } } }
        int slot = block_excl_scan(csel, wsum, F.lane, F.wave, tot);
#if MK_CHECK
        if (tid == 0 && tot != cap) CHK_FAIL(F, 60);
#endif
        { int er = eq_rank; int sm[16];
#pragma unroll
            for (int i = 0; i < 16; ++i) { sm[i] = -1; if (i < C) { bool sel = false; if (k[i] > thr) sel = true; else if (k[i] == thr) { sel = er < need; ++er; }
                const int tok = tok0 + i0 + i;
                if (sel) { const int r = sbase + slot; IDX[r] = tok; GATEV[r] = __uint_as_float(k[i]); sm[i] = r; ++slot; } } }
            u32x4* dst = (u32x4*)(SLOTMAP + (size_t)e * NTOK + tok0 + i0);
#pragma unroll
            for (int q = 0; q < 4; ++q) if (q * 4 < C) dst[q] = (u32x4){(unsigned)sm[4 * q], (unsigned)sm[4 * q + 1], (unsigned)sm[4 * q + 2], (unsigned)sm[4 * q + 3]}; }
    }
    __syncthreads();
}
__device__ __forceinline__ void phase_gather(const Frame& F) {
    const int* IDX = (const int*)(F.ws + WS_IDX);
#if MK_CHECK
    {
        const int* SLOTMAP = (const int*)(F.ws + WS_SLOTMAP); const float* GATEV = (const float*)(F.ws + WS_GATEV); const float* AFF = (const float*)(F.ws + WS_AFF);
        for (int r = F.gw * 64 + F.lane; r < NSLOTS; r += F.NGW * 64) { const int tok = IDX[r], e = r / ESLOTS; const bool latslot = (r % ESLOTS) >= CAPC;
            bool ok = tok >= 0 && tok < NTOK && ((tok >= NCTX) == latslot);
            if (ok) ok = SLOTMAP[(size_t)e * NTOK + tok] == r && GATEV[r] == AFF[(size_t)e * NTOK + tok];
            if (ok) { const unsigned h = hash_u(r * 7919u + 13u); const int t2 = latslot ? NCTX + (h % NLAT) : (h % NCTX); if (SLOTMAP[(size_t)e * NTOK + t2] < 0 && AFF[(size_t)e * NTOK + t2] > GATEV[r]) ok = false; }
            if (!ok) CHK_FAIL(F, 61); }
    }
#endif
}

__device__ __forceinline__ void ye_acc(f32x4& f, unsigned w) {
    const auto lo = __builtin_amdgcn_cvt_pk_f32_fp8((int)w, false), hi = __builtin_amdgcn_cvt_pk_f32_fp8((int)w, true); f[0] += lo[0]; f[1] += lo[1]; f[2] += hi[0]; f[3] += hi[1];
}
__device__ __forceinline__ void ye_add(f32x4 (&f)[4], const unsigned char* YE, int r, int lane) {
    const bool two = (r >> 8) >= DOWN_FULL_PANELS;
    unsigned w[4], w2[4];
#pragma unroll
    for (int j = 0; j < 4; ++j) { w[j] = ((const unsigned*)(YE + (size_t)r * D))[lane + 64 * j]; w2[j] = 0u; if (two) w2[j] = ((const unsigned*)(YE + (size_t)(NSLOTS + r) * D))[lane + 64 * j]; }
#pragma unroll
    for (int j = 0; j < 4; ++j) { ye_acc(f[j], w[j]); ye_acc(f[j], w2[j]); }
}
__device__ __forceinline__ void ye_add2(f32x4 (&f)[4], const unsigned char* YE, int r, int rb, int lane) {
    const bool two = (r >> 8) >= DOWN_FULL_PANELS, twob = (rb >> 8) >= DOWN_FULL_PANELS;
    unsigned w[4], w2[4], v[4], v2[4];
#pragma unroll
    for (int j = 0; j < 4; ++j) { w[j] = ((const unsigned*)(YE + (size_t)r * D))[lane + 64 * j]; w2[j] = 0u; if (two) w2[j] = ((const unsigned*)(YE + (size_t)(NSLOTS + r) * D))[lane + 64 * j];
        v[j] = ((const unsigned*)(YE + (size_t)rb * D))[lane + 64 * j]; v2[j] = 0u; if (twob) v2[j] = ((const unsigned*)(YE + (size_t)(NSLOTS + rb) * D))[lane + 64 * j]; }
#pragma unroll
    for (int j = 0; j < 4; ++j) { ye_acc(f[j], w[j]); ye_acc(f[j], w2[j]); ye_acc(f[j], v[j]); ye_acc(f[j], v2[j]); }
}
__device__ __forceinline__ void phase_combine(const Frame& F, const Args& a, int l) {
    bf16* X = (bf16*)(F.ws + WS_X); const bf16* X1 = (const bf16*)(F.ws + WS_X1); bf16* H = (bf16*)(F.ws + WS_H); const unsigned char* YE = F.ws + WS_YE; const int* SLOTMAP = (const int*)(F.ws + WS_SLOTMAP);
    int lane_ = F.lane; asm volatile("" : "+v"(lane_)); const int lane = lane_;
    const f32x4* lg = (const f32x4*)(a.in[10] + (size_t)(l * 2 + 1) * D); const f32x4* lb = (const f32x4*)(a.in[11] + (size_t)(l * 2 + 1) * D);
#if MK_CHECK
    const unsigned err = __hip_atomic_load(F.ctl + CW_ERR, __ATOMIC_RELAXED, __HIP_MEMORY_SCOPE_AGENT);
    const unsigned tmo = __hip_atomic_load(F.ctl + CW_BAR + XB_TMO, __ATOMIC_RELAXED, __HIP_MEMORY_SCOPE_AGENT);
#endif
    const int RPW = (NTOK + F.NGW - 1) / F.NGW, rbeg = F.gw * RPW, rend = (rbeg + RPW < NTOK) ? rbeg + RPW : NTOK;
    f32x4 lgv[4], lbv[4], g2v[4], shv[4], scv[4]; int ccur = -1;
#pragma unroll
    for (int j = 0; j < 4; ++j) { lgv[j] = lg[lane + 64 * j]; lbv[j] = lb[lane + 64 * j]; g2v[j] = lgv[j]; shv[j] = lgv[j]; scv[j] = lgv[j]; }
    auto ld_sm = [&](int r) { int v = -1; if (r < rend && lane < 16) v = SLOTMAP[(size_t)lane * NTOK + r]; return v; };
    u32x2 x1n[4]; unsigned pw[4], pw2[4], pv[4], pv2[4]; unsigned restn = 0u; int smn_keep = -1;
    auto issue = [&](int r, int smv) {
        unsigned mask = (unsigned)__ballot(smv >= 0) & 0xffffu; int r0 = -1, r1 = -1;
        if (mask) { const int e0 = __builtin_ctz(mask); mask &= mask - 1; r0 = __builtin_amdgcn_readlane(smv, e0); }
        if (mask) { const int e1 = __builtin_ctz(mask); mask &= mask - 1; r1 = __builtin_amdgcn_readlane(smv, e1); }
        restn = mask; smn_keep = smv;
        const int rr = r < rend ? r : rend - 1;
#pragma unroll
        for (int j = 0; j < 4; ++j) { x1n[j] = ((const u32x2*)(X1 + (size_t)rr * D))[lane + 64 * j]; pw[j] = 0u; pw2[j] = 0u; pv[j] = 0u; pv2[j] = 0u; }
        if (r0 >= 0) {
#pragma unroll
            for (int j = 0; j < 4; ++j) { pw[j] = ((const unsigned*)(YE + (size_t)r0 * D))[lane + 64 * j]; if ((r0 >> 8) >= DOWN_FULL_PANELS) pw2[j] = ((const unsigned*)(YE + (size_t)(NSLOTS + r0) * D))[lane + 64 * j]; } }
        if (r1 >= 0) {
#pragma unroll
            for (int j = 0; j < 4; ++j) { pv[j] = ((const unsigned*)(YE + (size_t)r1 * D))[lane + 64 * j]; if ((r1 >> 8) >= DOWN_FULL_PANELS) pv2[j] = ((const unsigned*)(YE + (size_t)(NSLOTS + r1) * D))[lane + 64 * j]; } }
    };
    int sm1 = ld_sm(rbeg + 1);
    if (rbeg < rend) issue(rbeg, ld_sm(rbeg));
    for (int row = rbeg; row < rend; ++row) {
        const int c = cond_of(row);
        if (c != ccur) { ccur = c; const f32x4* g2 = (const f32x4*)ada_vec(F, l, c, 5);
#pragma unroll
            for (int j = 0; j < 4; ++j) g2v[j] = g2[lane + 64 * j];
            if (l < 3) { const f32x4* sh = (const f32x4*)ada_vec(F, l + 1, c, 0); const f32x4* sc = (const f32x4*)ada_vec(F, l + 1, c, 1);
#pragma unroll
                for (int j = 0; j < 4; ++j) { shv[j] = sh[lane + 64 * j]; scv[j] = sc[lane + 64 * j] + 1.f; } } }
        f32x4 x1[4], f[4]; unsigned mask = restn; const int smc = smn_keep;
#pragma unroll
        for (int j = 0; j < 4; ++j) { x1[j] = bf4(x1n[j]); f[j] = (f32x4){0.f, 0.f, 0.f, 0.f}; ye_acc(f[j], pw[j]); ye_acc(f[j], pw2[j]); ye_acc(f[j], pv[j]); ye_acc(f[j], pv2[j]); }
        if (row + 1 < rend) { const int smv = sm1; sm1 = ld_sm(row + 2); issue(row + 1, smv); }
        while (mask) {
            const int e0 = __builtin_ctz(mask); mask &= mask - 1; const int r0 = __builtin_amdgcn_readlane(smc, e0);
            if (mask) { const int e1 = __builtin_ctz(mask); mask &= mask - 1; const int r1 = __builtin_amdgcn_readlane(smc, e1); ye_add2(f, YE, r0, r1, lane); }
            else ye_add(f, YE, r0, lane);
        }
        f32x4 y[4]; float s = 0.f, s2 = 0.f;
#pragma unroll
        for (int j = 0; j < 4; ++j) { y[j] = x1[j] * ALPHA + g2v[j] * f[j] * (1.f / YE8_SCALE); s += (y[j][0] + y[j][1]) + (y[j][2] + y[j][3]); s2 += (y[j][0] * y[j][0] + y[j][1] * y[j][1]) + (y[j][2] * y[j][2] + y[j][3] * y[j][3]); }
        s = wave_sum(s); s2 = wave_sum(s2);
        const float mean = s * (1.f / D), var = fmaxf(s2 * (1.f / D) - mean * mean, 0.f);
        const float rstd = 1.f / sqrtf(var + 1e-5f);
        if (l < 3) {
#pragma unroll
            for (int j = 0; j < 4; ++j) { const int q = lane + 64 * j; const f32x4 xn = (y[j] - mean) * rstd * lgv[j] + lbv[j]; ((u32x2*)(X + (size_t)row * D))[q] = pk4(xn);
                const f32x4 h = xn * scv[j] + shv[j]; u32x2 w; w.x = cvtpk(h[0], h[1]); w.y = cvtpk(h[2], h[3]); ((u32x2*)(H + (size_t)row * D))[q] = w; }
        } else {
#pragma unroll
            for (int j = 0; j < 4; ++j) { const int q = lane + 64 * j; f32x4 xn = (y[j] - mean) * rstd * lgv[j] + lbv[j];
#if MK_CHECK
                if (row == 0 && q == 0) { if (err) xn[0] = 100.f * (float)err; else if (tmo) xn[0] = 9900.f; }
#endif
                ((f32x4*)(F.out + (size_t)row * D))[q] = xn; }
        }
    }
}

#if !MK_SPLIT
#define GRID_BAR() xcd_barrier(bar)
#else
#define GRID_BAR() do { } while (0)
#endif
#define IN(k) (lo <= (k) && (k) < hi)
#define GEMM_PHASE(EPI, SCHED) do { for (int rep_ = 0; rep_ < MK_REP_GEMM; ++rep_) pg8::gemm_phase<EPI, SCHED, true, true>(F.lds, g, S, E); } while (0)
template <int KIND>
__device__ __forceinline__ void run_mixer(const Frame& F, const Args& a, const XcdBarrier& bar, int lo, int hi, int l, int j, int slot, int& cv_it) {
    const int base = 3 + 12 * l;
    const bf16* Hb = (const bf16*)(F.ws + WS_H);
    ChunkMap cm; cm.init(F.G, F.bid);
    const ConvJob J{a.in[26], a.in[27], a.in[28], F.ws + WS_WGU, F.ws + WS_WD};
    const int cv_cap = (l == 0 ? 32 : l == 1 ? 48 : l == 2 ? 82 : 96) * (CV_PER_LAYER / 24);
    if (KIND != 2) {
        const bf16* Wq = (const bf16*)(F.ws + WS_WQKV) + (size_t)slot * 1536 * 1024;
        if (IN(base + 0)) {
            unsigned* cnt = F.ctl + CW_KV + 16 * l;
            Gemm g{Hb, Wq, 1024, 1024}; QkvOrder S{cm}; EpiBf16P E{(bf16*)(F.ws + WS_QKV), 1536};
            GEMM_PHASE(EpiBf16P, QkvOrder);
            int nkv = 0; { Unit u; for (int i = 0; S.next(i, u); ++i) nkv += (u.pn >= 4) ? 1 : 0; }
            if (nkv && F.tid == 0) { __builtin_amdgcn_fence(__ATOMIC_RELEASE, "agent"); (void)__hip_atomic_fetch_add(cnt, (unsigned)nkv, __ATOMIC_RELAXED, __HIP_MEMORY_SCOPE_AGENT); }
            const int idx = cm.x * cm.chunk + cm.loc; int skip = 288 - F.G; if (skip < 0 || skip >= F.G) skip = 0;
            if (idx >= skip) {
                if (F.tid == 0) { while (__hip_atomic_load(cnt, __ATOMIC_RELAXED, __HIP_MEMORY_SCOPE_AGENT) < 96u) __builtin_amdgcn_s_sleep(2); __builtin_amdgcn_fence(__ATOMIC_ACQUIRE, "agent"); }
                __syncthreads();
                for (int rep = 0; rep < MK_REP_POST; ++rep) phase_kv_post(F, a, KIND, j, slot, (idx - skip) * 8 + F.wave, (F.G - skip) * 8);
            }
            GRID_BAR();
        }
#if MK_CHECK
        if (IN(base + 3)) check_gemm_bf16<int>(F, Hb, Wq, NTOK, 1536, 1024, (const bf16*)(F.ws + WS_QKV), 1536, 10 + l);
#endif
        if (IN(base + 4)) {
            for (int rep = 0; rep < MK_REP_ATTN; ++rep) { if (KIND == 0) attn_phase<64, 0>(F, a, j, J, cv_it, (l + 1) * CV_PER_LAYER, cv_cap); else attn_phase<64, 1>(F, a, j, J, cv_it, (l + 1) * CV_PER_LAYER, cv_cap); }
            GRID_BAR();
        }
    } else {
        if (IN(base + 0)) {
            Gemm g{Hb, (const bf16*)(F.ws + WS_WDN), 512, 1024}; SplitKOrder S{2, 2, 1024, 48 * 2 * 2, cm}; EpiF32 E{(float*)(F.ws + WS_QKV), 512, DWN_PART};
            GEMM_PHASE(EpiF32, SplitKOrder); GRID_BAR();
        }
        if (IN(base + 1)) {
#if MK_CHECK
            for (int sidx = 0; sidx < 2; ++sidx) { const unsigned h = hash_u((F.gw * 2 + sidx) * 2654435761u + (10 + l) * 97u); const int row = h % NTOK, col = (h >> 12) % 512;
                const float ref = dot_bf16(Hb + (size_t)row * 1024, (const bf16*)(F.ws + WS_WDN) + (size_t)col * 1024, 1024, F.lane); const float* dq = (const float*)(F.ws + WS_QKV) + (size_t)row * 512 + col;
                if (!close_enough(dq[0] + dq[DWN_PART], ref, 0.01f, 0.01f)) CHK_FAIL(F, 10 + l); }
#endif
            phase_mla_post1(F, a); GRID_BAR();
        }
        if (IN(base + 2)) {
            { Gemm g{(const bf16*)(F.ws + WS_QA), (const bf16*)(F.ws + WS_WUQ), 256, 256}; PlainOrder S{6, 48 * 6, cm}; EpiBf16P E{(bf16*)(F.ws + WS_QKV), 1536}; GEMM_PHASE(EpiBf16P, PlainOrder); }
            { Gemm g{(const bf16*)(F.ws + WS_CKVA), (const bf16*)(F.ws + WS_WUKV), 128, 128}; PlainOrder S{8, 56 * 8, cm}; EpiUkv E{(bf16*)(F.ws + WS_KB), (float*)(F.ws + WS_KVRAW)}; GEMM_PHASE(EpiUkv, PlainOrder); }
            GRID_BAR();
        }
        if (IN(base + 3)) {
#if MK_CHECK
            check_gemm_bf16<int>(F, (const bf16*)(F.ws + WS_QA), (const bf16*)(F.ws + WS_WUQ), NTOK, 1536, 256, (const bf16*)(F.ws + WS_QKV), 1536, 14);
            for (int sidx = 0; sidx < 2; ++sidx) {
                const unsigned h = hash_u((F.gw * 2 + sidx) * 2654435761u + 15u * 97u); const int row = h % 14336, col = (h >> 12) % 2048, hh = col >> 7, ii = col & 127;
                const float ref = dot_bf16((const bf16*)(F.ws + WS_CKVA) + (size_t)row * 128, (const bf16*)(F.ws + WS_WUKV) + (size_t)col * 128, 128, F.lane);
                bool lat; int b, s; mla_row(row, lat, b, s);
                const float got = (ii < 64) ? bf2f(((const bf16*)(F.ws + WS_KB))[kb_off(16, 96, lat, b, hh) + (size_t)s * 96 + ii]) : ((const float*)(F.ws + WS_KVRAW))[(size_t)row * 1024 + hh * 64 + ii - 64];
                if (!close_enough(got, ref, 0.02f, 0.02f)) CHK_FAIL(F, 15);
            }
#endif
            for (int rep = 0; rep < MK_REP_POST; ++rep) phase_mla_post2(F, a); GRID_BAR();
        }
        if (IN(base + 4)) { for (int rep = 0; rep < MK_REP_ATTN; ++rep) attn_phase<96, 2>(F, a, j, J, cv_it, (l + 1) * CV_PER_LAYER, cv_cap); GRID_BAR(); }
    }
}
__device__ __forceinline__ void run_moe(const Frame& F, const Args& a, const XcdBarrier& bar, int lo, int hi, int l, int kind) {
    const int base = 3 + 12 * l;
    ChunkMap cm; cm.init(F.G, F.bid);
    const bf16* Wo = (const bf16*)(F.ws + WS_WO) + (size_t)l * 1024 * 1024;
    if (IN(base + 5)) {
#if MK_CHECK
        if (kind == 0) check_attn<64, 0>(F, a, l / 3, 20 + l); else if (kind == 1) check_attn<64, 1>(F, a, 0, 20 + l); else check_attn<96, 2>(F, a, 0, 20 + l);
        __syncthreads();
#endif
        Gemm g{(const bf16*)(F.ws + WS_O), Wo, 1024, 1024}; PlainOrder S{4, 48 * 4, cm}; EpiBf16P E{(bf16*)(F.ws + WS_AO), 1024};
        GEMM_PHASE(EpiBf16P, PlainOrder); GRID_BAR();
    }
    if (IN(base + 6)) {
#if MK_CHECK
        check_gemm_bf16<int>(F, (const bf16*)(F.ws + WS_O), Wo, NTOK, 1024, 1024, (const bf16*)(F.ws + WS_AO), 1024, 30 + l);
#endif
        for (int rep = 0; rep < MK_REP_LN1; ++rep) phase_ln1_router(F, a, l); GRID_BAR();
    }
#if MK_CHECK
    if (IN(base + 7)) {
        const unsigned hsh = hash_u(F.gw * 2654435761u + 991u * l + 17u); const int row = hsh % NTOK, c = cond_of(row);
        const bf16* X1c = (const bf16*)(F.ws + WS_X1); const float* sh2 = ada_vec(F, l, c, 3); const float* sc2 = ada_vec(F, l, c, 4); const float* wrc = a.in[25] + (size_t)l * D * NE; const float* AFFc = (const float*)(F.ws + WS_AFF);
        float lgt[16];
#pragma unroll
        for (int e = 0; e < 16; ++e) { float sacc = 0.f; for (int k = F.lane; k < D; k += 64) { const float hh = bf2f(X1c[(size_t)row * D + k]) * (sc2[k] + 1.f) + sh2[k]; sacc += hh * wrc[k * NE + e]; } lgt[e] = wave_sum(sacc); }
        float mxc = lgt[0];
#pragma unroll
        for (int e = 1; e < 16; ++e) mxc = fmaxf(mxc, lgt[e]);
        float denc = 0.f;
#pragma unroll
        for (int e = 0; e < 16; ++e) denc += __expf(lgt[e] - mxc);
#pragma unroll
        for (int e = 0; e < 16; ++e) { const float ref = __expf(lgt[e] - mxc) / denc, got = AFFc[(size_t)e * NTOK + row]; if (!close_enough(got, ref, 0.03f, 2e-4f)) CHK_FAIL(F, 62); }
    }
#endif
    if (IN(base + 7)) { for (int rep = 0; rep < MK_REP_TOPK; ++rep) phase_topk(F); if (l < 3) ada_direct(F, a, l + 1, 32); GRID_BAR(); }
#if MK_CHECK
    if (IN(base + 8)) { phase_gather(F); GRID_BAR(); }
#endif
    const unsigned char* Wgu = F.ws + WS_WGU + (size_t)l * 16 * 4096 * 1024; const unsigned char* Wd = F.ws + WS_WD + (size_t)l * 16 * 1024 * 2048;
    if (IN(base + 9)) {
#if MK_CHECK
        for (int sidx = 0; sidx < 16; ++sidx) {
            const unsigned h = hash_u((F.gw * 16 + sidx) * 2654435761u + 71u * l + 3u); const int idx = h & 63, e = (h >> 6) & 15, kk = (h >> 10) & 1023, nn = (h >> 20) & 2047;
            const int k = kk + ((idx & 1) ? 1024 * ((h >> 31) & 1) : 0);
            float src, got;
            if (idx & 1) { const int n = nn & 1023; src = a.in[28][((size_t)(l * 16 + e) * 2048 + k) * 1024 + n]; got = fp8f(Wd + ((size_t)e * 1024 + n) * 2048, k); }
            else { const bool up = (idx & 2) != 0; src = (up ? a.in[27] : a.in[26])[((size_t)(l * 16 + e) * 1024 + kk) * 2048 + nn]; got = fp8f(Wgu + ((size_t)e * 4096 + (nn >> 7) * 256 + (up ? 128 : 0) + (nn & 127)) * 1024, kk); }
            { const unsigned pk = pk4_fp8(src * W8_SCALE, 0.f, 0.f, 0.f); if (F.lane == 0 && got != __builtin_amdgcn_cvt_f32_fp8((int)pk, 0)) CHK_FAIL(F, 70 + l); }
        }
#endif
        Gemm g{(const bf16*)(F.ws + WS_XE), (const bf16*)Wgu, 512, 512, (const int*)(F.ws + WS_IDX)}; GroupedOrder S{6, 16, 1, 0, cm}; EpiSwiglu E{F.ws + WS_HID};
        pg8::gemm_phase<EpiSwiglu, GroupedOrder, true, true, true, true>(F.lds, g, S, E); GRID_BAR();
    }
    if (IN(base + 10)) {
#if MK_CHECK
        for (int sidx = 0; sidx < 2; ++sidx) {
            const unsigned h = hash_u((F.gw * 2 + sidx) * 2654435761u + 977u * l); const int row = h % NSLOTS, cc = (h >> 12) % FF, e = row / ESLOTS;
            const unsigned char* xr = F.ws + WS_XE + (size_t)((const int*)(F.ws + WS_IDX))[row] * D; const unsigned char* wg = Wgu + ((size_t)e * 4096 + (cc >> 7) * 256 + (cc & 127)) * 1024;
            const float gd = dot_fp8(xr, wg, 1024, F.lane) * (1.f / W8_SCALE), ud = dot_fp8(xr, wg + 128 * 1024, 1024, F.lane) * (1.f / W8_SCALE);
            const float ref = gd / (1.f + __expf(-gd)) * ud, got = fp8f(F.ws + WS_HID + (size_t)row * FF, cc) * (1.f / H8_SCALE);
            if (!close_enough(got, ref, 0.08f, 0.01f)) CHK_FAIL(F, 40 + l);
        }
#endif
        EpiDown E{F.ws + WS_YE, (const float*)(F.ws + WS_GATEV)};
        { Gemm g{(const bf16*)(F.ws + WS_HID), (const bf16*)Wd, 1024, 1024, nullptr}; DownOrder S{0, cm}; pg8::gemm_phase<EpiDown, DownOrder, true, true, false, true>(F.lds, g, S, E); }
        { Gemm g{(const bf16*)(F.ws + WS_HID), (const bf16*)Wd, 512, 1024, nullptr}; DownOrder S{1, cm}; pg8::gemm_phase<EpiDown, DownOrder, true, true, false, true>(F.lds, g, S, E); }
        GRID_BAR();
    }
    if (IN(base + 11)) {
#if MK_CHECK
        for (int sidx = 0; sidx < 2; ++sidx) {
            const unsigned h = hash_u((F.gw * 2 + sidx) * 2654435761u + 577u * l + 5u); const int row = h % NSLOTS, cc = (h >> 12) % D, e = row / ESLOTS;
            const float dd = dot_fp8(F.ws + WS_HID + (size_t)row * FF, Wd + ((size_t)e * 1024 + cc) * 2048, 2048, F.lane) * (1.f / (W8_SCALE * H8_SCALE));
            const float ref = dd * ((const float*)(F.ws + WS_GATEV))[row], p1 = fp8f(F.ws + WS_YE + (size_t)row * D, cc) * (1.f / YE8_SCALE), p2 = ((row >> 8) >= DOWN_FULL_PANELS) ? fp8f(F.ws + WS_YE + (size_t)(NSLOTS + row) * D, cc) * (1.f / YE8_SCALE) : 0.f;
            if (!(fabsf(p1 + p2 - ref) <= 0.07f * (fabsf(p1) + fabsf(p2)) + 0.0005f)) CHK_FAIL(F, 50 + l);
        }
#endif
        for (int rep = 0; rep < MK_REP_COMB; ++rep) phase_combine(F, a, l); if (l < 3) GRID_BAR();
    }
}
#undef IN

constexpr int N_PHASES = 3 + 4 * 12;
__global__ void __launch_bounds__(512, 2) mk_fwd(Args a) {
    extern __shared__ __attribute__((aligned(16))) unsigned char lds_raw[];
    LAS unsigned char* lds0 = (LAS unsigned char*)lds_raw;
    Frame F;
    F.lds = lds0 + LDS_PH; F.ws = a.ws; F.out = a.out; F.ctl = (unsigned*)(a.ws + WS_CTL);
    F.tid = threadIdx.x; F.lane = F.tid & 63; F.wave = __builtin_amdgcn_readfirstlane(F.tid >> 6); F.G = gridDim.x; F.bid = blockIdx.x; F.gw = F.bid * 8 + F.wave; F.NGW = F.G * 8;
    if (F.tid < LDS_PH / 4) ((LAS unsigned*)lds0)[F.tid] = 0u;
    __syncthreads();
#if !MK_SPLIT
    XcdBarrier bar = xcd_barrier_post(F.ctl + CW_BAR, (volatile LAS unsigned*)lds0);
#else
    XcdBarrier bar; bar.bar = F.ctl + CW_BAR; bar.x = 0; bar.st = (volatile LAS unsigned*)lds0;
#endif
    const int lo = a.ph_lo, hi = a.ph_hi;
#define IN(k) (lo <= (k) && (k) < hi)
    if (IN(0)) { phase_prologue(F, a); GRID_BAR(); }
    if (IN(2)) { phase_mod0(F, a); GRID_BAR(); }
    int cv_it = F.gw;
    run_mixer<0>(F, a, bar, lo, hi, 0, 0, 0, cv_it);
    run_moe(F, a, bar, lo, hi, 0, 0);
    run_mixer<1>(F, a, bar, lo, hi, 1, 0, 1, cv_it);
    run_moe(F, a, bar, lo, hi, 1, 1);
    run_mixer<2>(F, a, bar, lo, hi, 2, 0, 0, cv_it);
    run_moe(F, a, bar, lo, hi, 2, 2);
    run_mixer<0>(F, a, bar, lo, hi, 3, 1, 2, cv_it);
    run_moe(F, a, bar, lo, hi, 3, 0);
#undef IN
}

extern "C" void kernel_launch(void* const* d_in, const int* in_sizes, int n_in, void* d_out, int out_size, void* d_ws, size_t ws_size, hipStream_t stream) {
    static int grid = 0;
    if (grid == 0) {
        if (n_in != 29 || out_size != 19529728 || ws_size < WS_END) { fprintf(stderr, "kernel_launch: unexpected sizes n_in %d out %d ws %zu\n", n_in, out_size, ws_size); grid = -1; return; }
        int dev = 0, cus = 0, per_cu = 0;
        if (hipGetDevice(&dev) != hipSuccess || hipDeviceGetAttribute(&cus, hipDeviceAttributeMultiprocessorCount, dev) != hipSuccess) { grid = -1; return; }
        if (hipFuncSetAttribute((const void*)mk_fwd, hipFuncAttributeMaxDynamicSharedMemorySize, LDS_BYTES) != hipSuccess) { fprintf(stderr, "kernel_launch: hipFuncSetAttribute failed\n"); grid = -1; return; }
        if (hipOccupancyMaxActiveBlocksPerMultiprocessor(&per_cu, (const void*)mk_fwd, 512, LDS_BYTES) != hipSuccess || per_cu < 1) fprintf(stderr, "kernel_launch: occupancy query says %d\n", per_cu);
        (void)hipGetLastError();
        grid = cus;
    }
    if (grid < 0) return;
    (void)hipMemsetAsync((char*)d_ws + WS_CTL, 0, CTL_BYTES, stream);
    Args a{};
    for (int i = 0; i < 29; ++i) a.in[i] = (const float*)d_in[i];
    a.out = (float*)d_out; a.ws = (unsigned char*)d_ws;
#if MK_SPLIT
    for (int p = 0; p < N_PHASES; ++p) {
        const int r = (p - 3) % 12, l = (p - 3) / 12;
        if (p >= 3) { const bool mla = (l % 3) == 2; if (!mla && (r == 1 || r == 2)) continue; }
        a.ph_lo = p; a.ph_hi = p + 1;
        hipLaunchKernelGGL(mk_fwd, dim3(grid), dim3(512), LDS_BYTES, stream, a);
    }
#else
    a.ph_lo = 0; a.ph_hi = N_PHASES;
    hipLaunchKernelGGL(mk_fwd, dim3(grid), dim3(512), LDS_BYTES, stream, a);
#endif
}
```

```cpp
#include <hip/hip_runtime.h>
#include <cstdio>
#include <cstdint>

#ifndef MK_SPLIT
#define MK_SPLIT 0
#endif
#ifndef MK_REP_ATTN
#define MK_REP_ATTN 1
#endif
#ifndef MK_REP_CONV
#define MK_REP_CONV 1
#endif
#ifndef MK_REP_POST
#define MK_REP_POST 1
#endif
#ifndef MK_REP_GEMM
#define MK_REP_GEMM 1
#endif
#ifndef MK_REP_LN1
#define MK_REP_LN1 1
#endif
#ifndef MK_REP_TOPK
#define MK_REP_TOPK 1
#endif
#ifndef MK_REP_GATH
#define MK_REP_GATH 1
#endif
#ifndef MK_REP_COMB
#define MK_REP_COMB 1
#endif
#ifndef MK_CHECK
#define MK_CHECK 0
#endif

#define LAS __attribute__((address_space(3)))
typedef unsigned short bf16;
typedef unsigned u32x4 __attribute__((ext_vector_type(4)));
typedef unsigned u32x2 __attribute__((ext_vector_type(2)));
typedef float f32x2 __attribute__((ext_vector_type(2)));
typedef float f32x4 __attribute__((ext_vector_type(4)));
typedef float f32x16 __attribute__((ext_vector_type(16)));
typedef short bf16x8 __attribute__((ext_vector_type(8)));
typedef __bf16 bf16x2_t __attribute__((ext_vector_type(2)));

constexpr int D = 1024, NCTX = 4096, NLAT = 8192, NTOK = 12288;
constexpr int NE = 16, FF = 2048, CAPC = 512, CAPL = 1024, ESLOTS = 1536, NSLOTS = 24576;
constexpr float ALPHA = 1.681792830507429f, LOG2E = 1.4426950408889634f;
constexpr float GQA_QS = 0.125f * LOG2E, MLA_QS = 0.10206207261596575f * LOG2E;
constexpr size_t DWN_PART = (size_t)8 << 20;
constexpr int OFF_YP = 0, OFF_NK = 12582912, OFF_NV = OFF_NK + 3145728, OFF_CKV = OFF_NV + 3145728, OFF_KPE = OFF_CKV + 524288;

constexpr size_t MiB = 1u << 20;
constexpr size_t WS_CTL = 0, CTL_BYTES = 1 * MiB;
constexpr size_t WS_ADAP = 1 * MiB, WS_ADA = 9 * MiB, WS_ROPE64 = 10 * MiB, WS_ROPE32 = 10 * MiB + 512 * 1024;
constexpr size_t WS_AFF = 11 * MiB, WS_IDX = 12 * MiB, WS_GATEV = 12 * MiB + 128 * 1024, WS_SLOTMAP = 13 * MiB;
constexpr size_t WS_X = 16 * MiB, WS_H = 64 * MiB, WS_O = 88 * MiB, WS_AO = 112 * MiB, WS_QKV = 160 * MiB, WS_KVRAW = 232 * MiB;
constexpr size_t WS_X1 = 292 * MiB  , WS_KB = 380 * MiB, WS_VT = 428 * MiB, WS_QA = 460 * MiB, WS_CKVA = 466 * MiB;
constexpr size_t WS_XE = 470 * MiB, WS_HID = 518 * MiB, WS_YE = 614 * MiB;
constexpr size_t WS_WQKV = 712 * MiB, WS_WO = 724 * MiB, WS_WDN = 732 * MiB, WS_WUQ = 733 * MiB, WS_WUKV = 734 * MiB;
constexpr size_t WS_WGU = 736 * MiB, WS_WD = 1248 * MiB, WS_END = 1504 * MiB;
constexpr int CW_ERR = 0, CW_BAR = 4096, CW_KV = 8192;

constexpr int LDS_BYTES = 147456, LDS_PH = 256;

__device__ __forceinline__ unsigned cvtpk(float lo, float hi) { f32x2 v = {lo, hi}; bf16x2_t b = __builtin_convertvector(v, bf16x2_t); return __builtin_bit_cast(unsigned, b); }
__device__ __forceinline__ bf16 f2bf(float f) { return (bf16)(cvtpk(f, 0.f) & 0xffffu); }
__device__ __forceinline__ float bf2f(bf16 b) { return __uint_as_float(((unsigned)b) << 16); }
__device__ __forceinline__ unsigned pk4_fp8(float a, float b, float c, float d) { int w = __builtin_amdgcn_cvt_pk_fp8_f32(a, b, 0, false); w = __builtin_amdgcn_cvt_pk_fp8_f32(c, d, w, true); return (unsigned)w; }
constexpr float W8_SCALE = 64.f, H8_SCALE = 8.f;
constexpr float YE8_SCALE = 128.f;
__device__ __forceinline__ float clamp8(float x) { return __builtin_amdgcn_fmed3f(x, -448.f, 448.f); }
__device__ __forceinline__ f32x4 bf4(u32x2 w) { return (f32x4){__uint_as_float(w.x << 16), __uint_as_float(w.x & 0xffff0000u), __uint_as_float(w.y << 16), __uint_as_float(w.y & 0xffff0000u)}; }
__device__ __forceinline__ u32x2 pk4(f32x4 v) { u32x2 w; w.x = cvtpk(v[0], v[1]); w.y = cvtpk(v[2], v[3]); return w; }
template <int CTRL> __device__ __forceinline__ float dppf(float v) { return __uint_as_float((unsigned)__builtin_amdgcn_update_dpp(0, (int)__float_as_uint(v), CTRL, 0xf, 0xf, true)); }
constexpr int DPP_X1 = 0xB1, DPP_X2 = 0x4E, DPP_HMIR = 0x141, DPP_MIR = 0x140, DPP_X8 = 0x128;
__device__ __forceinline__ float xsum16(float a, float b) { const auto r = __builtin_amdgcn_permlane16_swap(__float_as_uint(a), __float_as_uint(b), false, false); return __uint_as_float(r[0]) + __uint_as_float(r[1]); }
__device__ __forceinline__ float xsum32(float a, float b) { const auto r = __builtin_amdgcn_permlane32_swap(__float_as_uint(a), __float_as_uint(b), false, false); return __uint_as_float(r[0]) + __uint_as_float(r[1]); }
__device__ __forceinline__ float xmax16(float a) { const auto r = __builtin_amdgcn_permlane16_swap(__float_as_uint(a), __float_as_uint(a), false, false); return fmaxf(__uint_as_float(r[0]), __uint_as_float(r[1])); }
__device__ __forceinline__ float xmax32(float a) { const auto r = __builtin_amdgcn_permlane32_swap(__float_as_uint(a), __float_as_uint(a), false, false); return fmaxf(__uint_as_float(r[0]), __uint_as_float(r[1])); }
__device__ __forceinline__ float sum16(float v) { v += dppf<DPP_X1>(v); v += dppf<DPP_X2>(v); v += dppf<DPP_HMIR>(v); v += dppf<DPP_MIR>(v); return v; }
__device__ __forceinline__ float wave_sum(float v) { v = sum16(v); v = xsum16(v, v); return xsum32(v, v); }
__device__ __forceinline__ float wave_max(float v) {
    v = fmaxf(v, dppf<DPP_X1>(v)); v = fmaxf(v, dppf<DPP_X2>(v)); v = fmaxf(v, dppf<DPP_HMIR>(v)); v = fmaxf(v, dppf<DPP_MIR>(v)); v = xmax16(v); return xmax32(v);
}
__device__ __forceinline__ int cond_of(int t) { return t < NCTX ? 0 : 1 + ((t - NCTX) >> 11); }
__device__ __forceinline__ unsigned hash_u(unsigned x) { x ^= x >> 16; x *= 0x7feb352dU; x ^= x >> 15; x *= 0x846ca68bU; x ^= x >> 16; return x; }

#define XB_TMO      128
#define XB_XCNT(j)  (256  + 64 * (j))
#define XB_XSUB(j)  (1280 + 64 * (j))
#define XB_XGEN(j)  (2304 + 64 * (j))
#define XB_TOP      3328
#define XB_TOPGEN   3392
#define XCD_BAR_WORDS 3456
#define XB_SPIN_CAP (1u << 18)
__device__ __forceinline__ unsigned xb_ld(unsigned* p)              { return __hip_atomic_load(p, __ATOMIC_RELAXED, __HIP_MEMORY_SCOPE_AGENT); }
__device__ __forceinline__ unsigned xb_add(unsigned* p, unsigned v) { return __hip_atomic_fetch_add(p, v, __ATOMIC_RELAXED, __HIP_MEMORY_SCOPE_AGENT); }
__device__ __forceinline__ unsigned xb_xcc_id() { return (unsigned)__builtin_amdgcn_s_getreg((3 << 11) | 20) & 0xFu; }
#define XB_SPIN(cond, bar) do { unsigned _sp = 0; while (cond) { __builtin_amdgcn_s_sleep(1); \
    if ((++_sp & 255u) == 0u) { if (xb_ld(&(bar)[XB_TMO])) break; if (_sp > XB_SPIN_CAP) { atomicAdd(&(bar)[XB_TMO], 1u); break; } } } } while (0)
struct XcdBarrier { unsigned* bar; unsigned x; volatile LAS unsigned* st; };
__device__ __forceinline__ XcdBarrier xcd_barrier_post(unsigned* bar, volatile LAS unsigned* st) {
    XcdBarrier b; b.bar = bar; b.x = xb_xcc_id(); b.st = st;
    if (threadIdx.x == 0) (void)xb_add(&bar[XB_XCNT(b.x)], 1u);
    return b;
}
__device__ __forceinline__ void xcd_barrier_complete(unsigned* bar, unsigned x, unsigned& nloc, unsigned& nx) {
    const unsigned G = gridDim.x * gridDim.y * gridDim.z;
    unsigned sum, cnt, mine, sp = 0u;
    for (;;) {
        sum = 0u; cnt = 0u; mine = 0u;
#pragma unroll
        for (unsigned j = 0; j < 16; ++j) { const unsigned c = xb_ld(&bar[XB_XCNT(j)]); sum += c; cnt += (c > 0u) ? 1u : 0u; mine = (j == x) ? c : mine; }
        if (sum == G) break;
        __builtin_amdgcn_s_sleep(1);
        if ((++sp & 255u) == 0u) { if (xb_ld(&bar[XB_TMO])) break; if (sp > XB_SPIN_CAP) { atomicAdd(&bar[XB_TMO], 1u); break; } }
    }
    nloc = mine > 0u ? mine : 1u; nx = cnt > 0u ? cnt : 1u;
}
__device__ __forceinline__ void xcd_barrier(const XcdBarrier& b) {
    asm volatile("s_waitcnt vmcnt(0)" ::: "memory");
    __syncthreads();
    if (threadIdx.x == 0) {
        unsigned* bar = b.bar;
        __builtin_amdgcn_s_waitcnt(0);
        unsigned nloc = b.st[0], nx = b.st[1];
        if (nloc == 0u) { xcd_barrier_complete(bar, b.x, nloc, nx); b.st[0] = nloc; b.st[1] = nx; }
        const unsigned old = xb_add(&bar[XB_XSUB(b.x)], 1u);
        const unsigned gen = old / nloc;
        if (old + 1u == (gen + 1u) * nloc) {
            __builtin_amdgcn_fence(__ATOMIC_RELEASE, "agent");
            asm volatile("s_waitcnt vmcnt(0)" ::: "memory");
            const unsigned og = xb_add(&bar[XB_TOP], 1u);
            const unsigned tg = og / nx;
            if (og + 1u == (tg + 1u) * nx) xb_add(&bar[XB_TOPGEN], 1u);
            else XB_SPIN(xb_ld(&bar[XB_TOPGEN]) == tg, bar);
            __builtin_amdgcn_fence(__ATOMIC_ACQUIRE, "agent");
            xb_add(&bar[XB_XGEN(b.x)], 1u);
            asm volatile("s_waitcnt vmcnt(0)" ::: "memory");
        } else {
            XB_SPIN(xb_ld(&bar[XB_XGEN(b.x)]) == gen, bar);
            __builtin_amdgcn_fence(__ATOMIC_ACQUIRE, "agent");
            asm volatile("s_waitcnt vmcnt(0)" ::: "memory");
        }
    }
    __syncthreads();
}

struct Args { const float* in[29]; float* out; unsigned char* ws; int ph_lo, ph_hi; };
struct Frame {
    LAS unsigned char* lds;
    unsigned char* ws; float* out; unsigned* ctl;
    int tid, lane, wave, G, bid, gw, NGW;
};
#if MK_CHECK
#define CHK_FAIL(F, id) do { unsigned _e = 0u; __hip_atomic_compare_exchange_strong((F).ctl + CW_ERR, &_e, (unsigned)(id), __ATOMIC_RELAXED, __ATOMIC_RELAXED, __HIP_MEMORY_SCOPE_AGENT); } while (0)
#endif
__device__ __forceinline__ bool close_enough(float a, float b, float rel, float abs_) { const float d = fabsf(a - b); return d <= rel * fabsf(b) + abs_ && a == a; }

namespace pg8 {
#define PG8_LAS __attribute__((address_space(3)))
typedef unsigned short bf16_t;
typedef short bf16x8 __attribute__((ext_vector_type(8)));
typedef float f32x4 __attribute__((ext_vector_type(4)));
constexpr int BM = 256, BK = 64, HALF = 128, HTB = HALF * BK * 2  , STAGE_BYTES = 8 * HTB, NXCD = 8, WGM = 8;

__host__ __device__ __forceinline__ int lds_byte(int r, int c, int XM = 32) { const int st = (r >> 4) * 2 + (c >> 5), rr = r & 15, cc = c & 31, ob = rr * 64 + cc * 2; return st * 1024 + (ob ^ (((ob >> 9) & 1) * XM)); }
__host__ __device__ __forceinline__ void stage_rc(int b, int& R, int& C, int XM = 32) { const int st = b / 1024, sb = b % 1024, swz = sb ^ (((sb >> 9) & 1) * XM); R = (st >> 1) * 16 + swz / 64; C = (st & 1) * 32 + (swz % 64) / 2; }
__host__ __device__ __forceinline__ int perm32(int rho) { const int n = rho >> 4, i = rho & 15; return 8 * (i >> 2) + 4 * n + (i & 3); }
struct Unit { int pm, pn, kb; };
struct Gemm { const bf16_t* A; const bf16_t* Bt; int K, ld; const int* aidx; };
template <class Epi, class Sched, bool ALIGN_EPI = false, bool SP2 = false, bool GATHER = false, bool F8 = false>
__device__ __forceinline__ void gemm_phase(PG8_LAS unsigned char* lds, const Gemm g, const Sched& S, const Epi& E) {
    int tid_ = threadIdx.x; asm volatile("" : "+v"(tid_));
    const int tid = tid_, wid = __builtin_amdgcn_readfirstlane(tid >> 6), lane = tid & 63, wr = wid >> 2, wc = wid & 3, fr = lane & 15, fq = lane >> 4;
    const int K = g.K, LD = g.ld, nt = K / BK;
    unsigned voffA[2], voffB[2]; int RA[2]; unsigned CA2[2];
#pragma unroll
    for (int i = 0; i < 2; ++i) { int R, C; stage_rc(tid * 16 + i * 8192, R, C, F8 ? 48 : 32); const int Rb = Epi::PERM ? ((R & ~31) + perm32(R & 31)) : R;
        voffA[i] = (unsigned)(R * LD + C) * 2u; voffB[i] = (unsigned)(Rb * LD + C) * 2u; RA[i] = R; CA2[i] = (unsigned)C * 2u; }
    const size_t kstep = (size_t)(BK * 2);
    const size_t hstep = (size_t)HALF * LD * 2;
    const size_t tstep = 2 * hstep;
    const unsigned ldsw = (unsigned)wid * 1024u;
    const int aoff = lds_byte(wr * 64 + fr, F8 ? fq * 16 : fq * 8, F8 ? 48 : 32), boff = lds_byte(wc * 32 + fr, F8 ? fq * 16 : fq * 8, F8 ? 48 : 32);
    const int aoffh = aoff ^ 16, boffh = boff ^ 16;
    typedef int i32x8_t __attribute__((ext_vector_type(8)));
#define PG8_SA(b, h) (((b) * 2 + (h)) * HTB)
#define PG8_SB(b, h) ((4 + (b) * 2 + (h)) * HTB)
#define PG8_STAGE(bufoff, gbase, voff) do { _Pragma("unroll") for (int _i = 0; _i < 2; ++_i) \
        __builtin_amdgcn_global_load_lds((const unsigned*)((const char*)(gbase) + (voff)[_i]), (PG8_LAS unsigned*)(lds + (bufoff) + ldsw + _i * 8192), 16, 0, 0); } while (0)
#define PG8_GOFF(dst, unit) do { _Pragma("unroll") for (int _h = 0; _h < 2; ++_h) _Pragma("unroll") for (int _i = 0; _i < 2; ++_i) dst[_h][_i] = (unsigned)g.aidx[(unit).pm * 256 + _h * 128 + RA[_i]] * (unsigned)(LD * 2) + CA2[_i]; } while (0)
#define PG8_STAGE_A(bufoff, gbase, h, nx) do { if constexpr (GATHER) { unsigned _o[2] = {(nx) ? oN[h][0] : oC[h][0], (nx) ? oN[h][1] : oC[h][1]}; PG8_STAGE(bufoff, gbase, _o); } else { PG8_STAGE(bufoff, (gbase) + (h) * hstep, voffA); } } while (0)
#define PG8_LDA16(dst, b, h) do { _Pragma("unroll") for (int m = 0; m < 4; ++m) _Pragma("unroll") for (int k = 0; k < 2; ++k) dst[m][k] = *(const PG8_LAS bf16x8*)(lds + PG8_SA(b, h) + aoff + m * 2048 + k * 1024); } while (0)
#define PG8_LDB16(dst, b, h) do { _Pragma("unroll") for (int n = 0; n < 2; ++n) _Pragma("unroll") for (int k = 0; k < 2; ++k) dst[n][k] = *(const PG8_LAS bf16x8*)(lds + PG8_SB(b, h) + boff + n * 2048 + k * 1024); } while (0)
#define PG8_MMA16(ai, bj, At, Bt) do { __builtin_amdgcn_s_setprio(1); _Pragma("unroll") for (int m = 0; m < 4; ++m) _Pragma("unroll") for (int n = 0; n < 2; ++n) _Pragma("unroll") for (int k = 0; k < 2; ++k) \
        acc[ai][bj][m][n] = __builtin_amdgcn_mfma_f32_16x16x32_bf16(Bt[n][k], At[m][k], acc[ai][bj][m][n], 0, 0, 0); __builtin_amdgcn_s_setprio(0); } while (0)
#define PG8_LD32(p, lo, hi) __builtin_bit_cast(i32x8_t, __builtin_shufflevector(*(const PG8_LAS bf16x8*)((p) + (lo)), *(const PG8_LAS bf16x8*)((p) + (hi)), 0, 1, 2, 3, 4, 5, 6, 7, 8, 9, 10, 11, 12, 13, 14, 15))
#define PG8_LDA(dst, b, h) do { if constexpr (F8) { _Pragma("unroll") for (int m = 0; m < 4; ++m) dst##8[m] = PG8_LD32(lds + PG8_SA(b, h) + m * 2048, aoff, aoffh); } else { PG8_LDA16(dst, b, h); } } while (0)
#define PG8_LDB(dst, b, h) do { if constexpr (F8) { _Pragma("unroll") for (int n = 0; n < 2; ++n) dst##8[n] = PG8_LD32(lds + PG8_SB(b, h) + n * 2048, boff, boffh); } else { PG8_LDB16(dst, b, h); } } while (0)
#define PG8_MMA(ai, bj, At, Bt) do { if constexpr (F8) { __builtin_amdgcn_s_setprio(1); _Pragma("unroll") for (int m = 0; m < 4; ++m) _Pragma("unroll") for (int n = 0; n < 2; ++n) \
        asm volatile("v_mfma_f32_16x16x128_f8f6f4 %0, %1, %2, %0" : "+v"(acc[ai][bj][m][n]) : "v"(Bt##8[n]), "v"(At##8[m])); __builtin_amdgcn_s_setprio(0); } else { PG8_MMA16(ai, bj, At, Bt); } } while (0)
#define PG8_WAIT_V(n) asm volatile("s_waitcnt vmcnt(" #n ")" ::: "memory")
#define PG8_WAIT_L(n) asm volatile("s_waitcnt lgkmcnt(" #n ")" ::: "memory")
#define PG8_BAR __builtin_amdgcn_s_barrier()
#define PG8_SCHED __builtin_amdgcn_sched_barrier(0)
    Unit cur, nxt; int ui = 0;
    if (!S.next(0, cur)) return;
    unsigned oC[2][2] = {{0u, 0u}, {0u, 0u}}, oN[2][2] = {{0u, 0u}, {0u, 0u}};
    if constexpr (GATHER) PG8_GOFF(oC, cur);
    f32x4 acc[2][2][4][2];
#pragma unroll
    for (int a = 0; a < 2; ++a)
#pragma unroll
        for (int b = 0; b < 2; ++b)
#pragma unroll
            for (int m = 0; m < 4; ++m)
#pragma unroll
                for (int n = 0; n < 2; ++n) acc[a][b][m][n] = (f32x4){0.f, 0.f, 0.f, 0.f};
    bf16x8 At[4][2], B0[2][2], B1[2][2]; i32x8_t At8[4], B08[2], B18[2];
    const char* cA = GATHER ? (const char*)g.A + cur.kb : (const char*)g.A + (size_t)cur.pm * tstep + cur.kb; const char* cB = (const char*)g.Bt + (size_t)cur.pn * tstep + cur.kb;
    S.a_ready(cur);
    if constexpr (SP2) {
        PG8_STAGE(PG8_SB(0, 0), cB, voffB); PG8_STAGE(PG8_SB(0, 1), cB + hstep, voffB); PG8_STAGE_A(PG8_SA(0, 0), cA, 0, false); PG8_STAGE_A(PG8_SA(0, 1), cA, 1, false);
        if (wr == 1) PG8_BAR;
        PG8_WAIT_V(2); PG8_BAR;
        PG8_STAGE(PG8_SB(1, 0), cB + kstep, voffB); PG8_STAGE_A(PG8_SA(1, 0), cA + kstep, 0, false); PG8_STAGE(PG8_SB(1, 1), cB + hstep + kstep, voffB);
        PG8_WAIT_V(6); PG8_BAR;
    } else {
        PG8_STAGE(PG8_SB(0, 0), cB, voffB); PG8_STAGE_A(PG8_SA(0, 0), cA, 0, false); PG8_STAGE(PG8_SB(0, 1), cB + hstep, voffB); PG8_STAGE_A(PG8_SA(0, 1), cA, 1, false);
        if (wr == 1) PG8_BAR;
        PG8_WAIT_V(4); PG8_BAR;
        PG8_STAGE(PG8_SB(1, 0), cB + kstep, voffB); PG8_STAGE_A(PG8_SA(1, 0), cA + kstep, 0, false); PG8_STAGE(PG8_SB(1, 1), cB + hstep + kstep, voffB);
        PG8_WAIT_V(6); PG8_BAR;
    }
    for (;;) {
        const bool has_next = S.next(ui + 1, nxt);
        const char* nA = has_next ? (GATHER ? (const char*)g.A + nxt.kb : (const char*)g.A + (size_t)nxt.pm * tstep + nxt.kb) : cA;
        if constexpr (GATHER) { if (has_next) PG8_GOFF(oN, nxt); } const char* nB = has_next ? (const char*)g.Bt + (size_t)nxt.pn * tstep + nxt.kb : cB;
        for (int t = 0; t < nt; t += 2) {
            const bool last = (t == nt - 2); const bool lastn = last && has_next;
            const char* a1 = cA + (size_t)(t + 1) * kstep;
            const char* a2 = last ? nA : cA + (size_t)(t + 2) * kstep; const char* b2 = last ? nB : cB + (size_t)(t + 2) * kstep;
            const char* a3 = a2 + kstep; const char* b3 = b2 + kstep;
            if (last && has_next) S.a_ready(nxt);
            if constexpr (SP2) {
            PG8_LDB(B0, 0, 0); PG8_LDB(B1, 0, 1); PG8_SCHED; PG8_LDA(At, 0, 0); PG8_STAGE_A(PG8_SA(1, 1), a1, 1, false);
            PG8_WAIT_V(8); PG8_WAIT_L(0); PG8_BAR; PG8_MMA(0, 0, At, B0); PG8_MMA(0, 1, At, B1); PG8_BAR; PG8_SCHED;
            PG8_LDA(At, 0, 1); PG8_STAGE(PG8_SB(0, 0), b2, voffB); PG8_STAGE(PG8_SB(0, 1), b2 + hstep, voffB); PG8_STAGE_A(PG8_SA(0, 0), a2, 0, lastn);
            PG8_WAIT_V(8); PG8_WAIT_L(0); PG8_BAR; PG8_MMA(1, 0, At, B0); PG8_MMA(1, 1, At, B1); PG8_BAR; PG8_SCHED;
            PG8_LDB(B0, 1, 0); PG8_LDB(B1, 1, 1); PG8_SCHED; PG8_LDA(At, 1, 0); PG8_STAGE_A(PG8_SA(0, 1), a2, 1, lastn);
            PG8_WAIT_V(8); PG8_WAIT_L(0); PG8_BAR; PG8_MMA(0, 0, At, B0); PG8_MMA(0, 1, At, B1); PG8_BAR; PG8_SCHED;
            PG8_LDA(At, 1, 1); PG8_STAGE(PG8_SB(1, 0), b3, voffB); PG8_STAGE(PG8_SB(1, 1), b3 + hstep, voffB); PG8_STAGE_A(PG8_SA(1, 0), a3, 0, lastn);
            PG8_WAIT_V(8); PG8_WAIT_L(0); PG8_BAR; PG8_MMA(1, 0, At, B0); PG8_MMA(1, 1, At, B1); PG8_BAR; PG8_SCHED;
            } else {
            PG8_LDB(B0, 0, 0); PG8_SCHED; PG8_LDA(At, 0, 0); PG8_STAGE_A(PG8_SA(1, 1), a1, 1, false);
            PG8_WAIT_L(8); PG8_BAR; PG8_WAIT_L(0); PG8_MMA(0, 0, At, B0); PG8_BAR; PG8_SCHED;
            PG8_LDB(B1, 0, 1); PG8_STAGE(PG8_SB(0, 0), b2, voffB);
            PG8_BAR; PG8_WAIT_L(0); PG8_MMA(0, 1, At, B1); PG8_BAR;
            PG8_LDA(At, 0, 1); PG8_STAGE_A(PG8_SA(0, 0), a2, 0, lastn);
            PG8_BAR; PG8_WAIT_L(0); PG8_MMA(1, 0, At, B0); PG8_BAR; PG8_SCHED;
            PG8_STAGE(PG8_SB(0, 1), b2 + hstep, voffB);
            PG8_WAIT_V(6); PG8_BAR; PG8_MMA(1, 1, At, B1); PG8_BAR;
            PG8_LDB(B0, 1, 0); PG8_SCHED; PG8_LDA(At, 1, 0); PG8_STAGE_A(PG8_SA(0, 1), a2, 1, lastn);
            PG8_WAIT_L(8); PG8_BAR; PG8_WAIT_L(0); PG8_MMA(0, 0, At, B0); PG8_BAR; PG8_SCHED;
            PG8_LDB(B1, 1, 1); PG8_STAGE(PG8_SB(1, 0), b3, voffB);
            PG8_BAR; PG8_WAIT_L(0); PG8_MMA(0, 1, At, B1); PG8_BAR;
            PG8_LDA(At, 1, 1); PG8_STAGE_A(PG8_SA(1, 0), a3, 0, lastn);
            PG8_BAR; PG8_WAIT_L(0); PG8_MMA(1, 0, At, B0); PG8_BAR; PG8_SCHED;
            PG8_STAGE(PG8_SB(1, 1), b3 + hstep, voffB);
            PG8_WAIT_V(6); PG8_BAR; PG8_MMA(1, 1, At, B1); PG8_BAR;
            }
        }
        if constexpr (ALIGN_EPI) { if (wr == 0) PG8_BAR; }
        if constexpr (F8) {
#pragma unroll
            for (int a = 0; a < 2; ++a)
#pragma unroll
                for (int b = 0; b < 2; ++b)
                    asm volatile("s_nop 15\n\ts_nop 7" : "+v"(acc[a][b][0][0]), "+v"(acc[a][b][0][1]), "+v"(acc[a][b][1][0]), "+v"(acc[a][b][1][1]), "+v"(acc[a][b][2][0]), "+v"(acc[a][b][2][1]), "+v"(acc[a][b][3][0]), "+v"(acc[a][b][3][1])); }
        if constexpr (!Epi::AFTER_DRAIN) { E(acc, cur, wr, wc, fr, fq); S.done(cur); }
        if (!has_next) break;
#pragma unroll
        for (int a = 0; a < 2; ++a)
#pragma unroll
            for (int b = 0; b < 2; ++b)
#pragma unroll
                for (int m = 0; m < 4; ++m)
#pragma unroll
                    for (int n = 0; n < 2; ++n) acc[a][b][m][n] = (f32x4){0.f, 0.f, 0.f, 0.f};
        cur = nxt; cA = nA; cB = nB; ++ui;
        if constexpr (GATHER) { oC[0][0] = oN[0][0]; oC[0][1] = oN[0][1]; oC[1][0] = oN[1][0]; oC[1][1] = oN[1][1]; }
        if constexpr (ALIGN_EPI) { if (wr == 1) PG8_BAR; }
    }
    PG8_WAIT_V(0);
    if constexpr (!ALIGN_EPI) { if (wr == 0) PG8_BAR; }
    PG8_BAR;
    if constexpr (Epi::AFTER_DRAIN) { E.fused(acc, cur, wr, wc, fr, fq, lds, wid, lane); S.done(cur); }
#undef PG8_SA
#undef PG8_SB
#undef PG8_STAGE
#undef PG8_STAGE_A
#undef PG8_GOFF
#undef PG8_LDA
#undef PG8_LDA16
#undef PG8_LD32
#undef PG8_LDB16
#undef PG8_MMA16
#undef PG8_LDB
#undef PG8_MMA
#undef PG8_WAIT_V
#undef PG8_WAIT_L
#undef PG8_BAR
#undef PG8_SCHED
}
}
using pg8::Unit; using pg8::Gemm;
struct ChunkMap { int x, loc, nx, chunk;
    __device__ void init(int G, int bid) { if (G % 8 == 0) { nx = 8; chunk = G / 8; x = bid % 8; loc = bid / 8; } else { nx = 1; chunk = G; x = 0; loc = bid; } }
    __device__ __forceinline__ int lin(int i) const { return (i * nx + x) * chunk + loc; } };
struct PlainOrder {
    int nN, total; ChunkMap cm;
    __device__ bool next(int i, Unit& u) const { const int L = cm.lin(i); if (L >= total) return false; u.pm = L / nN; u.pn = L % nN; u.kb = 0; return true; }
    __device__ __forceinline__ void a_ready(const Unit&) const {}
    __device__ __forceinline__ void done(const Unit&) const {}
};
struct QkvOrder { ChunkMap cm;
    __device__ bool next(int i, Unit& u) const { const int L = cm.lin(i); if (L >= 288) return false;
        if (L >= 32 && L < 128) { const int r = L - 32; u.pm = r >> 1; u.pn = 4 + (r & 1); } else { const int r = L < 32 ? L : L - 96; u.pm = r >> 2; u.pn = r & 3; }
        u.kb = 0; return true; }
    __device__ __forceinline__ void a_ready(const Unit&) const {}
    __device__ __forceinline__ void done(const Unit&) const {}
};
struct SplitKOrder {
    int nN, ks, kbytes, total; ChunkMap cm;
    __device__ bool next(int i, Unit& u) const { const int L = cm.lin(i); if (L >= total) return false; const int t = L / ks; u.pm = t / nN; u.pn = t % nN; u.kb = (L % ks) * kbytes; return true; }
    __device__ __forceinline__ void a_ready(const Unit&) const {}
    __device__ __forceinline__ void done(const Unit&) const {}
};
struct GroupedOrder {
    int mt, nt, ks, kbytes; ChunkMap cm;
    __device__ bool next(int i, Unit& u) const { const int L = cm.lin(i), per = mt * nt * ks; if (L >= NE * per) return false; const int e = L / per, r = L % per, m = r / (nt * ks), q = r % (nt * ks);
        u.pm = e * mt + m; u.pn = e * nt + q / ks; u.kb = (q % ks) * kbytes; return true; }
    __device__ __forceinline__ void a_ready(const Unit&) const {}
    __device__ __forceinline__ void done(const Unit&) const {}
};
constexpr int DOWN_FULL_PANELS = 64;
struct DownOrder { int half; ChunkMap cm;
    __device__ bool next(int i, Unit& u) const { const int L = cm.lin(i); if (L >= 256) return false; const int T = half ? 256 + (L >> 1) : L; u.pm = T >> 2; u.pn = (u.pm / 6) * 4 + (T & 3); u.kb = half ? (L & 1) * 1024 : 0; return true; }
    __device__ __forceinline__ void a_ready(const Unit&) const {}
    __device__ __forceinline__ void done(const Unit&) const {}
};
struct EpiF32 { float* C; int ldc; size_t kstride; static constexpr bool PERM = false, AFTER_DRAIN = false;
    __device__ __forceinline__ void operator()(const f32x4 (&acc)[2][2][4][2], const Unit& u, int wr, int wc, int fr, int fq) const {
#pragma unroll
        for (int ai = 0; ai < 2; ++ai)
#pragma unroll
            for (int m = 0; m < 4; ++m) { float* rp = C + (u.kb ? kstride : (size_t)0) + (size_t)(u.pm * 256 + ai * 128 + wr * 64 + m * 16 + fr) * ldc + u.pn * 256 + wc * 32 + 4 * fq;
#pragma unroll
                for (int bj = 0; bj < 2; ++bj)
#pragma unroll
                    for (int n = 0; n < 2; ++n) *(f32x4*)(rp + bj * 128 + n * 16) = acc[ai][bj][m][n]; }
    }
};
struct EpiBf16P { bf16* C; int ldc; static constexpr bool PERM = true, AFTER_DRAIN = false;
    __device__ __forceinline__ void operator()(const f32x4 (&acc)[2][2][4][2], const Unit& u, int wr, int wc, int fr, int fq) const {
#pragma unroll
        for (int ai = 0; ai < 2; ++ai)
#pragma unroll
            for (int m = 0; m < 4; ++m) { bf16* rp = C + (size_t)(u.pm * 256 + ai * 128 + wr * 64 + m * 16 + fr) * ldc + u.pn * 256 + wc * 32 + 8 * fq;
#pragma unroll
                for (int bj = 0; bj < 2; ++bj) { const f32x4 v0 = acc[ai][bj][m][0], v1 = acc[ai][bj][m][1]; u32x4 w; w.x = cvtpk(v0[0], v0[1]); w.y = cvtpk(v0[2], v0[3]); w.z = cvtpk(v1[0], v1[1]); w.w = cvtpk(v1[2], v1[3]);
                    *(u32x4*)(rp + bj * 128) = w; } }
    }
};
__device__ __forceinline__ float silu_f(float x) { return x * __builtin_amdgcn_rcpf(1.f + __builtin_amdgcn_exp2f(-x * LOG2E)); }
struct EpiSwiglu { unsigned char* HID; static constexpr bool PERM = true, AFTER_DRAIN = false;
    __device__ __forceinline__ void operator()(const f32x4 (&acc)[2][2][4][2], const Unit& u, int wr, int wc, int fr, int fq) const {
        const int cb = (u.pn & 15) * 128 + wc * 32 + 8 * fq; constexpr float IS = 1.f / W8_SCALE;
#pragma unroll
        for (int ai = 0; ai < 2; ++ai)
#pragma unroll
            for (int m = 0; m < 4; ++m) { unsigned char* rp = HID + (size_t)(u.pm * 256 + ai * 128 + wr * 64 + m * 16 + fr) * FF + cb; u32x2 w;
#pragma unroll
                for (int n = 0; n < 2; ++n) { const f32x4 g = acc[ai][0][m][n] * IS, up = acc[ai][1][m][n] * (IS * H8_SCALE);
                    const unsigned pk = pk4_fp8(silu_f(g[0]) * up[0], silu_f(g[1]) * up[1], silu_f(g[2]) * up[2], silu_f(g[3]) * up[3]); if (n == 0) w.x = pk; else w.y = pk; }
                *(u32x2*)rp = w; asm volatile("" ::: "memory"); }
    }
};
struct EpiDown { unsigned char* YE; const float* gate; static constexpr bool PERM = true, AFTER_DRAIN = false;
    __device__ __forceinline__ void operator()(const f32x4 (&acc)[2][2][4][2], const Unit& u, int wr, int wc, int fr, int fq) const {
        const int cb = (u.pn & 3) * 256 + wc * 32 + 8 * fq;
#pragma unroll
        for (int ai = 0; ai < 2; ++ai)
#pragma unroll
            for (int m = 0; m < 4; ++m) { const int row = u.pm * 256 + ai * 128 + wr * 64 + m * 16 + fr; const float gv = gate[row] * (YE8_SCALE / (W8_SCALE * H8_SCALE)); unsigned char* rp = YE + (size_t)(u.kb ? NSLOTS : 0) * D + (size_t)row * D + cb;
#pragma unroll
                for (int bj = 0; bj < 2; ++bj) { const f32x4 v0 = acc[ai][bj][m][0] * gv, v1 = acc[ai][bj][m][1] * gv; u32x2 w;
                    w.x = pk4_fp8(clamp8(v0[0]), clamp8(v0[1]), clamp8(v0[2]), clamp8(v0[3])); w.y = pk4_fp8(clamp8(v1[0]), clamp8(v1[1]), clamp8(v1[2]), clamp8(v1[3])); *(u32x2*)(rp + bj * 128) = w; } }
    }
};

#if MK_CHECK
__device__ __forceinline__ float fp8f(const unsigned char* p, int i) { const int w = ((const int*)p)[i >> 2]; const int b = i & 3; return b == 0 ? __builtin_amdgcn_cvt_f32_fp8(w, 0) : b == 1 ? __builtin_amdgcn_cvt_f32_fp8(w, 1) : b == 2 ? __builtin_amdgcn_cvt_f32_fp8(w, 2) : __builtin_amdgcn_cvt_f32_fp8(w, 3); }
__device__ __forceinline__ float dot_fp8(const unsigned char* a, const unsigned char* b, int K, int lane) { float s = 0.f; for (int k = lane; k < K; k += 64) s += fp8f(a, k) * fp8f(b, k); return wave_sum(s); }
__device__ __forceinline__ float dot_bf16(const bf16* a, const bf16* b, int K, int lane) {
    float s = 0.f; for (int k = lane; k < K; k += 64) s += bf2f(a[k]) * bf2f(b[k]); return wave_sum(s);
}
#endif

__constant__ double INVF[16] = {1.0, 0.5623413251903491, 0.31622776601683794, 0.1778279410038923, 0.1, 0.05623413251903491, 0.03162277660168379, 0.01778279410038923,
                                0.01, 0.005623413251903491, 0.0031622776601683794, 0.0017782794100389228, 0.001, 0.0005623413251903491, 0.00031622776601683794, 0.00017782794100389227};
__device__ __forceinline__ void sincos_d(double a, float& s, float& c) {
    const double k = __builtin_rint(a * 0.6366197723675814), r = a - k * 1.5707963267948966, r2 = r * r;
    const double sr = r * (1.0 + r2 * (-1.0 / 6 + r2 * (1.0 / 120 + r2 * (-1.0 / 5040 + r2 * (1.0 / 362880 + r2 * (-1.0 / 39916800 + r2 * (1.0 / 6227020800.0)))))));
    const double cr = 1.0 + r2 * (-0.5 + r2 * (1.0 / 24 + r2 * (-1.0 / 720 + r2 * (1.0 / 40320 + r2 * (-1.0 / 3628800 + r2 * (1.0 / 479001600.0))))));
    const int q = ((int)k) & 3;
    const double ss = (q == 0) ? sr : (q == 1) ? cr : (q == 2) ? -sr : -cr;
    const double cc = (q == 0) ? cr : (q == 1) ? -sr : (q == 2) ? -cr : sr;
    s = (float)ss; c = (float)cc;
}
__device__ __forceinline__ void conv_load(f32x4 (&v)[16], const float* W, int N, int k0, int n0, int lane) {
    const int r4 = lane >> 4, c16 = lane & 15, n = n0 + 4 * c16;
    if (n >= N) return;
    const float* src = W + (size_t)(k0 + 16 * r4) * N + n;
#pragma unroll
    for (int i = 0; i < 16; ++i) v[i] = *(const f32x4*)(src + (size_t)i * N);
}
__device__ __forceinline__ void conv_store(const f32x4 (&v)[16], int N, bf16* WT, size_t rowbase, int ldk, int k0, int n0, int lane) {
    const int r4 = lane >> 4, c16 = lane & 15, n = n0 + 4 * c16;
    if (n >= N) return;
    bf16* dst = WT + (rowbase + 4 * c16) * (size_t)ldk + k0 + 16 * r4;
#pragma unroll
    for (int e = 0; e < 4; ++e) {
        u32x4 lo, hi;
        lo.x = cvtpk(v[0][e], v[1][e]); lo.y = cvtpk(v[2][e], v[3][e]); lo.z = cvtpk(v[4][e], v[5][e]); lo.w = cvtpk(v[6][e], v[7][e]);
        hi.x = cvtpk(v[8][e], v[9][e]); hi.y = cvtpk(v[10][e], v[11][e]); hi.z = cvtpk(v[12][e], v[13][e]); hi.w = cvtpk(v[14][e], v[15][e]);
        *(u32x4*)(dst + (size_t)e * ldk) = lo; *(u32x4*)(dst + (size_t)e * ldk + 8) = hi;
    }
}
__device__ __forceinline__ void conv_item(const float* W, int N, bf16* WT, size_t rowbase, int ldk, int k0, int n0, int lane) {
    f32x4 v[16]; conv_load(v, W, N, k0, n0, lane); conv_store(v, N, WT, rowbase, ldk, k0, n0, lane);
}
__device__ __forceinline__ void glds16(const void* gsrc, unsigned lds_dst) { unsigned keep;
    asm volatile("s_mov_b32 %0, m0\n\ts_mov_b32 m0, %2\n\ts_nop 0\n\tglobal_load_lds_dwordx4 %1, off\n\ts_mov_b32 m0, %0" : "=&s"(keep) : "v"(gsrc), "s"(lds_dst) : "memory"); }
__device__ __forceinline__ void glds16_nt(const void* gsrc, unsigned lds_dst) { unsigned keep;
    asm volatile("s_mov_b32 %0, m0\n\ts_mov_b32 m0, %2\n\ts_nop 0\n\tglobal_load_lds_dwordx4 %1, off nt\n\ts_mov_b32 m0, %0" : "=&s"(keep) : "v"(gsrc), "s"(lds_dst) : "memory"); }
__device__ __forceinline__ void conv_issue8(unsigned lds_scr, const float* W, int N, int k0, int n0, int lane) {
    const float* src = W + (size_t)(k0 + 8 * (lane >> 4)) * N + n0 + 4 * (lane & 15);
#pragma unroll
    for (int i = 0; i < 8; ++i) glds16_nt(src + (size_t)i * N, (unsigned)__builtin_amdgcn_readfirstlane(lds_scr + i * 1024));
}
__device__ __forceinline__ void conv_fetch8(f32x4 (&v)[8], const LAS unsigned char* scr, int lane) {
#pragma unroll
    for (int i = 0; i < 8; ++i) v[i] = *(const LAS f32x4*)(scr + i * 1024 + lane * 16);
}
__device__ __forceinline__ void conv_load8(f32x4 (&v)[8], const float* W, int N, int k0, int n0, int lane) {
    const float* src = W + (size_t)(k0 + 8 * (lane >> 4)) * N + n0 + 4 * (lane & 15);
#pragma unroll
    for (int i = 0; i < 8; ++i) v[i] = __builtin_nontemporal_load((const f32x4*)(src + (size_t)i * N));
}
__device__ __forceinline__ void conv_store8(const f32x4 (&v)[8], unsigned char* WT, size_t rowbase, int ldk, int k0, int lane) {
    unsigned char* dst = WT + (rowbase + 4 * (lane & 15)) * (size_t)ldk + k0 + 8 * (lane >> 4);
#pragma unroll
    for (int e = 0; e < 4; ++e) { u32x2 w; w.x = pk4_fp8(v[0][e] * W8_SCALE, v[1][e] * W8_SCALE, v[2][e] * W8_SCALE, v[3][e] * W8_SCALE); w.y = pk4_fp8(v[4][e] * W8_SCALE, v[5][e] * W8_SCALE, v[6][e] * W8_SCALE, v[7][e] * W8_SCALE);
        *(u32x2*)(dst + (size_t)e * ldk) = w; }
}
struct ConvJob { const float* gate; const float* up; const float* down; unsigned char* wgu; unsigned char* wd; };
constexpr int CV_PER_LAYER = 3 * 16 * 1024, CV_TOTAL = 4 * CV_PER_LAYER;
struct ConvItem { const float* W; unsigned char* WT; size_t rowbase; int N, ldk, k0, n0; };
__device__ __forceinline__ ConvItem cv_decode(const ConvJob& J, int it) {
    ConvItem c; const int L = it / CV_PER_LAYER, r0 = it % CV_PER_LAYER, fam = r0 >> 14, r = r0 & 16383, e = L * 16 + (r >> 10), q = r & 1023;
    if (fam < 2) { c.W = (fam ? J.up : J.gate) + (size_t)e * 1024 * 2048; c.N = 2048; c.k0 = (q >> 5) * 32; c.n0 = (q & 31) * 64; c.WT = J.wgu; c.ldk = 1024; c.rowbase = (size_t)e * 4096 + (c.n0 >> 7) * 256 + (c.n0 & 127) + (fam ? 128 : 0); }
    else { c.W = J.down + (size_t)e * 2048 * 1024; c.N = 1024; c.k0 = (q >> 4) * 32; c.n0 = (q & 15) * 64; c.WT = J.wd; c.ldk = 2048; c.rowbase = (size_t)e * 1024 + c.n0; }
    return c;
}
template <class RowBase>
__device__ __forceinline__ void conv_family(const Frame& F, const float* W, int K, int N, int nmat, bf16* WT, const RowBase& rb, int& base) {
    const int nblk = (N + 63) / 64, per = (K / 64) * nblk, total = per * nmat;
    const int gwr = F.G > 192 ? (F.gw + F.NGW - 192 * 8) % F.NGW : F.gw;
    const int first = (gwr + F.NGW - base % F.NGW) % F.NGW; base += total;
    for (int it = first; it < total; it += F.NGW) {
        const int mi = it / per, r = it % per, kb = r / nblk, nb = r % nblk;
        conv_item(W + (size_t)mi * K * N, N, WT, rb(mi, nb * 64), K, kb * 64, nb * 64, F.lane);
    }
}

__device__ __forceinline__ void ada_direct(const Frame& F, const Args& a, int l, int b0) {
    const int cg = F.bid - b0; if (cg < 0 || cg >= 192) return;
    LAS float* sc = (LAS float*)F.lds;
    LAS float* red = (LAS float*)(F.lds + 20480);
    for (int i = F.tid; i < 5 * D; i += 512) { const int c = i >> 10, k = i & 1023; const float x = (c == 0) ? a.in[7][k] : a.in[6][(c - 1) * D + k]; sc[i] = x / (1.f + __expf(-x)); }
    __syncthreads();
    const int col = F.tid & 31, kg = F.tid >> 5, n = cg * 32 + col;
    const float* w = a.in[8] + ((size_t)l * D + kg * 64) * 6144 + n;
    float acc[5] = {0.f, 0.f, 0.f, 0.f, 0.f};
#pragma unroll 16
    for (int k = 0; k < 64; ++k) { const float wv = w[(size_t)k * 6144];
#pragma unroll
        for (int c = 0; c < 5; ++c) acc[c] += sc[c * D + kg * 64 + k] * wv; }
#pragma unroll
    for (int c = 0; c < 5; ++c) red[(kg * 5 + c) * 32 + col] = acc[c];
    __syncthreads();
    if (F.tid < 160) { const int c = F.tid >> 5; float s = a.in[9][l * 6144 + n];
#pragma unroll
        for (int g = 0; g < 16; ++g) s += red[(g * 5 + c) * 32 + col];
        ((float*)(F.ws + WS_ADA))[(size_t)(l * 5 + c) * 6144 + n] = s; }
    __syncthreads();
}
__device__ __forceinline__ void phase_prologue(const Frame& F, const Args& a) {
    ada_direct(F, a, 0, 0);
    {
        float* R64 = (float*)(F.ws + WS_ROPE64); float* R32 = (float*)(F.ws + WS_ROPE32);
        for (int i = F.bid * 512 + F.tid; i < 2048 * 32; i += F.G * 512) { const int pos = i >> 5, j = i & 31; const double ang = (j < 16) ? (double)(pos >> 6) * INVF[j] : (double)(pos & 63) * INVF[j - 16];
            float s, c; sincos_d(ang, s, c); R64[i] = c; R64[2048 * 32 + i] = s; }
        for (int i = F.bid * 512 + F.tid; i < 2048 * 16; i += F.G * 512) { const int pos = i >> 4, j = i & 15; const double ang = (j < 8) ? (double)(pos >> 6) * INVF[2 * j] : (double)(pos & 63) * INVF[2 * (j - 8)];
            float s, c; sincos_d(ang, s, c); R32[i] = c; R32[2048 * 16 + i] = s; }
    }
    __syncthreads();
    for (int rep = 0; rep < MK_REP_CONV; ++rep) {
    bf16* WQKV = (bf16*)(F.ws + WS_WQKV); bf16* WO = (bf16*)(F.ws + WS_WO);
    int cvb = 0;
    conv_family(F, a.in[12], 1024, 1536, 2, WQKV, [](int mi, int n0) { return (size_t)(mi == 0 ? 0 : 2) * 1536 + n0; }, cvb);
    conv_family(F, a.in[16], 1024, 1536, 1, WQKV, [](int mi, int n0) { return (size_t)1536 + n0; }, cvb);
    conv_family(F, a.in[15], 1024, 1024, 2, WO, [](int mi, int n0) { return (size_t)(mi == 0 ? 0 : 3) * 1024 + n0; }, cvb);
    conv_family(F, a.in[18], 1024, 1024, 1, WO, [](int mi, int n0) { return (size_t)1024 + n0; }, cvb);
    conv_family(F, a.in[24], 1024, 1024, 1, WO, [](int mi, int n0) { return (size_t)2048 + n0; }, cvb);
    conv_family(F, a.in[19], 1024, 416, 1, (bf16*)(F.ws + WS_WDN), [](int mi, int n0) { return (size_t)n0; }, cvb);
    conv_family(F, a.in[21], 256, 1536, 1, (bf16*)(F.ws + WS_WUQ), [](int mi, int n0) { return (size_t)n0; }, cvb);
    conv_family(F, a.in[23], 128, 2048, 1, (bf16*)(F.ws + WS_WUKV), [](int mi, int n0) { return (size_t)n0; }, cvb);
    }
    { u32x4* z = (u32x4*)((bf16*)(F.ws + WS_WDN) + 416 * 1024); for (int i = F.bid * 512 + F.tid; i < 96 * 1024 / 8; i += F.G * 512) z[i] = (u32x4){0u, 0u, 0u, 0u}; }
}
__device__ __forceinline__ void phase_ada_reduce(const Frame& F, const Args& a) {
    const float* ADAP = (const float*)(F.ws + WS_ADAP); float* ADA = (float*)(F.ws + WS_ADA);
    for (int i = F.bid * 512 + F.tid; i < 4 * 5 * 6144; i += F.G * 512) {
        const int l = i / 30720, r = i % 30720, c = r / 6144, n = r % 6144;
        float s = a.in[9][l * 6144 + n];
        for (int kc = 0; kc < 16; ++kc) s += ADAP[((size_t)(kc * 4 + l) * 5 + c) * 6144 + n];
        ADA[i] = s;
    }
}
__device__ __forceinline__ const float* ada_vec(const Frame& F, int l, int c, int k) { return (const float*)(F.ws + WS_ADA) + ((size_t)(l * 5 + c) * 6 + k) * D; }

__device__ __forceinline__ void phase_mod0(const Frame& F, const Args& a) {
    bf16* X = (bf16*)(F.ws + WS_X); bf16* H = (bf16*)(F.ws + WS_H);
    const int RPW = (NTOK + F.NGW - 1) / F.NGW, rbeg = F.gw * RPW, rend = (rbeg + RPW < NTOK) ? rbeg + RPW : NTOK; int ccur = -1;
    f32x4 shv[4], scv[4];
#pragma unroll
    for (int j = 0; j < 4; ++j) { shv[j] = (f32x4){0.f, 0.f, 0.f, 0.f}; scv[j] = shv[j]; }
    for (int row = rbeg; row < rend; ++row) {
        const int c = cond_of(row);
        if (c != ccur) { ccur = c; const f32x4* sh = (const f32x4*)ada_vec(F, 0, c, 0); const f32x4* sc = (const f32x4*)ada_vec(F, 0, c, 1);
#pragma unroll
            for (int j = 0; j < 4; ++j) { shv[j] = sh[F.lane + 64 * j]; scv[j] = sc[F.lane + 64 * j] + 1.f; } }
        const f32x4* xi = (const f32x4*)((row < NCTX) ? a.in[0] + (size_t)row * D : a.in[1] + (size_t)(row - NCTX) * D);
#pragma unroll
        for (int j = 0; j < 4; ++j) { const int q = F.lane + 64 * j; const f32x4 x = xi[q]; ((u32x2*)(X + (size_t)row * D))[q] = pk4(x); ((u32x2*)(H + (size_t)row * D))[q] = pk4(x * scv[j] + shv[j]); }
    }
}

__device__ __forceinline__ size_t kb_off(int HK, int DK, bool lat, int b, int hk) { return lat ? (size_t)16 * HK * 256 * DK + ((size_t)(b * HK + hk) * 2560) * DK : ((size_t)(b * HK + hk) * 256) * DK; }
__device__ __forceinline__ size_t vt_off(int HK, bool lat, int b, int hk) { return lat ? (size_t)16 * HK * 64 * 256 + ((size_t)(b * HK + hk) * 64) * 2560 : ((size_t)(b * HK + hk) * 64) * 256; }
__device__ __forceinline__ int swap23(int k) { return (k & ~12) | ((k & 4) << 1) | ((k & 8) >> 1); }
__device__ __forceinline__ void vt_store(bf16* dst, const float (&vr)[64]) {
#pragma unroll
    for (int q = 0; q < 8; ++q) { const int b = 16 * (q >> 1) + 4 * (q & 1); u32x4 w; w.x = cvtpk(vr[b], vr[b + 1]); w.y = cvtpk(vr[b + 2], vr[b + 3]); w.z = cvtpk(vr[b + 8], vr[b + 9]); w.w = cvtpk(vr[b + 10], vr[b + 11]); ((u32x4*)dst)[q] = w; }
}

__device__ __forceinline__ void phase_kv_post(const Frame& F, const Args& a, int kind, int j, int slot, int gw, int NGW) {
    const bf16* QKV = (const bf16*)(F.ws + WS_QKV); bf16* Kb = (bf16*)(F.ws + WS_KB); bf16* Vt = (bf16*)(F.ws + WS_VT);
    const float* R64 = (const float*)(F.ws + WS_ROPE64);
    int lane_ = F.lane; asm volatile("" : "+v"(lane_)); const int lane = lane_, l16 = lane & 15, hk = lane >> 4;
    for (int it = gw * 64 + lane; it < 16 * 8192; it += NGW * 64) {
        const int bh = it >> 13, q = it & 8191, b = bh >> 2, hc = bh & 3;
        const f32x4 v = *(const f32x4*)(a.in[2] + ((size_t)((b * 3 + slot) * 4 + hc) * 512) * 64 + 4 * q);
        u32x2 w; w.x = cvtpk(v[0], v[1]); w.y = cvtpk(v[2], v[3]);
        *(u32x2*)(Kb + kb_off(4, 64, true, b, hc) + (size_t)2048 * 64 + 4 * q) = w;
    }
    for (int it = gw; it < 4 * 4 * 8; it += NGW) {
        const int b = it >> 5, hv = (it >> 3) & 3, tl = it & 7;
        float vr[64];
#pragma unroll
        for (int i = 0; i < 64; ++i) vr[i] = a.in[3][((size_t)((b * 3 + slot) * 4 + hv) * 512 + tl * 64 + i) * 64 + lane];
        vt_store(Vt + vt_off(4, true, b, hv) + (size_t)lane * 2560 + 2048 + tl * 64, vr);
    }
    f32x4 kn = (f32x4){1.f, 1.f, 1.f, 1.f}; if (kind == 0) kn = *(const f32x4*)(a.in[14] + j * 64 + 4 * l16);
    {
        const int RPW = (NTOK + NGW - 1) / NGW, rbeg = gw * RPW, rend = (rbeg + RPW < NTOK) ? rbeg + RPW : NTOK;
        u32x2 wqn = (u32x2){0u, 0u}; f32x4 cn = (f32x4){0.f, 0.f, 0.f, 0.f}, snn = cn;
        if (rbeg < rend) { wqn = *(const u32x2*)(QKV + (size_t)rbeg * 1536 + 1024 + 4 * lane);
            if (rbeg >= NCTX) { const int s0 = (rbeg - NCTX) & 2047; cn = *(const f32x4*)(R64 + s0 * 32 + 4 * (lane & 7)); snn = *(const f32x4*)(R64 + 2048 * 32 + s0 * 32 + 4 * (lane & 7)); } }
        for (int t = rbeg; t < rend; ++t) {
            const bool lat = t >= NCTX; const int b = lat ? (t - NCTX) >> 11 : t >> 8, s = lat ? (t - NCTX) & 2047 : t & 255;
            const u32x2 wq = wqn; const f32x4 c = cn, sn = snn;
            if (t + 1 < rend) { wqn = *(const u32x2*)(QKV + (size_t)(t + 1) * 1536 + 1024 + 4 * lane);
                if (t + 1 >= NCTX) { const int s1 = (t + 1 - NCTX) & 2047; cn = *(const f32x4*)(R64 + s1 * 32 + 4 * (lane & 7)); snn = *(const f32x4*)(R64 + 2048 * 32 + s1 * 32 + 4 * (lane & 7)); } }
            f32x4 v = bf4(wq);
            if (kind == 0) { float ss = (v[0] * v[0] + v[1] * v[1]) + (v[2] * v[2] + v[3] * v[3]); ss = sum16(ss);
                v = v * (__builtin_amdgcn_rsqf(ss * (1.f / 64.f) + 1e-6f)) * kn; }
            if (lat) { f32x4 p; p[0] = dppf<DPP_X8>(v[0]); p[1] = dppf<DPP_X8>(v[1]); p[2] = dppf<DPP_X8>(v[2]); p[3] = dppf<DPP_X8>(v[3]);
                v = (lane & 8) ? v * c + p * sn : v * c - p * sn; }
            *(u32x2*)(Kb + kb_off(4, 64, lat, b, hk) + (size_t)s * 64 + 4 * l16) = pk4(v);
            if (!lat) *(f32x4*)(F.out + OFF_NK + ((size_t)((b * 3 + slot) * 4 + hk) * 256 + s) * 64 + 4 * l16) = v;
        }
    }
    for (int it = gw; it < (NTOK / 64) * 4; it += NGW) {
        const int tt = it >> 2, hv = it & 3, t0 = tt * 64; const bool lat = t0 >= NCTX; const int b = lat ? (t0 - NCTX) >> 11 : t0 >> 8, s0 = lat ? (t0 - NCTX) & 2047 : t0 & 255;
        float vr[64];
#pragma unroll
        for (int i = 0; i < 64; ++i) vr[i] = bf2f(QKV[(size_t)(t0 + i) * 1536 + 1280 + hv * 64 + lane]);
        vt_store(Vt + vt_off(4, lat, b, hv) + (size_t)lane * (lat ? 2560 : 256) + s0, vr);
        if (!lat) {
#pragma unroll
            for (int i = 0; i < 64; ++i) F.out[OFF_NV + ((size_t)((b * 3 + slot) * 4 + hv) * 256 + s0 + i) * 64 + lane] = vr[i]; }
    }
}

__device__ __forceinline__ void phase_mla_post1(const Frame& F, const Args& a) {
    const float* DWN = (const float*)(F.ws + WS_QKV); bf16* QA = (bf16*)(F.ws + WS_QA); bf16* CKVA = (bf16*)(F.ws + WS_CKVA); bf16* Kb = (bf16*)(F.ws + WS_KB);
    const float* R32 = (const float*)(F.ws + WS_ROPE32);
    int lane_ = F.lane; asm volatile("" : "+v"(lane_)); const int lane = lane_;
    const f32x4 qn = ((const f32x4*)a.in[20])[lane]; const f32x4 kvn = ((const f32x4*)a.in[22])[lane & 31];
    for (int t = F.gw; t < NTOK + 2048; t += F.NGW) {
        if (t < NTOK) {
            const bool lat = t >= NCTX; const int b = lat ? (t - NCTX) >> 11 : t >> 8, s = lat ? (t - NCTX) & 2047 : t & 255;
            const float* row = DWN + (size_t)t * 512;
            { const f32x4 v = ((const f32x4*)row)[lane] + ((const f32x4*)(row + DWN_PART))[lane]; const float ss = wave_sum(v[0] * v[0] + v[1] * v[1] + v[2] * v[2] + v[3] * v[3]); const float r = __builtin_amdgcn_rsqf(ss * (1.f / 256.f) + 1e-6f);
              const f32x4 o = v * r * qn; u32x2 w; w.x = cvtpk(o[0], o[1]); w.y = cvtpk(o[2], o[3]); ((u32x2*)(QA + (size_t)t * 256))[lane] = w; }
            { f32x4 v = (f32x4){0.f, 0.f, 0.f, 0.f}; if (lane < 32) v = ((const f32x4*)(row + 256))[lane] + ((const f32x4*)(row + DWN_PART + 256))[lane];
              const float ss = wave_sum(v[0] * v[0] + v[1] * v[1] + v[2] * v[2] + v[3] * v[3]); const float r = __builtin_amdgcn_rsqf(ss * (1.f / 128.f) + 1e-6f);
              const f32x4 o = v * r * kvn;
              if (lane < 32) { u32x2 w; w.x = cvtpk(o[0], o[1]); w.y = cvtpk(o[2], o[3]); ((u32x2*)(CKVA + (size_t)t * 128))[lane] = w; if (!lat) ((f32x4*)(F.out + OFF_CKV + (size_t)t * 128))[lane] = o; } }
            { float x = (lane < 32) ? row[384 + lane] + row[DWN_PART + 384 + lane] : 0.f;
              if (!lat && lane < 32) F.out[OFF_KPE + (size_t)t * 32 + lane] = x;
              if (lat) { const float p = __shfl_xor(x, 16); const int i = lane & 15; const float c = R32[s * 16 + i], sn = R32[2048 * 16 + s * 16 + i]; x = ((lane & 31) < 16) ? x * c - p * sn : x * c + p * sn; }
              const bf16 xb = f2bf(x);
              if (lane < 32) { for (int h = 0; h < 16; ++h) Kb[kb_off(16, 96, lat, b, h) + (size_t)s * 96 + 64 + lane] = xb; } }
        } else {
            const int r = t - NTOK, b = r >> 9, s = r & 511;
            if (lane < 32) { const f32x4 v = ((const f32x4*)(a.in[4] + (size_t)r * 128))[lane]; u32x2 w; w.x = cvtpk(v[0], v[1]); w.y = cvtpk(v[2], v[3]); ((u32x2*)(CKVA + (size_t)t * 128))[lane] = w;
                const bf16 xb = f2bf(a.in[5][(size_t)r * 32 + lane]);
                for (int h = 0; h < 16; ++h) Kb[kb_off(16, 96, true, b, h) + (size_t)(2048 + s) * 96 + 64 + lane] = xb; }
        }
    }
}
__device__ __forceinline__ void mla_row(int row, bool& lat, int& b, int& s) {
    if (row < NCTX) { lat = false; b = row >> 8; s = row & 255; } else if (row < NTOK) { lat = true; b = (row - NCTX) >> 11; s = (row - NCTX) & 2047; } else { lat = true; b = (row - NTOK) >> 9; s = 2048 + ((row - NTOK) & 511); }
}
struct EpiUkv { bf16* Kb; bf16* VRAW; static constexpr bool PERM = false, AFTER_DRAIN = false;
    __device__ __forceinline__ void operator()(const f32x4 (&acc)[2][2][4][2], const Unit& u, int wr, int wc, int fr, int fq) const {
#pragma unroll
        for (int ai = 0; ai < 2; ++ai)
#pragma unroll
            for (int m = 0; m < 4; ++m) { const int row = u.pm * 256 + ai * 128 + wr * 64 + m * 16 + fr; bool lat; int b, s; mla_row(row, lat, b, s);
#pragma unroll
                for (int bj = 0; bj < 2; ++bj) { const int h = 2 * u.pn + bj;
                    if (wc < 2) { bf16* kp = Kb + kb_off(16, 96, lat, b, h) + (size_t)s * 96 + wc * 32 + 4 * fq;
#pragma unroll
                        for (int n = 0; n < 2; ++n) { const f32x4 v = acc[ai][bj][m][n]; u32x2 w; w.x = cvtpk(v[0], v[1]); w.y = cvtpk(v[2], v[3]); *(u32x2*)(kp + n * 16) = w; } }
                    else { bf16* vp = VRAW + (size_t)row * 1024 + h * 64 + (wc - 2) * 32 + 4 * fq;
#pragma unroll
                        for (int n = 0; n < 2; ++n) { const f32x4 v = acc[ai][bj][m][n]; u32x2 w; w.x = cvtpk(v[0], v[1]); w.y = cvtpk(v[2], v[3]); *(u32x2*)(vp + n * 16) = w; } } } }
    }
};
__device__ __forceinline__ void phase_mla_post2(const Frame& F, const Args& a) {
    const bf16* VRAW = (const bf16*)(F.ws + WS_KVRAW); bf16* Vt = (bf16*)(F.ws + WS_VT);
    int lane_ = F.lane; asm volatile("" : "+v"(lane_)); const int lane = lane_;
    for (int it = F.gw; it < 224 * 16; it += F.NGW) {
        const int tile = it >> 4, h = it & 15, row0 = tile * 64; bool lat; int b, s0; mla_row(row0, lat, b, s0);
        float vr[64];
#pragma unroll
        for (int i = 0; i < 64; ++i) vr[i] = bf2f(VRAW[(size_t)(row0 + i) * 1024 + h * 64 + lane]);
        vt_store(Vt + vt_off(16, lat, b, h) + (size_t)lane * (lat ? 2560 : 256) + s0, vr);
    }
}

__device__ __forceinline__ int crow(int r, int hi) { return (r & 3) + 8 * (r >> 2) + 4 * hi; }
__device__ __forceinline__ float max3f(float a, float b, float c) { float r; asm("v_max3_f32 %0, %1, %2, %3" : "=v"(r) : "v"(a), "v"(b), "v"(c)); return r; }
constexpr float THRL = 5.f;
template <int DK, int KIND>
__device__ __forceinline__ void attn_phase(const Frame& F, const Args& a, int j, const ConvJob& J, int& cv_it, int cv_need, int cv_cap) {
    constexpr int HK = (DK == 96) ? 16 : 4, CH = (DK == 96) ? 64 : 128, KPB = (DK + 8) * 2, VPB = (CH + 8) * 2, NDS = DK / 16, KCH = DK / 8;
    constexpr int NKC = CH * KCH, NKI = (NKC + 511) / 512, NVI = 64 * (CH / 8) / 512, NSUB = CH / 64;
    constexpr float QS = (DK == 96) ? MLA_QS : GQA_QS;
    const bf16* QRAW = (const bf16*)(F.ws + WS_QKV); const bf16* Kb = (const bf16*)(F.ws + WS_KB); const bf16* Vt = (const bf16*)(F.ws + WS_VT); bf16* O = (bf16*)(F.ws + WS_O);
    LAS unsigned char* Ks = F.lds; LAS unsigned char* Vs = F.lds + 2 * CH * KPB;
    LAS unsigned char* cvs = F.lds + 2 * CH * KPB + 2 * 64 * VPB + F.wave * 8192;
    const unsigned cvs_addr = (unsigned)(uintptr_t)cvs;
    int tid_ = F.tid; asm volatile("" : "+v"(tid_));
    const int tid = tid_, lane = tid & 63, wid = F.wave, r32 = lane & 31, hi = lane >> 5;
    constexpr bool CVP = true;
    int itc = 0;
    for (int un = F.bid; un < 768; un += F.G) {
        bool lat; int b, hq, q0, S, tok0;
        if (un < 512) { lat = true; b = un >> 7; hq = (un >> 3) & 15; q0 = (un & 7) * 256; S = 2560; tok0 = NCTX + b * 2048 + q0; }
        else { const int v = un - 512; lat = false; b = v >> 4; hq = v & 15; q0 = 0; S = 256; tok0 = b * 256; }
        const int hk = (HK == 4) ? (hq >> 2) : hq;
        const bf16* Kg = Kb + kb_off(HK, DK, lat, b, hk); const bf16* Vg = Vt + vt_off(HK, lat, b, hk);
        const int n2 = lat ? 512 / CH : 0; int lo = 0, hiK = lat ? 2048 : 256;
        const bool masked = (KIND == 1) && lat;
        if (masked) { lo = q0 - 128; lo = lo < 0 ? 0 : (lo > 1536 ? 1536 : lo); hiK = lo + 512; }
        const int nch = n2 + (hiK - lo) / CH;
        bf16x8 qf[NDS];
        {
            const bf16* qrow = QRAW + (size_t)(tok0 + wid * 32 + r32) * 1536 + hq * DK + 8 * hi;
            f32x4 v[NDS][2];
#pragma unroll
            for (int ds = 0; ds < NDS; ++ds) { const u32x4 wq = *(const u32x4*)(qrow + 16 * ds);
                v[ds][0] = (f32x4){__uint_as_float(wq.x << 16), __uint_as_float(wq.x & 0xffff0000u), __uint_as_float(wq.y << 16), __uint_as_float(wq.y & 0xffff0000u)};
                v[ds][1] = (f32x4){__uint_as_float(wq.z << 16), __uint_as_float(wq.z & 0xffff0000u), __uint_as_float(wq.w << 16), __uint_as_float(wq.w & 0xffff0000u)}; }
            if (KIND == 0) {
                float ss = 0.f;
#pragma unroll
                for (int ds = 0; ds < NDS; ++ds)
#pragma unroll
                    for (int h2 = 0; h2 < 2; ++h2) ss += (v[ds][h2][0] * v[ds][h2][0] + v[ds][h2][1] * v[ds][h2][1]) + (v[ds][h2][2] * v[ds][h2][2] + v[ds][h2][3] * v[ds][h2][3]);
                ss += __shfl_xor(ss, 32);
                const float r = __builtin_amdgcn_rsqf(ss * (1.f / 64.f) + 1e-6f);
                const float* qn = a.in[13] + j * 64 + 8 * hi;
#pragma unroll
                for (int ds = 0; ds < NDS; ++ds) { v[ds][0] = v[ds][0] * r * *(const f32x4*)(qn + 16 * ds); v[ds][1] = v[ds][1] * r * *(const f32x4*)(qn + 16 * ds + 4); }
            }
            if (lat) {
                const int s = q0 + wid * 32 + r32;
                if (DK == 64) {
                    const float* R64 = (const float*)(F.ws + WS_ROPE64);
#pragma unroll
                    for (int ds = 0; ds < 2; ++ds)
#pragma unroll
                        for (int h2 = 0; h2 < 2; ++h2) { const int idx = s * 32 + 16 * ds + 8 * hi + 4 * h2; const f32x4 c = *(const f32x4*)(R64 + idx), sn = *(const f32x4*)(R64 + 2048 * 32 + idx);
                            const f32x4 xa = v[ds][h2], xb = v[ds + 2][h2]; v[ds][h2] = xa * c - xb * sn; v[ds + 2][h2] = xb * c + xa * sn; }
                } else {
                    const float* R32 = (const float*)(F.ws + WS_ROPE32);
#pragma unroll
                    for (int h2 = 0; h2 < 2; ++h2) { const int idx = s * 16 + 8 * hi + 4 * h2; const f32x4 c = *(const f32x4*)(R32 + idx), sn = *(const f32x4*)(R32 + 2048 * 16 + idx);
                        const f32x4 xa = v[NDS - 2][h2], xb = v[NDS - 1][h2]; v[NDS - 2][h2] = xa * c - xb * sn; v[NDS - 1][h2] = xb * c + xa * sn; }
                }
            }
#pragma unroll
            for (int ds = 0; ds < NDS; ++ds) { u32x4 w; w.x = cvtpk(v[ds][0][0] * QS, v[ds][0][1] * QS); w.y = cvtpk(v[ds][0][2] * QS, v[ds][0][3] * QS); w.z = cvtpk(v[ds][1][0] * QS, v[ds][1][1] * QS); w.w = cvtpk(v[ds][1][2] * QS, v[ds][1][3] * QS);
                qf[ds] = __builtin_bit_cast(bf16x8, w); }
        }
        const int qw0 = q0 + wid * 32, qpos = qw0 + r32;
        float mhat = 0.f, l_run = 0.f; bool first = true; f32x16 o0, o1, negm;
#pragma unroll
        for (int r = 0; r < 16; ++r) { o0[r] = 0.f; o1[r] = 0.f; negm[r] = 0.f; }
        u32x4 kreg[NKI], vreg[NVI];
#define ATT_KEY0(c) ((c) < n2 ? 2048 + CH * (c) : lo + CH * ((c) - n2))
#define ATT_LOAD(c) do { const int k0_ = ATT_KEY0(c); \
            _Pragma("unroll") for (int i_ = 0; i_ < NKI; ++i_) { const int cc_ = tid + 512 * i_; if (NKC % 512 == 0 || cc_ < NKC) kreg[i_] = *(const u32x4*)(Kg + (size_t)(k0_ + cc_ / KCH) * DK + (cc_ % KCH) * 8); } \
            _Pragma("unroll") for (int i_ = 0; i_ < NVI; ++i_) { const int cc_ = tid + 512 * i_; vreg[i_] = *(const u32x4*)(Vg + (size_t)(cc_ / (CH / 8)) * S + k0_ + (cc_ % (CH / 8)) * 8); } } while (0)
#define ATT_STORE(buf) do { \
            _Pragma("unroll") for (int i_ = 0; i_ < NKI; ++i_) { const int cc_ = tid + 512 * i_; if (NKC % 512 == 0 || cc_ < NKC) *(LAS u32x4*)(Ks + (buf) * CH * KPB + (cc_ / KCH) * KPB + (cc_ % KCH) * 16) = kreg[i_]; } \
            _Pragma("unroll") for (int i_ = 0; i_ < NVI; ++i_) { const int cc_ = tid + 512 * i_; *(LAS u32x4*)(Vs + (buf) * 64 * VPB + (cc_ / (CH / 8)) * VPB + (cc_ % (CH / 8)) * 16) = vreg[i_]; } } while (0)
        ATT_LOAD(0);
        __syncthreads();
        ATT_STORE(0);
        __syncthreads();
        for (int c = 0; c < nch; ++c) {
            const int cur = c & 1;
            if (c + 1 < nch) ATT_LOAD(c + 1);
            const bool cv = CVP && ((CH == 128) || ((itc++ & 1) == 0)) && cv_it < cv_cap;
            if (cv) { const ConvItem ci = cv_decode(J, cv_it); conv_issue8(cvs_addr, ci.W, ci.N, ci.k0, ci.n0, lane); }
            const int key0c = ATT_KEY0(c);
            for (int sub = 0; sub < NSUB; ++sub) {
                const int key0 = key0c + 64 * sub;
                if (masked && c >= n2 && (key0 > qw0 + 159 || key0 + 63 < qw0 - 128)) continue;
                f32x16 p0, p1;
                const LAS unsigned char* kb_ = Ks + cur * CH * KPB + (sub * 64 + r32) * KPB + hi * 16;
                const LAS unsigned char* vb_ = Vs + cur * 64 * VPB + r32 * VPB + sub * 128 + hi * 16;
                bf16x8 kf[2 * NDS], vf[8];
#pragma unroll
                for (int ds = 0; ds < NDS; ++ds) { kf[2 * ds] = *(const LAS bf16x8*)(kb_ + ds * 32); kf[2 * ds + 1] = *(const LAS bf16x8*)(kb_ + 32 * KPB + ds * 32); }
#pragma unroll
                for (int s = 0; s < 4; ++s) { vf[2 * s] = *(const LAS bf16x8*)(vb_ + s * 32); vf[2 * s + 1] = *(const LAS bf16x8*)(vb_ + 32 * VPB + s * 32); }
                __builtin_amdgcn_sched_barrier(0);
#pragma unroll
                for (int ds = 0; ds < NDS; ++ds) {
                    if (ds == 0) { p0 = __builtin_amdgcn_mfma_f32_32x32x16_bf16(kf[0], qf[0], negm, 0, 0, 0); p1 = __builtin_amdgcn_mfma_f32_32x32x16_bf16(kf[1], qf[0], negm, 0, 0, 0); }
                    else { p0 = __builtin_amdgcn_mfma_f32_32x32x16_bf16(kf[2 * ds], qf[ds], p0, 0, 0, 0); p1 = __builtin_amdgcn_mfma_f32_32x32x16_bf16(kf[2 * ds + 1], qf[ds], p1, 0, 0, 0); }
                }
                if (masked && c >= n2) {
                    const int kbase = key0 - qpos;
#pragma unroll
                    for (int r = 0; r < 16; ++r) { const int d0 = kbase + crow(r, hi), d1 = d0 + 32;
                        if (d0 > 128 || d0 < -128) p0[r] = -INFINITY;
                        if (d1 > 128 || d1 < -128) p1[r] = -INFINITY; }
                }
                float rm;
                { float ma = max3f(p0[0], p0[1], p1[0]), mb = max3f(p0[2], p0[3], p1[1]); ma = max3f(ma, p1[2], p1[3]);
#pragma unroll
                  for (int r = 4; r < 16; r += 4) { ma = max3f(ma, p0[r], p0[r + 1]); mb = max3f(mb, p0[r + 2], p0[r + 3]); ma = max3f(ma, p1[r], p1[r + 1]); mb = max3f(mb, p1[r + 2], p1[r + 3]); }
                  const float m2 = max3f(ma, mb, mb);
                  auto rr = __builtin_amdgcn_permlane32_swap(__float_as_uint(m2), __float_as_uint(m2), false, false);
                  rm = max3f(__uint_as_float(rr[0]), __uint_as_float(rr[1]), m2); }
                if (first || __any(rm > THRL)) {
                    const float dl = first ? rm : fmaxf(rm, 0.f);
                    mhat += dl;
#pragma unroll
                    for (int r = 0; r < 16; ++r) { p0[r] -= dl; p1[r] -= dl; }
                    if (!first) { const float sc = __builtin_amdgcn_exp2f(-dl); l_run *= sc;
#pragma unroll
                        for (int r = 0; r < 16; ++r) { o0[r] *= sc; o1[r] *= sc; } }
#pragma unroll
                    for (int r = 0; r < 16; ++r) negm[r] = -mhat;
                    first = false;
                }
                float ls0 = 0.f, ls1 = 0.f;
#pragma unroll
                for (int r = 0; r < 16; ++r) { p0[r] = __builtin_amdgcn_exp2f(p0[r]); p1[r] = __builtin_amdgcn_exp2f(p1[r]); ls0 += p0[r]; ls1 += p1[r]; }
                l_run += ls0 + ls1;
                bf16x8 pb[4];
#pragma unroll
                for (int s = 0; s < 4; ++s) { u32x4 w;
                    if (s < 2) { w.x = cvtpk(p0[8 * s], p0[8 * s + 1]); w.y = cvtpk(p0[8 * s + 2], p0[8 * s + 3]); w.z = cvtpk(p0[8 * s + 4], p0[8 * s + 5]); w.w = cvtpk(p0[8 * s + 6], p0[8 * s + 7]); }
                    else { const int q = s - 2; w.x = cvtpk(p1[8 * q], p1[8 * q + 1]); w.y = cvtpk(p1[8 * q + 2], p1[8 * q + 3]); w.z = cvtpk(p1[8 * q + 4], p1[8 * q + 5]); w.w = cvtpk(p1[8 * q + 6], p1[8 * q + 7]); }
                    pb[s] = __builtin_bit_cast(bf16x8, w); }
#pragma unroll
                for (int s = 0; s < 4; ++s) {
                    o0 = __builtin_amdgcn_mfma_f32_32x32x16_bf16(vf[2 * s], pb[s], o0, 0, 0, 0);
                    o1 = __builtin_amdgcn_mfma_f32_32x32x16_bf16(vf[2 * s + 1], pb[s], o1, 0, 0, 0);
                }
            }
            if (c + 1 < nch) ATT_STORE(cur ^ 1);
            if (cv) { asm volatile("s_waitcnt vmcnt(0)" ::: "memory"); f32x4 cvv[8]; conv_fetch8(cvv, cvs, lane); const ConvItem ci = cv_decode(J, cv_it); conv_store8(cvv, ci.WT, ci.rowbase, ci.ldk, ci.k0, lane); cv_it += F.NGW; }
            __syncthreads();
        }
#undef ATT_KEY0
#undef ATT_LOAD
#undef ATT_STORE
        float l = l_run + __shfl_xor(l_run, 32);
        if (KIND == 1) l += __builtin_amdgcn_exp2f(a.in[17][hq] * LOG2E - mhat);
        const float inv = 1.f / l;
        bf16* op = O + (size_t)(tok0 + wid * 32 + r32) * 1024 + hq * 64 + 4 * hi;
#pragma unroll
        for (int g = 0; g < 4; ++g) {
            u32x2 w0, w1; w0.x = cvtpk(o0[4 * g] * inv, o0[4 * g + 1] * inv); w0.y = cvtpk(o0[4 * g + 2] * inv, o0[4 * g + 3] * inv);
            w1.x = cvtpk(o1[4 * g] * inv, o1[4 * g + 1] * inv); w1.y = cvtpk(o1[4 * g + 2] * inv, o1[4 * g + 3] * inv);
            *(u32x2*)(op + 8 * g) = w0; *(u32x2*)(op + 32 + 8 * g) = w1;
        }
    }
    for (; cv_it < cv_need; cv_it += 2 * F.NGW) {
        f32x4 v0[8], v1[8]; const ConvItem c0 = cv_decode(J, cv_it); conv_load8(v0, c0.W, c0.N, c0.k0, c0.n0, lane);
        const bool two = cv_it + F.NGW < CV_TOTAL; ConvItem c1 = c0; if (two) { c1 = cv_decode(J, cv_it + F.NGW); conv_load8(v1, c1.W, c1.N, c1.k0, c1.n0, lane); }
        conv_store8(v0, c0.WT, c0.rowbase, c0.ldk, c0.k0, lane); if (two) conv_store8(v1, c1.WT, c1.rowbase, c1.ldk, c1.k0, lane); }
}
#if MK_CHECK
template <int DK, int KIND>
__device__ __forceinline__ void check_attn(const Frame& F, const Args& a, int j, int id) {
    constexpr int HK = (DK == 96) ? 16 : 4; constexpr float QS = (DK == 96) ? MLA_QS : GQA_QS;
    const bf16* QRAW = (const bf16*)(F.ws + WS_QKV); const bf16* Kb = (const bf16*)(F.ws + WS_KB); const bf16* Vt = (const bf16*)(F.ws + WS_VT); const bf16* O = (const bf16*)(F.ws + WS_O);
    LAS float* scs = (LAS float*)(F.lds + F.wave * 12288); LAS float* qs = scs + 2560;
    const int lane = F.lane;
    const unsigned hsh = hash_u(F.gw * 2654435761u + id);
    const int t = (F.gw & 1) ? (hsh % NCTX) : NCTX + (hsh % NLAT), hq = (hsh >> 16) & 15;
    const bool lat = t >= NCTX; const int b = lat ? (t - NCTX) >> 11 : t >> 8, s = lat ? (t - NCTX) & 2047 : t & 255, S = lat ? 2560 : 256;
    const int hk = (HK == 4) ? (hq >> 2) : hq;
    const bf16* Kg = Kb + kb_off(HK, DK, lat, b, hk); const bf16* Vg = Vt + vt_off(HK, lat, b, hk); const bf16* q = QRAW + (size_t)t * 1536 + hq * DK;
    {
        float x = bf2f(q[lane]);
        if (KIND == 0) { const float ss = wave_sum(x * x); x = x * __builtin_amdgcn_rsqf(ss * (1.f / 64.f) + 1e-6f) * a.in[13][j * 64 + lane]; }
        if (DK == 64 && lat) { const float* R64 = (const float*)(F.ws + WS_ROPE64); const float p = __shfl_xor(x, 32); const int i = lane & 31; const float c = R64[s * 32 + i], sn = R64[2048 * 32 + s * 32 + i]; x = (lane < 32) ? x * c - p * sn : x * c + p * sn; }
        qs[lane] = bf2f(f2bf(x * QS));
        if (DK == 96) { float y = (lane < 32) ? bf2f(q[64 + lane]) : 0.f;
            if (lat) { const float* R32 = (const float*)(F.ws + WS_ROPE32); const float p = __shfl_xor(y, 16); const int i = lane & 15; const float c = R32[s * 16 + i], sn = R32[2048 * 16 + s * 16 + i]; y = ((lane & 31) < 16) ? y * c - p * sn : y * c + p * sn; }
            if (lane < 32) qs[64 + lane] = bf2f(f2bf(y * QS)); }
        asm volatile("s_waitcnt lgkmcnt(0)" ::: "memory");
    }
    float mx = -1e30f;
    for (int jk = lane; jk < S; jk += 64) {
        float sc = 0.f; for (int d = 0; d < DK; ++d) sc += qs[d] * bf2f(Kg[(size_t)jk * DK + d]);
        if (KIND == 1 && lat && jk < 2048 && (jk - s > 128 || jk - s < -128)) sc = -INFINITY;
        scs[jk] = sc; mx = fmaxf(mx, sc);
    }
    mx = wave_max(mx);
    asm volatile("s_waitcnt lgkmcnt(0)" ::: "memory");
    float l = 0.f, o = 0.f;
    for (int jk = 0; jk < S; ++jk) { const float p = __builtin_amdgcn_exp2f(scs[jk] - mx); l += p; o += bf2f(f2bf(p)) * bf2f(Vg[(size_t)lane * S + swap23(jk)]); }
    if (KIND == 1) l += __builtin_amdgcn_exp2f(a.in[17][hq] * LOG2E - mx);
    o /= l;
    const float got = bf2f(O[(size_t)t * 1024 + hq * 64 + lane]);
    if (!close_enough(got, o, 0.03f, 0.01f)) CHK_FAIL(F, id);
    asm volatile("s_waitcnt lgkmcnt(0)" ::: "memory");
}
template <class Fn>
__device__ __forceinline__ void check_gemm_f32(const Frame& F, const bf16* A, const bf16* Bt, int M, int N, int K, const float* C, int ldc, int id) {
    for (int sidx = 0; sidx < 2; ++sidx) {
        const unsigned h = hash_u((F.gw * 2 + sidx) * 2654435761u + id * 97u);
        const int row = h % M, col = (h >> 12) % N;
        const float ref = dot_bf16(A + (size_t)row * K, Bt + (size_t)col * K, K, F.lane);
        if (!close_enough(C[(size_t)row * ldc + col], ref, 0.01f, 0.01f)) CHK_FAIL(F, id);
    }
}
template <class Fn>
__device__ __forceinline__ void check_gemm_bf16(const Frame& F, const bf16* A, const bf16* Bt, int M, int N, int K, const bf16* C, int ldc, int id) {
    for (int sidx = 0; sidx < 2; ++sidx) {
        const unsigned h = hash_u((F.gw * 2 + sidx) * 2654435761u + id * 97u);
        const int row = h % M, col = (h >> 12) % N;
        const float ref = dot_bf16(A + (size_t)row * K, Bt + (size_t)col * K, K, F.lane);
        if (!close_enough(bf2f(C[(size_t)row * ldc + col]), ref, 0.02f, 0.02f)) CHK_FAIL(F, id);
    }
}
#endif

__device__ __forceinline__ void phase_ln1_router(const Frame& F, const Args& a, int l) {
    const bf16* X = (const bf16*)(F.ws + WS_X); bf16* X1 = (bf16*)(F.ws + WS_X1); const bf16* AO = (const bf16*)(F.ws + WS_AO); unsigned char* H8 = F.ws + WS_XE; float* AFF = (float*)(F.ws + WS_AFF);
    constexpr int RP = 1032, RB = 6;
    LAS bf16* Wb = (LAS bf16*)F.lds;
    LAS bf16* Hs = (LAS bf16*)(F.lds + 16 * RP * 2) + F.wave * (RB * RP);
    const float* wr = a.in[25] + (size_t)l * D * NE;
    for (int i = F.tid; i < D * NE; i += 512) Wb[(i & 15) * RP + (i >> 4)] = f2bf(wr[i]);
    __syncthreads();
    int lane_ = F.lane; asm volatile("" : "+v"(lane_)); const int lane = lane_;
    const f32x4* lg = (const f32x4*)(a.in[10] + (size_t)(l * 2 + 0) * D); const f32x4* lb = (const f32x4*)(a.in[11] + (size_t)(l * 2 + 0) * D);
    const int RPW = (NTOK + F.NGW - 1) / F.NGW, rbeg = F.gw * RPW, rend = (rbeg + RPW < NTOK) ? rbeg + RPW : NTOK;
    f32x4 lgv[4], lbv[4], g1v[4], sh2v[4], sc2v[4]; int ccur = -1;
#pragma unroll
    for (int j = 0; j < 4; ++j) { lgv[j] = lg[lane + 64 * j]; lbv[j] = lb[lane + 64 * j]; g1v[j] = lgv[j]; sh2v[j] = lgv[j]; sc2v[j] = lgv[j]; }
    u32x2 xc[4], ac[4], xd[4], ad[4];
    { const int r0 = rbeg < rend ? rbeg : NTOK - 1, r1 = rbeg + 1 < rend ? rbeg + 1 : r0;
#pragma unroll
      for (int j = 0; j < 4; ++j) { xc[j] = ((const u32x2*)(X + (size_t)r0 * D))[lane + 64 * j]; ac[j] = ((const u32x2*)(AO + (size_t)r0 * D))[lane + 64 * j];
          xd[j] = ((const u32x2*)(X + (size_t)r1 * D))[lane + 64 * j]; ad[j] = ((const u32x2*)(AO + (size_t)r1 * D))[lane + 64 * j]; } }
    for (int row = rbeg; row < rend; ++row) {
        const int c = cond_of(row);
        if (c != ccur) { ccur = c; const f32x4* g1 = (const f32x4*)ada_vec(F, l, c, 2); const f32x4* sh2 = (const f32x4*)ada_vec(F, l, c, 3); const f32x4* sc2 = (const f32x4*)ada_vec(F, l, c, 4);
#pragma unroll
            for (int j = 0; j < 4; ++j) { g1v[j] = g1[lane + 64 * j]; sh2v[j] = sh2[lane + 64 * j]; sc2v[j] = sc2[lane + 64 * j] + 1.f; } }
        f32x4 y[4]; float s = 0.f, s2 = 0.f;
#pragma unroll
        for (int j = 0; j < 4; ++j) { const f32x4 av = (f32x4){__uint_as_float(ac[j].x << 16), __uint_as_float(ac[j].x & 0xffff0000u), __uint_as_float(ac[j].y << 16), __uint_as_float(ac[j].y & 0xffff0000u)}; y[j] = bf4(xc[j]) * ALPHA + g1v[j] * av; s += (y[j][0] + y[j][1]) + (y[j][2] + y[j][3]); s2 += (y[j][0] * y[j][0] + y[j][1] * y[j][1]) + (y[j][2] * y[j][2] + y[j][3] * y[j][3]); }
        { const int nr = row + 2 < rend ? row + 2 : row;
#pragma unroll
          for (int j = 0; j < 4; ++j) { xc[j] = xd[j]; ac[j] = ad[j]; xd[j] = ((const u32x2*)(X + (size_t)nr * D))[lane + 64 * j]; ad[j] = ((const u32x2*)(AO + (size_t)nr * D))[lane + 64 * j]; } }
        s = wave_sum(s); s2 = wave_sum(s2);
        const float mean = s * (1.f / D), var = fmaxf(s2 * (1.f / D) - mean * mean, 0.f);
        const float rstd = 1.f / sqrtf(var + 1e-5f);
        f32x4 h[4];
#pragma unroll
        for (int j = 0; j < 4; ++j) { const int q = lane + 64 * j; const f32x4 xn = (y[j] - mean) * rstd * lgv[j] + lbv[j]; ((u32x2*)(X1 + (size_t)row * D))[q] = pk4(xn);
            h[j] = xn * sc2v[j] + sh2v[j]; ((unsigned*)(H8 + (size_t)row * D))[q] = pk4_fp8(h[j][0], h[j][1], h[j][2], h[j][3]); }
        const int br = (row - rbeg) % RB;
#pragma unroll
        for (int j = 0; j < 4; ++j) { u32x2 w; w.x = cvtpk(h[j][0], h[j][1]); w.y = cvtpk(h[j][2], h[j][3]); *(LAS u32x2*)(Hs + br * RP + 4 * (lane + 64 * j)) = w; }
        if (br == RB - 1 || row == rend - 1) {
            const int nrows = br + 1, row0 = row - br, n = lane & 15, kq = lane >> 4, nn = n < nrows ? n : 0;
            const LAS bf16* wp = Wb + n * RP + 8 * kq; const LAS bf16* hp = Hs + nn * RP + 8 * kq;
            f32x4 l0 = (f32x4){0.f, 0.f, 0.f, 0.f}, l1 = l0;
#pragma unroll 4
            for (int st = 0; st < 32; st += 2) {
                l0 = __builtin_amdgcn_mfma_f32_16x16x32_bf16(*(const LAS bf16x8*)(wp + 32 * st), *(const LAS bf16x8*)(hp + 32 * st), l0, 0, 0, 0);
                l1 = __builtin_amdgcn_mfma_f32_16x16x32_bf16(*(const LAS bf16x8*)(wp + 32 * st + 32), *(const LAS bf16x8*)(hp + 32 * st + 32), l1, 0, 0, 0); }
            const f32x4 lg4 = l0 + l1;
            float mx = fmaxf(fmaxf(lg4[0], lg4[1]), fmaxf(lg4[2], lg4[3])); mx = xmax16(mx); mx = xmax32(mx);
            f32x4 ex; ex[0] = __expf(lg4[0] - mx); ex[1] = __expf(lg4[1] - mx); ex[2] = __expf(lg4[2] - mx); ex[3] = __expf(lg4[3] - mx);
            float den = (ex[0] + ex[1]) + (ex[2] + ex[3]); den = xsum16(den, den); den = xsum32(den, den);
            const float inv = 1.f / den;
            if (n < nrows) {
#pragma unroll
                for (int i = 0; i < 4; ++i) AFF[(size_t)(4 * kq + i) * NTOK + row0 + n] = ex[i] * inv; }
        }
    }
    __syncthreads();
}

__device__ __forceinline__ int block_excl_scan(int v, LAS int* wsum, int lane, int wid, int& total) {
    int inc = v;
#pragma unroll
    for (int o = 1; o < 64; o <<= 1) { const int t = __shfl_up(inc, o); if (lane >= o) inc += t; }
    if (lane == 63) wsum[wid] = inc;
    __syncthreads();
    int off = 0, tot = 0;
#pragma unroll
    for (int w = 0; w < 8; ++w) { const int s = wsum[w]; if (w < wid) off += s; tot += s; }
    __syncthreads();
    total = tot; return off + inc - v;
}
__device__ __forceinline__ void phase_topk(const Frame& F) {
    const float* AFFT = (const float*)(F.ws + WS_AFF); int* IDX = (int*)(F.ws + WS_IDX); float* GATEV = (float*)(F.ws + WS_GATEV); int* SLOTMAP = (int*)(F.ws + WS_SLOTMAP);
    LAS int* hist = (LAS int*)F.lds;
    LAS int* wsum = (LAS int*)(F.lds + 1024);
    LAS unsigned* shv = (LAS unsigned*)(F.lds + 1024 + 64);
    const int tid = F.tid, lane = F.lane;
    for (int pr = F.bid; pr < 32; pr += F.G) {
        const int stream = pr >> 4, e = pr & 15, tok0 = stream ? NCTX : 0, cap = stream ? CAPL : CAPC, sbase = e * ESLOTS + (stream ? CAPC : 0);
        const int C = stream ? 16 : 8, i0 = tid * C;
        unsigned k[16];
        { const u32x4* src = (const u32x4*)(AFFT + (size_t)e * NTOK + tok0 + i0);
#pragma unroll
          for (int q = 0; q < 4; ++q) { u32x4 v = (u32x4){0u, 0u, 0u, 0u}; if (q * 4 < C) v = src[q]; k[4 * q] = v.x; k[4 * q + 1] = v.y; k[4 * q + 2] = v.z; k[4 * q + 3] = v.w; } }
        unsigned prefix = 0u; int remaining = cap;
        __syncthreads();
        for (int pass = 0; pass < 4; ++pass) {
            const int shift = 24 - 8 * pass;
            if (tid < 256) hist[tid] = 0;
            __syncthreads();
#pragma unroll
            for (int i = 0; i < 16; ++i) if (i < C) { const unsigned kk = k[i]; if (pass == 0 || (kk >> (shift + 8)) == prefix) __hip_atomic_fetch_add(&hist[(kk >> shift) & 255u], 1, __ATOMIC_RELAXED, __HIP_MEMORY_SCOPE_WORKGROUP); }
            __syncthreads();
            if (tid < 64) {
                const int h0 = hist[4 * lane], h1 = hist[4 * lane + 1], h2 = hist[4 * lane + 2], h3 = hist[4 * lane + 3], c = h0 + h1 + h2 + h3;
                int inc = c;
#pragma unroll
                for (int o = 1; o < 64; o <<= 1) { const int t = __shfl_down(inc, o); if (lane + o < 64) inc += t; }
                const int above = inc - c;
                if (above < remaining && remaining <= inc) {
                    int cum = above, sel;
                    if (cum + h3 >= remaining) sel = 3; else { cum += h3; if (cum + h2 >= remaining) sel = 2; else { cum += h2; if (cum + h1 >= remaining) sel = 1; else { cum += h1; sel = 0; } } }
                    shv[0] = (prefix << 8) | (unsigned)(4 * lane + sel); shv[1] = (unsigned)(remaining - cum);
                }
            }
            __syncthreads();
            prefix = shv[0]; remaining = (int)shv[1];
        }
        const unsigned thr = prefix; const int need = remaining;
        int ceq = 0;
#pragma unroll
        for (int i = 0; i < 16; ++i) if (i < C) ceq += (k[i] == thr) ? 1 : 0;
        int tot; const int eq_rank = block_excl_scan(ceq, wsum, F.lane, F.wave, tot);
        int csel = 0; { int er = eq_rank;
#pragma unroll
            for (int i = 0; i < 16; ++i) if (i < C) { if (k[i] > thr) ++csel; else if (k[i] == thr) { if (er < need) ++csel; ++er; } } }
        int slot = block_excl_scan(csel, wsum, F.lane, F.wave, tot);
#if MK_CHECK
        if (tid == 0 && tot != cap) CHK_FAIL(F, 60);
#endif
        { int er = eq_rank; int sm[16];
#pragma unroll
            for (int i = 0; i < 16; ++i) { sm[i] = -1; if (i < C) { bool sel = false; if (k[i] > thr) sel = true; else if (k[i] == thr) { sel = er < need; ++er; }
                const int tok = tok0 + i0 + i;
                if (sel) { const int r = sbase + slot; IDX[r] = tok; GATEV[r] = __uint_as_float(k[i]); sm[i] = r; ++slot; } } }
            u32x4* dst = (u32x4*)(SLOTMAP + (size_t)e * NTOK + tok0 + i0);
#pragma unroll
            for (int q = 0; q < 4; ++q) if (q * 4 < C) dst[q] = (u32x4){(unsigned)sm[4 * q], (unsigned)sm[4 * q + 1], (unsigned)sm[4 * q + 2], (unsigned)sm[4 * q + 3]}; }
    }
    __syncthreads();
}
__device__ __forceinline__ void phase_gather(const Frame& F) {
    const int* IDX = (const int*)(F.ws + WS_IDX);
#if MK_CHECK
    {
        const int* SLOTMAP = (const int*)(F.ws + WS_SLOTMAP); const float* GATEV = (const float*)(F.ws + WS_GATEV); const float* AFF = (const float*)(F.ws + WS_AFF);
        for (int r = F.gw * 64 + F.lane; r < NSLOTS; r += F.NGW * 64) { const int tok = IDX[r], e = r / ESLOTS; const bool latslot = (r % ESLOTS) >= CAPC;
            bool ok = tok >= 0 && tok < NTOK && ((tok >= NCTX) == latslot);
            if (ok) ok = SLOTMAP[(size_t)e * NTOK + tok] == r && GATEV[r] == AFF[(size_t)e * NTOK + tok];
            if (ok) { const unsigned h = hash_u(r * 7919u + 13u); const int t2 = latslot ? NCTX + (h % NLAT) : (h % NCTX); if (SLOTMAP[(size_t)e * NTOK + t2] < 0 && AFF[(size_t)e * NTOK + t2] > GATEV[r]) ok = false; }
            if (!ok) CHK_FAIL(F, 61); }
    }
#endif
}

__device__ __forceinline__ void ye_acc(f32x4& f, unsigned w) {
    const auto lo = __builtin_amdgcn_cvt_pk_f32_fp8((int)w, false), hi = __builtin_amdgcn_cvt_pk_f32_fp8((int)w, true); f[0] += lo[0]; f[1] += lo[1]; f[2] += hi[0]; f[3] += hi[1];
}
__device__ __forceinline__ void ye_add(f32x4 (&f)[4], const unsigned char* YE, int r, int lane) {
    const bool two = (r >> 8) >= DOWN_FULL_PANELS;
    unsigned w[4], w2[4];
#pragma unroll
    for (int j = 0; j < 4; ++j) { w[j] = ((const unsigned*)(YE + (size_t)r * D))[lane + 64 * j]; w2[j] = 0u; if (two) w2[j] = ((const unsigned*)(YE + (size_t)(NSLOTS + r) * D))[lane + 64 * j]; }
#pragma unroll
    for (int j = 0; j < 4; ++j) { ye_acc(f[j], w[j]); ye_acc(f[j], w2[j]); }
}
__device__ __forceinline__ void ye_add2(f32x4 (&f)[4], const unsigned char* YE, int r, int rb, int lane) {
    const bool two = (r >> 8) >= DOWN_FULL_PANELS, twob = (rb >> 8) >= DOWN_FULL_PANELS;
    unsigned w[4], w2[4], v[4], v2[4];
#pragma unroll
    for (int j = 0; j < 4; ++j) { w[j] = ((const unsigned*)(YE + (size_t)r * D))[lane + 64 * j]; w2[j] = 0u; if (two) w2[j] = ((const unsigned*)(YE + (size_t)(NSLOTS + r) * D))[lane + 64 * j];
        v[j] = ((const unsigned*)(YE + (size_t)rb * D))[lane + 64 * j]; v2[j] = 0u; if (twob) v2[j] = ((const unsigned*)(YE + (size_t)(NSLOTS + rb) * D))[lane + 64 * j]; }
#pragma unroll
    for (int j = 0; j < 4; ++j) { ye_acc(f[j], w[j]); ye_acc(f[j], w2[j]); ye_acc(f[j], v[j]); ye_acc(f[j], v2[j]); }
}
__device__ __forceinline__ void phase_combine(const Frame& F, const Args& a, int l) {
    bf16* X = (bf16*)(F.ws + WS_X); const bf16* X1 = (const bf16*)(F.ws + WS_X1); bf16* H = (bf16*)(F.ws + WS_H); const unsigned char* YE = F.ws + WS_YE; const int* SLOTMAP = (const int*)(F.ws + WS_SLOTMAP);
    int lane_ = F.lane; asm volatile("" : "+v"(lane_)); const int lane = lane_;
    const f32x4* lg = (const f32x4*)(a.in[10] + (size_t)(l * 2 + 1) * D); const f32x4* lb = (const f32x4*)(a.in[11] + (size_t)(l * 2 + 1) * D);
#if MK_CHECK
    const unsigned err = __hip_atomic_load(F.ctl + CW_ERR, __ATOMIC_RELAXED, __HIP_MEMORY_SCOPE_AGENT);
    const unsigned tmo = __hip_atomic_load(F.ctl + CW_BAR + XB_TMO, __ATOMIC_RELAXED, __HIP_MEMORY_SCOPE_AGENT);
#endif
    const int RPW = (NTOK + F.NGW - 1) / F.NGW, rbeg = F.gw * RPW, rend = (rbeg + RPW < NTOK) ? rbeg + RPW : NTOK;
    f32x4 lgv[4], lbv[4], g2v[4], shv[4], scv[4]; int ccur = -1;
#pragma unroll
    for (int j = 0; j < 4; ++j) { lgv[j] = lg[lane + 64 * j]; lbv[j] = lb[lane + 64 * j]; g2v[j] = lgv[j]; shv[j] = lgv[j]; scv[j] = lgv[j]; }
    auto ld_sm = [&](int r) { int v = -1; if (r < rend && lane < 16) v = SLOTMAP[(size_t)lane * NTOK + r]; return v; };
    u32x2 x1n[4]; unsigned pw[4], pw2[4], pv[4], pv2[4]; unsigned restn = 0u; int smn_keep = -1;
    auto issue = [&](int r, int smv) {
        unsigned mask = (unsigned)__ballot(smv >= 0) & 0xffffu; int r0 = -1, r1 = -1;
        if (mask) { const int e0 = __builtin_ctz(mask); mask &= mask - 1; r0 = __builtin_amdgcn_readlane(smv, e0); }
        if (mask) { const int e1 = __builtin_ctz(mask); mask &= mask - 1; r1 = __builtin_amdgcn_readlane(smv, e1); }
        restn = mask; smn_keep = smv;
        const int rr = r < rend ? r : rend - 1;
#pragma unroll
        for (int j = 0; j < 4; ++j) { x1n[j] = ((const u32x2*)(X1 + (size_t)rr * D))[lane + 64 * j]; pw[j] = 0u; pw2[j] = 0u; pv[j] = 0u; pv2[j] = 0u; }
        if (r0 >= 0) {
#pragma unroll
            for (int j = 0; j < 4; ++j) { pw[j] = ((const unsigned*)(YE + (size_t)r0 * D))[lane + 64 * j]; if ((r0 >> 8) >= DOWN_FULL_PANELS) pw2[j] = ((const unsigned*)(YE + (size_t)(NSLOTS + r0) * D))[lane + 64 * j]; } }
        if (r1 >= 0) {
#pragma unroll
            for (int j = 0; j < 4; ++j) { pv[j] = ((const unsigned*)(YE + (size_t)r1 * D))[lane + 64 * j]; if ((r1 >> 8) >= DOWN_FULL_PANELS) pv2[j] = ((const unsigned*)(YE + (size_t)(NSLOTS + r1) * D))[lane + 64 * j]; } }
    };
    int sm1 = ld_sm(rbeg + 1);
    if (rbeg < rend) issue(rbeg, ld_sm(rbeg));
    for (int row = rbeg; row < rend; ++row) {
        const int c = cond_of(row);
        if (c != ccur) { ccur = c; const f32x4* g2 = (const f32x4*)ada_vec(F, l, c, 5);
#pragma unroll
            for (int j = 0; j < 4; ++j) g2v[j] = g2[lane + 64 * j];
            if (l < 3) { const f32x4* sh = (const f32x4*)ada_vec(F, l + 1, c, 0); const f32x4* sc = (const f32x4*)ada_vec(F, l + 1, c, 1);
#pragma unroll
                for (int j = 0; j < 4; ++j) { shv[j] = sh[lane + 64 * j]; scv[j] = sc[lane + 64 * j] + 1.f; } } }
        f32x4 x1[4], f[4]; unsigned mask = restn; const int smc = smn_keep;
#pragma unroll
        for (int j = 0; j < 4; ++j) { x1[j] = bf4(x1n[j]); f[j] = (f32x4){0.f, 0.f, 0.f, 0.f}; ye_acc(f[j], pw[j]); ye_acc(f[j], pw2[j]); ye_acc(f[j], pv[j]); ye_acc(f[j], pv2[j]); }
        if (row + 1 < rend) { const int smv = sm1; sm1 = ld_sm(row + 2); issue(row + 1, smv); }
        while (mask) {
            const int e0 = __builtin_ctz(mask); mask &= mask - 1; const int r0 = __builtin_amdgcn_readlane(smc, e0);
            if (mask) { const int e1 = __builtin_ctz(mask); mask &= mask - 1; const int r1 = __builtin_amdgcn_readlane(smc, e1); ye_add2(f, YE, r0, r1, lane); }
            else ye_add(f, YE, r0, lane);
        }
        f32x4 y[4]; float s = 0.f, s2 = 0.f;
#pragma unroll
        for (int j = 0; j < 4; ++j) { y[j] = x1[j] * ALPHA + g2v[j] * f[j] * (1.f / YE8_SCALE); s += (y[j][0] + y[j][1]) + (y[j][2] + y[j][3]); s2 += (y[j][0] * y[j][0] + y[j][1] * y[j][1]) + (y[j][2] * y[j][2] + y[j][3] * y[j][3]); }
        s = wave_sum(s); s2 = wave_sum(s2);
        const float mean = s * (1.f / D), var = fmaxf(s2 * (1.f / D) - mean * mean, 0.f);
        const float rstd = 1.f / sqrtf(var + 1e-5f);
        if (l < 3) {
#pragma unroll
            for (int j = 0; j < 4; ++j) { const int q = lane + 64 * j; const f32x4 xn = (y[j] - mean) * rstd * lgv[j] + lbv[j]; ((u32x2*)(X + (size_t)row * D))[q] = pk4(xn);
                const f32x4 h = xn * scv[j] + shv[j]; u32x2 w; w.x = cvtpk(h[0], h[1]); w.y = cvtpk(h[2], h[3]); ((u32x2*)(H + (size_t)row * D))[q] = w; }
        } else {
#pragma unroll
            for (int j = 0; j < 4; ++j) { const int q = lane + 64 * j; f32x4 xn = (y[j] - mean) * rstd * lgv[j] + lbv[j];
#if MK_CHECK
                if (row == 0 && q == 0) { if (err) xn[0] = 100.f * (float)err; else if (tmo) xn[0] = 9900.f; }
#endif
                ((f32x4*)(F.out + (size_t)row * D))[q] = xn; }
        }
    }
}

#if !MK_SPLIT
#define GRID_BAR() xcd_barrier(bar)
#else
#define GRID_BAR() do { } while (0)
#endif
#define IN(k) (lo <= (k) && (k) < hi)
#define GEMM_PHASE(EPI, SCHED) do { for (int rep_ = 0; rep_ < MK_REP_GEMM; ++rep_) pg8::gemm_phase<EPI, SCHED, true, true>(F.lds, g, S, E); } while (0)
template <int KIND>
__device__ __forceinline__ void run_mixer(const Frame& F, const Args& a, const XcdBarrier& bar, int lo, int hi, int l, int j, int slot, int& cv_it) {
    const int base = 3 + 12 * l;
    const bf16* Hb = (const bf16*)(F.ws + WS_H);
    ChunkMap cm; cm.init(F.G, F.bid);
    const ConvJob J{a.in[26], a.in[27], a.in[28], F.ws + WS_WGU, F.ws + WS_WD};
    const int cv_cap = (l == 0 ? 32 : l == 1 ? 48 : l == 2 ? 82 : 96) * (CV_PER_LAYER / 24);
    if (KIND != 2) {
        const bf16* Wq = (const bf16*)(F.ws + WS_WQKV) + (size_t)slot * 1536 * 1024;
        if (IN(base + 0)) {
            unsigned* cnt = F.ctl + CW_KV + 16 * l;
            Gemm g{Hb, Wq, 1024, 1024}; QkvOrder S{cm}; EpiBf16P E{(bf16*)(F.ws + WS_QKV), 1536};
            GEMM_PHASE(EpiBf16P, QkvOrder);
            int nkv = 0; { Unit u; for (int i = 0; S.next(i, u); ++i) nkv += (u.pn >= 4) ? 1 : 0; }
            if (nkv && F.tid == 0) { __builtin_amdgcn_fence(__ATOMIC_RELEASE, "agent"); (void)__hip_atomic_fetch_add(cnt, (unsigned)nkv, __ATOMIC_RELAXED, __HIP_MEMORY_SCOPE_AGENT); }
            const int idx = cm.x * cm.chunk + cm.loc; int skip = 288 - F.G; if (skip < 0 || skip >= F.G) skip = 0;
            if (idx >= skip) {
                if (F.tid == 0) { while (__hip_atomic_load(cnt, __ATOMIC_RELAXED, __HIP_MEMORY_SCOPE_AGENT) < 96u) __builtin_amdgcn_s_sleep(2); __builtin_amdgcn_fence(__ATOMIC_ACQUIRE, "agent"); }
                __syncthreads();
                for (int rep = 0; rep < MK_REP_POST; ++rep) phase_kv_post(F, a, KIND, j, slot, (idx - skip) * 8 + F.wave, (F.G - skip) * 8);
            }
            GRID_BAR();
        }
#if MK_CHECK
        if (IN(base + 3)) check_gemm_bf16<int>(F, Hb, Wq, NTOK, 1536, 1024, (const bf16*)(F.ws + WS_QKV), 1536, 10 + l);
#endif
        if (IN(base + 4)) {
            for (int rep = 0; rep < MK_REP_ATTN; ++rep) { if (KIND == 0) attn_phase<64, 0>(F, a, j, J, cv_it, (l + 1) * CV_PER_LAYER, cv_cap); else attn_phase<64, 1>(F, a, j, J, cv_it, (l + 1) * CV_PER_LAYER, cv_cap); }
            GRID_BAR();
        }
    } else {
        if (IN(base + 0)) {
            Gemm g{Hb, (const bf16*)(F.ws + WS_WDN), 512, 1024}; SplitKOrder S{2, 2, 1024, 48 * 2 * 2, cm}; EpiF32 E{(float*)(F.ws + WS_QKV), 512, DWN_PART};
            GEMM_PHASE(EpiF32, SplitKOrder); GRID_BAR();
        }
        if (IN(base + 1)) {
#if MK_CHECK
            for (int sidx = 0; sidx < 2; ++sidx) { const unsigned h = hash_u((F.gw * 2 + sidx) * 2654435761u + (10 + l) * 97u); const int row = h % NTOK, col = (h >> 12) % 512;
                const float ref = dot_bf16(Hb + (size_t)row * 1024, (const bf16*)(F.ws + WS_WDN) + (size_t)col * 1024, 1024, F.lane); const float* dq = (const float*)(F.ws + WS_QKV) + (size_t)row * 512 + col;
                if (!close_enough(dq[0] + dq[DWN_PART], ref, 0.01f, 0.01f)) CHK_FAIL(F, 10 + l); }
#endif
            phase_mla_post1(F, a); GRID_BAR();
        }
        if (IN(base + 2)) {
            { Gemm g{(const bf16*)(F.ws + WS_QA), (const bf16*)(F.ws + WS_WUQ), 256, 256}; PlainOrder S{6, 48 * 6, cm}; EpiBf16P E{(bf16*)(F.ws + WS_QKV), 1536}; GEMM_PHASE(EpiBf16P, PlainOrder); }
            { Gemm g{(const bf16*)(F.ws + WS_CKVA), (const bf16*)(F.ws + WS_WUKV), 128, 128}; PlainOrder S{8, 56 * 8, cm}; EpiUkv E{(bf16*)(F.ws + WS_KB), (bf16*)(F.ws + WS_KVRAW)}; GEMM_PHASE(EpiUkv, PlainOrder); }
            GRID_BAR();
        }
        if (IN(base + 3)) {
#if MK_CHECK
            check_gemm_bf16<int>(F, (const bf16*)(F.ws + WS_QA), (const bf16*)(F.ws + WS_WUQ), NTOK, 1536, 256, (const bf16*)(F.ws + WS_QKV), 1536, 14);
            for (int sidx = 0; sidx < 2; ++sidx) {
                const unsigned h = hash_u((F.gw * 2 + sidx) * 2654435761u + 15u * 97u); const int row = h % 14336, col = (h >> 12) % 2048, hh = col >> 7, ii = col & 127;
                const float ref = dot_bf16((const bf16*)(F.ws + WS_CKVA) + (size_t)row * 128, (const bf16*)(F.ws + WS_WUKV) + (size_t)col * 128, 128, F.lane);
                bool lat; int b, s; mla_row(row, lat, b, s);
                const float got = (ii < 64) ? bf2f(((const bf16*)(F.ws + WS_KB))[kb_off(16, 96, lat, b, hh) + (size_t)s * 96 + ii]) : bf2f(((const bf16*)(F.ws + WS_KVRAW))[(size_t)row * 1024 + hh * 64 + ii - 64]);
                if (!close_enough(got, ref, 0.02f, 0.02f)) CHK_FAIL(F, 15);
            }
#endif
            for (int rep = 0; rep < MK_REP_POST; ++rep) phase_mla_post2(F, a); GRID_BAR();
        }
        if (IN(base + 4)) { for (int rep = 0; rep < MK_REP_ATTN; ++rep) attn_phase<96, 2>(F, a, j, J, cv_it, (l + 1) * CV_PER_LAYER, cv_cap); GRID_BAR(); }
    }
}
__device__ __forceinline__ void run_moe(const Frame& F, const Args& a, const XcdBarrier& bar, int lo, int hi, int l, int kind) {
    const int base = 3 + 12 * l;
    ChunkMap cm; cm.init(F.G, F.bid);
    const bf16* Wo = (const bf16*)(F.ws + WS_WO) + (size_t)l * 1024 * 1024;
    if (IN(base + 5)) {
#if MK_CHECK
        if (kind == 0) check_attn<64, 0>(F, a, l / 3, 20 + l); else if (kind == 1) check_attn<64, 1>(F, a, 0, 20 + l); else check_attn<96, 2>(F, a, 0, 20 + l);
        __syncthreads();
#endif
        Gemm g{(const bf16*)(F.ws + WS_O), Wo, 1024, 1024}; PlainOrder S{4, 48 * 4, cm}; EpiBf16P E{(bf16*)(F.ws + WS_AO), 1024};
        GEMM_PHASE(EpiBf16P, PlainOrder); GRID_BAR();
    }
    if (IN(base + 6)) {
#if MK_CHECK
        check_gemm_bf16<int>(F, (const bf16*)(F.ws + WS_O), Wo, NTOK, 1024, 1024, (const bf16*)(F.ws + WS_AO), 1024, 30 + l);
#endif
        for (int rep = 0; rep < MK_REP_LN1; ++rep) phase_ln1_router(F, a, l); GRID_BAR();
    }
#if MK_CHECK
    if (IN(base + 7)) {
        const unsigned hsh = hash_u(F.gw * 2654435761u + 991u * l + 17u); const int row = hsh % NTOK, c = cond_of(row);
        const bf16* X1c = (const bf16*)(F.ws + WS_X1); const float* sh2 = ada_vec(F, l, c, 3); const float* sc2 = ada_vec(F, l, c, 4); const float* wrc = a.in[25] + (size_t)l * D * NE; const float* AFFc = (const float*)(F.ws + WS_AFF);
        float lgt[16];
#pragma unroll
        for (int e = 0; e < 16; ++e) { float sacc = 0.f; for (int k = F.lane; k < D; k += 64) { const float hh = bf2f(X1c[(size_t)row * D + k]) * (sc2[k] + 1.f) + sh2[k]; sacc += hh * wrc[k * NE + e]; } lgt[e] = wave_sum(sacc); }
        float mxc = lgt[0];
#pragma unroll
        for (int e = 1; e < 16; ++e) mxc = fmaxf(mxc, lgt[e]);
        float denc = 0.f;
#pragma unroll
        for (int e = 0; e < 16; ++e) denc += __expf(lgt[e] - mxc);
#pragma unroll
        for (int e = 0; e < 16; ++e) { const float ref = __expf(lgt[e] - mxc) / denc, got = AFFc[(size_t)e * NTOK + row]; if (!close_enough(got, ref, 0.03f, 2e-4f)) CHK_FAIL(F, 62); }
    }
#endif
    if (IN(base + 7)) { for (int rep = 0; rep < MK_REP_TOPK; ++rep) phase_topk(F); if (l < 3) ada_direct(F, a, l + 1, 32); GRID_BAR(); }
#if MK_CHECK
    if (IN(base + 8)) { phase_gather(F); GRID_BAR(); }
#endif
    const unsigned char* Wgu = F.ws + WS_WGU + (size_t)l * 16 * 4096 * 1024; const unsigned char* Wd = F.ws + WS_WD + (size_t)l * 16 * 1024 * 2048;
    if (IN(base + 9)) {
#if MK_CHECK
        for (int sidx = 0; sidx < 16; ++sidx) {
            const unsigned h = hash_u((F.gw * 16 + sidx) * 2654435761u + 71u * l + 3u); const int idx = h & 63, e = (h >> 6) & 15, kk = (h >> 10) & 1023, nn = (h >> 20) & 2047;
            const int k = kk + ((idx & 1) ? 1024 * ((h >> 31) & 1) : 0);
            float src, got;
            if (idx & 1) { const int n = nn & 1023; src = a.in[28][((size_t)(l * 16 + e) * 2048 + k) * 1024 + n]; got = fp8f(Wd + ((size_t)e * 1024 + n) * 2048, k); }
            else { const bool up = (idx & 2) != 0; src = (up ? a.in[27] : a.in[26])[((size_t)(l * 16 + e) * 1024 + kk) * 2048 + nn]; got = fp8f(Wgu + ((size_t)e * 4096 + (nn >> 7) * 256 + (up ? 128 : 0) + (nn & 127)) * 1024, kk); }
            { const unsigned pk = pk4_fp8(src * W8_SCALE, 0.f, 0.f, 0.f); if (F.lane == 0 && got != __builtin_amdgcn_cvt_f32_fp8((int)pk, 0)) CHK_FAIL(F, 70 + l); }
        }
#endif
        Gemm g{(const bf16*)(F.ws + WS_XE), (const bf16*)Wgu, 512, 512, (const int*)(F.ws + WS_IDX)}; GroupedOrder S{6, 16, 1, 0, cm}; EpiSwiglu E{F.ws + WS_HID};
        pg8::gemm_phase<EpiSwiglu, GroupedOrder, true, true, true, true>(F.lds, g, S, E); GRID_BAR();
    }
    if (IN(base + 10)) {
#if MK_CHECK
        for (int sidx = 0; sidx < 2; ++sidx) {
            const unsigned h = hash_u((F.gw * 2 + sidx) * 2654435761u + 977u * l); const int row = h % NSLOTS, cc = (h >> 12) % FF, e = row / ESLOTS;
            const unsigned char* xr = F.ws + WS_XE + (size_t)((const int*)(F.ws + WS_IDX))[row] * D; const unsigned char* wg = Wgu + ((size_t)e * 4096 + (cc >> 7) * 256 + (cc & 127)) * 1024;
            const float gd = dot_fp8(xr, wg, 1024, F.lane) * (1.f / W8_SCALE), ud = dot_fp8(xr, wg + 128 * 1024, 1024, F.lane) * (1.f / W8_SCALE);
            const float ref = gd / (1.f + __expf(-gd)) * ud, got = fp8f(F.ws + WS_HID + (size_t)row * FF, cc) * (1.f / H8_SCALE);
            if (!close_enough(got, ref, 0.08f, 0.01f)) CHK_FAIL(F, 40 + l);
        }
#endif
        EpiDown E{F.ws + WS_YE, (const float*)(F.ws + WS_GATEV)};
        { Gemm g{(const bf16*)(F.ws + WS_HID), (const bf16*)Wd, 1024, 1024, nullptr}; DownOrder S{0, cm}; pg8::gemm_phase<EpiDown, DownOrder, true, true, false, true>(F.lds, g, S, E); }
        { Gemm g{(const bf16*)(F.ws + WS_HID), (const bf16*)Wd, 512, 1024, nullptr}; DownOrder S{1, cm}; pg8::gemm_phase<EpiDown, DownOrder, true, true, false, true>(F.lds, g, S, E); }
        GRID_BAR();
    }
    if (IN(base + 11)) {
#if MK_CHECK
        for (int sidx = 0; sidx < 2; ++sidx) {
            const unsigned h = hash_u((F.gw * 2 + sidx) * 2654435761u + 577u * l + 5u); const int row = h % NSLOTS, cc = (h >> 12) % D, e = row / ESLOTS;
            const float dd = dot_fp8(F.ws + WS_HID + (size_t)row * FF, Wd + ((size_t)e * 1024 + cc) * 2048, 2048, F.lane) * (1.f / (W8_SCALE * H8_SCALE));
            const float ref = dd * ((const float*)(F.ws + WS_GATEV))[row], p1 = fp8f(F.ws + WS_YE + (size_t)row * D, cc) * (1.f / YE8_SCALE), p2 = ((row >> 8) >= DOWN_FULL_PANELS) ? fp8f(F.ws + WS_YE + (size_t)(NSLOTS + row) * D, cc) * (1.f / YE8_SCALE) : 0.f;
            if (!(fabsf(p1 + p2 - ref) <= 0.07f * (fabsf(p1) + fabsf(p2)) + 0.0005f)) CHK_FAIL(F, 50 + l);
        }
#endif
        for (int rep = 0; rep < MK_REP_COMB; ++rep) phase_combine(F, a, l); if (l < 3) GRID_BAR();
    }
}
#undef IN

constexpr int N_PHASES = 3 + 4 * 12;
__global__ void __launch_bounds__(512, 2) mk_fwd(Args a) {
    extern __shared__ __attribute__((aligned(16))) unsigned char lds_raw[];
    LAS unsigned char* lds0 = (LAS unsigned char*)lds_raw;
    Frame F;
    F.lds = lds0 + LDS_PH; F.ws = a.ws; F.out = a.out; F.ctl = (unsigned*)(a.ws + WS_CTL);
    F.tid = threadIdx.x; F.lane = F.tid & 63; F.wave = __builtin_amdgcn_readfirstlane(F.tid >> 6); F.G = gridDim.x; F.bid = blockIdx.x; F.gw = F.bid * 8 + F.wave; F.NGW = F.G * 8;
    if (F.tid < LDS_PH / 4) ((LAS unsigned*)lds0)[F.tid] = 0u;
    __syncthreads();
#if !MK_SPLIT
    XcdBarrier bar = xcd_barrier_post(F.ctl + CW_BAR, (volatile LAS unsigned*)lds0);
#else
    XcdBarrier bar; bar.bar = F.ctl + CW_BAR; bar.x = 0; bar.st = (volatile LAS unsigned*)lds0;
#endif
    const int lo = a.ph_lo, hi = a.ph_hi;
#define IN(k) (lo <= (k) && (k) < hi)
    if (IN(0)) { phase_prologue(F, a); GRID_BAR(); }
    if (IN(2)) { phase_mod0(F, a); GRID_BAR(); }
    int cv_it = F.gw;
    run_mixer<0>(F, a, bar, lo, hi, 0, 0, 0, cv_it);
    run_moe(F, a, bar, lo, hi, 0, 0);
    run_mixer<1>(F, a, bar, lo, hi, 1, 0, 1, cv_it);
    run_moe(F, a, bar, lo, hi, 1, 1);
    run_mixer<2>(F, a, bar, lo, hi, 2, 0, 0, cv_it);
    run_moe(F, a, bar, lo, hi, 2, 2);
    run_mixer<0>(F, a, bar, lo, hi, 3, 1, 2, cv_it);
    run_moe(F, a, bar, lo, hi, 3, 0);
#undef IN
}

extern "C" void kernel_launch(void* const* d_in, const int* in_sizes, int n_in, void* d_out, int out_size, void* d_ws, size_t ws_size, hipStream_t stream) {
    static int grid = 0;
    if (grid == 0) {
        if (n_in != 29 || out_size != 19529728 || ws_size < WS_END) { fprintf(stderr, "kernel_launch: unexpected sizes n_in %d out %d ws %zu\n", n_in, out_size, ws_size); grid = -1; return; }
        int dev = 0, cus = 0, per_cu = 0;
        if (hipGetDevice(&dev) != hipSuccess || hipDeviceGetAttribute(&cus, hipDeviceAttributeMultiprocessorCount, dev) != hipSuccess) { grid = -1; return; }
        if (hipFuncSetAttribute((const void*)mk_fwd, hipFuncAttributeMaxDynamicSharedMemorySize, LDS_BYTES) != hipSuccess) { fprintf(stderr, "kernel_launch: hipFuncSetAttribute failed\n"); grid = -1; return; }
        if (hipOccupancyMaxActiveBlocksPerMultiprocessor(&per_cu, (const void*)mk_fwd, 512, LDS_BYTES) != hipSuccess || per_cu < 1) fprintf(stderr, "kernel_launch: occupancy query says %d\n", per_cu);
        (void)hipGetLastError();
        grid = cus;
    }
    if (grid < 0) return;
    (void)hipMemsetAsync((char*)d_ws + WS_CTL, 0, CTL_BYTES, stream);
    Args a{};
    for (int i = 0; i < 29; ++i) a.in[i] = (const float*)d_in[i];
    a.out = (float*)d_out; a.ws = (unsigned char*)d_ws;
#if MK_SPLIT
    for (int p = 0; p < N_PHASES; ++p) {
        const int r = (p - 3) % 12, l = (p - 3) / 12;
        if (p >= 3) { const bool mla = (l % 3) == 2; if (!mla && (r == 1 || r == 2)) continue; }
        a.ph_lo = p; a.ph_hi = p + 1;
        hipLaunchKernelGGL(mk_fwd, dim3(grid), dim3(512), LDS_BYTES, stream, a);
    }
#else
    a.ph_lo = 0; a.ph_hi = N_PHASES;
    hipLaunchKernelGGL(mk_fwd, dim3(grid), dim3(512), LDS_BYTES, stream, a);
#endif
}
```

```cpp
#include <hip/hip_runtime.h>
#include <cstdio>
#include <cstdint>

#ifndef MK_SPLIT
#define MK_SPLIT 0
#endif
#ifndef MK_REP_ATTN
#define MK_REP_ATTN 1
#endif
#ifndef MK_REP_CONV
#define MK_REP_CONV 1
#endif
#ifndef MK_REP_POST
#define MK_REP_POST 1
#endif
#ifndef MK_REP_GEMM
#define MK_REP_GEMM 1
#endif
#ifndef MK_REP_LN1
#define MK_REP_LN1 1
#endif
#ifndef MK_REP_TOPK
#define MK_REP_TOPK 1
#endif
#ifndef MK_REP_GATH
#define MK_REP_GATH 1
#endif
#ifndef MK_REP_COMB
#define MK_REP_COMB 1
#endif
#ifndef MK_CHECK
#define MK_CHECK 0
#endif

#define LAS __attribute__((address_space(3)))
typedef unsigned short bf16;
typedef unsigned u32x4 __attribute__((ext_vector_type(4)));
typedef unsigned u32x2 __attribute__((ext_vector_type(2)));
typedef float f32x2 __attribute__((ext_vector_type(2)));
typedef float f32x4 __attribute__((ext_vector_type(4)));
typedef float f32x16 __attribute__((ext_vector_type(16)));
typedef short bf16x8 __attribute__((ext_vector_type(8)));
typedef __bf16 bf16x2_t __attribute__((ext_vector_type(2)));

constexpr int D = 1024, NCTX = 4096, NLAT = 8192, NTOK = 12288;
constexpr int NE = 16, FF = 2048, CAPC = 512, CAPL = 1024, ESLOTS = 1536, NSLOTS = 24576;
constexpr float ALPHA = 1.681792830507429f, LOG2E = 1.4426950408889634f;
constexpr float GQA_QS = 0.125f * LOG2E, MLA_QS = 0.10206207261596575f * LOG2E;
constexpr size_t DWN_PART = (size_t)8 << 20;
constexpr int OFF_YP = 0, OFF_NK = 12582912, OFF_NV = OFF_NK + 3145728, OFF_CKV = OFF_NV + 3145728, OFF_KPE = OFF_CKV + 524288;

constexpr size_t MiB = 1u << 20;
constexpr size_t WS_CTL = 0, CTL_BYTES = 1 * MiB;
constexpr size_t WS_ADAP = 1 * MiB, WS_ADA = 9 * MiB, WS_ROPE64 = 10 * MiB, WS_ROPE32 = 10 * MiB + 512 * 1024;
constexpr size_t WS_AFF = 11 * MiB, WS_IDX = 12 * MiB, WS_GATEV = 12 * MiB + 128 * 1024, WS_SLOTMAP = 13 * MiB;
constexpr size_t WS_X = 16 * MiB, WS_H = 64 * MiB, WS_O = 88 * MiB, WS_AO = 112 * MiB, WS_QKV = 160 * MiB, WS_KVRAW = 232 * MiB;
constexpr size_t WS_X1 = 292 * MiB  , WS_KB = 380 * MiB, WS_VT = 428 * MiB, WS_QA = 460 * MiB, WS_CKVA = 466 * MiB;
constexpr size_t WS_XE = 470 * MiB, WS_HID = 518 * MiB, WS_YE = 614 * MiB;
constexpr size_t WS_WQKV = 712 * MiB, WS_WO = 724 * MiB, WS_WDN = 732 * MiB, WS_WUQ = 733 * MiB, WS_WUKV = 734 * MiB;
constexpr size_t WS_WGU = 736 * MiB, WS_WD = 1248 * MiB, WS_END = 1504 * MiB;
constexpr int CW_ERR = 0, CW_BAR = 4096, CW_KV = 8192;

constexpr int LDS_BYTES = 147456, LDS_PH = 256;

__device__ __forceinline__ unsigned cvtpk(float lo, float hi) { f32x2 v = {lo, hi}; bf16x2_t b = __builtin_convertvector(v, bf16x2_t); return __builtin_bit_cast(unsigned, b); }
__device__ __forceinline__ bf16 f2bf(float f) { return (bf16)(cvtpk(f, 0.f) & 0xffffu); }
__device__ __forceinline__ float bf2f(bf16 b) { return __uint_as_float(((unsigned)b) << 16); }
__device__ __forceinline__ unsigned pk4_fp8(float a, float b, float c, float d) { int w = __builtin_amdgcn_cvt_pk_fp8_f32(a, b, 0, false); w = __builtin_amdgcn_cvt_pk_fp8_f32(c, d, w, true); return (unsigned)w; }
constexpr float W8_SCALE = 64.f, H8_SCALE = 8.f;
constexpr float YE8_SCALE = 128.f;
__device__ __forceinline__ float clamp8(float x) { return __builtin_amdgcn_fmed3f(x, -448.f, 448.f); }
__device__ __forceinline__ f32x4 bf4(u32x2 w) { return (f32x4){__uint_as_float(w.x << 16), __uint_as_float(w.x & 0xffff0000u), __uint_as_float(w.y << 16), __uint_as_float(w.y & 0xffff0000u)}; }
__device__ __forceinline__ u32x2 pk4(f32x4 v) { u32x2 w; w.x = cvtpk(v[0], v[1]); w.y = cvtpk(v[2], v[3]); return w; }
template <int CTRL> __device__ __forceinline__ float dppf(float v) { return __uint_as_float((unsigned)__builtin_amdgcn_update_dpp(0, (int)__float_as_uint(v), CTRL, 0xf, 0xf, true)); }
constexpr int DPP_X1 = 0xB1, DPP_X2 = 0x4E, DPP_HMIR = 0x141, DPP_MIR = 0x140, DPP_X8 = 0x128;
__device__ __forceinline__ float xsum16(float a, float b) { const auto r = __builtin_amdgcn_permlane16_swap(__float_as_uint(a), __float_as_uint(b), false, false); return __uint_as_float(r[0]) + __uint_as_float(r[1]); }
__device__ __forceinline__ float xsum32(float a, float b) { const auto r = __builtin_amdgcn_permlane32_swap(__float_as_uint(a), __float_as_uint(b), false, false); return __uint_as_float(r[0]) + __uint_as_float(r[1]); }
__device__ __forceinline__ float xmax16(float a) { const auto r = __builtin_amdgcn_permlane16_swap(__float_as_uint(a), __float_as_uint(a), false, false); return fmaxf(__uint_as_float(r[0]), __uint_as_float(r[1])); }
__device__ __forceinline__ float xmax32(float a) { const auto r = __builtin_amdgcn_permlane32_swap(__float_as_uint(a), __float_as_uint(a), false, false); return fmaxf(__uint_as_float(r[0]), __uint_as_float(r[1])); }
__device__ __forceinline__ float sum16(float v) { v += dppf<DPP_X1>(v); v += dppf<DPP_X2>(v); v += dppf<DPP_HMIR>(v); v += dppf<DPP_MIR>(v); return v; }
__device__ __forceinline__ float wave_sum(float v) { v = sum16(v); v = xsum16(v, v); return xsum32(v, v); }
__device__ __forceinline__ float wave_max(float v) {
    v = fmaxf(v, dppf<DPP_X1>(v)); v = fmaxf(v, dppf<DPP_X2>(v)); v = fmaxf(v, dppf<DPP_HMIR>(v)); v = fmaxf(v, dppf<DPP_MIR>(v)); v = xmax16(v); return xmax32(v);
}
__device__ __forceinline__ int cond_of(int t) { return t < NCTX ? 0 : 1 + ((t - NCTX) >> 11); }
__device__ __forceinline__ unsigned hash_u(unsigned x) { x ^= x >> 16; x *= 0x7feb352dU; x ^= x >> 15; x *= 0x846ca68bU; x ^= x >> 16; return x; }

#define XB_TMO      128
#define XB_XCNT(j)  (256  + 64 * (j))
#define XB_XSUB(j)  (1280 + 64 * (j))
#define XB_XGEN(j)  (2304 + 64 * (j))
#define XB_TOP      3328
#define XB_TOPGEN   3392
#define XCD_BAR_WORDS 3456
#define XB_SPIN_CAP (1u << 18)
__device__ __forceinline__ unsigned xb_ld(unsigned* p)              { return __hip_atomic_load(p, __ATOMIC_RELAXED, __HIP_MEMORY_SCOPE_AGENT); }
__device__ __forceinline__ unsigned xb_add(unsigned* p, unsigned v) { return __hip_atomic_fetch_add(p, v, __ATOMIC_RELAXED, __HIP_MEMORY_SCOPE_AGENT); }
__device__ __forceinline__ unsigned xb_xcc_id() { return (unsigned)__builtin_amdgcn_s_getreg((3 << 11) | 20) & 0xFu; }
#define XB_SPIN(cond, bar) do { unsigned _sp = 0; while (cond) { __builtin_amdgcn_s_sleep(1); \
    if ((++_sp & 255u) == 0u) { if (xb_ld(&(bar)[XB_TMO])) break; if (_sp > XB_SPIN_CAP) { atomicAdd(&(bar)[XB_TMO], 1u); break; } } } } while (0)
struct XcdBarrier { unsigned* bar; unsigned x; volatile LAS unsigned* st; };
__device__ __forceinline__ XcdBarrier xcd_barrier_post(unsigned* bar, volatile LAS unsigned* st) {
    XcdBarrier b; b.bar = bar; b.x = xb_xcc_id(); b.st = st;
    if (threadIdx.x == 0) (void)xb_add(&bar[XB_XCNT(b.x)], 1u);
    return b;
}
__device__ __forceinline__ void xcd_barrier_complete(unsigned* bar, unsigned x, unsigned& nloc, unsigned& nx) {
    const unsigned G = gridDim.x * gridDim.y * gridDim.z;
    unsigned sum, cnt, mine, sp = 0u;
    for (;;) {
        sum = 0u; cnt = 0u; mine = 0u;
#pragma unroll
        for (unsigned j = 0; j < 16; ++j) { const unsigned c = xb_ld(&bar[XB_XCNT(j)]); sum += c; cnt += (c > 0u) ? 1u : 0u; mine = (j == x) ? c : mine; }
        if (sum == G) break;
        __builtin_amdgcn_s_sleep(1);
        if ((++sp & 255u) == 0u) { if (xb_ld(&bar[XB_TMO])) break; if (sp > XB_SPIN_CAP) { atomicAdd(&bar[XB_TMO], 1u); break; } }
    }
    nloc = mine > 0u ? mine : 1u; nx = cnt > 0u ? cnt : 1u;
}
__device__ __forceinline__ void xcd_barrier(const XcdBarrier& b) {
    asm volatile("s_waitcnt vmcnt(0)" ::: "memory");
    __syncthreads();
    if (threadIdx.x == 0) {
        unsigned* bar = b.bar;
        __builtin_amdgcn_s_waitcnt(0);
        unsigned nloc = b.st[0], nx = b.st[1];
        if (nloc == 0u) { xcd_barrier_complete(bar, b.x, nloc, nx); b.st[0] = nloc; b.st[1] = nx; }
        const unsigned old = xb_add(&bar[XB_XSUB(b.x)], 1u);
        const unsigned gen = old / nloc;
        if (old + 1u == (gen + 1u) * nloc) {
            __builtin_amdgcn_fence(__ATOMIC_RELEASE, "agent");
            asm volatile("s_waitcnt vmcnt(0)" ::: "memory");
            const unsigned og = xb_add(&bar[XB_TOP], 1u);
            const unsigned tg = og / nx;
            if (og + 1u == (tg + 1u) * nx) xb_add(&bar[XB_TOPGEN], 1u);
            else XB_SPIN(xb_ld(&bar[XB_TOPGEN]) == tg, bar);
            __builtin_amdgcn_fence(__ATOMIC_ACQUIRE, "agent");
            xb_add(&bar[XB_XGEN(b.x)], 1u);
            asm volatile("s_waitcnt vmcnt(0)" ::: "memory");
        } else {
            XB_SPIN(xb_ld(&bar[XB_XGEN(b.x)]) == gen, bar);
            __builtin_amdgcn_fence(__ATOMIC_ACQUIRE, "agent");
            asm volatile("s_waitcnt vmcnt(0)" ::: "memory");
        }
    }
    __syncthreads();
}

struct Args { const float* in[29]; float* out; unsigned char* ws; int ph_lo, ph_hi; };
struct Frame {
    LAS unsigned char* lds;
    unsigned char* ws; float* out; unsigned* ctl;
    int tid, lane, wave, G, bid, gw, NGW;
};
#if MK_CHECK
#define CHK_FAIL(F, id) do { unsigned _e = 0u; __hip_atomic_compare_exchange_strong((F).ctl + CW_ERR, &_e, (unsigned)(id), __ATOMIC_RELAXED, __ATOMIC_RELAXED, __HIP_MEMORY_SCOPE_AGENT); } while (0)
#endif
__device__ __forceinline__ bool close_enough(float a, float b, float rel, float abs_) { const float d = fabsf(a - b); return d <= rel * fabsf(b) + abs_ && a == a; }

namespace pg8 {
#define PG8_LAS __attribute__((address_space(3)))
typedef unsigned short bf16_t;
typedef short bf16x8 __attribute__((ext_vector_type(8)));
typedef float f32x4 __attribute__((ext_vector_type(4)));
constexpr int BM = 256, BK = 64, HALF = 128, HTB = HALF * BK * 2  , STAGE_BYTES = 8 * HTB, NXCD = 8, WGM = 8;

__host__ __device__ __forceinline__ int lds_byte(int r, int c, int XM = 32) { const int st = (r >> 4) * 2 + (c >> 5), rr = r & 15, cc = c & 31, ob = rr * 64 + cc * 2; return st * 1024 + (ob ^ (((ob >> 9) & 1) * XM)); }
__host__ __device__ __forceinline__ void stage_rc(int b, int& R, int& C, int XM = 32) { const int st = b / 1024, sb = b % 1024, swz = sb ^ (((sb >> 9) & 1) * XM); R = (st >> 1) * 16 + swz / 64; C = (st & 1) * 32 + (swz % 64) / 2; }
__host__ __device__ __forceinline__ int perm32(int rho) { const int n = rho >> 4, i = rho & 15; return 8 * (i >> 2) + 4 * n + (i & 3); }
struct Unit { int pm, pn, kb; };
struct Gemm { const bf16_t* A; const bf16_t* Bt; int K, ld; const int* aidx; };
template <class Epi, class Sched, bool ALIGN_EPI = false, bool SP2 = false, bool GATHER = false, bool F8 = false>
__device__ __forceinline__ void gemm_phase(PG8_LAS unsigned char* lds, const Gemm g, const Sched& S, const Epi& E) {
    int tid_ = threadIdx.x; asm volatile("" : "+v"(tid_));
    const int tid = tid_, wid = __builtin_amdgcn_readfirstlane(tid >> 6), lane = tid & 63, wr = wid >> 2, wc = wid & 3, fr = lane & 15, fq = lane >> 4;
    const int K = g.K, LD = g.ld, nt = K / BK;
    unsigned voffA[2], voffB[2]; int RA[2]; unsigned CA2[2];
#pragma unroll
    for (int i = 0; i < 2; ++i) { int R, C; stage_rc(tid * 16 + i * 8192, R, C, F8 ? 48 : 32); const int Rb = Epi::PERM ? ((R & ~31) + perm32(R & 31)) : R;
        voffA[i] = (unsigned)(R * LD + C) * 2u; voffB[i] = (unsigned)(Rb * LD + C) * 2u; RA[i] = R; CA2[i] = (unsigned)C * 2u; }
    const size_t kstep = (size_t)(BK * 2);
    const size_t hstep = (size_t)HALF * LD * 2;
    const size_t tstep = 2 * hstep;
    const unsigned ldsw = (unsigned)wid * 1024u;
    const int aoff = lds_byte(wr * 64 + fr, F8 ? fq * 16 : fq * 8, F8 ? 48 : 32), boff = lds_byte(wc * 32 + fr, F8 ? fq * 16 : fq * 8, F8 ? 48 : 32);
    const int aoffh = aoff ^ 16, boffh = boff ^ 16;
    typedef int i32x8_t __attribute__((ext_vector_type(8)));
#define PG8_SA(b, h) (((b) * 2 + (h)) * HTB)
#define PG8_SB(b, h) ((4 + (b) * 2 + (h)) * HTB)
#define PG8_STAGE(bufoff, gbase, voff) do { _Pragma("unroll") for (int _i = 0; _i < 2; ++_i) \
        __builtin_amdgcn_global_load_lds((const unsigned*)((const char*)(gbase) + (voff)[_i]), (PG8_LAS unsigned*)(lds + (bufoff) + ldsw + _i * 8192), 16, 0, 0); } while (0)
#define PG8_GOFF(dst, unit) do { _Pragma("unroll") for (int _h = 0; _h < 2; ++_h) _Pragma("unroll") for (int _i = 0; _i < 2; ++_i) dst[_h][_i] = (unsigned)g.aidx[(unit).pm * 256 + _h * 128 + RA[_i]] * (unsigned)(LD * 2) + CA2[_i]; } while (0)
#define PG8_STAGE_A(bufoff, gbase, h, nx) do { if constexpr (GATHER) { unsigned _o[2] = {(nx) ? oN[h][0] : oC[h][0], (nx) ? oN[h][1] : oC[h][1]}; PG8_STAGE(bufoff, gbase, _o); } else { PG8_STAGE(bufoff, (gbase) + (h) * hstep, voffA); } } while (0)
#define PG8_LDA16(dst, b, h) do { _Pragma("unroll") for (int m = 0; m < 4; ++m) _Pragma("unroll") for (int k = 0; k < 2; ++k) dst[m][k] = *(const PG8_LAS bf16x8*)(lds + PG8_SA(b, h) + aoff + m * 2048 + k * 1024); } while (0)
#define PG8_LDB16(dst, b, h) do { _Pragma("unroll") for (int n = 0; n < 2; ++n) _Pragma("unroll") for (int k = 0; k < 2; ++k) dst[n][k] = *(const PG8_LAS bf16x8*)(lds + PG8_SB(b, h) + boff + n * 2048 + k * 1024); } while (0)
#define PG8_MMA16(ai, bj, At, Bt) do { __builtin_amdgcn_s_setprio(1); _Pragma("unroll") for (int m = 0; m < 4; ++m) _Pragma("unroll") for (int n = 0; n < 2; ++n) _Pragma("unroll") for (int k = 0; k < 2; ++k) \
        acc[ai][bj][m][n] = __builtin_amdgcn_mfma_f32_16x16x32_bf16(Bt[n][k], At[m][k], acc[ai][bj][m][n], 0, 0, 0); __builtin_amdgcn_s_setprio(0); } while (0)
#define PG8_LD32(p, lo, hi) __builtin_bit_cast(i32x8_t, __builtin_shufflevector(*(const PG8_LAS bf16x8*)((p) + (lo)), *(const PG8_LAS bf16x8*)((p) + (hi)), 0, 1, 2, 3, 4, 5, 6, 7, 8, 9, 10, 11, 12, 13, 14, 15))
#define PG8_LDA(dst, b, h) do { if constexpr (F8) { _Pragma("unroll") for (int m = 0; m < 4; ++m) dst##8[m] = PG8_LD32(lds + PG8_SA(b, h) + m * 2048, aoff, aoffh); } else { PG8_LDA16(dst, b, h); } } while (0)
#define PG8_LDB(dst, b, h) do { if constexpr (F8) { _Pragma("unroll") for (int n = 0; n < 2; ++n) dst##8[n] = PG8_LD32(lds + PG8_SB(b, h) + n * 2048, boff, boffh); } else { PG8_LDB16(dst, b, h); } } while (0)
#define PG8_MMA(ai, bj, At, Bt) do { if constexpr (F8) { __builtin_amdgcn_s_setprio(1); _Pragma("unroll") for (int m = 0; m < 4; ++m) _Pragma("unroll") for (int n = 0; n < 2; ++n) \
        asm volatile("v_mfma_f32_16x16x128_f8f6f4 %0, %1, %2, %0" : "+v"(acc[ai][bj][m][n]) : "v"(Bt##8[n]), "v"(At##8[m])); __builtin_amdgcn_s_setprio(0); } else { PG8_MMA16(ai, bj, At, Bt); } } while (0)
#define PG8_WAIT_V(n) asm volatile("s_waitcnt vmcnt(" #n ")" ::: "memory")
#define PG8_WAIT_L(n) asm volatile("s_waitcnt lgkmcnt(" #n ")" ::: "memory")
#define PG8_BAR __builtin_amdgcn_s_barrier()
#define PG8_SCHED __builtin_amdgcn_sched_barrier(0)
    Unit cur, nxt; int ui = 0;
    if (!S.next(0, cur)) return;
    unsigned oC[2][2] = {{0u, 0u}, {0u, 0u}}, oN[2][2] = {{0u, 0u}, {0u, 0u}};
    if constexpr (GATHER) PG8_GOFF(oC, cur);
    f32x4 acc[2][2][4][2];
#pragma unroll
    for (int a = 0; a < 2; ++a)
#pragma unroll
        for (int b = 0; b < 2; ++b)
#pragma unroll
            for (int m = 0; m < 4; ++m)
#pragma unroll
                for (int n = 0; n < 2; ++n) acc[a][b][m][n] = (f32x4){0.f, 0.f, 0.f, 0.f};
    bf16x8 At[4][2], B0[2][2], B1[2][2]; i32x8_t At8[4], B08[2], B18[2];
    const char* cA = GATHER ? (const char*)g.A + cur.kb : (const char*)g.A + (size_t)cur.pm * tstep + cur.kb; const char* cB = (const char*)g.Bt + (size_t)cur.pn * tstep + cur.kb;
    S.a_ready(cur);
    if constexpr (SP2) {
        PG8_STAGE(PG8_SB(0, 0), cB, voffB); PG8_STAGE(PG8_SB(0, 1), cB + hstep, voffB); PG8_STAGE_A(PG8_SA(0, 0), cA, 0, false); PG8_STAGE_A(PG8_SA(0, 1), cA, 1, false);
        if (wr == 1) PG8_BAR;
        PG8_WAIT_V(2); PG8_BAR;
        PG8_STAGE(PG8_SB(1, 0), cB + kstep, voffB); PG8_STAGE_A(PG8_SA(1, 0), cA + kstep, 0, false); PG8_STAGE(PG8_SB(1, 1), cB + hstep + kstep, voffB);
        PG8_WAIT_V(6); PG8_BAR;
    } else {
        PG8_STAGE(PG8_SB(0, 0), cB, voffB); PG8_STAGE_A(PG8_SA(0, 0), cA, 0, false); PG8_STAGE(PG8_SB(0, 1), cB + hstep, voffB); PG8_STAGE_A(PG8_SA(0, 1), cA, 1, false);
        if (wr == 1) PG8_BAR;
        PG8_WAIT_V(4); PG8_BAR;
        PG8_STAGE(PG8_SB(1, 0), cB + kstep, voffB); PG8_STAGE_A(PG8_SA(1, 0), cA + kstep, 0, false); PG8_STAGE(PG8_SB(1, 1), cB + hstep + kstep, voffB);
        PG8_WAIT_V(6); PG8_BAR;
    }
    for (;;) {
        const bool has_next = S.next(ui + 1, nxt);
        const char* nA = has_next ? (GATHER ? (const char*)g.A + nxt.kb : (const char*)g.A + (size_t)nxt.pm * tstep + nxt.kb) : cA;
        if constexpr (GATHER) { if (has_next) PG8_GOFF(oN, nxt); } const char* nB = has_next ? (const char*)g.Bt + (size_t)nxt.pn * tstep + nxt.kb : cB;
        for (int t = 0; t < nt; t += 2) {
            const bool last = (t == nt - 2); const bool lastn = last && has_next;
            const char* a1 = cA + (size_t)(t + 1) * kstep;
            const char* a2 = last ? nA : cA + (size_t)(t + 2) * kstep; const char* b2 = last ? nB : cB + (size_t)(t + 2) * kstep;
            const char* a3 = a2 + kstep; const char* b3 = b2 + kstep;
            if (last && has_next) S.a_ready(nxt);
            if constexpr (SP2) {
            PG8_LDB(B0, 0, 0); PG8_LDB(B1, 0, 1); PG8_SCHED; PG8_LDA(At, 0, 0); PG8_STAGE_A(PG8_SA(1, 1), a1, 1, false);
            PG8_WAIT_V(8); PG8_WAIT_L(0); PG8_BAR; PG8_MMA(0, 0, At, B0); PG8_MMA(0, 1, At, B1); PG8_BAR; PG8_SCHED;
            PG8_LDA(At, 0, 1); PG8_STAGE(PG8_SB(0, 0), b2, voffB); PG8_STAGE(PG8_SB(0, 1), b2 + hstep, voffB); PG8_STAGE_A(PG8_SA(0, 0), a2, 0, lastn);
            PG8_WAIT_V(8); PG8_WAIT_L(0); PG8_BAR; PG8_MMA(1, 0, At, B0); PG8_MMA(1, 1, At, B1); PG8_BAR; PG8_SCHED;
            PG8_LDB(B0, 1, 0); PG8_LDB(B1, 1, 1); PG8_SCHED; PG8_LDA(At, 1, 0); PG8_STAGE_A(PG8_SA(0, 1), a2, 1, lastn);
            PG8_WAIT_V(8); PG8_WAIT_L(0); PG8_BAR; PG8_MMA(0, 0, At, B0); PG8_MMA(0, 1, At, B1); PG8_BAR; PG8_SCHED;
            PG8_LDA(At, 1, 1); PG8_STAGE(PG8_SB(1, 0), b3, voffB); PG8_STAGE(PG8_SB(1, 1), b3 + hstep, voffB); PG8_STAGE_A(PG8_SA(1, 0), a3, 0, lastn);
            PG8_WAIT_V(8); PG8_WAIT_L(0); PG8_BAR; PG8_MMA(1, 0, At, B0); PG8_MMA(1, 1, At, B1); PG8_BAR; PG8_SCHED;
            } else {
            PG8_LDB(B0, 0, 0); PG8_SCHED; PG8_LDA(At, 0, 0); PG8_STAGE_A(PG8_SA(1, 1), a1, 1, false);
            PG8_WAIT_L(8); PG8_BAR; PG8_WAIT_L(0); PG8_MMA(0, 0, At, B0); PG8_BAR; PG8_SCHED;
            PG8_LDB(B1, 0, 1); PG8_STAGE(PG8_SB(0, 0), b2, voffB);
            PG8_BAR; PG8_WAIT_L(0); PG8_MMA(0, 1, At, B1); PG8_BAR;
            PG8_LDA(At, 0, 1); PG8_STAGE_A(PG8_SA(0, 0), a2, 0, lastn);
            PG8_BAR; PG8_WAIT_L(0); PG8_MMA(1, 0, At, B0); PG8_BAR; PG8_SCHED;
            PG8_STAGE(PG8_SB(0, 1), b2 + hstep, voffB);
            PG8_WAIT_V(6); PG8_BAR; PG8_MMA(1, 1, At, B1); PG8_BAR;
            PG8_LDB(B0, 1, 0); PG8_SCHED; PG8_LDA(At, 1, 0); PG8_STAGE_A(PG8_SA(0, 1), a2, 1, lastn);
            PG8_WAIT_L(8); PG8_BAR; PG8_WAIT_L(0); PG8_MMA(0, 0, At, B0); PG8_BAR; PG8_SCHED;
            PG8_LDB(B1, 1, 1); PG8_STAGE(PG8_SB(1, 0), b3, voffB);
            PG8_BAR; PG8_WAIT_L(0); PG8_MMA(0, 1, At, B1); PG8_BAR;
            PG8_LDA(At, 1, 1); PG8_STAGE_A(PG8_SA(1, 0), a3, 0, lastn);
            PG8_BAR; PG8_WAIT_L(0); PG8_MMA(1, 0, At, B0); PG8_BAR; PG8_SCHED;
            PG8_STAGE(PG8_SB(1, 1), b3 + hstep, voffB);
            PG8_WAIT_V(6); PG8_BAR; PG8_MMA(1, 1, At, B1); PG8_BAR;
            }
        }
        if constexpr (ALIGN_EPI) { if (wr == 0) PG8_BAR; }
        if constexpr (F8) {
#pragma unroll
            for (int a = 0; a < 2; ++a)
#pragma unroll
                for (int b = 0; b < 2; ++b)
                    asm volatile("s_nop 15\n\ts_nop 7" : "+v"(acc[a][b][0][0]), "+v"(acc[a][b][0][1]), "+v"(acc[a][b][1][0]), "+v"(acc[a][b][1][1]), "+v"(acc[a][b][2][0]), "+v"(acc[a][b][2][1]), "+v"(acc[a][b][3][0]), "+v"(acc[a][b][3][1])); }
        if constexpr (!Epi::AFTER_DRAIN) { E(acc, cur, wr, wc, fr, fq); S.done(cur); }
        if (!has_next) break;
#pragma unroll
        for (int a = 0; a < 2; ++a)
#pragma unroll
            for (int b = 0; b < 2; ++b)
#pragma unroll
                for (int m = 0; m < 4; ++m)
#pragma unroll
                    for (int n = 0; n < 2; ++n) acc[a][b][m][n] = (f32x4){0.f, 0.f, 0.f, 0.f};
        cur = nxt; cA = nA; cB = nB; ++ui;
        if constexpr (GATHER) { oC[0][0] = oN[0][0]; oC[0][1] = oN[0][1]; oC[1][0] = oN[1][0]; oC[1][1] = oN[1][1]; }
        if constexpr (ALIGN_EPI) { if (wr == 1) PG8_BAR; }
    }
    PG8_WAIT_V(0);
    if constexpr (!ALIGN_EPI) { if (wr == 0) PG8_BAR; }
    PG8_BAR;
    if constexpr (Epi::AFTER_DRAIN) { E.fused(acc, cur, wr, wc, fr, fq, lds, wid, lane); S.done(cur); }
#undef PG8_SA
#undef PG8_SB
#undef PG8_STAGE
#undef PG8_STAGE_A
#undef PG8_GOFF
#undef PG8_LDA
#undef PG8_LDA16
#undef PG8_LD32
#undef PG8_LDB16
#undef PG8_MMA16
#undef PG8_LDB
#undef PG8_MMA
#undef PG8_WAIT_V
#undef PG8_WAIT_L
#undef PG8_BAR
#undef PG8_SCHED
}
}
using pg8::Unit; using pg8::Gemm;
struct ChunkMap { int x, loc, nx, chunk;
    __device__ void init(int G, int bid) { if (G % 8 == 0) { nx = 8; chunk = G / 8; x = bid % 8; loc = bid / 8; } else { nx = 1; chunk = G; x = 0; loc = bid; } }
    __device__ __forceinline__ int lin(int i) const { return (i * nx + x) * chunk + loc; } };
struct PlainOrder {
    int nN, total; ChunkMap cm;
    __device__ bool next(int i, Unit& u) const { const int L = cm.lin(i); if (L >= total) return false; u.pm = L / nN; u.pn = L % nN; u.kb = 0; return true; }
    __device__ __forceinline__ void a_ready(const Unit&) const {}
    __device__ __forceinline__ void done(const Unit&) const {}
};
struct QkvOrder { ChunkMap cm;
    __device__ bool next(int i, Unit& u) const { const int L = cm.lin(i); if (L >= 288) return false;
        if (L >= 32 && L < 128) { const int r = L - 32; u.pm = r >> 1; u.pn = 4 + (r & 1); } else { const int r = L < 32 ? L : L - 96; u.pm = r >> 2; u.pn = r & 3; }
        u.kb = 0; return true; }
    __device__ __forceinline__ void a_ready(const Unit&) const {}
    __device__ __forceinline__ void done(const Unit&) const {}
};
struct SplitKOrder {
    int nN, ks, kbytes, total; ChunkMap cm;
    __device__ bool next(int i, Unit& u) const { const int L = cm.lin(i); if (L >= total) return false; const int t = L / ks; u.pm = t / nN; u.pn = t % nN; u.kb = (L % ks) * kbytes; return true; }
    __device__ __forceinline__ void a_ready(const Unit&) const {}
    __device__ __forceinline__ void done(const Unit&) const {}
};
struct GroupedOrder {
    int mt, nt, ks, kbytes; ChunkMap cm;
    __device__ bool next(int i, Unit& u) const { const int L = cm.lin(i), per = mt * nt * ks; if (L >= NE * per) return false; const int e = L / per, r = L % per, m = r / (nt * ks), q = r % (nt * ks);
        u.pm = e * mt + m; u.pn = e * nt + q / ks; u.kb = (q % ks) * kbytes; return true; }
    __device__ __forceinline__ void a_ready(const Unit&) const {}
    __device__ __forceinline__ void done(const Unit&) const {}
};
constexpr int DOWN_FULL_PANELS = 64;
struct DownOrder { int half; ChunkMap cm;
    __device__ bool next(int i, Unit& u) const { const int L = cm.lin(i); if (L >= 256) return false; const int T = half ? 256 + (L >> 1) : L; u.pm = T >> 2; u.pn = (u.pm / 6) * 4 + (T & 3); u.kb = half ? (L & 1) * 1024 : 0; return true; }
    __device__ __forceinline__ void a_ready(const Unit&) const {}
    __device__ __forceinline__ void done(const Unit&) const {}
};
struct EpiF32 { float* C; int ldc; size_t kstride; static constexpr bool PERM = false, AFTER_DRAIN = false;
    __device__ __forceinline__ void operator()(const f32x4 (&acc)[2][2][4][2], const Unit& u, int wr, int wc, int fr, int fq) const {
#pragma unroll
        for (int ai = 0; ai < 2; ++ai)
#pragma unroll
            for (int m = 0; m < 4; ++m) { float* rp = C + (u.kb ? kstride : (size_t)0) + (size_t)(u.pm * 256 + ai * 128 + wr * 64 + m * 16 + fr) * ldc + u.pn * 256 + wc * 32 + 4 * fq;
#pragma unroll
                for (int bj = 0; bj < 2; ++bj)
#pragma unroll
                    for (int n = 0; n < 2; ++n) *(f32x4*)(rp + bj * 128 + n * 16) = acc[ai][bj][m][n]; }
    }
};
struct EpiBf16P { bf16* C; int ldc; static constexpr bool PERM = true, AFTER_DRAIN = false;
    __device__ __forceinline__ void operator()(const f32x4 (&acc)[2][2][4][2], const Unit& u, int wr, int wc, int fr, int fq) const {
#pragma unroll
        for (int ai = 0; ai < 2; ++ai)
#pragma unroll
            for (int m = 0; m < 4; ++m) { bf16* rp = C + (size_t)(u.pm * 256 + ai * 128 + wr * 64 + m * 16 + fr) * ldc + u.pn * 256 + wc * 32 + 8 * fq;
#pragma unroll
                for (int bj = 0; bj < 2; ++bj) { const f32x4 v0 = acc[ai][bj][m][0], v1 = acc[ai][bj][m][1]; u32x4 w; w.x = cvtpk(v0[0], v0[1]); w.y = cvtpk(v0[2], v0[3]); w.z = cvtpk(v1[0], v1[1]); w.w = cvtpk(v1[2], v1[3]);
                    *(u32x4*)(rp + bj * 128) = w; } }
    }
};
__device__ __forceinline__ float silu_f(float x) { return x * __builtin_amdgcn_rcpf(1.f + __builtin_amdgcn_exp2f(-x * LOG2E)); }
struct EpiSwiglu { unsigned char* HID; static constexpr bool PERM = true, AFTER_DRAIN = false;
    __device__ __forceinline__ void operator()(const f32x4 (&acc)[2][2][4][2], const Unit& u, int wr, int wc, int fr, int fq) const {
        const int cb = (u.pn & 15) * 128 + wc * 32 + 8 * fq; constexpr float IS = 1.f / W8_SCALE;
#pragma unroll
        for (int ai = 0; ai < 2; ++ai)
#pragma unroll
            for (int m = 0; m < 4; ++m) { unsigned char* rp = HID + (size_t)(u.pm * 256 + ai * 128 + wr * 64 + m * 16 + fr) * FF + cb; u32x2 w;
#pragma unroll
                for (int n = 0; n < 2; ++n) { const f32x4 g = acc[ai][0][m][n] * IS, up = acc[ai][1][m][n] * (IS * H8_SCALE);
                    const unsigned pk = pk4_fp8(silu_f(g[0]) * up[0], silu_f(g[1]) * up[1], silu_f(g[2]) * up[2], silu_f(g[3]) * up[3]); if (n == 0) w.x = pk; else w.y = pk; }
                *(u32x2*)rp = w; asm volatile("" ::: "memory"); }
    }
};
struct EpiDown { unsigned char* YE; const float* gate; static constexpr bool PERM = true, AFTER_DRAIN = false;
    __device__ __forceinline__ void operator()(const f32x4 (&acc)[2][2][4][2], const Unit& u, int wr, int wc, int fr, int fq) const {
        const int cb = (u.pn & 3) * 256 + wc * 32 + 8 * fq;
#pragma unroll
        for (int ai = 0; ai < 2; ++ai)
#pragma unroll
            for (int m = 0; m < 4; ++m) { const int row = u.pm * 256 + ai * 128 + wr * 64 + m * 16 + fr; const float gv = gate[row] * (YE8_SCALE / (W8_SCALE * H8_SCALE)); unsigned char* rp = YE + (size_t)(u.kb ? NSLOTS : 0) * D + (size_t)row * D + cb;
#pragma unroll
                for (int bj = 0; bj < 2; ++bj) { const f32x4 v0 = acc[ai][bj][m][0] * gv, v1 = acc[ai][bj][m][1] * gv; u32x2 w;
                    w.x = pk4_fp8(clamp8(v0[0]), clamp8(v0[1]), clamp8(v0[2]), clamp8(v0[3])); w.y = pk4_fp8(clamp8(v1[0]), clamp8(v1[1]), clamp8(v1[2]), clamp8(v1[3])); *(u32x2*)(rp + bj * 128) = w; } }
    }
};

#if MK_CHECK
__device__ __forceinline__ float fp8f(const unsigned char* p, int i) { const int w = ((const int*)p)[i >> 2]; const int b = i & 3; return b == 0 ? __builtin_amdgcn_cvt_f32_fp8(w, 0) : b == 1 ? __builtin_amdgcn_cvt_f32_fp8(w, 1) : b == 2 ? __builtin_amdgcn_cvt_f32_fp8(w, 2) : __builtin_amdgcn_cvt_f32_fp8(w, 3); }
__device__ __forceinline__ float dot_fp8(const unsigned char* a, const unsigned char* b, int K, int lane) { float s = 0.f; for (int k = lane; k < K; k += 64) s += fp8f(a, k) * fp8f(b, k); return wave_sum(s); }
__device__ __forceinline__ float dot_bf16(const bf16* a, const bf16* b, int K, int lane) {
    float s = 0.f; for (int k = lane; k < K; k += 64) s += bf2f(a[k]) * bf2f(b[k]); return wave_sum(s);
}
#endif

__constant__ double INVF[16] = {1.0, 0.5623413251903491, 0.31622776601683794, 0.1778279410038923, 0.1, 0.05623413251903491, 0.03162277660168379, 0.01778279410038923,
                                0.01, 0.005623413251903491, 0.0031622776601683794, 0.0017782794100389228, 0.001, 0.0005623413251903491, 0.00031622776601683794, 0.00017782794100389227};
__device__ __forceinline__ void sincos_d(double a, float& s, float& c) {
    const double k = __builtin_rint(a * 0.6366197723675814), r = a - k * 1.5707963267948966, r2 = r * r;
    const double sr = r * (1.0 + r2 * (-1.0 / 6 + r2 * (1.0 / 120 + r2 * (-1.0 / 5040 + r2 * (1.0 / 362880 + r2 * (-1.0 / 39916800 + r2 * (1.0 / 6227020800.0)))))));
    const double cr = 1.0 + r2 * (-0.5 + r2 * (1.0 / 24 + r2 * (-1.0 / 720 + r2 * (1.0 / 40320 + r2 * (-1.0 / 3628800 + r2 * (1.0 / 479001600.0))))));
    const int q = ((int)k) & 3;
    const double ss = (q == 0) ? sr : (q == 1) ? cr : (q == 2) ? -sr : -cr;
    const double cc = (q == 0) ? cr : (q == 1) ? -sr : (q == 2) ? -cr : sr;
    s = (float)ss; c = (float)cc;
}
__device__ __forceinline__ void conv_load(f32x4 (&v)[16], const float* W, int N, int k0, int n0, int lane) {
    const int r4 = lane >> 4, c16 = lane & 15, n = n0 + 4 * c16;
    if (n >= N) return;
    const float* src = W + (size_t)(k0 + 16 * r4) * N + n;
#pragma unroll
    for (int i = 0; i < 16; ++i) v[i] = *(const f32x4*)(src + (size_t)i * N);
}
__device__ __forceinline__ void conv_store(const f32x4 (&v)[16], int N, bf16* WT, size_t rowbase, int ldk, int k0, int n0, int lane) {
    const int r4 = lane >> 4, c16 = lane & 15, n = n0 + 4 * c16;
    if (n >= N) return;
    bf16* dst = WT + (rowbase + 4 * c16) * (size_t)ldk + k0 + 16 * r4;
#pragma unroll
    for (int e = 0; e < 4; ++e) {
        u32x4 lo, hi;
        lo.x = cvtpk(v[0][e], v[1][e]); lo.y = cvtpk(v[2][e], v[3][e]); lo.z = cvtpk(v[4][e], v[5][e]); lo.w = cvtpk(v[6][e], v[7][e]);
        hi.x = cvtpk(v[8][e], v[9][e]); hi.y = cvtpk(v[10][e], v[11][e]); hi.z = cvtpk(v[12][e], v[13][e]); hi.w = cvtpk(v[14][e], v[15][e]);
        *(u32x4*)(dst + (size_t)e * ldk) = lo; *(u32x4*)(dst + (size_t)e * ldk + 8) = hi;
    }
}
__device__ __forceinline__ void conv_item(const float* W, int N, bf16* WT, size_t rowbase, int ldk, int k0, int n0, int lane) {
    f32x4 v[16]; conv_load(v, W, N, k0, n0, lane); conv_store(v, N, WT, rowbase, ldk, k0, n0, lane);
}
__device__ __forceinline__ void glds16(const void* gsrc, unsigned lds_dst) { unsigned keep;
    asm volatile("s_mov_b32 %0, m0\n\ts_mov_b32 m0, %2\n\ts_nop 0\n\tglobal_load_lds_dwordx4 %1, off\n\ts_mov_b32 m0, %0" : "=&s"(keep) : "v"(gsrc), "s"(lds_dst) : "memory"); }
__device__ __forceinline__ void glds16_nt(const void* gsrc, unsigned lds_dst) { unsigned keep;
    asm volatile("s_mov_b32 %0, m0\n\ts_mov_b32 m0, %2\n\ts_nop 0\n\tglobal_load_lds_dwordx4 %1, off nt\n\ts_mov_b32 m0, %0" : "=&s"(keep) : "v"(gsrc), "s"(lds_dst) : "memory"); }
__device__ __forceinline__ void conv_issue8(unsigned lds_scr, const float* W, int N, int k0, int n0, int lane) {
    const float* src = W + (size_t)(k0 + 8 * (lane >> 4)) * N + n0 + 4 * (lane & 15);
#pragma unroll
    for (int i = 0; i < 8; ++i) glds16_nt(src + (size_t)i * N, (unsigned)__builtin_amdgcn_readfirstlane(lds_scr + i * 1024));
}
__device__ __forceinline__ void conv_fetch8(f32x4 (&v)[8], const LAS unsigned char* scr, int lane) {
#pragma unroll
    for (int i = 0; i < 8; ++i) v[i] = *(const LAS f32x4*)(scr + i * 1024 + lane * 16);
}
__device__ __forceinline__ void conv_load8(f32x4 (&v)[8], const float* W, int N, int k0, int n0, int lane) {
    const float* src = W + (size_t)(k0 + 8 * (lane >> 4)) * N + n0 + 4 * (lane & 15);
#pragma unroll
    for (int i = 0; i < 8; ++i) v[i] = __builtin_nontemporal_load((const f32x4*)(src + (size_t)i * N));
}
__device__ __forceinline__ void conv_store8(const f32x4 (&v)[8], unsigned char* WT, size_t rowbase, int ldk, int k0, int lane) {
    unsigned char* dst = WT + (rowbase + 4 * (lane & 15)) * (size_t)ldk + k0 + 8 * (lane >> 4);
#pragma unroll
    for (int e = 0; e < 4; ++e) { u32x2 w; w.x = pk4_fp8(v[0][e] * W8_SCALE, v[1][e] * W8_SCALE, v[2][e] * W8_SCALE, v[3][e] * W8_SCALE); w.y = pk4_fp8(v[4][e] * W8_SCALE, v[5][e] * W8_SCALE, v[6][e] * W8_SCALE, v[7][e] * W8_SCALE);
        *(u32x2*)(dst + (size_t)e * ldk) = w; }
}
struct ConvJob { const float* gate; const float* up; const float* down; unsigned char* wgu; unsigned char* wd; };
constexpr int CV_PER_LAYER = 3 * 16 * 1024, CV_TOTAL = 4 * CV_PER_LAYER;
struct ConvItem { const float* W; unsigned char* WT; size_t rowbase; int N, ldk, k0, n0; };
__device__ __forceinline__ ConvItem cv_decode(const ConvJob& J, int it) {
    ConvItem c; const int L = it / CV_PER_LAYER, r0 = it % CV_PER_LAYER, fam = r0 >> 14, r = r0 & 16383, e = L * 16 + (r >> 10), q = r & 1023;
    if (fam < 2) { c.W = (fam ? J.up : J.gate) + (size_t)e * 1024 * 2048; c.N = 2048; c.k0 = (q >> 5) * 32; c.n0 = (q & 31) * 64; c.WT = J.wgu; c.ldk = 1024; c.rowbase = (size_t)e * 4096 + (c.n0 >> 7) * 256 + (c.n0 & 127) + (fam ? 128 : 0); }
    else { c.W = J.down + (size_t)e * 2048 * 1024; c.N = 1024; c.k0 = (q >> 4) * 32; c.n0 = (q & 15) * 64; c.WT = J.wd; c.ldk = 2048; c.rowbase = (size_t)e * 1024 + c.n0; }
    return c;
}
template <class RowBase>
__device__ __forceinline__ void conv_family(const Frame& F, const float* W, int K, int N, int nmat, bf16* WT, const RowBase& rb, int& base) {
    const int nblk = (N + 63) / 64, per = (K / 64) * nblk, total = per * nmat;
    const int gwr = F.G > 192 ? (F.gw + F.NGW - 192 * 8) % F.NGW : F.gw;
    const int first = (gwr + F.NGW - base % F.NGW) % F.NGW; base += total;
    for (int it = first; it < total; it += F.NGW) {
        const int mi = it / per, r = it % per, kb = r / nblk, nb = r % nblk;
        conv_item(W + (size_t)mi * K * N, N, WT, rb(mi, nb * 64), K, kb * 64, nb * 64, F.lane);
    }
}

__device__ __forceinline__ void ada_direct(const Frame& F, const Args& a, int l, int b0) {
    const int cg = F.bid - b0; if (cg < 0 || cg >= 192) return;
    LAS float* sc = (LAS float*)F.lds;
    LAS float* red = (LAS float*)(F.lds + 20480);
    for (int i = F.tid; i < 5 * D; i += 512) { const int c = i >> 10, k = i & 1023; const float x = (c == 0) ? a.in[7][k] : a.in[6][(c - 1) * D + k]; sc[i] = x / (1.f + __expf(-x)); }
    __syncthreads();
    const int col = F.tid & 31, kg = F.tid >> 5, n = cg * 32 + col;
    const float* w = a.in[8] + ((size_t)l * D + kg * 64) * 6144 + n;
    float acc[5] = {0.f, 0.f, 0.f, 0.f, 0.f};
#pragma unroll 16
    for (int k = 0; k < 64; ++k) { const float wv = w[(size_t)k * 6144];
#pragma unroll
        for (int c = 0; c < 5; ++c) acc[c] += sc[c * D + kg * 64 + k] * wv; }
#pragma unroll
    for (int c = 0; c < 5; ++c) red[(kg * 5 + c) * 32 + col] = acc[c];
    __syncthreads();
    if (F.tid < 160) { const int c = F.tid >> 5; float s = a.in[9][l * 6144 + n];
#pragma unroll
        for (int g = 0; g < 16; ++g) s += red[(g * 5 + c) * 32 + col];
        ((float*)(F.ws + WS_ADA))[(size_t)(l * 5 + c) * 6144 + n] = s; }
    __syncthreads();
}
__device__ __forceinline__ void phase_prologue(const Frame& F, const Args& a) {
    ada_direct(F, a, 0, 0);
    {
        float* R64 = (float*)(F.ws + WS_ROPE64); float* R32 = (float*)(F.ws + WS_ROPE32);
        for (int i = F.bid * 512 + F.tid; i < 2048 * 32; i += F.G * 512) { const int pos = i >> 5, j = i & 31; const double ang = (j < 16) ? (double)(pos >> 6) * INVF[j] : (double)(pos & 63) * INVF[j - 16];
            float s, c; sincos_d(ang, s, c); R64[i] = c; R64[2048 * 32 + i] = s; }
        for (int i = F.bid * 512 + F.tid; i < 2048 * 16; i += F.G * 512) { const int pos = i >> 4, j = i & 15; const double ang = (j < 8) ? (double)(pos >> 6) * INVF[2 * j] : (double)(pos & 63) * INVF[2 * (j - 8)];
            float s, c; sincos_d(ang, s, c); R32[i] = c; R32[2048 * 16 + i] = s; }
    }
    __syncthreads();
    for (int rep = 0; rep < MK_REP_CONV; ++rep) {
    bf16* WQKV = (bf16*)(F.ws + WS_WQKV); bf16* WO = (bf16*)(F.ws + WS_WO);
    int cvb = 0;
    conv_family(F, a.in[12], 1024, 1536, 2, WQKV, [](int mi, int n0) { return (size_t)(mi == 0 ? 0 : 2) * 1536 + n0; }, cvb);
    conv_family(F, a.in[16], 1024, 1536, 1, WQKV, [](int mi, int n0) { return (size_t)1536 + n0; }, cvb);
    conv_family(F, a.in[15], 1024, 1024, 2, WO, [](int mi, int n0) { return (size_t)(mi == 0 ? 0 : 3) * 1024 + n0; }, cvb);
    conv_family(F, a.in[18], 1024, 1024, 1, WO, [](int mi, int n0) { return (size_t)1024 + n0; }, cvb);
    conv_family(F, a.in[24], 1024, 1024, 1, WO, [](int mi, int n0) { return (size_t)2048 + n0; }, cvb);
    conv_family(F, a.in[19], 1024, 416, 1, (bf16*)(F.ws + WS_WDN), [](int mi, int n0) { return (size_t)n0; }, cvb);
    conv_family(F, a.in[21], 256, 1536, 1, (bf16*)(F.ws + WS_WUQ), [](int mi, int n0) { return (size_t)n0; }, cvb);
    conv_family(F, a.in[23], 128, 2048, 1, (bf16*)(F.ws + WS_WUKV), [](int mi, int n0) { return (size_t)n0; }, cvb);
    }
    { u32x4* z = (u32x4*)((bf16*)(F.ws + WS_WDN) + 416 * 1024); for (int i = F.bid * 512 + F.tid; i < 96 * 1024 / 8; i += F.G * 512) z[i] = (u32x4){0u, 0u, 0u, 0u}; }
}
__device__ __forceinline__ void phase_ada_reduce(const Frame& F, const Args& a) {
    const float* ADAP = (const float*)(F.ws + WS_ADAP); float* ADA = (float*)(F.ws + WS_ADA);
    for (int i = F.bid * 512 + F.tid; i < 4 * 5 * 6144; i += F.G * 512) {
        const int l = i / 30720, r = i % 30720, c = r / 6144, n = r % 6144;
        float s = a.in[9][l * 6144 + n];
        for (int kc = 0; kc < 16; ++kc) s += ADAP[((size_t)(kc * 4 + l) * 5 + c) * 6144 + n];
        ADA[i] = s;
    }
}
__device__ __forceinline__ const float* ada_vec(const Frame& F, int l, int c, int k) { return (const float*)(F.ws + WS_ADA) + ((size_t)(l * 5 + c) * 6 + k) * D; }

__device__ __forceinline__ void phase_mod0(const Frame& F, const Args& a) {
    bf16* X = (bf16*)(F.ws + WS_X); bf16* H = (bf16*)(F.ws + WS_H);
    const int RPW = (NTOK + F.NGW - 1) / F.NGW, rbeg = F.gw * RPW, rend = (rbeg + RPW < NTOK) ? rbeg + RPW : NTOK; int ccur = -1;
    f32x4 shv[4], scv[4];
#pragma unroll
    for (int j = 0; j < 4; ++j) { shv[j] = (f32x4){0.f, 0.f, 0.f, 0.f}; scv[j] = shv[j]; }
    for (int row = rbeg; row < rend; ++row) {
        const int c = cond_of(row);
        if (c != ccur) { ccur = c; const f32x4* sh = (const f32x4*)ada_vec(F, 0, c, 0); const f32x4* sc = (const f32x4*)ada_vec(F, 0, c, 1);
#pragma unroll
            for (int j = 0; j < 4; ++j) { shv[j] = sh[F.lane + 64 * j]; scv[j] = sc[F.lane + 64 * j] + 1.f; } }
        const f32x4* xi = (const f32x4*)((row < NCTX) ? a.in[0] + (size_t)row * D : a.in[1] + (size_t)(row - NCTX) * D);
#pragma unroll
        for (int j = 0; j < 4; ++j) { const int q = F.lane + 64 * j; const f32x4 x = xi[q]; ((u32x2*)(X + (size_t)row * D))[q] = pk4(x); ((u32x2*)(H + (size_t)row * D))[q] = pk4(x * scv[j] + shv[j]); }
    }
}

__device__ __forceinline__ size_t kb_off(int HK, int DK, bool lat, int b, int hk) { return lat ? (size_t)16 * HK * 256 * DK + ((size_t)(b * HK + hk) * 2560) * DK : ((size_t)(b * HK + hk) * 256) * DK; }
__device__ __forceinline__ size_t vt_off(int HK, bool lat, int b, int hk) { return lat ? (size_t)16 * HK * 64 * 256 + ((size_t)(b * HK + hk) * 64) * 2560 : ((size_t)(b * HK + hk) * 64) * 256; }
__device__ __forceinline__ int swap23(int k) { return (k & ~12) | ((k & 4) << 1) | ((k & 8) >> 1); }
__device__ __forceinline__ void vt_store(bf16* dst, const float (&vr)[64]) {
#pragma unroll
    for (int q = 0; q < 8; ++q) { const int b = 16 * (q >> 1) + 4 * (q & 1); u32x4 w; w.x = cvtpk(vr[b], vr[b + 1]); w.y = cvtpk(vr[b + 2], vr[b + 3]); w.z = cvtpk(vr[b + 8], vr[b + 9]); w.w = cvtpk(vr[b + 10], vr[b + 11]); ((u32x4*)dst)[q] = w; }
}

__device__ __forceinline__ void phase_kv_post(const Frame& F, const Args& a, int kind, int j, int slot, int gw, int NGW) {
    const bf16* QKV = (const bf16*)(F.ws + WS_QKV); bf16* Kb = (bf16*)(F.ws + WS_KB); bf16* Vt = (bf16*)(F.ws + WS_VT);
    const float* R64 = (const float*)(F.ws + WS_ROPE64);
    int lane_ = F.lane; asm volatile("" : "+v"(lane_)); const int lane = lane_, l16 = lane & 15, hk = lane >> 4;
    for (int it = gw * 64 + lane; it < 16 * 8192; it += NGW * 64) {
        const int bh = it >> 13, q = it & 8191, b = bh >> 2, hc = bh & 3;
        const f32x4 v = *(const f32x4*)(a.in[2] + ((size_t)((b * 3 + slot) * 4 + hc) * 512) * 64 + 4 * q);
        u32x2 w; w.x = cvtpk(v[0], v[1]); w.y = cvtpk(v[2], v[3]);
        *(u32x2*)(Kb + kb_off(4, 64, true, b, hc) + (size_t)2048 * 64 + 4 * q) = w;
    }
    for (int it = gw; it < 4 * 4 * 8; it += NGW) {
        const int b = it >> 5, hv = (it >> 3) & 3, tl = it & 7;
        float vr[64];
#pragma unroll
        for (int i = 0; i < 64; ++i) vr[i] = a.in[3][((size_t)((b * 3 + slot) * 4 + hv) * 512 + tl * 64 + i) * 64 + lane];
        vt_store(Vt + vt_off(4, true, b, hv) + (size_t)lane * 2560 + 2048 + tl * 64, vr);
    }
    f32x4 kn = (f32x4){1.f, 1.f, 1.f, 1.f}; if (kind == 0) kn = *(const f32x4*)(a.in[14] + j * 64 + 4 * l16);
    {
        const int RPW = (NTOK + NGW - 1) / NGW, rbeg = gw * RPW, rend = (rbeg + RPW < NTOK) ? rbeg + RPW : NTOK;
        u32x2 wqn = (u32x2){0u, 0u}; f32x4 cn = (f32x4){0.f, 0.f, 0.f, 0.f}, snn = cn;
        if (rbeg < rend) { wqn = *(const u32x2*)(QKV + (size_t)rbeg * 1536 + 1024 + 4 * lane);
            if (rbeg >= NCTX) { const int s0 = (rbeg - NCTX) & 2047; cn = *(const f32x4*)(R64 + s0 * 32 + 4 * (lane & 7)); snn = *(const f32x4*)(R64 + 2048 * 32 + s0 * 32 + 4 * (lane & 7)); } }
        for (int t = rbeg; t < rend; ++t) {
            const bool lat = t >= NCTX; const int b = lat ? (t - NCTX) >> 11 : t >> 8, s = lat ? (t - NCTX) & 2047 : t & 255;
            const u32x2 wq = wqn; const f32x4 c = cn, sn = snn;
            if (t + 1 < rend) { wqn = *(const u32x2*)(QKV + (size_t)(t + 1) * 1536 + 1024 + 4 * lane);
                if (t + 1 >= NCTX) { const int s1 = (t + 1 - NCTX) & 2047; cn = *(const f32x4*)(R64 + s1 * 32 + 4 * (lane & 7)); snn = *(const f32x4*)(R64 + 2048 * 32 + s1 * 32 + 4 * (lane & 7)); } }
            f32x4 v = bf4(wq);
            if (kind == 0) { float ss = (v[0] * v[0] + v[1] * v[1]) + (v[2] * v[2] + v[3] * v[3]); ss = sum16(ss);
                v = v * (__builtin_amdgcn_rsqf(ss * (1.f / 64.f) + 1e-6f)) * kn; }
            if (lat) { f32x4 p; p[0] = dppf<DPP_X8>(v[0]); p[1] = dppf<DPP_X8>(v[1]); p[2] = dppf<DPP_X8>(v[2]); p[3] = dppf<DPP_X8>(v[3]);
                v = (lane & 8) ? v * c + p * sn : v * c - p * sn; }
            *(u32x2*)(Kb + kb_off(4, 64, lat, b, hk) + (size_t)s * 64 + 4 * l16) = pk4(v);
            if (!lat) *(f32x4*)(F.out + OFF_NK + ((size_t)((b * 3 + slot) * 4 + hk) * 256 + s) * 64 + 4 * l16) = v;
        }
    }
    for (int it = gw; it < (NTOK / 64) * 4; it += NGW) {
        const int tt = it >> 2, hv = it & 3, t0 = tt * 64; const bool lat = t0 >= NCTX; const int b = lat ? (t0 - NCTX) >> 11 : t0 >> 8, s0 = lat ? (t0 - NCTX) & 2047 : t0 & 255;
        float vr[64];
#pragma unroll
        for (int i = 0; i < 64; ++i) vr[i] = bf2f(QKV[(size_t)(t0 + i) * 1536 + 1280 + hv * 64 + lane]);
        vt_store(Vt + vt_off(4, lat, b, hv) + (size_t)lane * (lat ? 2560 : 256) + s0, vr);
        if (!lat) {
#pragma unroll
            for (int i = 0; i < 64; ++i) F.out[OFF_NV + ((size_t)((b * 3 + slot) * 4 + hv) * 256 + s0 + i) * 64 + lane] = vr[i]; }
    }
}

__device__ __forceinline__ void phase_mla_post1(const Frame& F, const Args& a) {
    const float* DWN = (const float*)(F.ws + WS_QKV); bf16* QA = (bf16*)(F.ws + WS_QA); bf16* CKVA = (bf16*)(F.ws + WS_CKVA); bf16* Kb = (bf16*)(F.ws + WS_KB);
    const float* R32 = (const float*)(F.ws + WS_ROPE32);
    int lane_ = F.lane; asm volatile("" : "+v"(lane_)); const int lane = lane_;
    const f32x4 qn = ((const f32x4*)a.in[20])[lane]; const f32x4 kvn = ((const f32x4*)a.in[22])[lane & 31];
    for (int t = F.gw; t < NTOK + 2048; t += F.NGW) {
        if (t < NTOK) {
            const bool lat = t >= NCTX; const int b = lat ? (t - NCTX) >> 11 : t >> 8, s = lat ? (t - NCTX) & 2047 : t & 255;
            const float* row = DWN + (size_t)t * 512;
            { const f32x4 v = ((const f32x4*)row)[lane] + ((const f32x4*)(row + DWN_PART))[lane]; const float ss = wave_sum(v[0] * v[0] + v[1] * v[1] + v[2] * v[2] + v[3] * v[3]); const float r = __builtin_amdgcn_rsqf(ss * (1.f / 256.f) + 1e-6f);
              const f32x4 o = v * r * qn; u32x2 w; w.x = cvtpk(o[0], o[1]); w.y = cvtpk(o[2], o[3]); ((u32x2*)(QA + (size_t)t * 256))[lane] = w; }
            { f32x4 v = (f32x4){0.f, 0.f, 0.f, 0.f}; if (lane < 32) v = ((const f32x4*)(row + 256))[lane] + ((const f32x4*)(row + DWN_PART + 256))[lane];
              const float ss = wave_sum(v[0] * v[0] + v[1] * v[1] + v[2] * v[2] + v[3] * v[3]); const float r = __builtin_amdgcn_rsqf(ss * (1.f / 128.f) + 1e-6f);
              const f32x4 o = v * r * kvn;
              if (lane < 32) { u32x2 w; w.x = cvtpk(o[0], o[1]); w.y = cvtpk(o[2], o[3]); ((u32x2*)(CKVA + (size_t)t * 128))[lane] = w; if (!lat) ((f32x4*)(F.out + OFF_CKV + (size_t)t * 128))[lane] = o; } }
            { float x = (lane < 32) ? row[384 + lane] + row[DWN_PART + 384 + lane] : 0.f;
              if (!lat && lane < 32) F.out[OFF_KPE + (size_t)t * 32 + lane] = x;
              if (lat) { const float p = __shfl_xor(x, 16); const int i = lane & 15; const float c = R32[s * 16 + i], sn = R32[2048 * 16 + s * 16 + i]; x = ((lane & 31) < 16) ? x * c - p * sn : x * c + p * sn; }
              const bf16 xb = f2bf(x);
              if (lane < 32) { for (int h = 0; h < 16; ++h) Kb[kb_off(16, 96, lat, b, h) + (size_t)s * 96 + 64 + lane] = xb; } }
        } else {
            const int r = t - NTOK, b = r >> 9, s = r & 511;
            if (lane < 32) { const f32x4 v = ((const f32x4*)(a.in[4] + (size_t)r * 128))[lane]; u32x2 w; w.x = cvtpk(v[0], v[1]); w.y = cvtpk(v[2], v[3]); ((u32x2*)(CKVA + (size_t)t * 128))[lane] = w;
                const bf16 xb = f2bf(a.in[5][(size_t)r * 32 + lane]);
                for (int h = 0; h < 16; ++h) Kb[kb_off(16, 96, true, b, h) + (size_t)(2048 + s) * 96 + 64 + lane] = xb; }
        }
    }
}
__device__ __forceinline__ void mla_row(int row, bool& lat, int& b, int& s) {
    if (row < NCTX) { lat = false; b = row >> 8; s = row & 255; } else if (row < NTOK) { lat = true; b = (row - NCTX) >> 11; s = (row - NCTX) & 2047; } else { lat = true; b = (row - NTOK) >> 9; s = 2048 + ((row - NTOK) & 511); }
}
struct EpiUkv { bf16* Kb; bf16* VRAW; static constexpr bool PERM = false, AFTER_DRAIN = false;
    __device__ __forceinline__ void operator()(const f32x4 (&acc)[2][2][4][2], const Unit& u, int wr, int wc, int fr, int fq) const {
#pragma unroll
        for (int ai = 0; ai < 2; ++ai)
#pragma unroll
            for (int m = 0; m < 4; ++m) { const int row = u.pm * 256 + ai * 128 + wr * 64 + m * 16 + fr; bool lat; int b, s; mla_row(row, lat, b, s);
#pragma unroll
                for (int bj = 0; bj < 2; ++bj) { const int h = 2 * u.pn + bj;
                    if (wc < 2) { bf16* kp = Kb + kb_off(16, 96, lat, b, h) + (size_t)s * 96 + wc * 32 + 4 * fq;
#pragma unroll
                        for (int n = 0; n < 2; ++n) { const f32x4 v = acc[ai][bj][m][n]; u32x2 w; w.x = cvtpk(v[0], v[1]); w.y = cvtpk(v[2], v[3]); *(u32x2*)(kp + n * 16) = w; } }
                    else { bf16* vp = VRAW + (size_t)row * 1024 + h * 64 + (wc - 2) * 32 + 4 * fq;
#pragma unroll
                        for (int n = 0; n < 2; ++n) { const f32x4 v = acc[ai][bj][m][n]; u32x2 w; w.x = cvtpk(v[0], v[1]); w.y = cvtpk(v[2], v[3]); *(u32x2*)(vp + n * 16) = w; } } } }
    }
};
__device__ __forceinline__ void phase_mla_post2(const Frame& F, const Args& a) {
    const bf16* VRAW = (const bf16*)(F.ws + WS_KVRAW); bf16* Vt = (bf16*)(F.ws + WS_VT);
    int lane_ = F.lane; asm volatile("" : "+v"(lane_)); const int lane = lane_;
    for (int it = F.gw; it < 224 * 16; it += F.NGW) {
        const int tile = it >> 4, h = it & 15, row0 = tile * 64; bool lat; int b, s0; mla_row(row0, lat, b, s0);
        float vr[64];
#pragma unroll
        for (int i = 0; i < 64; ++i) vr[i] = bf2f(VRAW[(size_t)(row0 + i) * 1024 + h * 64 + lane]);
        vt_store(Vt + vt_off(16, lat, b, h) + (size_t)lane * (lat ? 2560 : 256) + s0, vr);
    }
}

__device__ __forceinline__ int crow(int r, int hi) { return (r & 3) + 8 * (r >> 2) + 4 * hi; }
__device__ __forceinline__ float max3f(float a, float b, float c) { float r; asm("v_max3_f32 %0, %1, %2, %3" : "=v"(r) : "v"(a), "v"(b), "v"(c)); return r; }
constexpr float THRL = 5.f;
template <int DK, int KIND>
__device__ __forceinline__ void attn_phase(const Frame& F, const Args& a, int j, const ConvJob& J, int& cv_it, int cv_need, int cv_cap) {
    constexpr int HK = (DK == 96) ? 16 : 4, CH = (DK == 96) ? 64 : 128, KPB = (DK + 8) * 2, VPB = (CH + 8) * 2, NDS = DK / 16, KCH = DK / 8;
    constexpr int NKC = CH * KCH, NKI = (NKC + 511) / 512, NVI = 64 * (CH / 8) / 512, NSUB = CH / 64;
    constexpr float QS = (DK == 96) ? MLA_QS : GQA_QS;
    const bf16* QRAW = (const bf16*)(F.ws + WS_QKV); const bf16* Kb = (const bf16*)(F.ws + WS_KB); const bf16* Vt = (const bf16*)(F.ws + WS_VT); bf16* O = (bf16*)(F.ws + WS_O);
    LAS unsigned char* Ks = F.lds; LAS unsigned char* Vs = F.lds + 2 * CH * KPB;
    LAS unsigned char* cvs = F.lds + 2 * CH * KPB + 2 * 64 * VPB + F.wave * 8192;
    const unsigned cvs_addr = (unsigned)(uintptr_t)cvs;
    int tid_ = F.tid; asm volatile("" : "+v"(tid_));
    const int tid = tid_, lane = tid & 63, wid = F.wave, r32 = lane & 31, hi = lane >> 5;
    constexpr bool CVP = true;
    int itc = 0;
    for (int un = F.bid; un < 768; un += F.G) {
        bool lat; int b, hq, q0, S, tok0;
        if (un < 512) { lat = true; b = un >> 7; hq = (un >> 3) & 15; q0 = (un & 7) * 256; S = 2560; tok0 = NCTX + b * 2048 + q0; }
        else { const int v = un - 512; lat = false; b = v >> 4; hq = v & 15; q0 = 0; S = 256; tok0 = b * 256; }
        const int hk = (HK == 4) ? (hq >> 2) : hq;
        const bf16* Kg = Kb + kb_off(HK, DK, lat, b, hk); const bf16* Vg = Vt + vt_off(HK, lat, b, hk);
        const int n2 = lat ? 512 / CH : 0; int lo = 0, hiK = lat ? 2048 : 256;
        const bool masked = (KIND == 1) && lat;
        if (masked) { lo = q0 - 128; lo = lo < 0 ? 0 : (lo > 1536 ? 1536 : lo); hiK = lo + 512; }
        const int nch = n2 + (hiK - lo) / CH;
        bf16x8 qf[NDS];
        {
            const bf16* qrow = QRAW + (size_t)(tok0 + wid * 32 + r32) * 1536 + hq * DK + 8 * hi;
            f32x4 v[NDS][2];
#pragma unroll
            for (int ds = 0; ds < NDS; ++ds) { const u32x4 wq = *(const u32x4*)(qrow + 16 * ds);
                v[ds][0] = (f32x4){__uint_as_float(wq.x << 16), __uint_as_float(wq.x & 0xffff0000u), __uint_as_float(wq.y << 16), __uint_as_float(wq.y & 0xffff0000u)};
                v[ds][1] = (f32x4){__uint_as_float(wq.z << 16), __uint_as_float(wq.z & 0xffff0000u), __uint_as_float(wq.w << 16), __uint_as_float(wq.w & 0xffff0000u)}; }
            if (KIND == 0) {
                float ss = 0.f;
#pragma unroll
                for (int ds = 0; ds < NDS; ++ds)
#pragma unroll
                    for (int h2 = 0; h2 < 2; ++h2) ss += (v[ds][h2][0] * v[ds][h2][0] + v[ds][h2][1] * v[ds][h2][1]) + (v[ds][h2][2] * v[ds][h2][2] + v[ds][h2][3] * v[ds][h2][3]);
                ss += __shfl_xor(ss, 32);
                const float r = __builtin_amdgcn_rsqf(ss * (1.f / 64.f) + 1e-6f);
                const float* qn = a.in[13] + j * 64 + 8 * hi;
#pragma unroll
                for (int ds = 0; ds < NDS; ++ds) { v[ds][0] = v[ds][0] * r * *(const f32x4*)(qn + 16 * ds); v[ds][1] = v[ds][1] * r * *(const f32x4*)(qn + 16 * ds + 4); }
            }
            if (lat) {
                const int s = q0 + wid * 32 + r32;
                if (DK == 64) {
                    const float* R64 = (const float*)(F.ws + WS_ROPE64);
#pragma unroll
                    for (int ds = 0; ds < 2; ++ds)
#pragma unroll
                        for (int h2 = 0; h2 < 2; ++h2) { const int idx = s * 32 + 16 * ds + 8 * hi + 4 * h2; const f32x4 c = *(const f32x4*)(R64 + idx), sn = *(const f32x4*)(R64 + 2048 * 32 + idx);
                            const f32x4 xa = v[ds][h2], xb = v[ds + 2][h2]; v[ds][h2] = xa * c - xb * sn; v[ds + 2][h2] = xb * c + xa * sn; }
                } else {
                    const float* R32 = (const float*)(F.ws + WS_ROPE32);
#pragma unroll
                    for (int h2 = 0; h2 < 2; ++h2) { const int idx = s * 16 + 8 * hi + 4 * h2; const f32x4 c = *(const f32x4*)(R32 + idx), sn = *(const f32x4*)(R32 + 2048 * 16 + idx);
                        const f32x4 xa = v[NDS - 2][h2], xb = v[NDS - 1][h2]; v[NDS - 2][h2] = xa * c - xb * sn; v[NDS - 1][h2] = xb * c + xa * sn; }
                }
            }
#pragma unroll
            for (int ds = 0; ds < NDS; ++ds) { u32x4 w; w.x = cvtpk(v[ds][0][0] * QS, v[ds][0][1] * QS); w.y = cvtpk(v[ds][0][2] * QS, v[ds][0][3] * QS); w.z = cvtpk(v[ds][1][0] * QS, v[ds][1][1] * QS); w.w = cvtpk(v[ds][1][2] * QS, v[ds][1][3] * QS);
                qf[ds] = __builtin_bit_cast(bf16x8, w); }
        }
        const int qw0 = q0 + wid * 32, qpos = qw0 + r32;
        float mhat = 0.f, l_run = 0.f; bool first = true; f32x16 o0, o1, negm;
#pragma unroll
        for (int r = 0; r < 16; ++r) { o0[r] = 0.f; o1[r] = 0.f; negm[r] = 0.f; }
        u32x4 kreg[NKI], vreg[NVI];
#define ATT_KEY0(c) ((c) < n2 ? 2048 + CH * (c) : lo + CH * ((c) - n2))
#define ATT_LOAD(c) do { const int k0_ = ATT_KEY0(c); \
            _Pragma("unroll") for (int i_ = 0; i_ < NKI; ++i_) { const int cc_ = tid + 512 * i_; if (NKC % 512 == 0 || cc_ < NKC) kreg[i_] = *(const u32x4*)(Kg + (size_t)(k0_ + cc_ / KCH) * DK + (cc_ % KCH) * 8); } \
            _Pragma("unroll") for (int i_ = 0; i_ < NVI; ++i_) { const int cc_ = tid + 512 * i_; vreg[i_] = *(const u32x4*)(Vg + (size_t)(cc_ / (CH / 8)) * S + k0_ + (cc_ % (CH / 8)) * 8); } } while (0)
#define ATT_STORE(buf) do { \
            _Pragma("unroll") for (int i_ = 0; i_ < NKI; ++i_) { const int cc_ = tid + 512 * i_; if (NKC % 512 == 0 || cc_ < NKC) *(LAS u32x4*)(Ks + (buf) * CH * KPB + (cc_ / KCH) * KPB + (cc_ % KCH) * 16) = kreg[i_]; } \
            _Pragma("unroll") for (int i_ = 0; i_ < NVI; ++i_) { const int cc_ = tid + 512 * i_; *(LAS u32x4*)(Vs + (buf) * 64 * VPB + (cc_ / (CH / 8)) * VPB + (cc_ % (CH / 8)) * 16) = vreg[i_]; } } while (0)
        ATT_LOAD(0);
        __syncthreads();
        ATT_STORE(0);
        __syncthreads();
        for (int c = 0; c < nch; ++c) {
            const int cur = c & 1;
            if (c + 1 < nch) ATT_LOAD(c + 1);
            const bool cv = CVP && ((CH == 128) || ((itc++ & 1) == 0)) && cv_it < cv_cap;
            if (cv) { const ConvItem ci = cv_decode(J, cv_it); conv_issue8(cvs_addr, ci.W, ci.N, ci.k0, ci.n0, lane); }
            const int key0c = ATT_KEY0(c);
            for (int sub = 0; sub < NSUB; ++sub) {
                const int key0 = key0c + 64 * sub;
                if (masked && c >= n2 && (key0 > qw0 + 159 || key0 + 63 < qw0 - 128)) continue;
                f32x16 p0, p1;
                const LAS unsigned char* kb_ = Ks + cur * CH * KPB + (sub * 64 + r32) * KPB + hi * 16;
                const LAS unsigned char* vb_ = Vs + cur * 64 * VPB + r32 * VPB + sub * 128 + hi * 16;
                bf16x8 kf[2 * NDS], vf[8];
#pragma unroll
                for (int ds = 0; ds < NDS; ++ds) { kf[2 * ds] = *(const LAS bf16x8*)(kb_ + ds * 32); kf[2 * ds + 1] = *(const LAS bf16x8*)(kb_ + 32 * KPB + ds * 32); }
#pragma unroll
                for (int s = 0; s < 4; ++s) { vf[2 * s] = *(const LAS bf16x8*)(vb_ + s * 32); vf[2 * s + 1] = *(const LAS bf16x8*)(vb_ + 32 * VPB + s * 32); }
                __builtin_amdgcn_sched_barrier(0);
#pragma unroll
                for (int ds = 0; ds < NDS; ++ds) {
                    if (ds == 0) { p0 = __builtin_amdgcn_mfma_f32_32x32x16_bf16(kf[0], qf[0], negm, 0, 0, 0); p1 = __builtin_amdgcn_mfma_f32_32x32x16_bf16(kf[1], qf[0], negm, 0, 0, 0); }
                    else { p0 = __builtin_amdgcn_mfma_f32_32x32x16_bf16(kf[2 * ds], qf[ds], p0, 0, 0, 0); p1 = __builtin_amdgcn_mfma_f32_32x32x16_bf16(kf[2 * ds + 1], qf[ds], p1, 0, 0, 0); }
                }
                if (masked && c >= n2) {
                    const int kbase = key0 - qpos;
#pragma unroll
                    for (int r = 0; r < 16; ++r) { const int d0 = kbase + crow(r, hi), d1 = d0 + 32;
                        if (d0 > 128 || d0 < -128) p0[r] = -INFINITY;
                        if (d1 > 128 || d1 < -128) p1[r] = -INFINITY; }
                }
                float rm;
                { float ma = max3f(p0[0], p0[1], p1[0]), mb = max3f(p0[2], p0[3], p1[1]); ma = max3f(ma, p1[2], p1[3]);
#pragma unroll
                  for (int r = 4; r < 16; r += 4) { ma = max3f(ma, p0[r], p0[r + 1]); mb = max3f(mb, p0[r + 2], p0[r + 3]); ma = max3f(ma, p1[r], p1[r + 1]); mb = max3f(mb, p1[r + 2], p1[r + 3]); }
                  const float m2 = max3f(ma, mb, mb);
                  auto rr = __builtin_amdgcn_permlane32_swap(__float_as_uint(m2), __float_as_uint(m2), false, false);
                  rm = max3f(__uint_as_float(rr[0]), __uint_as_float(rr[1]), m2); }
                if (first || __any(rm > THRL)) {
                    const float dl = first ? rm : fmaxf(rm, 0.f);
                    mhat += dl;
#pragma unroll
                    for (int r = 0; r < 16; ++r) { p0[r] -= dl; p1[r] -= dl; }
                    if (!first) { const float sc = __builtin_amdgcn_exp2f(-dl); l_run *= sc;
#pragma unroll
                        for (int r = 0; r < 16; ++r) { o0[r] *= sc; o1[r] *= sc; } }
#pragma unroll
                    for (int r = 0; r < 16; ++r) negm[r] = -mhat;
                    first = false;
                }
                float ls0 = 0.f, ls1 = 0.f;
#pragma unroll
                for (int r = 0; r < 16; ++r) { p0[r] = __builtin_amdgcn_exp2f(p0[r]); p1[r] = __builtin_amdgcn_exp2f(p1[r]); ls0 += p0[r]; ls1 += p1[r]; }
                l_run += ls0 + ls1;
                bf16x8 pb[4];
#pragma unroll
                for (int s = 0; s < 4; ++s) { u32x4 w;
                    if (s < 2) { w.x = cvtpk(p0[8 * s], p0[8 * s + 1]); w.y = cvtpk(p0[8 * s + 2], p0[8 * s + 3]); w.z = cvtpk(p0[8 * s + 4], p0[8 * s + 5]); w.w = cvtpk(p0[8 * s + 6], p0[8 * s + 7]); }
                    else { const int q = s - 2; w.x = cvtpk(p1[8 * q], p1[8 * q + 1]); w.y = cvtpk(p1[8 * q + 2], p1[8 * q + 3]); w.z = cvtpk(p1[8 * q + 4], p1[8 * q + 5]); w.w = cvtpk(p1[8 * q + 6], p1[8 * q + 7]); }
                    pb[s] = __builtin_bit_cast(bf16x8, w); }
#pragma unroll
                for (int s = 0; s < 4; ++s) {
                    o0 = __builtin_amdgcn_mfma_f32_32x32x16_bf16(vf[2 * s], pb[s], o0, 0, 0, 0);
                    o1 = __builtin_amdgcn_mfma_f32_32x32x16_bf16(vf[2 * s + 1], pb[s], o1, 0, 0, 0);
                }
            }
            if (c + 1 < nch) ATT_STORE(cur ^ 1);
            if (cv) { asm volatile("s_waitcnt vmcnt(0)" ::: "memory"); f32x4 cvv[8]; conv_fetch8(cvv, cvs, lane); const ConvItem ci = cv_decode(J, cv_it); conv_store8(cvv, ci.WT, ci.rowbase, ci.ldk, ci.k0, lane); cv_it += F.NGW; }
            __syncthreads();
        }
#undef ATT_KEY0
#undef ATT_LOAD
#undef ATT_STORE
        float l = l_run + __shfl_xor(l_run, 32);
        if (KIND == 1) l += __builtin_amdgcn_exp2f(a.in[17][hq] * LOG2E - mhat);
        const float inv = 1.f / l;
        bf16* op = O + (size_t)(tok0 + wid * 32 + r32) * 1024 + hq * 64 + 4 * hi;
#pragma unroll
        for (int g = 0; g < 4; ++g) {
            u32x2 w0, w1; w0.x = cvtpk(o0[4 * g] * inv, o0[4 * g + 1] * inv); w0.y = cvtpk(o0[4 * g + 2] * inv, o0[4 * g + 3] * inv);
            w1.x = cvtpk(o1[4 * g] * inv, o1[4 * g + 1] * inv); w1.y = cvtpk(o1[4 * g + 2] * inv, o1[4 * g + 3] * inv);
            *(u32x2*)(op + 8 * g) = w0; *(u32x2*)(op + 32 + 8 * g) = w1;
        }
    }
    for (; cv_it < cv_need; cv_it += 2 * F.NGW) {
        f32x4 v0[8], v1[8]; const ConvItem c0 = cv_decode(J, cv_it); conv_load8(v0, c0.W, c0.N, c0.k0, c0.n0, lane);
        const bool two = cv_it + F.NGW < CV_TOTAL; ConvItem c1 = c0; if (two) { c1 = cv_decode(J, cv_it + F.NGW); conv_load8(v1, c1.W, c1.N, c1.k0, c1.n0, lane); }
        conv_store8(v0, c0.WT, c0.rowbase, c0.ldk, c0.k0, lane); if (two) conv_store8(v1, c1.WT, c1.rowbase, c1.ldk, c1.k0, lane); }
}
#if MK_CHECK
template <int DK, int KIND>
__device__ __forceinline__ void check_attn(const Frame& F, const Args& a, int j, int id) {
    constexpr int HK = (DK == 96) ? 16 : 4; constexpr float QS = (DK == 96) ? MLA_QS : GQA_QS;
    const bf16* QRAW = (const bf16*)(F.ws + WS_QKV); const bf16* Kb = (const bf16*)(F.ws + WS_KB); const bf16* Vt = (const bf16*)(F.ws + WS_VT); const bf16* O = (const bf16*)(F.ws + WS_O);
    LAS float* scs = (LAS float*)(F.lds + F.wave * 12288); LAS float* qs = scs + 2560;
    const int lane = F.lane;
    const unsigned hsh = hash_u(F.gw * 2654435761u + id);
    const int t = (F.gw & 1) ? (hsh % NCTX) : NCTX + (hsh % NLAT), hq = (hsh >> 16) & 15;
    const bool lat = t >= NCTX; const int b = lat ? (t - NCTX) >> 11 : t >> 8, s = lat ? (t - NCTX) & 2047 : t & 255, S = lat ? 2560 : 256;
    const int hk = (HK == 4) ? (hq >> 2) : hq;
    const bf16* Kg = Kb + kb_off(HK, DK, lat, b, hk); const bf16* Vg = Vt + vt_off(HK, lat, b, hk); const bf16* q = QRAW + (size_t)t * 1536 + hq * DK;
    {
        float x = bf2f(q[lane]);
        if (KIND == 0) { const float ss = wave_sum(x * x); x = x * __builtin_amdgcn_rsqf(ss * (1.f / 64.f) + 1e-6f) * a.in[13][j * 64 + lane]; }
        if (DK == 64 && lat) { const float* R64 = (const float*)(F.ws + WS_ROPE64); const float p = __shfl_xor(x, 32); const int i = lane & 31; const float c = R64[s * 32 + i], sn = R64[2048 * 32 + s * 32 + i]; x = (lane < 32) ? x * c - p * sn : x * c + p * sn; }
        qs[lane] = bf2f(f2bf(x * QS));
        if (DK == 96) { float y = (lane < 32) ? bf2f(q[64 + lane]) : 0.f;
            if (lat) { const float* R32 = (const float*)(F.ws + WS_ROPE32); const float p = __shfl_xor(y, 16); const int i = lane & 15; const float c = R32[s * 16 + i], sn = R32[2048 * 16 + s * 16 + i]; y = ((lane & 31) < 16) ? y * c - p * sn : y * c + p * sn; }
            if (lane < 32) qs[64 + lane] = bf2f(f2bf(y * QS)); }
        asm volatile("s_waitcnt lgkmcnt(0)" ::: "memory");
    }
    float mx = -1e30f;
    for (int jk = lane; jk < S; jk += 64) {
        float sc = 0.f; for (int d = 0; d < DK; ++d) sc += qs[d] * bf2f(Kg[(size_t)jk * DK + d]);
        if (KIND == 1 && lat && jk < 2048 && (jk - s > 128 || jk - s < -128)) sc = -INFINITY;
        scs[jk] = sc; mx = fmaxf(mx, sc);
    }
    mx = wave_max(mx);
    asm volatile("s_waitcnt lgkmcnt(0)" ::: "memory");
    float l = 0.f, o = 0.f;
    for (int jk = 0; jk < S; ++jk) { const float p = __builtin_amdgcn_exp2f(scs[jk] - mx); l += p; o += bf2f(f2bf(p)) * bf2f(Vg[(size_t)lane * S + swap23(jk)]); }
    if (KIND == 1) l += __builtin_amdgcn_exp2f(a.in[17][hq] * LOG2E - mx);
    o /= l;
    const float got = bf2f(O[(size_t)t * 1024 + hq * 64 + lane]);
    if (!close_enough(got, o, 0.03f, 0.01f)) CHK_FAIL(F, id);
    asm volatile("s_waitcnt lgkmcnt(0)" ::: "memory");
}
template <class Fn>
__device__ __forceinline__ void check_gemm_f32(const Frame& F, const bf16* A, const bf16* Bt, int M, int N, int K, const float* C, int ldc, int id) {
    for (int sidx = 0; sidx < 2; ++sidx) {
        const unsigned h = hash_u((F.gw * 2 + sidx) * 2654435761u + id * 97u);
        const int row = h % M, col = (h >> 12) % N;
        const float ref = dot_bf16(A + (size_t)row * K, Bt + (size_t)col * K, K, F.lane);
        if (!close_enough(C[(size_t)row * ldc + col], ref, 0.01f, 0.01f)) CHK_FAIL(F, id);
    }
}
template <class Fn>
__device__ __forceinline__ void check_gemm_bf16(const Frame& F, const bf16* A, const bf16* Bt, int M, int N, int K, const bf16* C, int ldc, int id) {
    for (int sidx = 0; sidx < 2; ++sidx) {
        const unsigned h = hash_u((F.gw * 2 + sidx) * 2654435761u + id * 97u);
        const int row = h % M, col = (h >> 12) % N;
        const float ref = dot_bf16(A + (size_t)row * K, Bt + (size_t)col * K, K, F.lane);
        if (!close_enough(bf2f(C[(size_t)row * ldc + col]), ref, 0.02f, 0.02f)) CHK_FAIL(F, id);
    }
}
#endif

__device__ __forceinline__ void phase_ln1_router(const Frame& F, const Args& a, int l) {
    const bf16* X = (const bf16*)(F.ws + WS_X); bf16* X1 = (bf16*)(F.ws + WS_X1); const bf16* AO = (const bf16*)(F.ws + WS_AO); unsigned char* H8 = F.ws + WS_XE; float* AFF = (float*)(F.ws + WS_AFF);
    constexpr int RP = 1032, RB = 6;
    LAS bf16* Wb = (LAS bf16*)F.lds;
    LAS bf16* Hs = (LAS bf16*)(F.lds + 16 * RP * 2) + F.wave * (RB * RP);
    const float* wr = a.in[25] + (size_t)l * D * NE;
    for (int i = F.tid; i < D * NE; i += 512) Wb[(i & 15) * RP + (i >> 4)] = f2bf(wr[i]);
    __syncthreads();
    int lane_ = F.lane; asm volatile("" : "+v"(lane_)); const int lane = lane_;
    const f32x4* lg = (const f32x4*)(a.in[10] + (size_t)(l * 2 + 0) * D); const f32x4* lb = (const f32x4*)(a.in[11] + (size_t)(l * 2 + 0) * D);
    const int RPW = (NTOK + F.NGW - 1) / F.NGW, rbeg = F.gw * RPW, rend = (rbeg + RPW < NTOK) ? rbeg + RPW : NTOK;
    f32x4 lgv[4], lbv[4], g1v[4], sh2v[4], sc2v[4]; int ccur = -1;
#pragma unroll
    for (int j = 0; j < 4; ++j) { lgv[j] = lg[lane + 64 * j]; lbv[j] = lb[lane + 64 * j]; g1v[j] = lgv[j]; sh2v[j] = lgv[j]; sc2v[j] = lgv[j]; }
    u32x2 xc[4], ac[4], xd[4], ad[4];
    { const int r0 = rbeg < rend ? rbeg : NTOK - 1, r1 = rbeg + 1 < rend ? rbeg + 1 : r0;
#pragma unroll
      for (int j = 0; j < 4; ++j) { xc[j] = ((const u32x2*)(X + (size_t)r0 * D))[lane + 64 * j]; ac[j] = ((const u32x2*)(AO + (size_t)r0 * D))[lane + 64 * j];
          xd[j] = ((const u32x2*)(X + (size_t)r1 * D))[lane + 64 * j]; ad[j] = ((const u32x2*)(AO + (size_t)r1 * D))[lane + 64 * j]; } }
    for (int row = rbeg; row < rend; ++row) {
        const int c = cond_of(row);
        if (c != ccur) { ccur = c; const f32x4* g1 = (const f32x4*)ada_vec(F, l, c, 2); const f32x4* sh2 = (const f32x4*)ada_vec(F, l, c, 3); const f32x4* sc2 = (const f32x4*)ada_vec(F, l, c, 4);
#pragma unroll
            for (int j = 0; j < 4; ++j) { g1v[j] = g1[lane + 64 * j]; sh2v[j] = sh2[lane + 64 * j]; sc2v[j] = sc2[lane + 64 * j] + 1.f; } }
        f32x4 y[4]; float s = 0.f, s2 = 0.f;
#pragma unroll
        for (int j = 0; j < 4; ++j) { const f32x4 av = (f32x4){__uint_as_float(ac[j].x << 16), __uint_as_float(ac[j].x & 0xffff0000u), __uint_as_float(ac[j].y << 16), __uint_as_float(ac[j].y & 0xffff0000u)}; y[j] = bf4(xc[j]) * ALPHA + g1v[j] * av; s += (y[j][0] + y[j][1]) + (y[j][2] + y[j][3]); s2 += (y[j][0] * y[j][0] + y[j][1] * y[j][1]) + (y[j][2] * y[j][2] + y[j][3] * y[j][3]); }
        { const int nr = row + 2 < rend ? row + 2 : row;
#pragma unroll
          for (int j = 0; j < 4; ++j) { xc[j] = xd[j]; ac[j] = ad[j]; xd[j] = ((const u32x2*)(X + (size_t)nr * D))[lane + 64 * j]; ad[j] = ((const u32x2*)(AO + (size_t)nr * D))[lane + 64 * j]; } }
        s = wave_sum(s); s2 = wave_sum(s2);
        const float mean = s * (1.f / D), var = fmaxf(s2 * (1.f / D) - mean * mean, 0.f);
        const float rstd = 1.f / sqrtf(var + 1e-5f);
        f32x4 h[4];
#pragma unroll
        for (int j = 0; j < 4; ++j) { const int q = lane + 64 * j; const f32x4 xn = (y[j] - mean) * rstd * lgv[j] + lbv[j]; ((u32x2*)(X1 + (size_t)row * D))[q] = pk4(xn);
            h[j] = xn * sc2v[j] + sh2v[j]; ((unsigned*)(H8 + (size_t)row * D))[q] = pk4_fp8(h[j][0], h[j][1], h[j][2], h[j][3]); }
        const int br = (row - rbeg) % RB;
#pragma unroll
        for (int j = 0; j < 4; ++j) { u32x2 w; w.x = cvtpk(h[j][0], h[j][1]); w.y = cvtpk(h[j][2], h[j][3]); *(LAS u32x2*)(Hs + br * RP + 4 * (lane + 64 * j)) = w; }
        if (br == RB - 1 || row == rend - 1) {
            const int nrows = br + 1, row0 = row - br, n = lane & 15, kq = lane >> 4, nn = n < nrows ? n : 0;
            const LAS bf16* wp = Wb + n * RP + 8 * kq; const LAS bf16* hp = Hs + nn * RP + 8 * kq;
            f32x4 l0 = (f32x4){0.f, 0.f, 0.f, 0.f}, l1 = l0;
#pragma unroll 4
            for (int st = 0; st < 32; st += 2) {
                l0 = __builtin_amdgcn_mfma_f32_16x16x32_bf16(*(const LAS bf16x8*)(wp + 32 * st), *(const LAS bf16x8*)(hp + 32 * st), l0, 0, 0, 0);
                l1 = __builtin_amdgcn_mfma_f32_16x16x32_bf16(*(const LAS bf16x8*)(wp + 32 * st + 32), *(const LAS bf16x8*)(hp + 32 * st + 32), l1, 0, 0, 0); }
            const f32x4 lg4 = l0 + l1;
            float mx = fmaxf(fmaxf(lg4[0], lg4[1]), fmaxf(lg4[2], lg4[3])); mx = xmax16(mx); mx = xmax32(mx);
            f32x4 ex; ex[0] = __expf(lg4[0] - mx); ex[1] = __expf(lg4[1] - mx); ex[2] = __expf(lg4[2] - mx); ex[3] = __expf(lg4[3] - mx);
            float den = (ex[0] + ex[1]) + (ex[2] + ex[3]); den = xsum16(den, den); den = xsum32(den, den);
            const float inv = 1.f / den;
            if (n < nrows) {
#pragma unroll
                for (int i = 0; i < 4; ++i) AFF[(size_t)(4 * kq + i) * NTOK + row0 + n] = ex[i] * inv; }
        }
    }
    __syncthreads();
}

__device__ __forceinline__ int block_excl_scan(int v, LAS int* wsum, int lane, int wid, int& total) {
    int inc = v;
#pragma unroll
    for (int o = 1; o < 64; o <<= 1) { const int t = __shfl_up(inc, o); if (lane >= o) inc += t; }
    if (lane == 63) wsum[wid] = inc;
    __syncthreads();
    int off = 0, tot = 0;
#pragma unroll
    for (int w = 0; w < 8; ++w) { const int s = wsum[w]; if (w < wid) off += s; tot += s; }
    __syncthreads();
    total = tot; return off + inc - v;
}
__device__ __forceinline__ void phase_topk(const Frame& F) {
    const float* AFFT = (const float*)(F.ws + WS_AFF); int* IDX = (int*)(F.ws + WS_IDX); float* GATEV = (float*)(F.ws + WS_GATEV); int* SLOTMAP = (int*)(F.ws + WS_SLOTMAP);
    LAS int* hist = (LAS int*)F.lds;
    LAS int* wsum = (LAS int*)(F.lds + 1024);
    LAS unsigned* shv = (LAS unsigned*)(F.lds + 1024 + 64);
    const int tid = F.tid, lane = F.lane;
    for (int pr = F.bid; pr < 32; pr += F.G) {
        const int stream = pr >> 4, e = pr & 15, tok0 = stream ? NCTX : 0, cap = stream ? CAPL : CAPC, sbase = e * ESLOTS + (stream ? CAPC : 0);
        const int C = stream ? 16 : 8, i0 = tid * C;
        unsigned k[16];
        { const u32x4* src = (const u32x4*)(AFFT + (size_t)e * NTOK + tok0 + i0);
#pragma unroll
          for (int q = 0; q < 4; ++q) { u32x4 v = (u32x4){0u, 0u, 0u, 0u}; if (q * 4 < C) v = src[q]; k[4 * q] = v.x; k[4 * q + 1] = v.y; k[4 * q + 2] = v.z; k[4 * q + 3] = v.w; } }
        unsigned prefix = 0u; int remaining = cap;
        __syncthreads();
        for (int pass = 0; pass < 4; ++pass) {
            const int shift = 24 - 8 * pass;
            if (tid < 256) hist[tid] = 0;
            __syncthreads();
#pragma unroll
            for (int i = 0; i < 16; ++i) if (i < C) { const unsigned kk = k[i]; if (pass == 0 || (kk >> (shift + 8)) == prefix) __hip_atomic_fetch_add(&hist[(kk >> shift) & 255u], 1, __ATOMIC_RELAXED, __HIP_MEMORY_SCOPE_WORKGROUP); }
            __syncthreads();
            if (tid < 64) {
                const int h0 = hist[4 * lane], h1 = hist[4 * lane + 1], h2 = hist[4 * lane + 2], h3 = hist[4 * lane + 3], c = h0 + h1 + h2 + h3;
                int inc = c;
#pragma unroll
                for (int o = 1; o < 64; o <<= 1) { const int t = __shfl_down(inc, o); if (lane + o < 64) inc += t; }
                const int above = inc - c;
                if (above < remaining && remaining <= inc) {
                    int cum = above, sel;
                    if (cum + h3 >= remaining) sel = 3; else { cum += h3; if (cum + h2 >= remaining) sel = 2; else { cum += h2; if (cum + h1 >= remaining) sel = 1; else { cum += h1; sel = 0; } } }
                    shv[0] = (prefix << 8) | (unsigned)(4 * lane + sel); shv[1] = (unsigned)(remaining - cum);
                }
            }
            __syncthreads();
            prefix = shv[0]; remaining = (int)shv[1];
        }
        const unsigned thr = prefix; const int need = remaining;
        int ceq = 0;
#pragma unroll
        for (int i = 0; i < 16; ++i) if (i < C) ceq += (k[i] == thr) ? 1 : 0;
        int tot; const int eq_rank = block_excl_scan(ceq, wsum, F.lane, F.wave, tot);
        int csel = 0; { int er = eq_rank;
#pragma unroll
            for (int i = 0; i < 16; ++i) if (i < C) { if (k[i] > thr) ++csel; else if (k[i] == thr) { if (er < need) ++csel; ++er; } } }
        int slot = block_excl_scan(csel, wsum, F.lane, F.wave, tot);
#if MK_CHECK
        if (tid == 0 && tot != cap) CHK_FAIL(F, 60);
#endif
        { int er = eq_rank; int sm[16];
#pragma unroll
            for (int i = 0; i < 16; ++i) { sm[i] = -1; if (i < C) { bool sel = false; if (k[i] > thr) sel = true; else if (k[i] == thr) { sel = er < need; ++er; }
                const int tok = tok0 + i0 + i;
                if (sel) { const int r = sbase + slot; IDX[r] = tok; GATEV[r] = __uint_as_float(k[i]); sm[i] = r; ++slot; } } }
            u32x4* dst = (u32x4*)(SLOTMAP + (size_t)e * NTOK + tok0 + i0);
#pragma unroll
            for (int q = 0; q < 4; ++q) if (q * 4 < C) dst[q] = (u32x4){(unsigned)sm[4 * q], (unsigned)sm[4 * q + 1], (unsigned)sm[4 * q + 2], (unsigned)sm[4 * q + 3]}; }
    }
    __syncthreads();
}
__device__ __forceinline__ void phase_gather(const Frame& F) {
    const int* IDX = (const int*)(F.ws + WS_IDX);
#if MK_CHECK
    {
        const int* SLOTMAP = (const int*)(F.ws + WS_SLOTMAP); const float* GATEV = (const float*)(F.ws + WS_GATEV); const float* AFF = (const float*)(F.ws + WS_AFF);
        for (int r = F.gw * 64 + F.lane; r < NSLOTS; r += F.NGW * 64) { const int tok = IDX[r], e = r / ESLOTS; const bool latslot = (r % ESLOTS) >= CAPC;
            bool ok = tok >= 0 && tok < NTOK && ((tok >= NCTX) == latslot);
            if (ok) ok = SLOTMAP[(size_t)e * NTOK + tok] == r && GATEV[r] == AFF[(size_t)e * NTOK + tok];
            if (ok) { const unsigned h = hash_u(r * 7919u + 13u); const int t2 = latslot ? NCTX + (h % NLAT) : (h % NCTX); if (SLOTMAP[(size_t)e * NTOK + t2] < 0 && AFF[(size_t)e * NTOK + t2] > GATEV[r]) ok = false; }
            if (!ok) CHK_FAIL(F, 61); }
    }
#endif
}

__device__ __forceinline__ void ye_acc(f32x4& f, unsigned w) {
    const auto lo = __builtin_amdgcn_cvt_pk_f32_fp8((int)w, false), hi = __builtin_amdgcn_cvt_pk_f32_fp8((int)w, true); f[0] += lo[0]; f[1] += lo[1]; f[2] += hi[0]; f[3] += hi[1];
}
__device__ __forceinline__ void ye_add(f32x4 (&f)[4], const unsigned char* YE, int r, int lane) {
    const bool two = (r >> 8) >= DOWN_FULL_PANELS;
    unsigned w[4], w2[4];
#pragma unroll
    for (int j = 0; j < 4; ++j) { w[j] = ((const unsigned*)(YE + (size_t)r * D))[lane + 64 * j]; w2[j] = 0u; if (two) w2[j] = ((const unsigned*)(YE + (size_t)(NSLOTS + r) * D))[lane + 64 * j]; }
#pragma unroll
    for (int j = 0; j < 4; ++j) { ye_acc(f[j], w[j]); ye_acc(f[j], w2[j]); }
}
__device__ __forceinline__ void ye_add2(f32x4 (&f)[4], const unsigned char* YE, int r, int rb, int lane) {
    const bool two = (r >> 8) >= DOWN_FULL_PANELS, twob = (rb >> 8) >= DOWN_FULL_PANELS;
    unsigned w[4], w2[4], v[4], v2[4];
#pragma unroll
    for (int j = 0; j < 4; ++j) { w[j] = ((const unsigned*)(YE + (size_t)r * D))[lane + 64 * j]; w2[j] = 0u; if (two) w2[j] = ((const unsigned*)(YE + (size_t)(NSLOTS + r) * D))[lane + 64 * j];
        v[j] = ((const unsigned*)(YE + (size_t)rb * D))[lane + 64 * j]; v2[j] = 0u; if (twob) v2[j] = ((const unsigned*)(YE + (size_t)(NSLOTS + rb) * D))[lane + 64 * j]; }
#pragma unroll
    for (int j = 0; j < 4; ++j) { ye_acc(f[j], w[j]); ye_acc(f[j], w2[j]); ye_acc(f[j], v[j]); ye_acc(f[j], v2[j]); }
}
__device__ __forceinline__ void phase_combine(const Frame& F, const Args& a, int l) {
    bf16* X = (bf16*)(F.ws + WS_X); const bf16* X1 = (const bf16*)(F.ws + WS_X1); bf16* H = (bf16*)(F.ws + WS_H); const unsigned char* YE = F.ws + WS_YE; const int* SLOTMAP = (const int*)(F.ws + WS_SLOTMAP);
    int lane_ = F.lane; asm volatile("" : "+v"(lane_)); const int lane = lane_;
    const f32x4* lg = (const f32x4*)(a.in[10] + (size_t)(l * 2 + 1) * D); const f32x4* lb = (const f32x4*)(a.in[11] + (size_t)(l * 2 + 1) * D);
#if MK_CHECK
    const unsigned err = __hip_atomic_load(F.ctl + CW_ERR, __ATOMIC_RELAXED, __HIP_MEMORY_SCOPE_AGENT);
    const unsigned tmo = __hip_atomic_load(F.ctl + CW_BAR + XB_TMO, __ATOMIC_RELAXED, __HIP_MEMORY_SCOPE_AGENT);
#endif
    const int RPW = (NTOK + F.NGW - 1) / F.NGW, rbeg = F.gw * RPW, rend = (rbeg + RPW < NTOK) ? rbeg + RPW : NTOK;
    f32x4 lgv[4], lbv[4], g2v[4], shv[4], scv[4]; int ccur = -1;
#pragma unroll
    for (int j = 0; j < 4; ++j) { lgv[j] = lg[lane + 64 * j]; lbv[j] = lb[lane + 64 * j]; g2v[j] = lgv[j]; shv[j] = lgv[j]; scv[j] = lgv[j]; }
    auto ld_sm = [&](int r) { int v = -1; if (r < rend && lane < 16) v = SLOTMAP[(size_t)lane * NTOK + r]; return v; };
    u32x2 x1n[4]; unsigned pw[4], pw2[4], pv[4], pv2[4]; unsigned restn = 0u; int smn_keep = -1;
    auto issue = [&](int r, int smv) {
        unsigned mask = (unsigned)__ballot(smv >= 0) & 0xffffu; int r0 = -1, r1 = -1;
        if (mask) { const int e0 = __builtin_ctz(mask); mask &= mask - 1; r0 = __builtin_amdgcn_readlane(smv, e0); }
        if (mask) { const int e1 = __builtin_ctz(mask); mask &= mask - 1; r1 = __builtin_amdgcn_readlane(smv, e1); }
        restn = mask; smn_keep = smv;
        const int rr = r < rend ? r : rend - 1;
#pragma unroll
        for (int j = 0; j < 4; ++j) { x1n[j] = ((const u32x2*)(X1 + (size_t)rr * D))[lane + 64 * j]; pw[j] = 0u; pw2[j] = 0u; pv[j] = 0u; pv2[j] = 0u; }
        if (r0 >= 0) {
#pragma unroll
            for (int j = 0; j < 4; ++j) { pw[j] = ((const unsigned*)(YE + (size_t)r0 * D))[lane + 64 * j]; if ((r0 >> 8) >= DOWN_FULL_PANELS) pw2[j] = ((const unsigned*)(YE + (size_t)(NSLOTS + r0) * D))[lane + 64 * j]; } }
        if (r1 >= 0) {
#pragma unroll
            for (int j = 0; j < 4; ++j) { pv[j] = ((const unsigned*)(YE + (size_t)r1 * D))[lane + 64 * j]; if ((r1 >> 8) >= DOWN_FULL_PANELS) pv2[j] = ((const unsigned*)(YE + (size_t)(NSLOTS + r1) * D))[lane + 64 * j]; } }
    };
    int sm1 = ld_sm(rbeg + 1);
    if (rbeg < rend) issue(rbeg, ld_sm(rbeg));
    for (int row = rbeg; row < rend; ++row) {
        const int c = cond_of(row);
        if (c != ccur) { ccur = c; const f32x4* g2 = (const f32x4*)ada_vec(F, l, c, 5);
#pragma unroll
            for (int j = 0; j < 4; ++j) g2v[j] = g2[lane + 64 * j];
            if (l < 3) { const f32x4* sh = (const f32x4*)ada_vec(F, l + 1, c, 0); const f32x4* sc = (const f32x4*)ada_vec(F, l + 1, c, 1);
#pragma unroll
                for (int j = 0; j < 4; ++j) { shv[j] = sh[lane + 64 * j]; scv[j] = sc[lane + 64 * j] + 1.f; } } }
        f32x4 x1[4], f[4]; unsigned mask = restn; const int smc = smn_keep;
#pragma unroll
        for (int j = 0; j < 4; ++j) { x1[j] = bf4(x1n[j]); f[j] = (f32x4){0.f, 0.f, 0.f, 0.f}; ye_acc(f[j], pw[j]); ye_acc(f[j], pw2[j]); ye_acc(f[j], pv[j]); ye_acc(f[j], pv2[j]); }
        if (row + 1 < rend) { const int smv = sm1; sm1 = ld_sm(row + 2); issue(row + 1, smv); }
        while (mask) {
            const int e0 = __builtin_ctz(mask); mask &= mask - 1; const int r0 = __builtin_amdgcn_readlane(smc, e0);
            if (mask) { const int e1 = __builtin_ctz(mask); mask &= mask - 1; const int r1 = __builtin_amdgcn_readlane(smc, e1); ye_add2(f, YE, r0, r1, lane); }
            else ye_add(f, YE, r0, lane);
        }
        f32x4 y[4]; float s = 0.f, s2 = 0.f;
#pragma unroll
        for (int j = 0; j < 4; ++j) { y[j] = x1[j] * ALPHA + g2v[j] * f[j] * (1.f / YE8_SCALE); s += (y[j][0] + y[j][1]) + (y[j][2] + y[j][3]); s2 += (y[j][0] * y[j][0] + y[j][1] * y[j][1]) + (y[j][2] * y[j][2] + y[j][3] * y[j][3]); }
        s = wave_sum(s); s2 = wave_sum(s2);
        const float mean = s * (1.f / D), var = fmaxf(s2 * (1.f / D) - mean * mean, 0.f);
        const float rstd = 1.f / sqrtf(var + 1e-5f);
        if (l < 3) {
#pragma unroll
            for (int j = 0; j < 4; ++j) { const int q = lane + 64 * j; const f32x4 xn = (y[j] - mean) * rstd * lgv[j] + lbv[j]; ((u32x2*)(X + (size_t)row * D))[q] = pk4(xn);
                const f32x4 h = xn * scv[j] + shv[j]; u32x2 w; w.x = cvtpk(h[0], h[1]); w.y = cvtpk(h[2], h[3]); ((u32x2*)(H + (size_t)row * D))[q] = w; }
        } else {
#pragma unroll
            for (int j = 0; j < 4; ++j) { const int q = lane + 64 * j; f32x4 xn = (y[j] - mean) * rstd * lgv[j] + lbv[j];
#if MK_CHECK
                if (row == 0 && q == 0) { if (err) xn[0] = 100.f * (float)err; else if (tmo) xn[0] = 9900.f; }
#endif
                ((f32x4*)(F.out + (size_t)row * D))[q] = xn; }
        }
    }
}

#if !MK_SPLIT
#define GRID_BAR() xcd_barrier(bar)
#else
#define GRID_BAR() do { } while (0)
#endif
#define IN(k) (lo <= (k) && (k) < hi)
#define GEMM_PHASE(EPI, SCHED) do { for (int rep_ = 0; rep_ < MK_REP_GEMM; ++rep_) pg8::gemm_phase<EPI, SCHED, true, true>(F.lds, g, S, E); } while (0)
template <int KIND>
__device__ __forceinline__ void run_mixer(const Frame& F, const Args& a, const XcdBarrier& bar, int lo, int hi, int l, int j, int slot, int& cv_it) {
    const int base = 3 + 12 * l;
    const bf16* Hb = (const bf16*)(F.ws + WS_H);
    ChunkMap cm; cm.init(F.G, F.bid);
    const ConvJob J{a.in[26], a.in[27], a.in[28], F.ws + WS_WGU, F.ws + WS_WD};
    const int cv_cap = (l == 0 ? 32 : l == 1 ? 48 : l == 2 ? 82 : 96) * (CV_PER_LAYER / 24);
    if (KIND != 2) {
        const bf16* Wq = (const bf16*)(F.ws + WS_WQKV) + (size_t)slot * 1536 * 1024;
        if (IN(base + 0)) {
            unsigned* cnt = F.ctl + CW_KV + 16 * l;
            Gemm g{Hb, Wq, 1024, 1024}; QkvOrder S{cm}; EpiBf16P E{(bf16*)(F.ws + WS_QKV), 1536};
            GEMM_PHASE(EpiBf16P, QkvOrder);
            int nkv = 0; { Unit u; for (int i = 0; S.next(i, u); ++i) nkv += (u.pn >= 4) ? 1 : 0; }
            if (nkv && F.tid == 0) { __builtin_amdgcn_fence(__ATOMIC_RELEASE, "agent"); (void)__hip_atomic_fetch_add(cnt, (unsigned)nkv, __ATOMIC_RELAXED, __HIP_MEMORY_SCOPE_AGENT); }
            const int idx = cm.x * cm.chunk + cm.loc; int skip = 288 - F.G; if (skip < 0 || skip >= F.G) skip = 0;
            if (idx >= skip) {
                if (F.tid == 0) { while (__hip_atomic_load(cnt, __ATOMIC_RELAXED, __HIP_MEMORY_SCOPE_AGENT) < 96u) __builtin_amdgcn_s_sleep(2); __builtin_amdgcn_fence(__ATOMIC_ACQUIRE, "agent"); }
                __syncthreads();
                for (int rep = 0; rep < MK_REP_POST; ++rep) phase_kv_post(F, a, KIND, j, slot, (idx - skip) * 8 + F.wave, (F.G - skip) * 8);
            }
            GRID_BAR();
        }
#if MK_CHECK
        if (IN(base + 3)) check_gemm_bf16<int>(F, Hb, Wq, NTOK, 1536, 1024, (const bf16*)(F.ws + WS_QKV), 1536, 10 + l);
#endif
        if (IN(base + 4)) {
            for (int rep = 0; rep < MK_REP_ATTN; ++rep) { if (KIND == 0) attn_phase<64, 0>(F, a, j, J, cv_it, (l + 1) * CV_PER_LAYER, cv_cap); else attn_phase<64, 1>(F, a, j, J, cv_it, (l + 1) * CV_PER_LAYER, cv_cap); }
            GRID_BAR();
        }
    } else {
        if (IN(base + 0)) {
            Gemm g{Hb, (const bf16*)(F.ws + WS_WDN), 512, 1024}; SplitKOrder S{2, 2, 1024, 48 * 2 * 2, cm}; EpiF32 E{(float*)(F.ws + WS_QKV), 512, DWN_PART};
            GEMM_PHASE(EpiF32, SplitKOrder); GRID_BAR();
        }
        if (IN(base + 1)) {
#if MK_CHECK
            for (int sidx = 0; sidx < 2; ++sidx) { const unsigned h = hash_u((F.gw * 2 + sidx) * 2654435761u + (10 + l) * 97u); const int row = h % NTOK, col = (h >> 12) % 512;
                const float ref = dot_bf16(Hb + (size_t)row * 1024, (const bf16*)(F.ws + WS_WDN) + (size_t)col * 1024, 1024, F.lane); const float* dq = (const float*)(F.ws + WS_QKV) + (size_t)row * 512 + col;
                if (!close_enough(dq[0] + dq[DWN_PART], ref, 0.01f, 0.01f)) CHK_FAIL(F, 10 + l); }
#endif
            phase_mla_post1(F, a); GRID_BAR();
        }
        if (IN(base + 2)) {
            { Gemm g{(const bf16*)(F.ws + WS_QA), (const bf16*)(F.ws + WS_WUQ), 256, 256}; PlainOrder S{6, 48 * 6, cm}; EpiBf16P E{(bf16*)(F.ws + WS_QKV), 1536}; GEMM_PHASE(EpiBf16P, PlainOrder); }
            { Gemm g{(const bf16*)(F.ws + WS_CKVA), (const bf16*)(F.ws + WS_WUKV), 128, 128}; ChunkMap cmr = cm; cmr.x = cm.nx - 1 - cm.x; PlainOrder S{8, 56 * 8, cmr};     EpiUkv E{(bf16*)(F.ws + WS_KB), (bf16*)(F.ws + WS_KVRAW)}; GEMM_PHASE(EpiUkv, PlainOrder); }
            GRID_BAR();
        }
        if (IN(base + 3)) {
#if MK_CHECK
            check_gemm_bf16<int>(F, (const bf16*)(F.ws + WS_QA), (const bf16*)(F.ws + WS_WUQ), NTOK, 1536, 256, (const bf16*)(F.ws + WS_QKV), 1536, 14);
            for (int sidx = 0; sidx < 2; ++sidx) {
                const unsigned h = hash_u((F.gw * 2 + sidx) * 2654435761u + 15u * 97u); const int row = h % 14336, col = (h >> 12) % 2048, hh = col >> 7, ii = col & 127;
                const float ref = dot_bf16((const bf16*)(F.ws + WS_CKVA) + (size_t)row * 128, (const bf16*)(F.ws + WS_WUKV) + (size_t)col * 128, 128, F.lane);
                bool lat; int b, s; mla_row(row, lat, b, s);
                const float got = (ii < 64) ? bf2f(((const bf16*)(F.ws + WS_KB))[kb_off(16, 96, lat, b, hh) + (size_t)s * 96 + ii]) : bf2f(((const bf16*)(F.ws + WS_KVRAW))[(size_t)row * 1024 + hh * 64 + ii - 64]);
                if (!close_enough(got, ref, 0.02f, 0.02f)) CHK_FAIL(F, 15);
            }
#endif
            for (int rep = 0; rep < MK_REP_POST; ++rep) phase_mla_post2(F, a); GRID_BAR();
        }
        if (IN(base + 4)) { for (int rep = 0; rep < MK_REP_ATTN; ++rep) attn_phase<96, 2>(F, a, j, J, cv_it, (l + 1) * CV_PER_LAYER, cv_cap); GRID_BAR(); }
    }
}
__device__ __forceinline__ void run_moe(const Frame& F, const Args& a, const XcdBarrier& bar, int lo, int hi, int l, int kind) {
    const int base = 3 + 12 * l;
    ChunkMap cm; cm.init(F.G, F.bid);
    const bf16* Wo = (const bf16*)(F.ws + WS_WO) + (size_t)l * 1024 * 1024;
    if (IN(base + 5)) {
#if MK_CHECK
        if (kind == 0) check_attn<64, 0>(F, a, l / 3, 20 + l); else if (kind == 1) check_attn<64, 1>(F, a, 0, 20 + l); else check_attn<96, 2>(F, a, 0, 20 + l);
        __syncthreads();
#endif
        Gemm g{(const bf16*)(F.ws + WS_O), Wo, 1024, 1024}; PlainOrder S{4, 48 * 4, cm}; EpiBf16P E{(bf16*)(F.ws + WS_AO), 1024};
        GEMM_PHASE(EpiBf16P, PlainOrder); GRID_BAR();
    }
    if (IN(base + 6)) {
#if MK_CHECK
        check_gemm_bf16<int>(F, (const bf16*)(F.ws + WS_O), Wo, NTOK, 1024, 1024, (const bf16*)(F.ws + WS_AO), 1024, 30 + l);
#endif
        for (int rep = 0; rep < MK_REP_LN1; ++rep) phase_ln1_router(F, a, l); GRID_BAR();
    }
#if MK_CHECK
    if (IN(base + 7)) {
        const unsigned hsh = hash_u(F.gw * 2654435761u + 991u * l + 17u); const int row = hsh % NTOK, c = cond_of(row);
        const bf16* X1c = (const bf16*)(F.ws + WS_X1); const float* sh2 = ada_vec(F, l, c, 3); const float* sc2 = ada_vec(F, l, c, 4); const float* wrc = a.in[25] + (size_t)l * D * NE; const float* AFFc = (const float*)(F.ws + WS_AFF);
        float lgt[16];
#pragma unroll
        for (int e = 0; e < 16; ++e) { float sacc = 0.f; for (int k = F.lane; k < D; k += 64) { const float hh = bf2f(X1c[(size_t)row * D + k]) * (sc2[k] + 1.f) + sh2[k]; sacc += hh * wrc[k * NE + e]; } lgt[e] = wave_sum(sacc); }
        float mxc = lgt[0];
#pragma unroll
        for (int e = 1; e < 16; ++e) mxc = fmaxf(mxc, lgt[e]);
        float denc = 0.f;
#pragma unroll
        for (int e = 0; e < 16; ++e) denc += __expf(lgt[e] - mxc);
#pragma unroll
        for (int e = 0; e < 16; ++e) { const float ref = __expf(lgt[e] - mxc) / denc, got = AFFc[(size_t)e * NTOK + row]; if (!close_enough(got, ref, 0.03f, 2e-4f)) CHK_FAIL(F, 62); }
    }
#endif
    if (IN(base + 7)) { for (int rep = 0; rep < MK_REP_TOPK; ++rep) phase_topk(F); if (l < 3) ada_direct(F, a, l + 1, 32); GRID_BAR(); }
#if MK_CHECK
    if (IN(base + 8)) { phase_gather(F); GRID_BAR(); }
#endif
    const unsigned char* Wgu = F.ws + WS_WGU + (size_t)l * 16 * 4096 * 1024; const unsigned char* Wd = F.ws + WS_WD + (size_t)l * 16 * 1024 * 2048;
    if (IN(base + 9)) {
#if MK_CHECK
        for (int sidx = 0; sidx < 16; ++sidx) {
            const unsigned h = hash_u((F.gw * 16 + sidx) * 2654435761u + 71u * l + 3u); const int idx = h & 63, e = (h >> 6) & 15, kk = (h >> 10) & 1023, nn = (h >> 20) & 2047;
            const int k = kk + ((idx & 1) ? 1024 * ((h >> 31) & 1) : 0);
            float src, got;
            if (idx & 1) { const int n = nn & 1023; src = a.in[28][((size_t)(l * 16 + e) * 2048 + k) * 1024 + n]; got = fp8f(Wd + ((size_t)e * 1024 + n) * 2048, k); }
            else { const bool up = (idx & 2) != 0; src = (up ? a.in[27] : a.in[26])[((size_t)(l * 16 + e) * 1024 + kk) * 2048 + nn]; got = fp8f(Wgu + ((size_t)e * 4096 + (nn >> 7) * 256 + (up ? 128 : 0) + (nn & 127)) * 1024, kk); }
            { const unsigned pk = pk4_fp8(src * W8_SCALE, 0.f, 0.f, 0.f); if (F.lane == 0 && got != __builtin_amdgcn_cvt_f32_fp8((int)pk, 0)) CHK_FAIL(F, 70 + l); }
        }
#endif
        Gemm g{(const bf16*)(F.ws + WS_XE), (const bf16*)Wgu, 512, 512, (const int*)(F.ws + WS_IDX)}; GroupedOrder S{6, 16, 1, 0, cm}; EpiSwiglu E{F.ws + WS_HID};
        pg8::gemm_phase<EpiSwiglu, GroupedOrder, true, true, true, true>(F.lds, g, S, E); GRID_BAR();
    }
    if (IN(base + 10)) {
#if MK_CHECK
        for (int sidx = 0; sidx < 2; ++sidx) {
            const unsigned h = hash_u((F.gw * 2 + sidx) * 2654435761u + 977u * l); const int row = h % NSLOTS, cc = (h >> 12) % FF, e = row / ESLOTS;
            const unsigned char* xr = F.ws + WS_XE + (size_t)((const int*)(F.ws + WS_IDX))[row] * D; const unsigned char* wg = Wgu + ((size_t)e * 4096 + (cc >> 7) * 256 + (cc & 127)) * 1024;
            const float gd = dot_fp8(xr, wg, 1024, F.lane) * (1.f / W8_SCALE), ud = dot_fp8(xr, wg + 128 * 1024, 1024, F.lane) * (1.f / W8_SCALE);
            const float ref = gd / (1.f + __expf(-gd)) * ud, got = fp8f(F.ws + WS_HID + (size_t)row * FF, cc) * (1.f / H8_SCALE);
            if (!close_enough(got, ref, 0.08f, 0.01f)) CHK_FAIL(F, 40 + l);
        }
#endif
        EpiDown E{F.ws + WS_YE, (const float*)(F.ws + WS_GATEV)};
        { Gemm g{(const bf16*)(F.ws + WS_HID), (const bf16*)Wd, 1024, 1024, nullptr}; DownOrder S{0, cm}; pg8::gemm_phase<EpiDown, DownOrder, true, true, false, true>(F.lds, g, S, E); }
        { Gemm g{(const bf16*)(F.ws + WS_HID), (const bf16*)Wd, 512, 1024, nullptr}; DownOrder S{1, cm}; pg8::gemm_phase<EpiDown, DownOrder, true, true, false, true>(F.lds, g, S, E); }
        GRID_BAR();
    }
    if (IN(base + 11)) {
#if MK_CHECK
        for (int sidx = 0; sidx < 2; ++sidx) {
            const unsigned h = hash_u((F.gw * 2 + sidx) * 2654435761u + 577u * l + 5u); const int row = h % NSLOTS, cc = (h >> 12) % D, e = row / ESLOTS;
            const float dd = dot_fp8(F.ws + WS_HID + (size_t)row * FF, Wd + ((size_t)e * 1024 + cc) * 2048, 2048, F.lane) * (1.f / (W8_SCALE * H8_SCALE));
            const float ref = dd * ((const float*)(F.ws + WS_GATEV))[row], p1 = fp8f(F.ws + WS_YE + (size_t)row * D, cc) * (1.f / YE8_SCALE), p2 = ((row >> 8) >= DOWN_FULL_PANELS) ? fp8f(F.ws + WS_YE + (size_t)(NSLOTS + row) * D, cc) * (1.f / YE8_SCALE) : 0.f;
            if (!(fabsf(p1 + p2 - ref) <= 0.07f * (fabsf(p1) + fabsf(p2)) + 0.0005f)) CHK_FAIL(F, 50 + l);
        }
#endif
        for (int rep = 0; rep < MK_REP_COMB; ++rep) phase_combine(F, a, l); if (l < 3) GRID_BAR();
    }
}
#undef IN

constexpr int N_PHASES = 3 + 4 * 12;
__global__ void __launch_bounds__(512, 2) mk_fwd(Args a) {
    extern __shared__ __attribute__((aligned(16))) unsigned char lds_raw[];
    LAS unsigned char* lds0 = (LAS unsigned char*)lds_raw;
    Frame F;
    F.lds = lds0 + LDS_PH; F.ws = a.ws; F.out = a.out; F.ctl = (unsigned*)(a.ws + WS_CTL);
    F.tid = threadIdx.x; F.lane = F.tid & 63; F.wave = __builtin_amdgcn_readfirstlane(F.tid >> 6); F.G = gridDim.x; F.bid = blockIdx.x; F.gw = F.bid * 8 + F.wave; F.NGW = F.G * 8;
    if (F.tid < LDS_PH / 4) ((LAS unsigned*)lds0)[F.tid] = 0u;
    __syncthreads();
#if !MK_SPLIT
    XcdBarrier bar = xcd_barrier_post(F.ctl + CW_BAR, (volatile LAS unsigned*)lds0);
#else
    XcdBarrier bar; bar.bar = F.ctl + CW_BAR; bar.x = 0; bar.st = (volatile LAS unsigned*)lds0;
#endif
    const int lo = a.ph_lo, hi = a.ph_hi;
#define IN(k) (lo <= (k) && (k) < hi)
    if (IN(0)) { phase_prologue(F, a); GRID_BAR(); }
    if (IN(2)) { phase_mod0(F, a); GRID_BAR(); }
    int cv_it = F.gw;
    run_mixer<0>(F, a, bar, lo, hi, 0, 0, 0, cv_it);
    run_moe(F, a, bar, lo, hi, 0, 0);
    run_mixer<1>(F, a, bar, lo, hi, 1, 0, 1, cv_it);
    run_moe(F, a, bar, lo, hi, 1, 1);
    run_mixer<2>(F, a, bar, lo, hi, 2, 0, 0, cv_it);
    run_moe(F, a, bar, lo, hi, 2, 2);
    run_mixer<0>(F, a, bar, lo, hi, 3, 1, 2, cv_it);
    run_moe(F, a, bar, lo, hi, 3, 0);
#undef IN
}

extern "C" void kernel_launch(void* const* d_in, const int* in_sizes, int n_in, void* d_out, int out_size, void* d_ws, size_t ws_size, hipStream_t stream) {
    static int grid = 0;
    if (grid == 0) {
        if (n_in != 29 || out_size != 19529728 || ws_size < WS_END) { fprintf(stderr, "kernel_launch: unexpected sizes n_in %d out %d ws %zu\n", n_in, out_size, ws_size); grid = -1; return; }
        int dev = 0, cus = 0, per_cu = 0;
        if (hipGetDevice(&dev) != hipSuccess || hipDeviceGetAttribute(&cus, hipDeviceAttributeMultiprocessorCount, dev) != hipSuccess) { grid = -1; return; }
        if (hipFuncSetAttribute((const void*)mk_fwd, hipFuncAttributeMaxDynamicSharedMemorySize, LDS_BYTES) != hipSuccess) { fprintf(stderr, "kernel_launch: hipFuncSetAttribute failed\n"); grid = -1; return; }
        if (hipOccupancyMaxActiveBlocksPerMultiprocessor(&per_cu, (const void*)mk_fwd, 512, LDS_BYTES) != hipSuccess || per_cu < 1) fprintf(stderr, "kernel_launch: occupancy query says %d\n", per_cu);
        (void)hipGetLastError();
        grid = cus;
    }
    if (grid < 0) return;
    (void)hipMemsetAsync((char*)d_ws + WS_CTL, 0, CTL_BYTES, stream);
    Args a{};
    for (int i = 0; i < 29; ++i) a.in[i] = (const float*)d_in[i];
    a.out = (float*)d_out; a.ws = (unsigned char*)d_ws;
#if MK_SPLIT
    for (int p = 0; p < N_PHASES; ++p) {
        const int r = (p - 3) % 12, l = (p - 3) / 12;
        if (p >= 3) { const bool mla = (l % 3) == 2; if (!mla && (r == 1 || r == 2)) continue; }
        a.ph_lo = p; a.ph_hi = p + 1;
        hipLaunchKernelGGL(mk_fwd, dim3(grid), dim3(512), LDS_BYTES, stream, a);
    }
#else
    a.ph_lo = 0; a.ph_hi = N_PHASES;
    hipLaunchKernelGGL(mk_fwd, dim3(grid), dim3(512), LDS_BYTES, stream, a);
#endif
}
```

```cpp
#include <hip/hip_runtime.h>
#include <cstdio>
#include <cstdint>

#ifndef MK_SPLIT
#define MK_SPLIT 0
#endif
#ifndef MK_REP_ATTN
#define MK_REP_ATTN 1
#endif
#ifndef MK_REP_CONV
#define MK_REP_CONV 1
#endif
#ifndef MK_REP_POST
#define MK_REP_POST 1
#endif
#ifndef MK_REP_GEMM
#define MK_REP_GEMM 1
#endif
#ifndef MK_REP_LN1
#define MK_REP_LN1 1
#endif
#ifndef MK_REP_TOPK
#define MK_REP_TOPK 1
#endif
#ifndef MK_REP_GATH
#define MK_REP_GATH 1
#endif
#ifndef MK_REP_COMB
#define MK_REP_COMB 1
#endif
#ifndef MK_CHECK
#define MK_CHECK 0
#endif

#define LAS __attribute__((address_space(3)))
typedef unsigned short bf16;
typedef unsigned u32x4 __attribute__((ext_vector_type(4)));
typedef unsigned u32x2 __attribute__((ext_vector_type(2)));
typedef float f32x2 __attribute__((ext_vector_type(2)));
typedef float f32x4 __attribute__((ext_vector_type(4)));
typedef float f32x16 __attribute__((ext_vector_type(16)));
typedef short bf16x8 __attribute__((ext_vector_type(8)));
typedef __bf16 bf16x2_t __attribute__((ext_vector_type(2)));

constexpr int D = 1024, NCTX = 4096, NLAT = 8192, NTOK = 12288;
constexpr int NE = 16, FF = 2048, CAPC = 512, CAPL = 1024, ESLOTS = 1536, NSLOTS = 24576;
constexpr float ALPHA = 1.681792830507429f, LOG2E = 1.4426950408889634f;
constexpr float GQA_QS = 0.125f * LOG2E, MLA_QS = 0.10206207261596575f * LOG2E;
constexpr size_t DWN_PART = (size_t)8 << 20;
constexpr int OFF_YP = 0, OFF_NK = 12582912, OFF_NV = OFF_NK + 3145728, OFF_CKV = OFF_NV + 3145728, OFF_KPE = OFF_CKV + 524288;

constexpr size_t MiB = 1u << 20;
constexpr size_t WS_CTL = 0, CTL_BYTES = 1 * MiB;
constexpr size_t WS_ADAP = 1 * MiB, WS_ADA = 9 * MiB, WS_ROPE64 = 10 * MiB, WS_ROPE32 = 10 * MiB + 512 * 1024;
constexpr size_t WS_AFF = 11 * MiB, WS_IDX = 12 * MiB, WS_GATEV = 12 * MiB + 128 * 1024, WS_SLOTMAP = 13 * MiB;
constexpr size_t WS_X = 16 * MiB, WS_H = 64 * MiB, WS_O = 88 * MiB, WS_AO = 112 * MiB, WS_QKV = 160 * MiB, WS_KVRAW = 232 * MiB;
constexpr size_t WS_X1 = 292 * MiB  , WS_KB = 380 * MiB, WS_VT = 428 * MiB, WS_QA = 460 * MiB, WS_CKVA = 466 * MiB;
constexpr size_t WS_XE = 470 * MiB, WS_HID = 518 * MiB, WS_YE = 614 * MiB;
constexpr size_t WS_WQKV = 712 * MiB, WS_WO = 724 * MiB, WS_WDN = 732 * MiB, WS_WUQ = 733 * MiB, WS_WUKV = 734 * MiB;
constexpr size_t WS_WGU = 736 * MiB, WS_WD = 1248 * MiB, WS_END = 1504 * MiB;
constexpr int CW_ERR = 0, CW_BAR = 4096, CW_KV = 8192;

constexpr int LDS_BYTES = 147456, LDS_PH = 256;

__device__ __forceinline__ unsigned cvtpk(float lo, float hi) { f32x2 v = {lo, hi}; bf16x2_t b = __builtin_convertvector(v, bf16x2_t); return __builtin_bit_cast(unsigned, b); }
__device__ __forceinline__ bf16 f2bf(float f) { return (bf16)(cvtpk(f, 0.f) & 0xffffu); }
__device__ __forceinline__ float bf2f(bf16 b) { return __uint_as_float(((unsigned)b) << 16); }
__device__ __forceinline__ unsigned pk4_fp8(float a, float b, float c, float d) { int w = __builtin_amdgcn_cvt_pk_fp8_f32(a, b, 0, false); w = __builtin_amdgcn_cvt_pk_fp8_f32(c, d, w, true); return (unsigned)w; }
constexpr float W8_SCALE = 64.f, H8_SCALE = 8.f;
constexpr float YE8_SCALE = 128.f;
__device__ __forceinline__ float clamp8(float x) { return __builtin_amdgcn_fmed3f(x, -448.f, 448.f); }
__device__ __forceinline__ f32x4 bf4(u32x2 w) { return (f32x4){__uint_as_float(w.x << 16), __uint_as_float(w.x & 0xffff0000u), __uint_as_float(w.y << 16), __uint_as_float(w.y & 0xffff0000u)}; }
__device__ __forceinline__ u32x2 pk4(f32x4 v) { u32x2 w; w.x = cvtpk(v[0], v[1]); w.y = cvtpk(v[2], v[3]); return w; }
template <int CTRL> __device__ __forceinline__ float dppf(float v) { return __uint_as_float((unsigned)__builtin_amdgcn_update_dpp(0, (int)__float_as_uint(v), CTRL, 0xf, 0xf, true)); }
constexpr int DPP_X1 = 0xB1, DPP_X2 = 0x4E, DPP_HMIR = 0x141, DPP_MIR = 0x140, DPP_X8 = 0x128;
__device__ __forceinline__ float xsum16(float a, float b) { const auto r = __builtin_amdgcn_permlane16_swap(__float_as_uint(a), __float_as_uint(b), false, false); return __uint_as_float(r[0]) + __uint_as_float(r[1]); }
__device__ __forceinline__ float xsum32(float a, float b) { const auto r = __builtin_amdgcn_permlane32_swap(__float_as_uint(a), __float_as_uint(b), false, false); return __uint_as_float(r[0]) + __uint_as_float(r[1]); }
__device__ __forceinline__ float xmax16(float a) { const auto r = __builtin_amdgcn_permlane16_swap(__float_as_uint(a), __float_as_uint(a), false, false); return fmaxf(__uint_as_float(r[0]), __uint_as_float(r[1])); }
__device__ __forceinline__ float xmax32(float a) { const auto r = __builtin_amdgcn_permlane32_swap(__float_as_uint(a), __float_as_uint(a), false, false); return fmaxf(__uint_as_float(r[0]), __uint_as_float(r[1])); }
__device__ __forceinline__ float sum16(float v) { v += dppf<DPP_X1>(v); v += dppf<DPP_X2>(v); v += dppf<DPP_HMIR>(v); v += dppf<DPP_MIR>(v); return v; }
__device__ __forceinline__ float wave_sum(float v) { v = sum16(v); v = xsum16(v, v); return xsum32(v, v); }
__device__ __forceinline__ float wave_max(float v) {
    v = fmaxf(v, dppf<DPP_X1>(v)); v = fmaxf(v, dppf<DPP_X2>(v)); v = fmaxf(v, dppf<DPP_HMIR>(v)); v = fmaxf(v, dppf<DPP_MIR>(v)); v = xmax16(v); return xmax32(v);
}
__device__ __forceinline__ int cond_of(int t) { return t < NCTX ? 0 : 1 + ((t - NCTX) >> 11); }
__device__ __forceinline__ unsigned hash_u(unsigned x) { x ^= x >> 16; x *= 0x7feb352dU; x ^= x >> 15; x *= 0x846ca68bU; x ^= x >> 16; return x; }

#define XB_TMO      128
#define XB_XCNT(j)  (256  + 64 * (j))
#define XB_XSUB(j)  (1280 + 64 * (j))
#define XB_XGEN(j)  (2304 + 64 * (j))
#define XB_TOP      3328
#define XB_TOPGEN   3392
#define XCD_BAR_WORDS 3456
#define XB_SPIN_CAP (1u << 18)
__device__ __forceinline__ unsigned xb_ld(unsigned* p)              { return __hip_atomic_load(p, __ATOMIC_RELAXED, __HIP_MEMORY_SCOPE_AGENT); }
__device__ __forceinline__ unsigned xb_add(unsigned* p, unsigned v) { return __hip_atomic_fetch_add(p, v, __ATOMIC_RELAXED, __HIP_MEMORY_SCOPE_AGENT); }
__device__ __forceinline__ unsigned xb_xcc_id() { return (unsigned)__builtin_amdgcn_s_getreg((3 << 11) | 20) & 0xFu; }
#define XB_SPIN(cond, bar) do { unsigned _sp = 0; while (cond) { __builtin_amdgcn_s_sleep(1); \
    if ((++_sp & 255u) == 0u) { if (xb_ld(&(bar)[XB_TMO])) break; if (_sp > XB_SPIN_CAP) { atomicAdd(&(bar)[XB_TMO], 1u); break; } } } } while (0)
struct XcdBarrier { unsigned* bar; unsigned x; volatile LAS unsigned* st; };
__device__ __forceinline__ XcdBarrier xcd_barrier_post(unsigned* bar, volatile LAS unsigned* st) {
    XcdBarrier b; b.bar = bar; b.x = xb_xcc_id(); b.st = st;
    if (threadIdx.x == 0) (void)xb_add(&bar[XB_XCNT(b.x)], 1u);
    return b;
}
__device__ __forceinline__ void xcd_barrier_complete(unsigned* bar, unsigned x, unsigned& nloc, unsigned& nx) {
    const unsigned G = gridDim.x * gridDim.y * gridDim.z;
    unsigned sum, cnt, mine, sp = 0u;
    for (;;) {
        sum = 0u; cnt = 0u; mine = 0u;
#pragma unroll
        for (unsigned j = 0; j < 16; ++j) { const unsigned c = xb_ld(&bar[XB_XCNT(j)]); sum += c; cnt += (c > 0u) ? 1u : 0u; mine = (j == x) ? c : mine; }
        if (sum == G) break;
        __builtin_amdgcn_s_sleep(1);
        if ((++sp & 255u) == 0u) { if (xb_ld(&bar[XB_TMO])) break; if (sp > XB_SPIN_CAP) { atomicAdd(&bar[XB_TMO], 1u); break; } }
    }
    nloc = mine > 0u ? mine : 1u; nx = cnt > 0u ? cnt : 1u;
}
__device__ __forceinline__ void xcd_barrier(const XcdBarrier& b) {
    asm volatile("s_waitcnt vmcnt(0)" ::: "memory");
    __syncthreads();
    if (threadIdx.x == 0) {
        unsigned* bar = b.bar;
        __builtin_amdgcn_s_waitcnt(0);
        unsigned nloc = b.st[0], nx = b.st[1];
        if (nloc == 0u) { xcd_barrier_complete(bar, b.x, nloc, nx); b.st[0] = nloc; b.st[1] = nx; }
        const unsigned old = xb_add(&bar[XB_XSUB(b.x)], 1u);
        const unsigned gen = old / nloc;
        if (old + 1u == (gen + 1u) * nloc) {
            __builtin_amdgcn_fence(__ATOMIC_RELEASE, "agent");
            asm volatile("s_waitcnt vmcnt(0)" ::: "memory");
            const unsigned og = xb_add(&bar[XB_TOP], 1u);
            const unsigned tg = og / nx;
            if (og + 1u == (tg + 1u) * nx) xb_add(&bar[XB_TOPGEN], 1u);
            else XB_SPIN(xb_ld(&bar[XB_TOPGEN]) == tg, bar);
            __builtin_amdgcn_fence(__ATOMIC_ACQUIRE, "agent");
            xb_add(&bar[XB_XGEN(b.x)], 1u);
            asm volatile("s_waitcnt vmcnt(0)" ::: "memory");
        } else {
            XB_SPIN(xb_ld(&bar[XB_XGEN(b.x)]) == gen, bar);
            __builtin_amdgcn_fence(__ATOMIC_ACQUIRE, "agent");
            asm volatile("s_waitcnt vmcnt(0)" ::: "memory");
        }
    }
    __syncthreads();
}

struct Args { const float* in[29]; float* out; unsigned char* ws; int ph_lo, ph_hi; };
struct Frame {
    LAS unsigned char* lds;
    unsigned char* ws; float* out; unsigned* ctl;
    int tid, lane, wave, G, bid, gw, NGW;
};
#if MK_CHECK
#define CHK_FAIL(F, id) do { unsigned _e = 0u; __hip_atomic_compare_exchange_strong((F).ctl + CW_ERR, &_e, (unsigned)(id), __ATOMIC_RELAXED, __ATOMIC_RELAXED, __HIP_MEMORY_SCOPE_AGENT); } while (0)
#endif
__device__ __forceinline__ bool close_enough(float a, float b, float rel, float abs_) { const float d = fabsf(a - b); return d <= rel * fabsf(b) + abs_ && a == a; }

namespace pg8 {
#define PG8_LAS __attribute__((address_space(3)))
typedef unsigned short bf16_t;
typedef short bf16x8 __attribute__((ext_vector_type(8)));
typedef float f32x4 __attribute__((ext_vector_type(4)));
constexpr int BM = 256, BK = 64, HALF = 128, HTB = HALF * BK * 2  , STAGE_BYTES = 8 * HTB, NXCD = 8, WGM = 8;

__host__ __device__ __forceinline__ int lds_byte(int r, int c, int XM = 32) { const int st = (r >> 4) * 2 + (c >> 5), rr = r & 15, cc = c & 31, ob = rr * 64 + cc * 2; return st * 1024 + (ob ^ (((ob >> 9) & 1) * XM)); }
__host__ __device__ __forceinline__ void stage_rc(int b, int& R, int& C, int XM = 32) { const int st = b / 1024, sb = b % 1024, swz = sb ^ (((sb >> 9) & 1) * XM); R = (st >> 1) * 16 + swz / 64; C = (st & 1) * 32 + (swz % 64) / 2; }
__host__ __device__ __forceinline__ int perm32(int rho) { const int n = rho >> 4, i = rho & 15; return 8 * (i >> 2) + 4 * n + (i & 3); }
struct Unit { int pm, pn, kb; int kt = 0; };
struct Gemm { const bf16_t* A; const bf16_t* Bt; int K, ld; const int* aidx; };
template <class Epi, class Sched, bool ALIGN_EPI = false, bool SP2 = false, bool GATHER = false, bool F8 = false>
__device__ __forceinline__ void gemm_phase(PG8_LAS unsigned char* lds, const Gemm g, const Sched& S, const Epi& E) {
    int tid_ = threadIdx.x; asm volatile("" : "+v"(tid_));
    const int tid = tid_, wid = __builtin_amdgcn_readfirstlane(tid >> 6), lane = tid & 63, wr = wid >> 2, wc = wid & 3, fr = lane & 15, fq = lane >> 4;
    const int K = g.K, LD = g.ld, nt = K / BK;
    unsigned voffA[2], voffB[2]; int RA[2]; unsigned CA2[2];
#pragma unroll
    for (int i = 0; i < 2; ++i) { int R, C; stage_rc(tid * 16 + i * 8192, R, C, F8 ? 48 : 32); const int Rb = Epi::PERM ? ((R & ~31) + perm32(R & 31)) : R;
        voffA[i] = (unsigned)(R * LD + C) * 2u; voffB[i] = (unsigned)(Rb * LD + C) * 2u; RA[i] = R; CA2[i] = (unsigned)C * 2u; }
    const size_t kstep = (size_t)(BK * 2);
    const size_t hstep = (size_t)HALF * LD * 2;
    const size_t tstep = 2 * hstep;
    const unsigned ldsw = (unsigned)wid * 1024u;
    const int aoff = lds_byte(wr * 64 + fr, F8 ? fq * 16 : fq * 8, F8 ? 48 : 32), boff = lds_byte(wc * 32 + fr, F8 ? fq * 16 : fq * 8, F8 ? 48 : 32);
    const int aoffh = aoff ^ 16, boffh = boff ^ 16;
    typedef int i32x8_t __attribute__((ext_vector_type(8)));
#define PG8_SA(b, h) (((b) * 2 + (h)) * HTB)
#define PG8_SB(b, h) ((4 + (b) * 2 + (h)) * HTB)
#define PG8_STAGE(bufoff, gbase, voff) do { _Pragma("unroll") for (int _i = 0; _i < 2; ++_i) \
        __builtin_amdgcn_global_load_lds((const unsigned*)((const char*)(gbase) + (voff)[_i]), (PG8_LAS unsigned*)(lds + (bufoff) + ldsw + _i * 8192), 16, 0, 0); } while (0)
#define PG8_GOFF(dst, unit) do { _Pragma("unroll") for (int _h = 0; _h < 2; ++_h) _Pragma("unroll") for (int _i = 0; _i < 2; ++_i) dst[_h][_i] = (unsigned)g.aidx[(unit).pm * 256 + _h * 128 + RA[_i]] * (unsigned)(LD * 2) + CA2[_i]; } while (0)
#define PG8_STAGE_A(bufoff, gbase, h, nx) do { if constexpr (GATHER) { unsigned _o[2] = {(nx) ? oN[h][0] : oC[h][0], (nx) ? oN[h][1] : oC[h][1]}; PG8_STAGE(bufoff, gbase, _o); } else { PG8_STAGE(bufoff, (gbase) + (h) * hstep, voffA); } } while (0)
#define PG8_LDA16(dst, b, h) do { _Pragma("unroll") for (int m = 0; m < 4; ++m) _Pragma("unroll") for (int k = 0; k < 2; ++k) dst[m][k] = *(const PG8_LAS bf16x8*)(lds + PG8_SA(b, h) + aoff + m * 2048 + k * 1024); } while (0)
#define PG8_LDB16(dst, b, h) do { _Pragma("unroll") for (int n = 0; n < 2; ++n) _Pragma("unroll") for (int k = 0; k < 2; ++k) dst[n][k] = *(const PG8_LAS bf16x8*)(lds + PG8_SB(b, h) + boff + n * 2048 + k * 1024); } while (0)
#define PG8_MMA16(ai, bj, At, Bt) do { __builtin_amdgcn_s_setprio(1); _Pragma("unroll") for (int m = 0; m < 4; ++m) _Pragma("unroll") for (int n = 0; n < 2; ++n) _Pragma("unroll") for (int k = 0; k < 2; ++k) \
        acc[ai][bj][m][n] = __builtin_amdgcn_mfma_f32_16x16x32_bf16(Bt[n][k], At[m][k], acc[ai][bj][m][n], 0, 0, 0); __builtin_amdgcn_s_setprio(0); } while (0)
#define PG8_LD32(p, lo, hi) __builtin_bit_cast(i32x8_t, __builtin_shufflevector(*(const PG8_LAS bf16x8*)((p) + (lo)), *(const PG8_LAS bf16x8*)((p) + (hi)), 0, 1, 2, 3, 4, 5, 6, 7, 8, 9, 10, 11, 12, 13, 14, 15))
#define PG8_LDA(dst, b, h) do { if constexpr (F8) { _Pragma("unroll") for (int m = 0; m < 4; ++m) dst##8[m] = PG8_LD32(lds + PG8_SA(b, h) + m * 2048, aoff, aoffh); } else { PG8_LDA16(dst, b, h); } } while (0)
#define PG8_LDB(dst, b, h) do { if constexpr (F8) { _Pragma("unroll") for (int n = 0; n < 2; ++n) dst##8[n] = PG8_LD32(lds + PG8_SB(b, h) + n * 2048, boff, boffh); } else { PG8_LDB16(dst, b, h); } } while (0)
#define PG8_MMA(ai, bj, At, Bt) do { if constexpr (F8) { __builtin_amdgcn_s_setprio(1); _Pragma("unroll") for (int m = 0; m < 4; ++m) _Pragma("unroll") for (int n = 0; n < 2; ++n) \
        asm volatile("v_mfma_f32_16x16x128_f8f6f4 %0, %1, %2, %0" : "+v"(acc[ai][bj][m][n]) : "v"(Bt##8[n]), "v"(At##8[m])); __builtin_amdgcn_s_setprio(0); } else { PG8_MMA16(ai, bj, At, Bt); } } while (0)
#define PG8_WAIT_V(n) asm volatile("s_waitcnt vmcnt(" #n ")" ::: "memory")
#define PG8_WAIT_L(n) asm volatile("s_waitcnt lgkmcnt(" #n ")" ::: "memory")
#define PG8_BAR __builtin_amdgcn_s_barrier()
#define PG8_SCHED __builtin_amdgcn_sched_barrier(0)
    Unit cur, nxt; int ui = 0;
    if (!S.next(0, cur)) return;
    unsigned oC[2][2] = {{0u, 0u}, {0u, 0u}}, oN[2][2] = {{0u, 0u}, {0u, 0u}};
    if constexpr (GATHER) PG8_GOFF(oC, cur);
    f32x4 acc[2][2][4][2];
#pragma unroll
    for (int a = 0; a < 2; ++a)
#pragma unroll
        for (int b = 0; b < 2; ++b)
#pragma unroll
            for (int m = 0; m < 4; ++m)
#pragma unroll
                for (int n = 0; n < 2; ++n) acc[a][b][m][n] = (f32x4){0.f, 0.f, 0.f, 0.f};
    bf16x8 At[4][2], B0[2][2], B1[2][2]; i32x8_t At8[4], B08[2], B18[2];
    const char* cA = GATHER ? (const char*)g.A + cur.kb : (const char*)g.A + (size_t)cur.pm * tstep + cur.kb; const char* cB = (const char*)g.Bt + (size_t)cur.pn * tstep + cur.kb;
    S.a_ready(cur);
    if constexpr (SP2) {
        PG8_STAGE(PG8_SB(0, 0), cB, voffB); PG8_STAGE(PG8_SB(0, 1), cB + hstep, voffB); PG8_STAGE_A(PG8_SA(0, 0), cA, 0, false); PG8_STAGE_A(PG8_SA(0, 1), cA, 1, false);
        if (wr == 1) PG8_BAR;
        PG8_WAIT_V(2); PG8_BAR;
        PG8_STAGE(PG8_SB(1, 0), cB + kstep, voffB); PG8_STAGE_A(PG8_SA(1, 0), cA + kstep, 0, false); PG8_STAGE(PG8_SB(1, 1), cB + hstep + kstep, voffB);
        PG8_WAIT_V(6); PG8_BAR;
    } else {
        PG8_STAGE(PG8_SB(0, 0), cB, voffB); PG8_STAGE_A(PG8_SA(0, 0), cA, 0, false); PG8_STAGE(PG8_SB(0, 1), cB + hstep, voffB); PG8_STAGE_A(PG8_SA(0, 1), cA, 1, false);
        if (wr == 1) PG8_BAR;
        PG8_WAIT_V(4); PG8_BAR;
        PG8_STAGE(PG8_SB(1, 0), cB + kstep, voffB); PG8_STAGE_A(PG8_SA(1, 0), cA + kstep, 0, false); PG8_STAGE(PG8_SB(1, 1), cB + hstep + kstep, voffB);
        PG8_WAIT_V(6); PG8_BAR;
    }
    for (;;) {
        const bool has_next = S.next(ui + 1, nxt);
        const char* nA = has_next ? (GATHER ? (const char*)g.A + nxt.kb : (const char*)g.A + (size_t)nxt.pm * tstep + nxt.kb) : cA;
        if constexpr (GATHER) { if (has_next) PG8_GOFF(oN, nxt); } const char* nB = has_next ? (const char*)g.Bt + (size_t)nxt.pn * tstep + nxt.kb : cB;
        const int unt = cur.kt ? cur.kt : nt;
        for (int t = 0; t < unt; t += 2) {
            const bool last = (t == unt - 2); const bool lastn = last && has_next;
            const char* a1 = cA + (size_t)(t + 1) * kstep;
            const char* a2 = last ? nA : cA + (size_t)(t + 2) * kstep; const char* b2 = last ? nB : cB + (size_t)(t + 2) * kstep;
            const char* a3 = a2 + kstep; const char* b3 = b2 + kstep;
            if (last && has_next) S.a_ready(nxt);
            if constexpr (SP2) {
            PG8_LDB(B0, 0, 0); PG8_LDB(B1, 0, 1); PG8_SCHED; PG8_LDA(At, 0, 0); PG8_STAGE_A(PG8_SA(1, 1), a1, 1, false);
            PG8_WAIT_V(8); PG8_WAIT_L(0); PG8_BAR; PG8_MMA(0, 0, At, B0); PG8_MMA(0, 1, At, B1); PG8_BAR; PG8_SCHED;
            PG8_LDA(At, 0, 1); PG8_STAGE(PG8_SB(0, 0), b2, voffB); PG8_STAGE(PG8_SB(0, 1), b2 + hstep, voffB); PG8_STAGE_A(PG8_SA(0, 0), a2, 0, lastn);
            PG8_WAIT_V(8); PG8_WAIT_L(0); PG8_BAR; PG8_MMA(1, 0, At, B0); PG8_MMA(1, 1, At, B1); PG8_BAR; PG8_SCHED;
            PG8_LDB(B0, 1, 0); PG8_LDB(B1, 1, 1); PG8_SCHED; PG8_LDA(At, 1, 0); PG8_STAGE_A(PG8_SA(0, 1), a2, 1, lastn);
            PG8_WAIT_V(8); PG8_WAIT_L(0); PG8_BAR; PG8_MMA(0, 0, At, B0); PG8_MMA(0, 1, At, B1); PG8_BAR; PG8_SCHED;
            PG8_LDA(At, 1, 1); PG8_STAGE(PG8_SB(1, 0), b3, voffB); PG8_STAGE(PG8_SB(1, 1), b3 + hstep, voffB); PG8_STAGE_A(PG8_SA(1, 0), a3, 0, lastn);
            PG8_WAIT_V(8); PG8_WAIT_L(0); PG8_BAR; PG8_MMA(1, 0, At, B0); PG8_MMA(1, 1, At, B1); PG8_BAR; PG8_SCHED;
            } else {
            PG8_LDB(B0, 0, 0); PG8_SCHED; PG8_LDA(At, 0, 0); PG8_STAGE_A(PG8_SA(1, 1), a1, 1, false);
            PG8_WAIT_L(8); PG8_BAR; PG8_WAIT_L(0); PG8_MMA(0, 0, At, B0); PG8_BAR; PG8_SCHED;
            PG8_LDB(B1, 0, 1); PG8_STAGE(PG8_SB(0, 0), b2, voffB);
            PG8_BAR; PG8_WAIT_L(0); PG8_MMA(0, 1, At, B1); PG8_BAR;
            PG8_LDA(At, 0, 1); PG8_STAGE_A(PG8_SA(0, 0), a2, 0, lastn);
            PG8_BAR; PG8_WAIT_L(0); PG8_MMA(1, 0, At, B0); PG8_BAR; PG8_SCHED;
            PG8_STAGE(PG8_SB(0, 1), b2 + hstep, voffB);
            PG8_WAIT_V(6); PG8_BAR; PG8_MMA(1, 1, At, B1); PG8_BAR;
            PG8_LDB(B0, 1, 0); PG8_SCHED; PG8_LDA(At, 1, 0); PG8_STAGE_A(PG8_SA(0, 1), a2, 1, lastn);
            PG8_WAIT_L(8); PG8_BAR; PG8_WAIT_L(0); PG8_MMA(0, 0, At, B0); PG8_BAR; PG8_SCHED;
            PG8_LDB(B1, 1, 1); PG8_STAGE(PG8_SB(1, 0), b3, voffB);
            PG8_BAR; PG8_WAIT_L(0); PG8_MMA(0, 1, At, B1); PG8_BAR;
            PG8_LDA(At, 1, 1); PG8_STAGE_A(PG8_SA(1, 0), a3, 0, lastn);
            PG8_BAR; PG8_WAIT_L(0); PG8_MMA(1, 0, At, B0); PG8_BAR; PG8_SCHED;
            PG8_STAGE(PG8_SB(1, 1), b3 + hstep, voffB);
            PG8_WAIT_V(6); PG8_BAR; PG8_MMA(1, 1, At, B1); PG8_BAR;
            }
        }
        if constexpr (ALIGN_EPI) { if (wr == 0) PG8_BAR; }
        if constexpr (F8) {
#pragma unroll
            for (int a = 0; a < 2; ++a)
#pragma unroll
                for (int b = 0; b < 2; ++b)
                    asm volatile("s_nop 15\n\ts_nop 7" : "+v"(acc[a][b][0][0]), "+v"(acc[a][b][0][1]), "+v"(acc[a][b][1][0]), "+v"(acc[a][b][1][1]), "+v"(acc[a][b][2][0]), "+v"(acc[a][b][2][1]), "+v"(acc[a][b][3][0]), "+v"(acc[a][b][3][1])); }
        if constexpr (!Epi::AFTER_DRAIN) { E(acc, cur, wr, wc, fr, fq); S.done(cur); }
        if (!has_next) break;
#pragma unroll
        for (int a = 0; a < 2; ++a)
#pragma unroll
            for (int b = 0; b < 2; ++b)
#pragma unroll
                for (int m = 0; m < 4; ++m)
#pragma unroll
                    for (int n = 0; n < 2; ++n) acc[a][b][m][n] = (f32x4){0.f, 0.f, 0.f, 0.f};
        cur = nxt; cA = nA; cB = nB; ++ui;
        if constexpr (GATHER) { oC[0][0] = oN[0][0]; oC[0][1] = oN[0][1]; oC[1][0] = oN[1][0]; oC[1][1] = oN[1][1]; }
        if constexpr (ALIGN_EPI) { if (wr == 1) PG8_BAR; }
    }
    PG8_WAIT_V(0);
    if constexpr (!ALIGN_EPI) { if (wr == 0) PG8_BAR; }
    PG8_BAR;
    if constexpr (Epi::AFTER_DRAIN) { E.fused(acc, cur, wr, wc, fr, fq, lds, wid, lane); S.done(cur); }
#undef PG8_SA
#undef PG8_SB
#undef PG8_STAGE
#undef PG8_STAGE_A
#undef PG8_GOFF
#undef PG8_LDA
#undef PG8_LDA16
#undef PG8_LD32
#undef PG8_LDB16
#undef PG8_MMA16
#undef PG8_LDB
#undef PG8_MMA
#undef PG8_WAIT_V
#undef PG8_WAIT_L
#undef PG8_BAR
#undef PG8_SCHED
}
}
using pg8::Unit; using pg8::Gemm;
struct ChunkMap { int x, loc, nx, chunk;
    __device__ void init(int G, int bid) { if (G % 8 == 0) { nx = 8; chunk = G / 8; x = bid % 8; loc = bid / 8; } else { nx = 1; chunk = G; x = 0; loc = bid; } }
    __device__ __forceinline__ int lin(int i) const { return (i * nx + x) * chunk + loc; } };
struct PlainOrder {
    int nN, total; ChunkMap cm;
    __device__ bool next(int i, Unit& u) const { const int L = cm.lin(i); if (L >= total) return false; u.pm = L / nN; u.pn = L % nN; u.kb = 0; return true; }
    __device__ __forceinline__ void a_ready(const Unit&) const {}
    __device__ __forceinline__ void done(const Unit&) const {}
};
struct QkvOrder { ChunkMap cm;
    __device__ bool next(int i, Unit& u) const { const int L = cm.lin(i); if (L >= 288) return false;
        if (L >= 32 && L < 128) { const int r = L - 32; u.pm = r >> 1; u.pn = 4 + (r & 1); } else { const int r = L < 32 ? L : L - 96; u.pm = r >> 2; u.pn = r & 3; }
        u.kb = 0; return true; }
    __device__ __forceinline__ void a_ready(const Unit&) const {}
    __device__ __forceinline__ void done(const Unit&) const {}
};
struct SplitKOrder {
    int nN, ks, kbytes, total; ChunkMap cm;
    __device__ bool next(int i, Unit& u) const { const int L = cm.lin(i); if (L >= total) return false; const int t = L / ks; u.pm = t / nN; u.pn = t % nN; u.kb = (L % ks) * kbytes; return true; }
    __device__ __forceinline__ void a_ready(const Unit&) const {}
    __device__ __forceinline__ void done(const Unit&) const {}
};
struct GroupedOrder {
    int mt, nt, ks, kbytes; ChunkMap cm;
    __device__ bool next(int i, Unit& u) const { const int L = cm.lin(i), per = mt * nt * ks; if (L >= NE * per) return false; const int e = L / per, r = L % per, m = r / (nt * ks), q = r % (nt * ks);
        u.pm = e * mt + m; u.pn = e * nt + q / ks; u.kb = (q % ks) * kbytes; return true; }
    __device__ __forceinline__ void a_ready(const Unit&) const {}
    __device__ __forceinline__ void done(const Unit&) const {}
};
constexpr int DOWN_FULL_PANELS = 64;
struct DownOrder { ChunkMap cm;
    __device__ bool next(int i, Unit& u) const { const int L = cm.lin(i >> 1); if (L >= 256) return false; const int half = i & 1; const int T = half ? 256 + (L >> 1) : L;
        u.pm = T >> 2; u.pn = (u.pm / 6) * 4 + (T & 3); u.kb = half ? (L & 1) * 1024 : 0; u.kt = half ? 8 : 16; return true; }
    __device__ __forceinline__ void a_ready(const Unit&) const {}
    __device__ __forceinline__ void done(const Unit&) const {}
};
struct EpiF32 { float* C; int ldc; size_t kstride; static constexpr bool PERM = false, AFTER_DRAIN = false;
    __device__ __forceinline__ void operator()(const f32x4 (&acc)[2][2][4][2], const Unit& u, int wr, int wc, int fr, int fq) const {
#pragma unroll
        for (int ai = 0; ai < 2; ++ai)
#pragma unroll
            for (int m = 0; m < 4; ++m) { float* rp = C + (u.kb ? kstride : (size_t)0) + (size_t)(u.pm * 256 + ai * 128 + wr * 64 + m * 16 + fr) * ldc + u.pn * 256 + wc * 32 + 4 * fq;
#pragma unroll
                for (int bj = 0; bj < 2; ++bj)
#pragma unroll
                    for (int n = 0; n < 2; ++n) *(f32x4*)(rp + bj * 128 + n * 16) = acc[ai][bj][m][n]; }
    }
};
struct EpiBf16P { bf16* C; int ldc; static constexpr bool PERM = true, AFTER_DRAIN = false;
    __device__ __forceinline__ void operator()(const f32x4 (&acc)[2][2][4][2], const Unit& u, int wr, int wc, int fr, int fq) const {
#pragma unroll
        for (int ai = 0; ai < 2; ++ai)
#pragma unroll
            for (int m = 0; m < 4; ++m) { bf16* rp = C + (size_t)(u.pm * 256 + ai * 128 + wr * 64 + m * 16 + fr) * ldc + u.pn * 256 + wc * 32 + 8 * fq;
#pragma unroll
                for (int bj = 0; bj < 2; ++bj) { const f32x4 v0 = acc[ai][bj][m][0], v1 = acc[ai][bj][m][1]; u32x4 w; w.x = cvtpk(v0[0], v0[1]); w.y = cvtpk(v0[2], v0[3]); w.z = cvtpk(v1[0], v1[1]); w.w = cvtpk(v1[2], v1[3]);
                    *(u32x4*)(rp + bj * 128) = w; } }
    }
};
__device__ __forceinline__ float silu_f(float x) { return x * __builtin_amdgcn_rcpf(1.f + __builtin_amdgcn_exp2f(-x * LOG2E)); }
struct EpiSwiglu { unsigned char* HID; static constexpr bool PERM = true, AFTER_DRAIN = false;
    __device__ __forceinline__ void operator()(const f32x4 (&acc)[2][2][4][2], const Unit& u, int wr, int wc, int fr, int fq) const {
        const int cb = (u.pn & 15) * 128 + wc * 32 + 8 * fq; constexpr float IS = 1.f / W8_SCALE;
#pragma unroll
        for (int ai = 0; ai < 2; ++ai)
#pragma unroll
            for (int m = 0; m < 4; ++m) { unsigned char* rp = HID + (size_t)(u.pm * 256 + ai * 128 + wr * 64 + m * 16 + fr) * FF + cb; u32x2 w;
#pragma unroll
                for (int n = 0; n < 2; ++n) { const f32x4 g = acc[ai][0][m][n] * IS, up = acc[ai][1][m][n] * (IS * H8_SCALE);
                    const unsigned pk = pk4_fp8(silu_f(g[0]) * up[0], silu_f(g[1]) * up[1], silu_f(g[2]) * up[2], silu_f(g[3]) * up[3]); if (n == 0) w.x = pk; else w.y = pk; }
                *(u32x2*)rp = w; asm volatile("" ::: "memory"); }
    }
};
struct EpiDown { unsigned char* YE; const float* gate; static constexpr bool PERM = true, AFTER_DRAIN = false;
    __device__ __forceinline__ void operator()(const f32x4 (&acc)[2][2][4][2], const Unit& u, int wr, int wc, int fr, int fq) const {
        const int cb = (u.pn & 3) * 256 + wc * 32 + 8 * fq;
#pragma unroll
        for (int ai = 0; ai < 2; ++ai)
#pragma unroll
            for (int m = 0; m < 4; ++m) { const int row = u.pm * 256 + ai * 128 + wr * 64 + m * 16 + fr; const float gv = gate[row] * (YE8_SCALE / (W8_SCALE * H8_SCALE)); unsigned char* rp = YE + (size_t)(u.kb ? NSLOTS : 0) * D + (size_t)row * D + cb;
#pragma unroll
                for (int bj = 0; bj < 2; ++bj) { const f32x4 v0 = acc[ai][bj][m][0] * gv, v1 = acc[ai][bj][m][1] * gv; u32x2 w;
                    w.x = pk4_fp8(clamp8(v0[0]), clamp8(v0[1]), clamp8(v0[2]), clamp8(v0[3])); w.y = pk4_fp8(clamp8(v1[0]), clamp8(v1[1]), clamp8(v1[2]), clamp8(v1[3])); *(u32x2*)(rp + bj * 128) = w; } }
    }
};

#if MK_CHECK
__device__ __forceinline__ float fp8f(const unsigned char* p, int i) { const int w = ((const int*)p)[i >> 2]; const int b = i & 3; return b == 0 ? __builtin_amdgcn_cvt_f32_fp8(w, 0) : b == 1 ? __builtin_amdgcn_cvt_f32_fp8(w, 1) : b == 2 ? __builtin_amdgcn_cvt_f32_fp8(w, 2) : __builtin_amdgcn_cvt_f32_fp8(w, 3); }
__device__ __forceinline__ float dot_fp8(const unsigned char* a, const unsigned char* b, int K, int lane) { float s = 0.f; for (int k = lane; k < K; k += 64) s += fp8f(a, k) * fp8f(b, k); return wave_sum(s); }
__device__ __forceinline__ float dot_bf16(const bf16* a, const bf16* b, int K, int lane) {
    float s = 0.f; for (int k = lane; k < K; k += 64) s += bf2f(a[k]) * bf2f(b[k]); return wave_sum(s);
}
#endif

__constant__ double INVF[16] = {1.0, 0.5623413251903491, 0.31622776601683794, 0.1778279410038923, 0.1, 0.05623413251903491, 0.03162277660168379, 0.01778279410038923,
                                0.01, 0.005623413251903491, 0.0031622776601683794, 0.0017782794100389228, 0.001, 0.0005623413251903491, 0.00031622776601683794, 0.00017782794100389227};
__device__ __forceinline__ void sincos_d(double a, float& s, float& c) {
    const double k = __builtin_rint(a * 0.6366197723675814), r = a - k * 1.5707963267948966, r2 = r * r;
    const double sr = r * (1.0 + r2 * (-1.0 / 6 + r2 * (1.0 / 120 + r2 * (-1.0 / 5040 + r2 * (1.0 / 362880 + r2 * (-1.0 / 39916800 + r2 * (1.0 / 6227020800.0)))))));
    const double cr = 1.0 + r2 * (-0.5 + r2 * (1.0 / 24 + r2 * (-1.0 / 720 + r2 * (1.0 / 40320 + r2 * (-1.0 / 3628800 + r2 * (1.0 / 479001600.0))))));
    const int q = ((int)k) & 3;
    const double ss = (q == 0) ? sr : (q == 1) ? cr : (q == 2) ? -sr : -cr;
    const double cc = (q == 0) ? cr : (q == 1) ? -sr : (q == 2) ? -cr : sr;
    s = (float)ss; c = (float)cc;
}
__device__ __forceinline__ void conv_load(f32x4 (&v)[16], const float* W, int N, int k0, int n0, int lane) {
    const int r4 = lane >> 4, c16 = lane & 15, n = n0 + 4 * c16;
    if (n >= N) return;
    const float* src = W + (size_t)(k0 + 16 * r4) * N + n;
#pragma unroll
    for (int i = 0; i < 16; ++i) v[i] = *(const f32x4*)(src + (size_t)i * N);
}
__device__ __forceinline__ void conv_store(const f32x4 (&v)[16], int N, bf16* WT, size_t rowbase, int ldk, int k0, int n0, int lane) {
    const int r4 = lane >> 4, c16 = lane & 15, n = n0 + 4 * c16;
    if (n >= N) return;
    bf16* dst = WT + (rowbase + 4 * c16) * (size_t)ldk + k0 + 16 * r4;
#pragma unroll
    for (int e = 0; e < 4; ++e) {
        u32x4 lo, hi;
        lo.x = cvtpk(v[0][e], v[1][e]); lo.y = cvtpk(v[2][e], v[3][e]); lo.z = cvtpk(v[4][e], v[5][e]); lo.w = cvtpk(v[6][e], v[7][e]);
        hi.x = cvtpk(v[8][e], v[9][e]); hi.y = cvtpk(v[10][e], v[11][e]); hi.z = cvtpk(v[12][e], v[13][e]); hi.w = cvtpk(v[14][e], v[15][e]);
        *(u32x4*)(dst + (size_t)e * ldk) = lo; *(u32x4*)(dst + (size_t)e * ldk + 8) = hi;
    }
}
__device__ __forceinline__ void conv_item(const float* W, int N, bf16* WT, size_t rowbase, int ldk, int k0, int n0, int lane) {
    f32x4 v[16]; conv_load(v, W, N, k0, n0, lane); conv_store(v, N, WT, rowbase, ldk, k0, n0, lane);
}
__device__ __forceinline__ void glds16(const void* gsrc, unsigned lds_dst) { unsigned keep;
    asm volatile("s_mov_b32 %0, m0\n\ts_mov_b32 m0, %2\n\ts_nop 0\n\tglobal_load_lds_dwordx4 %1, off\n\ts_mov_b32 m0, %0" : "=&s"(keep) : "v"(gsrc), "s"(lds_dst) : "memory"); }
__device__ __forceinline__ void glds16_nt(const void* gsrc, unsigned lds_dst) { unsigned keep;
    asm volatile("s_mov_b32 %0, m0\n\ts_mov_b32 m0, %2\n\ts_nop 0\n\tglobal_load_lds_dwordx4 %1, off nt\n\ts_mov_b32 m0, %0" : "=&s"(keep) : "v"(gsrc), "s"(lds_dst) : "memory"); }
__device__ __forceinline__ void conv_issue8(unsigned lds_scr, const float* W, int N, int k0, int n0, int lane) {
    const float* src = W + (size_t)(k0 + 8 * (lane >> 4)) * N + n0 + 4 * (lane & 15);
#pragma unroll
    for (int i = 0; i < 8; ++i) glds16_nt(src + (size_t)i * N, (unsigned)__builtin_amdgcn_readfirstlane(lds_scr + i * 1024));
}
__device__ __forceinline__ void conv_fetch8(f32x4 (&v)[8], const LAS unsigned char* scr, int lane) {
#pragma unroll
    for (int i = 0; i < 8; ++i) v[i] = *(const LAS f32x4*)(scr + i * 1024 + lane * 16);
}
__device__ __forceinline__ void conv_load8(f32x4 (&v)[8], const float* W, int N, int k0, int n0, int lane) {
    const float* src = W + (size_t)(k0 + 8 * (lane >> 4)) * N + n0 + 4 * (lane & 15);
#pragma unroll
    for (int i = 0; i < 8; ++i) v[i] = __builtin_nontemporal_load((const f32x4*)(src + (size_t)i * N));
}
__device__ __forceinline__ void conv_store8(const f32x4 (&v)[8], unsigned char* WT, size_t rowbase, int ldk, int k0, int lane) {
    unsigned char* dst = WT + (rowbase + 4 * (lane & 15)) * (size_t)ldk + k0 + 8 * (lane >> 4);
#pragma unroll
    for (int e = 0; e < 4; ++e) { u32x2 w; w.x = pk4_fp8(v[0][e] * W8_SCALE, v[1][e] * W8_SCALE, v[2][e] * W8_SCALE, v[3][e] * W8_SCALE); w.y = pk4_fp8(v[4][e] * W8_SCALE, v[5][e] * W8_SCALE, v[6][e] * W8_SCALE, v[7][e] * W8_SCALE);
        *(u32x2*)(dst + (size_t)e * ldk) = w; }
}
struct ConvJob { const float* gate; const float* up; const float* down; unsigned char* wgu; unsigned char* wd; };
constexpr int CV_PER_LAYER = 3 * 16 * 1024, CV_TOTAL = 4 * CV_PER_LAYER;
struct ConvItem { const float* W; unsigned char* WT; size_t rowbase; int N, ldk, k0, n0; };
__device__ __forceinline__ ConvItem cv_decode(const ConvJob& J, int it) {
    ConvItem c; const int L = it / CV_PER_LAYER, r0 = it % CV_PER_LAYER, fam = r0 >> 14, r = r0 & 16383, e = L * 16 + (r >> 10), q = r & 1023;
    if (fam < 2) { c.W = (fam ? J.up : J.gate) + (size_t)e * 1024 * 2048; c.N = 2048; c.k0 = (q >> 5) * 32; c.n0 = (q & 31) * 64; c.WT = J.wgu; c.ldk = 1024; c.rowbase = (size_t)e * 4096 + (c.n0 >> 7) * 256 + (c.n0 & 127) + (fam ? 128 : 0); }
    else { c.W = J.down + (size_t)e * 2048 * 1024; c.N = 1024; c.k0 = (q >> 4) * 32; c.n0 = (q & 15) * 64; c.WT = J.wd; c.ldk = 2048; c.rowbase = (size_t)e * 1024 + c.n0; }
    return c;
}
template <class RowBase>
__device__ __forceinline__ void conv_family(const Frame& F, const float* W, int K, int N, int nmat, bf16* WT, const RowBase& rb, int& base) {
    const int nblk = (N + 63) / 64, per = (K / 64) * nblk, total = per * nmat;
    const int gwr = F.G > 192 ? (F.gw + F.NGW - 192 * 8) % F.NGW : F.gw;
    const int first = (gwr + F.NGW - base % F.NGW) % F.NGW; base += total;
    for (int it = first; it < total; it += F.NGW) {
        const int mi = it / per, r = it % per, kb = r / nblk, nb = r % nblk;
        conv_item(W + (size_t)mi * K * N, N, WT, rb(mi, nb * 64), K, kb * 64, nb * 64, F.lane);
    }
}

__device__ __forceinline__ void ada_direct(const Frame& F, const Args& a, int l, int b0) {
    const int cg = F.bid - b0; if (cg < 0 || cg >= 192) return;
    LAS float* sc = (LAS float*)F.lds;
    LAS float* red = (LAS float*)(F.lds + 20480);
    for (int i = F.tid; i < 5 * D; i += 512) { const int c = i >> 10, k = i & 1023; const float x = (c == 0) ? a.in[7][k] : a.in[6][(c - 1) * D + k]; sc[i] = x / (1.f + __expf(-x)); }
    __syncthreads();
    const int col = F.tid & 31, kg = F.tid >> 5, n = cg * 32 + col;
    const float* w = a.in[8] + ((size_t)l * D + kg * 64) * 6144 + n;
    float acc[5] = {0.f, 0.f, 0.f, 0.f, 0.f};
#pragma unroll 16
    for (int k = 0; k < 64; ++k) { const float wv = w[(size_t)k * 6144];
#pragma unroll
        for (int c = 0; c < 5; ++c) acc[c] += sc[c * D + kg * 64 + k] * wv; }
#pragma unroll
    for (int c = 0; c < 5; ++c) red[(kg * 5 + c) * 32 + col] = acc[c];
    __syncthreads();
    if (F.tid < 160) { const int c = F.tid >> 5; float s = a.in[9][l * 6144 + n];
#pragma unroll
        for (int g = 0; g < 16; ++g) s += red[(g * 5 + c) * 32 + col];
        ((float*)(F.ws + WS_ADA))[(size_t)(l * 5 + c) * 6144 + n] = s; }
    __syncthreads();
}
__device__ __forceinline__ void phase_prologue(const Frame& F, const Args& a) {
    ada_direct(F, a, 0, 0);
    {
        float* R64 = (float*)(F.ws + WS_ROPE64); float* R32 = (float*)(F.ws + WS_ROPE32);
        for (int i = F.bid * 512 + F.tid; i < 2048 * 32; i += F.G * 512) { const int pos = i >> 5, j = i & 31; const double ang = (j < 16) ? (double)(pos >> 6) * INVF[j] : (double)(pos & 63) * INVF[j - 16];
            float s, c; sincos_d(ang, s, c); R64[i] = c; R64[2048 * 32 + i] = s; }
        for (int i = F.bid * 512 + F.tid; i < 2048 * 16; i += F.G * 512) { const int pos = i >> 4, j = i & 15; const double ang = (j < 8) ? (double)(pos >> 6) * INVF[2 * j] : (double)(pos & 63) * INVF[2 * (j - 8)];
            float s, c; sincos_d(ang, s, c); R32[i] = c; R32[2048 * 16 + i] = s; }
    }
    __syncthreads();
    for (int rep = 0; rep < MK_REP_CONV; ++rep) {
    bf16* WQKV = (bf16*)(F.ws + WS_WQKV); bf16* WO = (bf16*)(F.ws + WS_WO);
    int cvb = 0;
    conv_family(F, a.in[12], 1024, 1536, 2, WQKV, [](int mi, int n0) { return (size_t)(mi == 0 ? 0 : 2) * 1536 + n0; }, cvb);
    conv_family(F, a.in[16], 1024, 1536, 1, WQKV, [](int mi, int n0) { return (size_t)1536 + n0; }, cvb);
    conv_family(F, a.in[15], 1024, 1024, 2, WO, [](int mi, int n0) { return (size_t)(mi == 0 ? 0 : 3) * 1024 + n0; }, cvb);
    conv_family(F, a.in[18], 1024, 1024, 1, WO, [](int mi, int n0) { return (size_t)1024 + n0; }, cvb);
    conv_family(F, a.in[24], 1024, 1024, 1, WO, [](int mi, int n0) { return (size_t)2048 + n0; }, cvb);
    conv_family(F, a.in[19], 1024, 416, 1, (bf16*)(F.ws + WS_WDN), [](int mi, int n0) { return (size_t)n0; }, cvb);
    conv_family(F, a.in[21], 256, 1536, 1, (bf16*)(F.ws + WS_WUQ), [](int mi, int n0) { return (size_t)n0; }, cvb);
    conv_family(F, a.in[23], 128, 2048, 1, (bf16*)(F.ws + WS_WUKV), [](int mi, int n0) { return (size_t)n0; }, cvb);
    }
    { u32x4* z = (u32x4*)((bf16*)(F.ws + WS_WDN) + 416 * 1024); for (int i = F.bid * 512 + F.tid; i < 96 * 1024 / 8; i += F.G * 512) z[i] = (u32x4){0u, 0u, 0u, 0u}; }
}
__device__ __forceinline__ void phase_ada_reduce(const Frame& F, const Args& a) {
    const float* ADAP = (const float*)(F.ws + WS_ADAP); float* ADA = (float*)(F.ws + WS_ADA);
    for (int i = F.bid * 512 + F.tid; i < 4 * 5 * 6144; i += F.G * 512) {
        const int l = i / 30720, r = i % 30720, c = r / 6144, n = r % 6144;
        float s = a.in[9][l * 6144 + n];
        for (int kc = 0; kc < 16; ++kc) s += ADAP[((size_t)(kc * 4 + l) * 5 + c) * 6144 + n];
        ADA[i] = s;
    }
}
__device__ __forceinline__ const float* ada_vec(const Frame& F, int l, int c, int k) { return (const float*)(F.ws + WS_ADA) + ((size_t)(l * 5 + c) * 6 + k) * D; }

__device__ __forceinline__ void phase_mod0(const Frame& F, const Args& a) {
    bf16* X = (bf16*)(F.ws + WS_X); bf16* H = (bf16*)(F.ws + WS_H);
    const int RPW = (NTOK + F.NGW - 1) / F.NGW, rbeg = F.gw * RPW, rend = (rbeg + RPW < NTOK) ? rbeg + RPW : NTOK; int ccur = -1;
    f32x4 shv[4], scv[4];
#pragma unroll
    for (int j = 0; j < 4; ++j) { shv[j] = (f32x4){0.f, 0.f, 0.f, 0.f}; scv[j] = shv[j]; }
    for (int row = rbeg; row < rend; ++row) {
        const int c = cond_of(row);
        if (c != ccur) { ccur = c; const f32x4* sh = (const f32x4*)ada_vec(F, 0, c, 0); const f32x4* sc = (const f32x4*)ada_vec(F, 0, c, 1);
#pragma unroll
            for (int j = 0; j < 4; ++j) { shv[j] = sh[F.lane + 64 * j]; scv[j] = sc[F.lane + 64 * j] + 1.f; } }
        const f32x4* xi = (const f32x4*)((row < NCTX) ? a.in[0] + (size_t)row * D : a.in[1] + (size_t)(row - NCTX) * D);
#pragma unroll
        for (int j = 0; j < 4; ++j) { const int q = F.lane + 64 * j; const f32x4 x = xi[q]; ((u32x2*)(X + (size_t)row * D))[q] = pk4(x); ((u32x2*)(H + (size_t)row * D))[q] = pk4(x * scv[j] + shv[j]); }
    }
}

__device__ __forceinline__ size_t kb_off(int HK, int DK, bool lat, int b, int hk) { return lat ? (size_t)16 * HK * 256 * DK + ((size_t)(b * HK + hk) * 2560) * DK : ((size_t)(b * HK + hk) * 256) * DK; }
__device__ __forceinline__ size_t vt_off(int HK, bool lat, int b, int hk) { return lat ? (size_t)16 * HK * 64 * 256 + ((size_t)(b * HK + hk) * 64) * 2560 : ((size_t)(b * HK + hk) * 64) * 256; }
__device__ __forceinline__ int swap23(int k) { return (k & ~12) | ((k & 4) << 1) | ((k & 8) >> 1); }
__device__ __forceinline__ void vt_store(bf16* dst, const float (&vr)[64]) {
#pragma unroll
    for (int q = 0; q < 8; ++q) { const int b = 16 * (q >> 1) + 4 * (q & 1); u32x4 w; w.x = cvtpk(vr[b], vr[b + 1]); w.y = cvtpk(vr[b + 2], vr[b + 3]); w.z = cvtpk(vr[b + 8], vr[b + 9]); w.w = cvtpk(vr[b + 10], vr[b + 11]); ((u32x4*)dst)[q] = w; }
}

__device__ __forceinline__ void phase_kv_post(const Frame& F, const Args& a, int kind, int j, int slot, int gw, int NGW) {
    const bf16* QKV = (const bf16*)(F.ws + WS_QKV); bf16* Kb = (bf16*)(F.ws + WS_KB); bf16* Vt = (bf16*)(F.ws + WS_VT);
    const float* R64 = (const float*)(F.ws + WS_ROPE64);
    int lane_ = F.lane; asm volatile("" : "+v"(lane_)); const int lane = lane_, l16 = lane & 15, hk = lane >> 4;
    for (int it = gw * 64 + lane; it < 16 * 8192; it += NGW * 64) {
        const int bh = it >> 13, q = it & 8191, b = bh >> 2, hc = bh & 3;
        const f32x4 v = *(const f32x4*)(a.in[2] + ((size_t)((b * 3 + slot) * 4 + hc) * 512) * 64 + 4 * q);
        u32x2 w; w.x = cvtpk(v[0], v[1]); w.y = cvtpk(v[2], v[3]);
        *(u32x2*)(Kb + kb_off(4, 64, true, b, hc) + (size_t)2048 * 64 + 4 * q) = w;
    }
    for (int it = gw; it < 4 * 4 * 8; it += NGW) {
        const int b = it >> 5, hv = (it >> 3) & 3, tl = it & 7;
        float vr[64];
#pragma unroll
        for (int i = 0; i < 64; ++i) vr[i] = a.in[3][((size_t)((b * 3 + slot) * 4 + hv) * 512 + tl * 64 + i) * 64 + lane];
        vt_store(Vt + vt_off(4, true, b, hv) + (size_t)lane * 2560 + 2048 + tl * 64, vr);
    }
    f32x4 kn = (f32x4){1.f, 1.f, 1.f, 1.f}; if (kind == 0) kn = *(const f32x4*)(a.in[14] + j * 64 + 4 * l16);
    {
        const int RPW = (NTOK + NGW - 1) / NGW, rbeg = gw * RPW, rend = (rbeg + RPW < NTOK) ? rbeg + RPW : NTOK;
        u32x2 wqn = (u32x2){0u, 0u}; f32x4 cn = (f32x4){0.f, 0.f, 0.f, 0.f}, snn = cn;
        if (rbeg < rend) { wqn = *(const u32x2*)(QKV + (size_t)rbeg * 1536 + 1024 + 4 * lane);
            if (rbeg >= NCTX) { const int s0 = (rbeg - NCTX) & 2047; cn = *(const f32x4*)(R64 + s0 * 32 + 4 * (lane & 7)); snn = *(const f32x4*)(R64 + 2048 * 32 + s0 * 32 + 4 * (lane & 7)); } }
        for (int t = rbeg; t < rend; ++t) {
            const bool lat = t >= NCTX; const int b = lat ? (t - NCTX) >> 11 : t >> 8, s = lat ? (t - NCTX) & 2047 : t & 255;
            const u32x2 wq = wqn; const f32x4 c = cn, sn = snn;
            if (t + 1 < rend) { wqn = *(const u32x2*)(QKV + (size_t)(t + 1) * 1536 + 1024 + 4 * lane);
                if (t + 1 >= NCTX) { const int s1 = (t + 1 - NCTX) & 2047; cn = *(const f32x4*)(R64 + s1 * 32 + 4 * (lane & 7)); snn = *(const f32x4*)(R64 + 2048 * 32 + s1 * 32 + 4 * (lane & 7)); } }
            f32x4 v = bf4(wq);
            if (kind == 0) { float ss = (v[0] * v[0] + v[1] * v[1]) + (v[2] * v[2] + v[3] * v[3]); ss = sum16(ss);
                v = v * (__builtin_amdgcn_rsqf(ss * (1.f / 64.f) + 1e-6f)) * kn; }
            if (lat) { f32x4 p; p[0] = dppf<DPP_X8>(v[0]); p[1] = dppf<DPP_X8>(v[1]); p[2] = dppf<DPP_X8>(v[2]); p[3] = dppf<DPP_X8>(v[3]);
                v = (lane & 8) ? v * c + p * sn : v * c - p * sn; }
            *(u32x2*)(Kb + kb_off(4, 64, lat, b, hk) + (size_t)s * 64 + 4 * l16) = pk4(v);
            if (!lat) *(f32x4*)(F.out + OFF_NK + ((size_t)((b * 3 + slot) * 4 + hk) * 256 + s) * 64 + 4 * l16) = v;
        }
    }
    for (int it = gw; it < (NTOK / 64) * 4; it += NGW) {
        const int tt = it >> 2, hv = it & 3, t0 = tt * 64; const bool lat = t0 >= NCTX; const int b = lat ? (t0 - NCTX) >> 11 : t0 >> 8, s0 = lat ? (t0 - NCTX) & 2047 : t0 & 255;
        float vr[64];
#pragma unroll
        for (int i = 0; i < 64; ++i) vr[i] = bf2f(QKV[(size_t)(t0 + i) * 1536 + 1280 + hv * 64 + lane]);
        vt_store(Vt + vt_off(4, lat, b, hv) + (size_t)lane * (lat ? 2560 : 256) + s0, vr);
        if (!lat) {
#pragma unroll
            for (int i = 0; i < 64; ++i) F.out[OFF_NV + ((size_t)((b * 3 + slot) * 4 + hv) * 256 + s0 + i) * 64 + lane] = vr[i]; }
    }
}

__device__ __forceinline__ void phase_mla_post1(const Frame& F, const Args& a) {
    const float* DWN = (const float*)(F.ws + WS_QKV); bf16* QA = (bf16*)(F.ws + WS_QA); bf16* CKVA = (bf16*)(F.ws + WS_CKVA); bf16* Kb = (bf16*)(F.ws + WS_KB);
    const float* R32 = (const float*)(F.ws + WS_ROPE32);
    int lane_ = F.lane; asm volatile("" : "+v"(lane_)); const int lane = lane_;
    const f32x4 qn = ((const f32x4*)a.in[20])[lane]; const f32x4 kvn = ((const f32x4*)a.in[22])[lane & 31];
    for (int t = F.gw; t < NTOK + 2048; t += F.NGW) {
        if (t < NTOK) {
            const bool lat = t >= NCTX; const int b = lat ? (t - NCTX) >> 11 : t >> 8, s = lat ? (t - NCTX) & 2047 : t & 255;
            const float* row = DWN + (size_t)t * 512;
            { const f32x4 v = ((const f32x4*)row)[lane] + ((const f32x4*)(row + DWN_PART))[lane]; const float ss = wave_sum(v[0] * v[0] + v[1] * v[1] + v[2] * v[2] + v[3] * v[3]); const float r = __builtin_amdgcn_rsqf(ss * (1.f / 256.f) + 1e-6f);
              const f32x4 o = v * r * qn; u32x2 w; w.x = cvtpk(o[0], o[1]); w.y = cvtpk(o[2], o[3]); ((u32x2*)(QA + (size_t)t * 256))[lane] = w; }
            { f32x4 v = (f32x4){0.f, 0.f, 0.f, 0.f}; if (lane < 32) v = ((const f32x4*)(row + 256))[lane] + ((const f32x4*)(row + DWN_PART + 256))[lane];
              const float ss = wave_sum(v[0] * v[0] + v[1] * v[1] + v[2] * v[2] + v[3] * v[3]); const float r = __builtin_amdgcn_rsqf(ss * (1.f / 128.f) + 1e-6f);
              const f32x4 o = v * r * kvn;
              if (lane < 32) { u32x2 w; w.x = cvtpk(o[0], o[1]); w.y = cvtpk(o[2], o[3]); ((u32x2*)(CKVA + (size_t)t * 128))[lane] = w; if (!lat) ((f32x4*)(F.out + OFF_CKV + (size_t)t * 128))[lane] = o; } }
            { float x = (lane < 32) ? row[384 + lane] + row[DWN_PART + 384 + lane] : 0.f;
              if (!lat && lane < 32) F.out[OFF_KPE + (size_t)t * 32 + lane] = x;
              if (lat) { const float p = __shfl_xor(x, 16); const int i = lane & 15; const float c = R32[s * 16 + i], sn = R32[2048 * 16 + s * 16 + i]; x = ((lane & 31) < 16) ? x * c - p * sn : x * c + p * sn; }
              const bf16 xb = f2bf(x);
              if (lane < 32) { for (int h = 0; h < 16; ++h) Kb[kb_off(16, 96, lat, b, h) + (size_t)s * 96 + 64 + lane] = xb; } }
        } else {
            const int r = t - NTOK, b = r >> 9, s = r & 511;
            if (lane < 32) { const f32x4 v = ((const f32x4*)(a.in[4] + (size_t)r * 128))[lane]; u32x2 w; w.x = cvtpk(v[0], v[1]); w.y = cvtpk(v[2], v[3]); ((u32x2*)(CKVA + (size_t)t * 128))[lane] = w;
                const bf16 xb = f2bf(a.in[5][(size_t)r * 32 + lane]);
                for (int h = 0; h < 16; ++h) Kb[kb_off(16, 96, true, b, h) + (size_t)(2048 + s) * 96 + 64 + lane] = xb; }
        }
    }
}
__device__ __forceinline__ void mla_row(int row, bool& lat, int& b, int& s) {
    if (row < NCTX) { lat = false; b = row >> 8; s = row & 255; } else if (row < NTOK) { lat = true; b = (row - NCTX) >> 11; s = (row - NCTX) & 2047; } else { lat = true; b = (row - NTOK) >> 9; s = 2048 + ((row - NTOK) & 511); }
}
struct EpiUkv { bf16* Kb; bf16* VRAW; static constexpr bool PERM = false, AFTER_DRAIN = false;
    __device__ __forceinline__ void operator()(const f32x4 (&acc)[2][2][4][2], const Unit& u, int wr, int wc, int fr, int fq) const {
#pragma unroll
        for (int ai = 0; ai < 2; ++ai)
#pragma unroll
            for (int m = 0; m < 4; ++m) { const int row = u.pm * 256 + ai * 128 + wr * 64 + m * 16 + fr; bool lat; int b, s; mla_row(row, lat, b, s);
#pragma unroll
                for (int bj = 0; bj < 2; ++bj) { const int h = 2 * u.pn + bj;
                    if (wc < 2) { bf16* kp = Kb + kb_off(16, 96, lat, b, h) + (size_t)s * 96 + wc * 32 + 4 * fq;
#pragma unroll
                        for (int n = 0; n < 2; ++n) { const f32x4 v = acc[ai][bj][m][n]; u32x2 w; w.x = cvtpk(v[0], v[1]); w.y = cvtpk(v[2], v[3]); *(u32x2*)(kp + n * 16) = w; } }
                    else { bf16* vp = VRAW + (size_t)row * 1024 + h * 64 + (wc - 2) * 32 + 4 * fq;
#pragma unroll
                        for (int n = 0; n < 2; ++n) { const f32x4 v = acc[ai][bj][m][n]; u32x2 w; w.x = cvtpk(v[0], v[1]); w.y = cvtpk(v[2], v[3]); *(u32x2*)(vp + n * 16) = w; } } } }
    }
};
__device__ __forceinline__ void phase_mla_post2(const Frame& F, const Args& a) {
    const bf16* VRAW = (const bf16*)(F.ws + WS_KVRAW); bf16* Vt = (bf16*)(F.ws + WS_VT);
    int lane_ = F.lane; asm volatile("" : "+v"(lane_)); const int lane = lane_;
    for (int it = F.gw; it < 224 * 16; it += F.NGW) {
        const int tile = it >> 4, h = it & 15, row0 = tile * 64; bool lat; int b, s0; mla_row(row0, lat, b, s0);
        float vr[64];
#pragma unroll
        for (int i = 0; i < 64; ++i) vr[i] = bf2f(VRAW[(size_t)(row0 + i) * 1024 + h * 64 + lane]);
        vt_store(Vt + vt_off(16, lat, b, h) + (size_t)lane * (lat ? 2560 : 256) + s0, vr);
    }
}

__device__ __forceinline__ int crow(int r, int hi) { return (r & 3) + 8 * (r >> 2) + 4 * hi; }
__device__ __forceinline__ float max3f(float a, float b, float c) { float r; asm("v_max3_f32 %0, %1, %2, %3" : "=v"(r) : "v"(a), "v"(b), "v"(c)); return r; }
constexpr float THRL = 5.f;
template <int DK, int KIND>
__device__ __forceinline__ void attn_phase(const Frame& F, const Args& a, int j, const ConvJob& J, int& cv_it, int cv_need, int cv_cap) {
    constexpr int HK = (DK == 96) ? 16 : 4, CH = (DK == 96) ? 64 : 128, KPB = (DK + 8) * 2, VPB = (CH + 8) * 2, NDS = DK / 16, KCH = DK / 8;
    constexpr int NKC = CH * KCH, NKI = (NKC + 511) / 512, NVI = 64 * (CH / 8) / 512, NSUB = CH / 64;
    constexpr float QS = (DK == 96) ? MLA_QS : GQA_QS;
    const bf16* QRAW = (const bf16*)(F.ws + WS_QKV); const bf16* Kb = (const bf16*)(F.ws + WS_KB); const bf16* Vt = (const bf16*)(F.ws + WS_VT); bf16* O = (bf16*)(F.ws + WS_O);
    LAS unsigned char* Ks = F.lds; LAS unsigned char* Vs = F.lds + 2 * CH * KPB;
    LAS unsigned char* cvs = F.lds + 2 * CH * KPB + 2 * 64 * VPB + F.wave * 8192;
    const unsigned cvs_addr = (unsigned)(uintptr_t)cvs;
    int tid_ = F.tid; asm volatile("" : "+v"(tid_));
    const int tid = tid_, lane = tid & 63, wid = F.wave, r32 = lane & 31, hi = lane >> 5;
    constexpr bool CVP = true;
    int itc = 0;
    for (int un = F.bid; un < 768; un += F.G) {
        bool lat; int b, hq, q0, S, tok0;
        if (un < 512) { lat = true; b = un >> 7; hq = (un >> 3) & 15; q0 = (un & 7) * 256; S = 2560; tok0 = NCTX + b * 2048 + q0; }
        else { const int v = un - 512; lat = false; b = v >> 4; hq = v & 15; q0 = 0; S = 256; tok0 = b * 256; }
        const int hk = (HK == 4) ? (hq >> 2) : hq;
        const bf16* Kg = Kb + kb_off(HK, DK, lat, b, hk); const bf16* Vg = Vt + vt_off(HK, lat, b, hk);
        const int n2 = lat ? 512 / CH : 0; int lo = 0, hiK = lat ? 2048 : 256;
        const bool masked = (KIND == 1) && lat;
        if (masked) { lo = q0 - 128; lo = lo < 0 ? 0 : (lo > 1536 ? 1536 : lo); hiK = lo + 512; }
        const int nch = n2 + (hiK - lo) / CH;
        bf16x8 qf[NDS];
        {
            const bf16* qrow = QRAW + (size_t)(tok0 + wid * 32 + r32) * 1536 + hq * DK + 8 * hi;
            f32x4 v[NDS][2];
#pragma unroll
            for (int ds = 0; ds < NDS; ++ds) { const u32x4 wq = *(const u32x4*)(qrow + 16 * ds);
                v[ds][0] = (f32x4){__uint_as_float(wq.x << 16), __uint_as_float(wq.x & 0xffff0000u), __uint_as_float(wq.y << 16), __uint_as_float(wq.y & 0xffff0000u)};
                v[ds][1] = (f32x4){__uint_as_float(wq.z << 16), __uint_as_float(wq.z & 0xffff0000u), __uint_as_float(wq.w << 16), __uint_as_float(wq.w & 0xffff0000u)}; }
            if (KIND == 0) {
                float ss = 0.f;
#pragma unroll
                for (int ds = 0; ds < NDS; ++ds)
#pragma unroll
                    for (int h2 = 0; h2 < 2; ++h2) ss += (v[ds][h2][0] * v[ds][h2][0] + v[ds][h2][1] * v[ds][h2][1]) + (v[ds][h2][2] * v[ds][h2][2] + v[ds][h2][3] * v[ds][h2][3]);
                ss += __shfl_xor(ss, 32);
                const float r = __builtin_amdgcn_rsqf(ss * (1.f / 64.f) + 1e-6f);
                const float* qn = a.in[13] + j * 64 + 8 * hi;
#pragma unroll
                for (int ds = 0; ds < NDS; ++ds) { v[ds][0] = v[ds][0] * r * *(const f32x4*)(qn + 16 * ds); v[ds][1] = v[ds][1] * r * *(const f32x4*)(qn + 16 * ds + 4); }
            }
            if (lat) {
                const int s = q0 + wid * 32 + r32;
                if (DK == 64) {
                    const float* R64 = (const float*)(F.ws + WS_ROPE64);
#pragma unroll
                    for (int ds = 0; ds < 2; ++ds)
#pragma unroll
                        for (int h2 = 0; h2 < 2; ++h2) { const int idx = s * 32 + 16 * ds + 8 * hi + 4 * h2; const f32x4 c = *(const f32x4*)(R64 + idx), sn = *(const f32x4*)(R64 + 2048 * 32 + idx);
                            const f32x4 xa = v[ds][h2], xb = v[ds + 2][h2]; v[ds][h2] = xa * c - xb * sn; v[ds + 2][h2] = xb * c + xa * sn; }
                } else {
                    const float* R32 = (const float*)(F.ws + WS_ROPE32);
#pragma unroll
                    for (int h2 = 0; h2 < 2; ++h2) { const int idx = s * 16 + 8 * hi + 4 * h2; const f32x4 c = *(const f32x4*)(R32 + idx), sn = *(const f32x4*)(R32 + 2048 * 16 + idx);
                        const f32x4 xa = v[NDS - 2][h2], xb = v[NDS - 1][h2]; v[NDS - 2][h2] = xa * c - xb * sn; v[NDS - 1][h2] = xb * c + xa * sn; }
                }
            }
#pragma unroll
            for (int ds = 0; ds < NDS; ++ds) { u32x4 w; w.x = cvtpk(v[ds][0][0] * QS, v[ds][0][1] * QS); w.y = cvtpk(v[ds][0][2] * QS, v[ds][0][3] * QS); w.z = cvtpk(v[ds][1][0] * QS, v[ds][1][1] * QS); w.w = cvtpk(v[ds][1][2] * QS, v[ds][1][3] * QS);
                qf[ds] = __builtin_bit_cast(bf16x8, w); }
        }
        const int qw0 = q0 + wid * 32, qpos = qw0 + r32;
        float mhat = 0.f, l_run = 0.f; bool first = true; f32x16 o0, o1, negm;
#pragma unroll
        for (int r = 0; r < 16; ++r) { o0[r] = 0.f; o1[r] = 0.f; negm[r] = 0.f; }
        u32x4 kreg[NKI], vreg[NVI];
#define ATT_KEY0(c) ((c) < n2 ? 2048 + CH * (c) : lo + CH * ((c) - n2))
#define ATT_LOAD(c) do { const int k0_ = ATT_KEY0(c); \
            _Pragma("unroll") for (int i_ = 0; i_ < NKI; ++i_) { const int cc_ = tid + 512 * i_; if (NKC % 512 == 0 || cc_ < NKC) kreg[i_] = *(const u32x4*)(Kg + (size_t)(k0_ + cc_ / KCH) * DK + (cc_ % KCH) * 8); } \
            _Pragma("unroll") for (int i_ = 0; i_ < NVI; ++i_) { const int cc_ = tid + 512 * i_; vreg[i_] = *(const u32x4*)(Vg + (size_t)(cc_ / (CH / 8)) * S + k0_ + (cc_ % (CH / 8)) * 8); } } while (0)
#define ATT_STORE(buf) do { \
            _Pragma("unroll") for (int i_ = 0; i_ < NKI; ++i_) { const int cc_ = tid + 512 * i_; if (NKC % 512 == 0 || cc_ < NKC) *(LAS u32x4*)(Ks + (buf) * CH * KPB + (cc_ / KCH) * KPB + (cc_ % KCH) * 16) = kreg[i_]; } \
            _Pragma("unroll") for (int i_ = 0; i_ < NVI; ++i_) { const int cc_ = tid + 512 * i_; *(LAS u32x4*)(Vs + (buf) * 64 * VPB + (cc_ / (CH / 8)) * VPB + (cc_ % (CH / 8)) * 16) = vreg[i_]; } } while (0)
        ATT_LOAD(0);
        __syncthreads();
        ATT_STORE(0);
        __syncthreads();
        for (int c = 0; c < nch; ++c) {
            const int cur = c & 1;
            if (c + 1 < nch) ATT_LOAD(c + 1);
            const bool cv = CVP && ((CH == 128) || ((itc++ & 1) == 0)) && cv_it < cv_cap;
            if (cv) { const ConvItem ci = cv_decode(J, cv_it); conv_issue8(cvs_addr, ci.W, ci.N, ci.k0, ci.n0, lane); }
            const int key0c = ATT_KEY0(c);
            for (int sub = 0; sub < NSUB; ++sub) {
                const int key0 = key0c + 64 * sub;
                if (masked && c >= n2 && (key0 > qw0 + 159 || key0 + 63 < qw0 - 128)) continue;
                f32x16 p0, p1;
                const LAS unsigned char* kb_ = Ks + cur * CH * KPB + (sub * 64 + r32) * KPB + hi * 16;
                const LAS unsigned char* vb_ = Vs + cur * 64 * VPB + r32 * VPB + sub * 128 + hi * 16;
                bf16x8 kf[2 * NDS], vf[8];
#pragma unroll
                for (int ds = 0; ds < NDS; ++ds) { kf[2 * ds] = *(const LAS bf16x8*)(kb_ + ds * 32); kf[2 * ds + 1] = *(const LAS bf16x8*)(kb_ + 32 * KPB + ds * 32); }
#pragma unroll
                for (int s = 0; s < 4; ++s) { vf[2 * s] = *(const LAS bf16x8*)(vb_ + s * 32); vf[2 * s + 1] = *(const LAS bf16x8*)(vb_ + 32 * VPB + s * 32); }
                __builtin_amdgcn_sched_barrier(0);
#pragma unroll
                for (int ds = 0; ds < NDS; ++ds) {
                    if (ds == 0) { p0 = __builtin_amdgcn_mfma_f32_32x32x16_bf16(kf[0], qf[0], negm, 0, 0, 0); p1 = __builtin_amdgcn_mfma_f32_32x32x16_bf16(kf[1], qf[0], negm, 0, 0, 0); }
                    else { p0 = __builtin_amdgcn_mfma_f32_32x32x16_bf16(kf[2 * ds], qf[ds], p0, 0, 0, 0); p1 = __builtin_amdgcn_mfma_f32_32x32x16_bf16(kf[2 * ds + 1], qf[ds], p1, 0, 0, 0); }
                }
                if (masked && c >= n2) {
                    const int kbase = key0 - qpos;
#pragma unroll
                    for (int r = 0; r < 16; ++r) { const int d0 = kbase + crow(r, hi), d1 = d0 + 32;
                        if (d0 > 128 || d0 < -128) p0[r] = -INFINITY;
                        if (d1 > 128 || d1 < -128) p1[r] = -INFINITY; }
                }
                float rm;
                { float ma = max3f(p0[0], p0[1], p1[0]), mb = max3f(p0[2], p0[3], p1[1]); ma = max3f(ma, p1[2], p1[3]);
#pragma unroll
                  for (int r = 4; r < 16; r += 4) { ma = max3f(ma, p0[r], p0[r + 1]); mb = max3f(mb, p0[r + 2], p0[r + 3]); ma = max3f(ma, p1[r], p1[r + 1]); mb = max3f(mb, p1[r + 2], p1[r + 3]); }
                  const float m2 = max3f(ma, mb, mb);
                  auto rr = __builtin_amdgcn_permlane32_swap(__float_as_uint(m2), __float_as_uint(m2), false, false);
                  rm = max3f(__uint_as_float(rr[0]), __uint_as_float(rr[1]), m2); }
                if (first || __any(rm > THRL)) {
                    const float dl = first ? rm : fmaxf(rm, 0.f);
                    mhat += dl;
#pragma unroll
                    for (int r = 0; r < 16; ++r) { p0[r] -= dl; p1[r] -= dl; }
                    if (!first) { const float sc = __builtin_amdgcn_exp2f(-dl); l_run *= sc;
#pragma unroll
                        for (int r = 0; r < 16; ++r) { o0[r] *= sc; o1[r] *= sc; } }
#pragma unroll
                    for (int r = 0; r < 16; ++r) negm[r] = -mhat;
                    first = false;
                }
                float ls0 = 0.f, ls1 = 0.f;
#pragma unroll
                for (int r = 0; r < 16; ++r) { p0[r] = __builtin_amdgcn_exp2f(p0[r]); p1[r] = __builtin_amdgcn_exp2f(p1[r]); ls0 += p0[r]; ls1 += p1[r]; }
                l_run += ls0 + ls1;
                bf16x8 pb[4];
#pragma unroll
                for (int s = 0; s < 4; ++s) { u32x4 w;
                    if (s < 2) { w.x = cvtpk(p0[8 * s], p0[8 * s + 1]); w.y = cvtpk(p0[8 * s + 2], p0[8 * s + 3]); w.z = cvtpk(p0[8 * s + 4], p0[8 * s + 5]); w.w = cvtpk(p0[8 * s + 6], p0[8 * s + 7]); }
                    else { const int q = s - 2; w.x = cvtpk(p1[8 * q], p1[8 * q + 1]); w.y = cvtpk(p1[8 * q + 2], p1[8 * q + 3]); w.z = cvtpk(p1[8 * q + 4], p1[8 * q + 5]); w.w = cvtpk(p1[8 * q + 6], p1[8 * q + 7]); }
                    pb[s] = __builtin_bit_cast(bf16x8, w); }
#pragma unroll
                for (int s = 0; s < 4; ++s) {
                    o0 = __builtin_amdgcn_mfma_f32_32x32x16_bf16(vf[2 * s], pb[s], o0, 0, 0, 0);
                    o1 = __builtin_amdgcn_mfma_f32_32x32x16_bf16(vf[2 * s + 1], pb[s], o1, 0, 0, 0);
                }
            }
            if (c + 1 < nch) ATT_STORE(cur ^ 1);
            if (cv) { asm volatile("s_waitcnt vmcnt(0)" ::: "memory"); f32x4 cvv[8]; conv_fetch8(cvv, cvs, lane); const ConvItem ci = cv_decode(J, cv_it); conv_store8(cvv, ci.WT, ci.rowbase, ci.ldk, ci.k0, lane); cv_it += F.NGW; }
            __syncthreads();
        }
#undef ATT_KEY0
#undef ATT_LOAD
#undef ATT_STORE
        float l = l_run + __shfl_xor(l_run, 32);
        if (KIND == 1) l += __builtin_amdgcn_exp2f(a.in[17][hq] * LOG2E - mhat);
        const float inv = 1.f / l;
        bf16* op = O + (size_t)(tok0 + wid * 32 + r32) * 1024 + hq * 64 + 4 * hi;
#pragma unroll
        for (int g = 0; g < 4; ++g) {
            u32x2 w0, w1; w0.x = cvtpk(o0[4 * g] * inv, o0[4 * g + 1] * inv); w0.y = cvtpk(o0[4 * g + 2] * inv, o0[4 * g + 3] * inv);
            w1.x = cvtpk(o1[4 * g] * inv, o1[4 * g + 1] * inv); w1.y = cvtpk(o1[4 * g + 2] * inv, o1[4 * g + 3] * inv);
            *(u32x2*)(op + 8 * g) = w0; *(u32x2*)(op + 32 + 8 * g) = w1;
        }
    }
    for (; cv_it < cv_need; cv_it += 2 * F.NGW) {
        f32x4 v0[8], v1[8]; const ConvItem c0 = cv_decode(J, cv_it); conv_load8(v0, c0.W, c0.N, c0.k0, c0.n0, lane);
        const bool two = cv_it + F.NGW < CV_TOTAL; ConvItem c1 = c0; if (two) { c1 = cv_decode(J, cv_it + F.NGW); conv_load8(v1, c1.W, c1.N, c1.k0, c1.n0, lane); }
        conv_store8(v0, c0.WT, c0.rowbase, c0.ldk, c0.k0, lane); if (two) conv_store8(v1, c1.WT, c1.rowbase, c1.ldk, c1.k0, lane); }
}
#if MK_CHECK
template <int DK, int KIND>
__device__ __forceinline__ void check_attn(const Frame& F, const Args& a, int j, int id) {
    constexpr int HK = (DK == 96) ? 16 : 4; constexpr float QS = (DK == 96) ? MLA_QS : GQA_QS;
    const bf16* QRAW = (const bf16*)(F.ws + WS_QKV); const bf16* Kb = (const bf16*)(F.ws + WS_KB); const bf16* Vt = (const bf16*)(F.ws + WS_VT); const bf16* O = (const bf16*)(F.ws + WS_O);
    LAS float* scs = (LAS float*)(F.lds + F.wave * 12288); LAS float* qs = scs + 2560;
    const int lane = F.lane;
    const unsigned hsh = hash_u(F.gw * 2654435761u + id);
    const int t = (F.gw & 1) ? (hsh % NCTX) : NCTX + (hsh % NLAT), hq = (hsh >> 16) & 15;
    const bool lat = t >= NCTX; const int b = lat ? (t - NCTX) >> 11 : t >> 8, s = lat ? (t - NCTX) & 2047 : t & 255, S = lat ? 2560 : 256;
    const int hk = (HK == 4) ? (hq >> 2) : hq;
    const bf16* Kg = Kb + kb_off(HK, DK, lat, b, hk); const bf16* Vg = Vt + vt_off(HK, lat, b, hk); const bf16* q = QRAW + (size_t)t * 1536 + hq * DK;
    {
        float x = bf2f(q[lane]);
        if (KIND == 0) { const float ss = wave_sum(x * x); x = x * __builtin_amdgcn_rsqf(ss * (1.f / 64.f) + 1e-6f) * a.in[13][j * 64 + lane]; }
        if (DK == 64 && lat) { const float* R64 = (const float*)(F.ws + WS_ROPE64); const float p = __shfl_xor(x, 32); const int i = lane & 31; const float c = R64[s * 32 + i], sn = R64[2048 * 32 + s * 32 + i]; x = (lane < 32) ? x * c - p * sn : x * c + p * sn; }
        qs[lane] = bf2f(f2bf(x * QS));
        if (DK == 96) { float y = (lane < 32) ? bf2f(q[64 + lane]) : 0.f;
            if (lat) { const float* R32 = (const float*)(F.ws + WS_ROPE32); const float p = __shfl_xor(y, 16); const int i = lane & 15; const float c = R32[s * 16 + i], sn = R32[2048 * 16 + s * 16 + i]; y = ((lane & 31) < 16) ? y * c - p * sn : y * c + p * sn; }
            if (lane < 32) qs[64 + lane] = bf2f(f2bf(y * QS)); }
        asm volatile("s_waitcnt lgkmcnt(0)" ::: "memory");
    }
    float mx = -1e30f;
    for (int jk = lane; jk < S; jk += 64) {
        float sc = 0.f; for (int d = 0; d < DK; ++d) sc += qs[d] * bf2f(Kg[(size_t)jk * DK + d]);
        if (KIND == 1 && lat && jk < 2048 && (jk - s > 128 || jk - s < -128)) sc = -INFINITY;
        scs[jk] = sc; mx = fmaxf(mx, sc);
    }
    mx = wave_max(mx);
    asm volatile("s_waitcnt lgkmcnt(0)" ::: "memory");
    float l = 0.f, o = 0.f;
    for (int jk = 0; jk < S; ++jk) { const float p = __builtin_amdgcn_exp2f(scs[jk] - mx); l += p; o += bf2f(f2bf(p)) * bf2f(Vg[(size_t)lane * S + swap23(jk)]); }
    if (KIND == 1) l += __builtin_amdgcn_exp2f(a.in[17][hq] * LOG2E - mx);
    o /= l;
    const float got = bf2f(O[(size_t)t * 1024 + hq * 64 + lane]);
    if (!close_enough(got, o, 0.03f, 0.01f)) CHK_FAIL(F, id);
    asm volatile("s_waitcnt lgkmcnt(0)" ::: "memory");
}
template <class Fn>
__device__ __forceinline__ void check_gemm_f32(const Frame& F, const bf16* A, const bf16* Bt, int M, int N, int K, const float* C, int ldc, int id) {
    for (int sidx = 0; sidx < 2; ++sidx) {
        const unsigned h = hash_u((F.gw * 2 + sidx) * 2654435761u + id * 97u);
        const int row = h % M, col = (h >> 12) % N;
        const float ref = dot_bf16(A + (size_t)row * K, Bt + (size_t)col * K, K, F.lane);
        if (!close_enough(C[(size_t)row * ldc + col], ref, 0.01f, 0.01f)) CHK_FAIL(F, id);
    }
}
template <class Fn>
__device__ __forceinline__ void check_gemm_bf16(const Frame& F, const bf16* A, const bf16* Bt, int M, int N, int K, const bf16* C, int ldc, int id) {
    for (int sidx = 0; sidx < 2; ++sidx) {
        const unsigned h = hash_u((F.gw * 2 + sidx) * 2654435761u + id * 97u);
        const int row = h % M, col = (h >> 12) % N;
        const float ref = dot_bf16(A + (size_t)row * K, Bt + (size_t)col * K, K, F.lane);
        if (!close_enough(bf2f(C[(size_t)row * ldc + col]), ref, 0.02f, 0.02f)) CHK_FAIL(F, id);
    }
}
#endif

__device__ __forceinline__ void phase_ln1_router(const Frame& F, const Args& a, int l) {
    const bf16* X = (const bf16*)(F.ws + WS_X); bf16* X1 = (bf16*)(F.ws + WS_X1); const bf16* AO = (const bf16*)(F.ws + WS_AO); unsigned char* H8 = F.ws + WS_XE; float* AFF = (float*)(F.ws + WS_AFF);
    constexpr int RP = 1032, RB = 6;
    LAS bf16* Wb = (LAS bf16*)F.lds;
    LAS bf16* Hs = (LAS bf16*)(F.lds + 16 * RP * 2) + F.wave * (RB * RP);
    const float* wr = a.in[25] + (size_t)l * D * NE;
    for (int i = F.tid; i < D * NE; i += 512) Wb[(i & 15) * RP + (i >> 4)] = f2bf(wr[i]);
    __syncthreads();
    int lane_ = F.lane; asm volatile("" : "+v"(lane_)); const int lane = lane_;
    const f32x4* lg = (const f32x4*)(a.in[10] + (size_t)(l * 2 + 0) * D); const f32x4* lb = (const f32x4*)(a.in[11] + (size_t)(l * 2 + 0) * D);
    const int RPW = (NTOK + F.NGW - 1) / F.NGW, rbeg = F.gw * RPW, rend = (rbeg + RPW < NTOK) ? rbeg + RPW : NTOK;
    f32x4 lgv[4], lbv[4], g1v[4], sh2v[4], sc2v[4]; int ccur = -1;
#pragma unroll
    for (int j = 0; j < 4; ++j) { lgv[j] = lg[lane + 64 * j]; lbv[j] = lb[lane + 64 * j]; g1v[j] = lgv[j]; sh2v[j] = lgv[j]; sc2v[j] = lgv[j]; }
    u32x2 xc[4], ac[4], xd[4], ad[4];
    { const int r0 = rbeg < rend ? rbeg : NTOK - 1, r1 = rbeg + 1 < rend ? rbeg + 1 : r0;
#pragma unroll
      for (int j = 0; j < 4; ++j) { xc[j] = ((const u32x2*)(X + (size_t)r0 * D))[lane + 64 * j]; ac[j] = ((const u32x2*)(AO + (size_t)r0 * D))[lane + 64 * j];
          xd[j] = ((const u32x2*)(X + (size_t)r1 * D))[lane + 64 * j]; ad[j] = ((const u32x2*)(AO + (size_t)r1 * D))[lane + 64 * j]; } }
    for (int row = rbeg; row < rend; ++row) {
        const int c = cond_of(row);
        if (c != ccur) { ccur = c; const f32x4* g1 = (const f32x4*)ada_vec(F, l, c, 2); const f32x4* sh2 = (const f32x4*)ada_vec(F, l, c, 3); const f32x4* sc2 = (const f32x4*)ada_vec(F, l, c, 4);
#pragma unroll
            for (int j = 0; j < 4; ++j) { g1v[j] = g1[lane + 64 * j]; sh2v[j] = sh2[lane + 64 * j]; sc2v[j] = sc2[lane + 64 * j] + 1.f; } }
        f32x4 y[4]; float s = 0.f, s2 = 0.f;
#pragma unroll
        for (int j = 0; j < 4; ++j) { const f32x4 av = (f32x4){__uint_as_float(ac[j].x << 16), __uint_as_float(ac[j].x & 0xffff0000u), __uint_as_float(ac[j].y << 16), __uint_as_float(ac[j].y & 0xffff0000u)}; y[j] = bf4(xc[j]) * ALPHA + g1v[j] * av; s += (y[j][0] + y[j][1]) + (y[j][2] + y[j][3]); s2 += (y[j][0] * y[j][0] + y[j][1] * y[j][1]) + (y[j][2] * y[j][2] + y[j][3] * y[j][3]); }
        { const int nr = row + 2 < rend ? row + 2 : row;
#pragma unroll
          for (int j = 0; j < 4; ++j) { xc[j] = xd[j]; ac[j] = ad[j]; xd[j] = ((const u32x2*)(X + (size_t)nr * D))[lane + 64 * j]; ad[j] = ((const u32x2*)(AO + (size_t)nr * D))[lane + 64 * j]; } }
        s = wave_sum(s); s2 = wave_sum(s2);
        const float mean = s * (1.f / D), var = fmaxf(s2 * (1.f / D) - mean * mean, 0.f);
        const float rstd = 1.f / sqrtf(var + 1e-5f);
        f32x4 h[4];
#pragma unroll
        for (int j = 0; j < 4; ++j) { const int q = lane + 64 * j; const f32x4 xn = (y[j] - mean) * rstd * lgv[j] + lbv[j]; ((u32x2*)(X1 + (size_t)row * D))[q] = pk4(xn);
            h[j] = xn * sc2v[j] + sh2v[j]; ((unsigned*)(H8 + (size_t)row * D))[q] = pk4_fp8(h[j][0], h[j][1], h[j][2], h[j][3]); }
        const int br = (row - rbeg) % RB;
#pragma unroll
        for (int j = 0; j < 4; ++j) { u32x2 w; w.x = cvtpk(h[j][0], h[j][1]); w.y = cvtpk(h[j][2], h[j][3]); *(LAS u32x2*)(Hs + br * RP + 4 * (lane + 64 * j)) = w; }
        if (br == RB - 1 || row == rend - 1) {
            const int nrows = br + 1, row0 = row - br, n = lane & 15, kq = lane >> 4, nn = n < nrows ? n : 0;
            const LAS bf16* wp = Wb + n * RP + 8 * kq; const LAS bf16* hp = Hs + nn * RP + 8 * kq;
            f32x4 l0 = (f32x4){0.f, 0.f, 0.f, 0.f}, l1 = l0;
#pragma unroll 4
            for (int st = 0; st < 32; st += 2) {
                l0 = __builtin_amdgcn_mfma_f32_16x16x32_bf16(*(const LAS bf16x8*)(wp + 32 * st), *(const LAS bf16x8*)(hp + 32 * st), l0, 0, 0, 0);
                l1 = __builtin_amdgcn_mfma_f32_16x16x32_bf16(*(const LAS bf16x8*)(wp + 32 * st + 32), *(const LAS bf16x8*)(hp + 32 * st + 32), l1, 0, 0, 0); }
            const f32x4 lg4 = l0 + l1;
            float mx = fmaxf(fmaxf(lg4[0], lg4[1]), fmaxf(lg4[2], lg4[3])); mx = xmax16(mx); mx = xmax32(mx);
            f32x4 ex; ex[0] = __expf(lg4[0] - mx); ex[1] = __expf(lg4[1] - mx); ex[2] = __expf(lg4[2] - mx); ex[3] = __expf(lg4[3] - mx);
            float den = (ex[0] + ex[1]) + (ex[2] + ex[3]); den = xsum16(den, den); den = xsum32(den, den);
            const float inv = 1.f / den;
            if (n < nrows) {
#pragma unroll
                for (int i = 0; i < 4; ++i) AFF[(size_t)(4 * kq + i) * NTOK + row0 + n] = ex[i] * inv; }
        }
    }
    __syncthreads();
}

__device__ __forceinline__ int block_excl_scan(int v, LAS int* wsum, int lane, int wid, int& total) {
    int inc = v;
#pragma unroll
    for (int o = 1; o < 64; o <<= 1) { const int t = __shfl_up(inc, o); if (lane >= o) inc += t; }
    if (lane == 63) wsum[wid] = inc;
    __syncthreads();
    int off = 0, tot = 0;
#pragma unroll
    for (int w = 0; w < 8; ++w) { const int s = wsum[w]; if (w < wid) off += s; tot += s; }
    __syncthreads();
    total = tot; return off + inc - v;
}
__device__ __forceinline__ void phase_topk(const Frame& F) {
    const float* AFFT = (const float*)(F.ws + WS_AFF); int* IDX = (int*)(F.ws + WS_IDX); float* GATEV = (float*)(F.ws + WS_GATEV); int* SLOTMAP = (int*)(F.ws + WS_SLOTMAP);
    LAS int* hist = (LAS int*)F.lds;
    LAS int* wsum = (LAS int*)(F.lds + 1024);
    LAS unsigned* shv = (LAS unsigned*)(F.lds + 1024 + 64);
    const int tid = F.tid, lane = F.lane;
    for (int pr = F.bid; pr < 32; pr += F.G) {
        const int stream = pr >> 4, e = pr & 15, tok0 = stream ? NCTX : 0, cap = stream ? CAPL : CAPC, sbase = e * ESLOTS + (stream ? CAPC : 0);
        const int C = stream ? 16 : 8, i0 = tid * C;
        unsigned k[16];
        { const u32x4* src = (const u32x4*)(AFFT + (size_t)e * NTOK + tok0 + i0);
#pragma unroll
          for (int q = 0; q < 4; ++q) { u32x4 v = (u32x4){0u, 0u, 0u, 0u}; if (q * 4 < C) v = src[q]; k[4 * q] = v.x; k[4 * q + 1] = v.y; k[4 * q + 2] = v.z; k[4 * q + 3] = v.w; } }
        unsigned prefix = 0u; int remaining = cap;
        __syncthreads();
        for (int pass = 0; pass < 4; ++pass) {
            const int shift = 24 - 8 * pass;
            if (tid < 256) hist[tid] = 0;
            __syncthreads();
#pragma unroll
            for (int i = 0; i < 16; ++i) if (i < C) { const unsigned kk = k[i]; if (pass == 0 || (kk >> (shift + 8)) == prefix) __hip_atomic_fetch_add(&hist[(kk >> shift) & 255u], 1, __ATOMIC_RELAXED, __HIP_MEMORY_SCOPE_WORKGROUP); }
            __syncthreads();
            if (tid < 64) {
                const int h0 = hist[4 * lane], h1 = hist[4 * lane + 1], h2 = hist[4 * lane + 2], h3 = hist[4 * lane + 3], c = h0 + h1 + h2 + h3;
                int inc = c;
#pragma unroll
                for (int o = 1; o < 64; o <<= 1) { const int t = __shfl_down(inc, o); if (lane + o < 64) inc += t; }
                const int above = inc - c;
                if (above < remaining && remaining <= inc) {
                    int cum = above, sel;
                    if (cum + h3 >= remaining) sel = 3; else { cum += h3; if (cum + h2 >= remaining) sel = 2; else { cum += h2; if (cum + h1 >= remaining) sel = 1; else { cum += h1; sel = 0; } } }
                    shv[0] = (prefix << 8) | (unsigned)(4 * lane + sel); shv[1] = (unsigned)(remaining - cum);
                }
            }
            __syncthreads();
            prefix = shv[0]; remaining = (int)shv[1];
        }
        const unsigned thr = prefix; const int need = remaining;
        int ceq = 0;
#pragma unroll
        for (int i = 0; i < 16; ++i) if (i < C) ceq += (k[i] == thr) ? 1 : 0;
        int tot; const int eq_rank = block_excl_scan(ceq, wsum, F.lane, F.wave, tot);
        int csel = 0; { int er = eq_rank;
#pragma unroll
            for (int i = 0; i < 16; ++i) if (i < C) { if (k[i] > thr) ++csel; else if (k[i] == thr) { if (er < need) ++csel; ++er; } } }
        int slot = block_excl_scan(csel, wsum, F.lane, F.wave, tot);
#if MK_CHECK
        if (tid == 0 && tot != cap) CHK_FAIL(F, 60);
#endif
        { int er = eq_rank; int sm[16];
#pragma unroll
            for (int i = 0; i < 16; ++i) { sm[i] = -1; if (i < C) { bool sel = false; if (k[i] > thr) sel = true; else if (k[i] == thr) { sel = er < need; ++er; }
                const int tok = tok0 + i0 + i;
                if (sel) { const int r = sbase + slot; IDX[r] = tok; GATEV[r] = __uint_as_float(k[i]); sm[i] = r; ++slot; } } }
            u32x4* dst = (u32x4*)(SLOTMAP + (size_t)e * NTOK + tok0 + i0);
#pragma unroll
            for (int q = 0; q < 4; ++q) if (q * 4 < C) dst[q] = (u32x4){(unsigned)sm[4 * q], (unsigned)sm[4 * q + 1], (unsigned)sm[4 * q + 2], (unsigned)sm[4 * q + 3]}; }
    }
    __syncthreads();
}
__device__ __forceinline__ void phase_gather(const Frame& F) {
    const int* IDX = (const int*)(F.ws + WS_IDX);
#if MK_CHECK
    {
        const int* SLOTMAP = (const int*)(F.ws + WS_SLOTMAP); const float* GATEV = (const float*)(F.ws + WS_GATEV); const float* AFF = (const float*)(F.ws + WS_AFF);
        for (int r = F.gw * 64 + F.lane; r < NSLOTS; r += F.NGW * 64) { const int tok = IDX[r], e = r / ESLOTS; const bool latslot = (r % ESLOTS) >= CAPC;
            bool ok = tok >= 0 && tok < NTOK && ((tok >= NCTX) == latslot);
            if (ok) ok = SLOTMAP[(size_t)e * NTOK + tok] == r && GATEV[r] == AFF[(size_t)e * NTOK + tok];
            if (ok) { const unsigned h = hash_u(r * 7919u + 13u); const int t2 = latslot ? NCTX + (h % NLAT) : (h % NCTX); if (SLOTMAP[(size_t)e * NTOK + t2] < 0 && AFF[(size_t)e * NTOK + t2] > GATEV[r]) ok = false; }
            if (!ok) CHK_FAIL(F, 61); }
    }
#endif
}

__device__ __forceinline__ void ye_acc(f32x4& f, unsigned w) {
    const auto lo = __builtin_amdgcn_cvt_pk_f32_fp8((int)w, false), hi = __builtin_amdgcn_cvt_pk_f32_fp8((int)w, true); f[0] += lo[0]; f[1] += lo[1]; f[2] += hi[0]; f[3] += hi[1];
}
__device__ __forceinline__ void ye_add(f32x4 (&f)[4], const unsigned char* YE, int r, int lane) {
    const bool two = (r >> 8) >= DOWN_FULL_PANELS;
    unsigned w[4], w2[4];
#pragma unroll
    for (int j = 0; j < 4; ++j) { w[j] = ((const unsigned*)(YE + (size_t)r * D))[lane + 64 * j]; w2[j] = 0u; if (two) w2[j] = ((const unsigned*)(YE + (size_t)(NSLOTS + r) * D))[lane + 64 * j]; }
#pragma unroll
    for (int j = 0; j < 4; ++j) { ye_acc(f[j], w[j]); ye_acc(f[j], w2[j]); }
}
__device__ __forceinline__ void ye_add2(f32x4 (&f)[4], const unsigned char* YE, int r, int rb, int lane) {
    const bool two = (r >> 8) >= DOWN_FULL_PANELS, twob = (rb >> 8) >= DOWN_FULL_PANELS;
    unsigned w[4], w2[4], v[4], v2[4];
#pragma unroll
    for (int j = 0; j < 4; ++j) { w[j] = ((const unsigned*)(YE + (size_t)r * D))[lane + 64 * j]; w2[j] = 0u; if (two) w2[j] = ((const unsigned*)(YE + (size_t)(NSLOTS + r) * D))[lane + 64 * j];
        v[j] = ((const unsigned*)(YE + (size_t)rb * D))[lane + 64 * j]; v2[j] = 0u; if (twob) v2[j] = ((const unsigned*)(YE + (size_t)(NSLOTS + rb) * D))[lane + 64 * j]; }
#pragma unroll
    for (int j = 0; j < 4; ++j) { ye_acc(f[j], w[j]); ye_acc(f[j], w2[j]); ye_acc(f[j], v[j]); ye_acc(f[j], v2[j]); }
}
__device__ __forceinline__ void phase_combine(const Frame& F, const Args& a, int l) {
    bf16* X = (bf16*)(F.ws + WS_X); const bf16* X1 = (const bf16*)(F.ws + WS_X1); bf16* H = (bf16*)(F.ws + WS_H); const unsigned char* YE = F.ws + WS_YE; const int* SLOTMAP = (const int*)(F.ws + WS_SLOTMAP);
    int lane_ = F.lane; asm volatile("" : "+v"(lane_)); const int lane = lane_;
    const f32x4* lg = (const f32x4*)(a.in[10] + (size_t)(l * 2 + 1) * D); const f32x4* lb = (const f32x4*)(a.in[11] + (size_t)(l * 2 + 1) * D);
#if MK_CHECK
    const unsigned err = __hip_atomic_load(F.ctl + CW_ERR, __ATOMIC_RELAXED, __HIP_MEMORY_SCOPE_AGENT);
    const unsigned tmo = __hip_atomic_load(F.ctl + CW_BAR + XB_TMO, __ATOMIC_RELAXED, __HIP_MEMORY_SCOPE_AGENT);
#endif
    const int RPW = (NTOK + F.NGW - 1) / F.NGW, rbeg = F.gw * RPW, rend = (rbeg + RPW < NTOK) ? rbeg + RPW : NTOK;
    f32x4 lgv[4], lbv[4], g2v[4], shv[4], scv[4]; int ccur = -1;
#pragma unroll
    for (int j = 0; j < 4; ++j) { lgv[j] = lg[lane + 64 * j]; lbv[j] = lb[lane + 64 * j]; g2v[j] = lgv[j]; shv[j] = lgv[j]; scv[j] = lgv[j]; }
    auto ld_sm = [&](int r) { int v = -1; if (r < rend && lane < 16) v = SLOTMAP[(size_t)lane * NTOK + r]; return v; };
    u32x2 x1n[4]; unsigned pw[4], pw2[4], pv[4], pv2[4]; unsigned restn = 0u; int smn_keep = -1;
    auto issue = [&](int r, int smv) {
        unsigned mask = (unsigned)__ballot(smv >= 0) & 0xffffu; int r0 = -1, r1 = -1;
        if (mask) { const int e0 = __builtin_ctz(mask); mask &= mask - 1; r0 = __builtin_amdgcn_readlane(smv, e0); }
        if (mask) { const int e1 = __builtin_ctz(mask); mask &= mask - 1; r1 = __builtin_amdgcn_readlane(smv, e1); }
        restn = mask; smn_keep = smv;
        const int rr = r < rend ? r : rend - 1;
#pragma unroll
        for (int j = 0; j < 4; ++j) { x1n[j] = ((const u32x2*)(X1 + (size_t)rr * D))[lane + 64 * j]; pw[j] = 0u; pw2[j] = 0u; pv[j] = 0u; pv2[j] = 0u; }
        if (r0 >= 0) {
#pragma unroll
            for (int j = 0; j < 4; ++j) { pw[j] = ((const unsigned*)(YE + (size_t)r0 * D))[lane + 64 * j]; if ((r0 >> 8) >= DOWN_FULL_PANELS) pw2[j] = ((const unsigned*)(YE + (size_t)(NSLOTS + r0) * D))[lane + 64 * j]; } }
        if (r1 >= 0) {
#pragma unroll
            for (int j = 0; j < 4; ++j) { pv[j] = ((const unsigned*)(YE + (size_t)r1 * D))[lane + 64 * j]; if ((r1 >> 8) >= DOWN_FULL_PANELS) pv2[j] = ((const unsigned*)(YE + (size_t)(NSLOTS + r1) * D))[lane + 64 * j]; } }
    };
    int sm1 = ld_sm(rbeg + 1);
    if (rbeg < rend) issue(rbeg, ld_sm(rbeg));
    for (int row = rbeg; row < rend; ++row) {
        const int c = cond_of(row);
        if (c != ccur) { ccur = c; const f32x4* g2 = (const f32x4*)ada_vec(F, l, c, 5);
#pragma unroll
            for (int j = 0; j < 4; ++j) g2v[j] = g2[lane + 64 * j];
            if (l < 3) { const f32x4* sh = (const f32x4*)ada_vec(F, l + 1, c, 0); const f32x4* sc = (const f32x4*)ada_vec(F, l + 1, c, 1);
#pragma unroll
                for (int j = 0; j < 4; ++j) { shv[j] = sh[lane + 64 * j]; scv[j] = sc[lane + 64 * j] + 1.f; } } }
        f32x4 x1[4], f[4]; unsigned mask = restn; const int smc = smn_keep;
#pragma unroll
        for (int j = 0; j < 4; ++j) { x1[j] = bf4(x1n[j]); f[j] = (f32x4){0.f, 0.f, 0.f, 0.f}; ye_acc(f[j], pw[j]); ye_acc(f[j], pw2[j]); ye_acc(f[j], pv[j]); ye_acc(f[j], pv2[j]); }
        if (row + 1 < rend) { const int smv = sm1; sm1 = ld_sm(row + 2); issue(row + 1, smv); }
        while (mask) {
            const int e0 = __builtin_ctz(mask); mask &= mask - 1; const int r0 = __builtin_amdgcn_readlane(smc, e0);
            if (mask) { const int e1 = __builtin_ctz(mask); mask &= mask - 1; const int r1 = __builtin_amdgcn_readlane(smc, e1); ye_add2(f, YE, r0, r1, lane); }
            else ye_add(f, YE, r0, lane);
        }
        f32x4 y[4]; float s = 0.f, s2 = 0.f;
#pragma unroll
        for (int j = 0; j < 4; ++j) { y[j] = x1[j] * ALPHA + g2v[j] * f[j] * (1.f / YE8_SCALE); s += (y[j][0] + y[j][1]) + (y[j][2] + y[j][3]); s2 += (y[j][0] * y[j][0] + y[j][1] * y[j][1]) + (y[j][2] * y[j][2] + y[j][3] * y[j][3]); }
        s = wave_sum(s); s2 = wave_sum(s2);
        const float mean = s * (1.f / D), var = fmaxf(s2 * (1.f / D) - mean * mean, 0.f);
        const float rstd = 1.f / sqrtf(var + 1e-5f);
        if (l < 3) {
#pragma unroll
            for (int j = 0; j < 4; ++j) { const int q = lane + 64 * j; const f32x4 xn = (y[j] - mean) * rstd * lgv[j] + lbv[j]; ((u32x2*)(X + (size_t)row * D))[q] = pk4(xn);
                const f32x4 h = xn * scv[j] + shv[j]; u32x2 w; w.x = cvtpk(h[0], h[1]); w.y = cvtpk(h[2], h[3]); ((u32x2*)(H + (size_t)row * D))[q] = w; }
        } else {
#pragma unroll
            for (int j = 0; j < 4; ++j) { const int q = lane + 64 * j; f32x4 xn = (y[j] - mean) * rstd * lgv[j] + lbv[j];
#if MK_CHECK
                if (row == 0 && q == 0) { if (err) xn[0] = 100.f * (float)err; else if (tmo) xn[0] = 9900.f; }
#endif
                ((f32x4*)(F.out + (size_t)row * D))[q] = xn; }
        }
    }
}

#if !MK_SPLIT
#define GRID_BAR() xcd_barrier(bar)
#else
#define GRID_BAR() do { } while (0)
#endif
#define IN(k) (lo <= (k) && (k) < hi)
#define GEMM_PHASE(EPI, SCHED) do { for (int rep_ = 0; rep_ < MK_REP_GEMM; ++rep_) pg8::gemm_phase<EPI, SCHED, true, true>(F.lds, g, S, E); } while (0)
template <int KIND>
__device__ __forceinline__ void run_mixer(const Frame& F, const Args& a, const XcdBarrier& bar, int lo, int hi, int l, int j, int slot, int& cv_it) {
    const int base = 3 + 12 * l;
    const bf16* Hb = (const bf16*)(F.ws + WS_H);
    ChunkMap cm; cm.init(F.G, F.bid);
    const ConvJob J{a.in[26], a.in[27], a.in[28], F.ws + WS_WGU, F.ws + WS_WD};
    const int cv_cap = (l == 0 ? 32 : l == 1 ? 48 : l == 2 ? 82 : 96) * (CV_PER_LAYER / 24);
    if (KIND != 2) {
        const bf16* Wq = (const bf16*)(F.ws + WS_WQKV) + (size_t)slot * 1536 * 1024;
        if (IN(base + 0)) {
            unsigned* cnt = F.ctl + CW_KV + 16 * l;
            Gemm g{Hb, Wq, 1024, 1024}; QkvOrder S{cm}; EpiBf16P E{(bf16*)(F.ws + WS_QKV), 1536};
            GEMM_PHASE(EpiBf16P, QkvOrder);
            int nkv = 0; { Unit u; for (int i = 0; S.next(i, u); ++i) nkv += (u.pn >= 4) ? 1 : 0; }
            if (nkv && F.tid == 0) { __builtin_amdgcn_fence(__ATOMIC_RELEASE, "agent"); (void)__hip_atomic_fetch_add(cnt, (unsigned)nkv, __ATOMIC_RELAXED, __HIP_MEMORY_SCOPE_AGENT); }
            const int idx = cm.x * cm.chunk + cm.loc; int skip = 288 - F.G; if (skip < 0 || skip >= F.G) skip = 0;
            if (idx >= skip) {
                if (F.tid == 0) { while (__hip_atomic_load(cnt, __ATOMIC_RELAXED, __HIP_MEMORY_SCOPE_AGENT) < 96u) __builtin_amdgcn_s_sleep(2); __builtin_amdgcn_fence(__ATOMIC_ACQUIRE, "agent"); }
                __syncthreads();
                for (int rep = 0; rep < MK_REP_POST; ++rep) phase_kv_post(F, a, KIND, j, slot, (idx - skip) * 8 + F.wave, (F.G - skip) * 8);
            }
            GRID_BAR();
        }
#if MK_CHECK
        if (IN(base + 3)) check_gemm_bf16<int>(F, Hb, Wq, NTOK, 1536, 1024, (const bf16*)(F.ws + WS_QKV), 1536, 10 + l);
#endif
        if (IN(base + 4)) {
            for (int rep = 0; rep < MK_REP_ATTN; ++rep) { if (KIND == 0) attn_phase<64, 0>(F, a, j, J, cv_it, (l + 1) * CV_PER_LAYER, cv_cap); else attn_phase<64, 1>(F, a, j, J, cv_it, (l + 1) * CV_PER_LAYER, cv_cap); }
            GRID_BAR();
        }
    } else {
        if (IN(base + 0)) {
            Gemm g{Hb, (const bf16*)(F.ws + WS_WDN), 512, 1024}; SplitKOrder S{2, 2, 1024, 48 * 2 * 2, cm}; EpiF32 E{(float*)(F.ws + WS_QKV), 512, DWN_PART};
            GEMM_PHASE(EpiF32, SplitKOrder); GRID_BAR();
        }
        if (IN(base + 1)) {
#if MK_CHECK
            for (int sidx = 0; sidx < 2; ++sidx) { const unsigned h = hash_u((F.gw * 2 + sidx) * 2654435761u + (10 + l) * 97u); const int row = h % NTOK, col = (h >> 12) % 512;
                const float ref = dot_bf16(Hb + (size_t)row * 1024, (const bf16*)(F.ws + WS_WDN) + (size_t)col * 1024, 1024, F.lane); const float* dq = (const float*)(F.ws + WS_QKV) + (size_t)row * 512 + col;
                if (!close_enough(dq[0] + dq[DWN_PART], ref, 0.01f, 0.01f)) CHK_FAIL(F, 10 + l); }
#endif
            phase_mla_post1(F, a); GRID_BAR();
        }
        if (IN(base + 2)) {
            { Gemm g{(const bf16*)(F.ws + WS_QA), (const bf16*)(F.ws + WS_WUQ), 256, 256}; PlainOrder S{6, 48 * 6, cm}; EpiBf16P E{(bf16*)(F.ws + WS_QKV), 1536}; GEMM_PHASE(EpiBf16P, PlainOrder); }
            { Gemm g{(const bf16*)(F.ws + WS_CKVA), (const bf16*)(F.ws + WS_WUKV), 128, 128}; ChunkMap cmr = cm; cmr.x = cm.nx - 1 - cm.x; PlainOrder S{8, 56 * 8, cmr};     EpiUkv E{(bf16*)(F.ws + WS_KB), (bf16*)(F.ws + WS_KVRAW)}; GEMM_PHASE(EpiUkv, PlainOrder); }
            GRID_BAR();
        }
        if (IN(base + 3)) {
#if MK_CHECK
            check_gemm_bf16<int>(F, (const bf16*)(F.ws + WS_QA), (const bf16*)(F.ws + WS_WUQ), NTOK, 1536, 256, (const bf16*)(F.ws + WS_QKV), 1536, 14);
            for (int sidx = 0; sidx < 2; ++sidx) {
                const unsigned h = hash_u((F.gw * 2 + sidx) * 2654435761u + 15u * 97u); const int row = h % 14336, col = (h >> 12) % 2048, hh = col >> 7, ii = col & 127;
                const float ref = dot_bf16((const bf16*)(F.ws + WS_CKVA) + (size_t)row * 128, (const bf16*)(F.ws + WS_WUKV) + (size_t)col * 128, 128, F.lane);
                bool lat; int b, s; mla_row(row, lat, b, s);
                const float got = (ii < 64) ? bf2f(((const bf16*)(F.ws + WS_KB))[kb_off(16, 96, lat, b, hh) + (size_t)s * 96 + ii]) : bf2f(((const bf16*)(F.ws + WS_KVRAW))[(size_t)row * 1024 + hh * 64 + ii - 64]);
                if (!close_enough(got, ref, 0.02f, 0.02f)) CHK_FAIL(F, 15);
            }
#endif
            for (int rep = 0; rep < MK_REP_POST; ++rep) phase_mla_post2(F, a); GRID_BAR();
        }
        if (IN(base + 4)) { for (int rep = 0; rep < MK_REP_ATTN; ++rep) attn_phase<96, 2>(F, a, j, J, cv_it, (l + 1) * CV_PER_LAYER, cv_cap); GRID_BAR(); }
    }
}
__device__ __forceinline__ void run_moe(const Frame& F, const Args& a, const XcdBarrier& bar, int lo, int hi, int l, int kind) {
    const int base = 3 + 12 * l;
    ChunkMap cm; cm.init(F.G, F.bid);
    const bf16* Wo = (const bf16*)(F.ws + WS_WO) + (size_t)l * 1024 * 1024;
    if (IN(base + 5)) {
#if MK_CHECK
        if (kind == 0) check_attn<64, 0>(F, a, l / 3, 20 + l); else if (kind == 1) check_attn<64, 1>(F, a, 0, 20 + l); else check_attn<96, 2>(F, a, 0, 20 + l);
        __syncthreads();
#endif
        Gemm g{(const bf16*)(F.ws + WS_O), Wo, 1024, 1024}; PlainOrder S{4, 48 * 4, cm}; EpiBf16P E{(bf16*)(F.ws + WS_AO), 1024};
        GEMM_PHASE(EpiBf16P, PlainOrder); GRID_BAR();
    }
    if (IN(base + 6)) {
#if MK_CHECK
        check_gemm_bf16<int>(F, (const bf16*)(F.ws + WS_O), Wo, NTOK, 1024, 1024, (const bf16*)(F.ws + WS_AO), 1024, 30 + l);
#endif
        for (int rep = 0; rep < MK_REP_LN1; ++rep) phase_ln1_router(F, a, l); GRID_BAR();
    }
#if MK_CHECK
    if (IN(base + 7)) {
        const unsigned hsh = hash_u(F.gw * 2654435761u + 991u * l + 17u); const int row = hsh % NTOK, c = cond_of(row);
        const bf16* X1c = (const bf16*)(F.ws + WS_X1); const float* sh2 = ada_vec(F, l, c, 3); const float* sc2 = ada_vec(F, l, c, 4); const float* wrc = a.in[25] + (size_t)l * D * NE; const float* AFFc = (const float*)(F.ws + WS_AFF);
        float lgt[16];
#pragma unroll
        for (int e = 0; e < 16; ++e) { float sacc = 0.f; for (int k = F.lane; k < D; k += 64) { const float hh = bf2f(X1c[(size_t)row * D + k]) * (sc2[k] + 1.f) + sh2[k]; sacc += hh * wrc[k * NE + e]; } lgt[e] = wave_sum(sacc); }
        float mxc = lgt[0];
#pragma unroll
        for (int e = 1; e < 16; ++e) mxc = fmaxf(mxc, lgt[e]);
        float denc = 0.f;
#pragma unroll
        for (int e = 0; e < 16; ++e) denc += __expf(lgt[e] - mxc);
#pragma unroll
        for (int e = 0; e < 16; ++e) { const float ref = __expf(lgt[e] - mxc) / denc, got = AFFc[(size_t)e * NTOK + row]; if (!close_enough(got, ref, 0.03f, 2e-4f)) CHK_FAIL(F, 62); }
    }
#endif
    if (IN(base + 7)) { for (int rep = 0; rep < MK_REP_TOPK; ++rep) phase_topk(F); if (l < 3) ada_direct(F, a, l + 1, 32); GRID_BAR(); }
#if MK_CHECK
    if (IN(base + 8)) { phase_gather(F); GRID_BAR(); }
#endif
    const unsigned char* Wgu = F.ws + WS_WGU + (size_t)l * 16 * 4096 * 1024; const unsigned char* Wd = F.ws + WS_WD + (size_t)l * 16 * 1024 * 2048;
    if (IN(base + 9)) {
#if MK_CHECK
        for (int sidx = 0; sidx < 16; ++sidx) {
            const unsigned h = hash_u((F.gw * 16 + sidx) * 2654435761u + 71u * l + 3u); const int idx = h & 63, e = (h >> 6) & 15, kk = (h >> 10) & 1023, nn = (h >> 20) & 2047;
            const int k = kk + ((idx & 1) ? 1024 * ((h >> 31) & 1) : 0);
            float src, got;
            if (idx & 1) { const int n = nn & 1023; src = a.in[28][((size_t)(l * 16 + e) * 2048 + k) * 1024 + n]; got = fp8f(Wd + ((size_t)e * 1024 + n) * 2048, k); }
            else { const bool up = (idx & 2) != 0; src = (up ? a.in[27] : a.in[26])[((size_t)(l * 16 + e) * 1024 + kk) * 2048 + nn]; got = fp8f(Wgu + ((size_t)e * 4096 + (nn >> 7) * 256 + (up ? 128 : 0) + (nn & 127)) * 1024, kk); }
            { const unsigned pk = pk4_fp8(src * W8_SCALE, 0.f, 0.f, 0.f); if (F.lane == 0 && got != __builtin_amdgcn_cvt_f32_fp8((int)pk, 0)) CHK_FAIL(F, 70 + l); }
        }
#endif
        Gemm g{(const bf16*)(F.ws + WS_XE), (const bf16*)Wgu, 512, 512, (const int*)(F.ws + WS_IDX)}; GroupedOrder S{6, 16, 1, 0, cm}; EpiSwiglu E{F.ws + WS_HID};
        pg8::gemm_phase<EpiSwiglu, GroupedOrder, true, true, true, true>(F.lds, g, S, E); GRID_BAR();
    }
    if (IN(base + 10)) {
#if MK_CHECK
        for (int sidx = 0; sidx < 2; ++sidx) {
            const unsigned h = hash_u((F.gw * 2 + sidx) * 2654435761u + 977u * l); const int row = h % NSLOTS, cc = (h >> 12) % FF, e = row / ESLOTS;
            const unsigned char* xr = F.ws + WS_XE + (size_t)((const int*)(F.ws + WS_IDX))[row] * D; const unsigned char* wg = Wgu + ((size_t)e * 4096 + (cc >> 7) * 256 + (cc & 127)) * 1024;
            const float gd = dot_fp8(xr, wg, 1024, F.lane) * (1.f / W8_SCALE), ud = dot_fp8(xr, wg + 128 * 1024, 1024, F.lane) * (1.f / W8_SCALE);
            const float ref = gd / (1.f + __expf(-gd)) * ud, got = fp8f(F.ws + WS_HID + (size_t)row * FF, cc) * (1.f / H8_SCALE);
            if (!close_enough(got, ref, 0.08f, 0.01f)) CHK_FAIL(F, 40 + l);
        }
#endif
        EpiDown E{F.ws + WS_YE, (const float*)(F.ws + WS_GATEV)};
        { Gemm g{(const bf16*)(F.ws + WS_HID), (const bf16*)Wd, 1024, 1024, nullptr}; DownOrder S{cm}; pg8::gemm_phase<EpiDown, DownOrder, true, true, false, true>(F.lds, g, S, E); }
        GRID_BAR();
    }
    if (IN(base + 11)) {
#if MK_CHECK
        for (int sidx = 0; sidx < 2; ++sidx) {
            const unsigned h = hash_u((F.gw * 2 + sidx) * 2654435761u + 577u * l + 5u); const int row = h % NSLOTS, cc = (h >> 12) % D, e = row / ESLOTS;
            const float dd = dot_fp8(F.ws + WS_HID + (size_t)row * FF, Wd + ((size_t)e * 1024 + cc) * 2048, 2048, F.lane) * (1.f / (W8_SCALE * H8_SCALE));
            const float ref = dd * ((const float*)(F.ws + WS_GATEV))[row], p1 = fp8f(F.ws + WS_YE + (size_t)row * D, cc) * (1.f / YE8_SCALE), p2 = ((row >> 8) >= DOWN_FULL_PANELS) ? fp8f(F.ws + WS_YE + (size_t)(NSLOTS + row) * D, cc) * (1.f / YE8_SCALE) : 0.f;
            if (!(fabsf(p1 + p2 - ref) <= 0.07f * (fabsf(p1) + fabsf(p2)) + 0.0005f)) CHK_FAIL(F, 50 + l);
        }
#endif
        for (int rep = 0; rep < MK_REP_COMB; ++rep) phase_combine(F, a, l); if (l < 3) GRID_BAR();
    }
}
#undef IN

constexpr int N_PHASES = 3 + 4 * 12;
__global__ void __launch_bounds__(512, 2) mk_fwd(Args a) {
    extern __shared__ __attribute__((aligned(16))) unsigned char lds_raw[];
    LAS unsigned char* lds0 = (LAS unsigned char*)lds_raw;
    Frame F;
    F.lds = lds0 + LDS_PH; F.ws = a.ws; F.out = a.out; F.ctl = (unsigned*)(a.ws + WS_CTL);
    F.tid = threadIdx.x; F.lane = F.tid & 63; F.wave = __builtin_amdgcn_readfirstlane(F.tid >> 6); F.G = gridDim.x; F.bid = blockIdx.x; F.gw = F.bid * 8 + F.wave; F.NGW = F.G * 8;
    if (F.tid < LDS_PH / 4) ((LAS unsigned*)lds0)[F.tid] = 0u;
    __syncthreads();
#if !MK_SPLIT
    XcdBarrier bar = xcd_barrier_post(F.ctl + CW_BAR, (volatile LAS unsigned*)lds0);
#else
    XcdBarrier bar; bar.bar = F.ctl + CW_BAR; bar.x = 0; bar.st = (volatile LAS unsigned*)lds0;
#endif
    const int lo = a.ph_lo, hi = a.ph_hi;
#define IN(k) (lo <= (k) && (k) < hi)
    if (IN(0)) { phase_prologue(F, a); GRID_BAR(); }
    if (IN(2)) { phase_mod0(F, a); GRID_BAR(); }
    int cv_it = F.gw;
    run_mixer<0>(F, a, bar, lo, hi, 0, 0, 0, cv_it);
    run_moe(F, a, bar, lo, hi, 0, 0);
    run_mixer<1>(F, a, bar, lo, hi, 1, 0, 1, cv_it);
    run_moe(F, a, bar, lo, hi, 1, 1);
    run_mixer<2>(F, a, bar, lo, hi, 2, 0, 0, cv_it);
    run_moe(F, a, bar, lo, hi, 2, 2);
    run_mixer<0>(F, a, bar, lo, hi, 3, 1, 2, cv_it);
    run_moe(F, a, bar, lo, hi, 3, 0);
#undef IN
}

extern "C" void kernel_launch(void* const* d_in, const int* in_sizes, int n_in, void* d_out, int out_size, void* d_ws, size_t ws_size, hipStream_t stream) {
    static int grid = 0;
    if (grid == 0) {
        if (n_in != 29 || out_size != 19529728 || ws_size < WS_END) { fprintf(stderr, "kernel_launch: unexpected sizes n_in %d out %d ws %zu\n", n_in, out_size, ws_size); grid = -1; return; }
        int dev = 0, cus = 0, per_cu = 0;
        if (hipGetDevice(&dev) != hipSuccess || hipDeviceGetAttribute(&cus, hipDeviceAttributeMultiprocessorCount, dev) != hipSuccess) { grid = -1; return; }
        if (hipFuncSetAttribute((const void*)mk_fwd, hipFuncAttributeMaxDynamicSharedMemorySize, LDS_BYTES) != hipSuccess) { fprintf(stderr, "kernel_launch: hipFuncSetAttribute failed\n"); grid = -1; return; }
        if (hipOccupancyMaxActiveBlocksPerMultiprocessor(&per_cu, (const void*)mk_fwd, 512, LDS_BYTES) != hipSuccess || per_cu < 1) fprintf(stderr, "kernel_launch: occupancy query says %d\n", per_cu);
        (void)hipGetLastError();
        grid = cus;
    }
    if (grid < 0) return;
    (void)hipMemsetAsync((char*)d_ws + WS_CTL, 0, CTL_BYTES, stream);
    Args a{};
    for (int i = 0; i < 29; ++i) a.in[i] = (const float*)d_in[i];
    a.out = (float*)d_out; a.ws = (unsigned char*)d_ws;
#if MK_SPLIT
    for (int p = 0; p < N_PHASES; ++p) {
        const int r = (p - 3) % 12, l = (p - 3) / 12;
        if (p >= 3) { const bool mla = (l % 3) == 2; if (!mla && (r == 1 || r == 2)) continue; }
        a.ph_lo = p; a.ph_hi = p + 1;
        hipLaunchKernelGGL(mk_fwd, dim3(grid), dim3(512), LDS_BYTES, stream, a);
    }
#else
    a.ph_lo = 0; a.ph_hi = N_PHASES;
    hipLaunchKernelGGL(mk_fwd, dim3(grid), dim3(512), LDS_BYTES, stream, a);
#endif
}
```

```cpp
#include <hip/hip_runtime.h>
#include <cstdio>
#include <cstdint>

#ifndef MK_SPLIT
#define MK_SPLIT 0
#endif
#ifndef MK_REP_ATTN
#define MK_REP_ATTN 1
#endif
#ifndef MK_REP_CONV
#define MK_REP_CONV 1
#endif
#ifndef MK_REP_POST
#define MK_REP_POST 1
#endif
#ifndef MK_REP_GEMM
#define MK_REP_GEMM 1
#endif
#ifndef MK_REP_LN1
#define MK_REP_LN1 1
#endif
#ifndef MK_REP_TOPK
#define MK_REP_TOPK 1
#endif
#ifndef MK_REP_GATH
#define MK_REP_GATH 1
#endif
#ifndef MK_REP_COMB
#define MK_REP_COMB 1
#endif
#ifndef MK_CHECK
#define MK_CHECK 0
#endif

#define LAS __attribute__((address_space(3)))
typedef unsigned short bf16;
typedef unsigned u32x4 __attribute__((ext_vector_type(4)));
typedef unsigned u32x2 __attribute__((ext_vector_type(2)));
typedef float f32x2 __attribute__((ext_vector_type(2)));
typedef float f32x4 __attribute__((ext_vector_type(4)));
typedef float f32x16 __attribute__((ext_vector_type(16)));
typedef short bf16x8 __attribute__((ext_vector_type(8)));
typedef __bf16 bf16x2_t __attribute__((ext_vector_type(2)));

constexpr int D = 1024, NCTX = 4096, NLAT = 8192, NTOK = 12288;
constexpr int NE = 16, FF = 2048, CAPC = 512, CAPL = 1024, ESLOTS = 1536, NSLOTS = 24576;
constexpr float ALPHA = 1.681792830507429f, LOG2E = 1.4426950408889634f;
constexpr float GQA_QS = 0.125f * LOG2E, MLA_QS = 0.10206207261596575f * LOG2E;
constexpr size_t DWN_PART = (size_t)8 << 20;
constexpr int OFF_YP = 0, OFF_NK = 12582912, OFF_NV = OFF_NK + 3145728, OFF_CKV = OFF_NV + 3145728, OFF_KPE = OFF_CKV + 524288;

constexpr size_t MiB = 1u << 20;
constexpr size_t WS_CTL = 0, CTL_BYTES = 1 * MiB;
constexpr size_t WS_ADAP = 1 * MiB, WS_ADA = 9 * MiB, WS_ROPE64 = 10 * MiB, WS_ROPE32 = 10 * MiB + 512 * 1024;
constexpr size_t WS_AFF = 11 * MiB, WS_IDX = 12 * MiB, WS_GATEV = 12 * MiB + 128 * 1024, WS_SLOTMAP = 13 * MiB;
constexpr size_t WS_X = 16 * MiB, WS_H = 64 * MiB, WS_O = 88 * MiB, WS_AO = 112 * MiB, WS_QKV = 160 * MiB, WS_KVRAW = 232 * MiB;
constexpr size_t WS_X1 = 292 * MiB  , WS_KB = 380 * MiB, WS_VT = 428 * MiB, WS_QA = 460 * MiB, WS_CKVA = 466 * MiB;
constexpr size_t WS_XE = 470 * MiB, WS_HID = 518 * MiB, WS_YE = 614 * MiB;
constexpr size_t WS_WQKV = 712 * MiB, WS_WO = 724 * MiB, WS_WDN = 732 * MiB, WS_WUQ = 733 * MiB, WS_WUKV = 734 * MiB;
constexpr size_t WS_WGU = 736 * MiB, WS_WD = 1248 * MiB, WS_END = 1504 * MiB;
constexpr int CW_ERR = 0, CW_BAR = 4096, CW_KV = 8192;

constexpr int LDS_BYTES = 147456, LDS_PH = 256;

__device__ __forceinline__ unsigned cvtpk(float lo, float hi) { f32x2 v = {lo, hi}; bf16x2_t b = __builtin_convertvector(v, bf16x2_t); return __builtin_bit_cast(unsigned, b); }
__device__ __forceinline__ bf16 f2bf(float f) { return (bf16)(cvtpk(f, 0.f) & 0xffffu); }
__device__ __forceinline__ float bf2f(bf16 b) { return __uint_as_float(((unsigned)b) << 16); }
__device__ __forceinline__ unsigned pk4_fp8(float a, float b, float c, float d) { int w = __builtin_amdgcn_cvt_pk_fp8_f32(a, b, 0, false); w = __builtin_amdgcn_cvt_pk_fp8_f32(c, d, w, true); return (unsigned)w; }
constexpr float W8_SCALE = 64.f, H8_SCALE = 8.f;
constexpr float YE8_SCALE = 128.f;
__device__ __forceinline__ float clamp8(float x) { return __builtin_amdgcn_fmed3f(x, -448.f, 448.f); }
__device__ __forceinline__ f32x4 bf4(u32x2 w) { return (f32x4){__uint_as_float(w.x << 16), __uint_as_float(w.x & 0xffff0000u), __uint_as_float(w.y << 16), __uint_as_float(w.y & 0xffff0000u)}; }
__device__ __forceinline__ u32x2 pk4(f32x4 v) { u32x2 w; w.x = cvtpk(v[0], v[1]); w.y = cvtpk(v[2], v[3]); return w; }
template <int CTRL> __device__ __forceinline__ float dppf(float v) { return __uint_as_float((unsigned)__builtin_amdgcn_update_dpp(0, (int)__float_as_uint(v), CTRL, 0xf, 0xf, true)); }
constexpr int DPP_X1 = 0xB1, DPP_X2 = 0x4E, DPP_HMIR = 0x141, DPP_MIR = 0x140, DPP_X8 = 0x128;
__device__ __forceinline__ float xsum16(float a, float b) { const auto r = __builtin_amdgcn_permlane16_swap(__float_as_uint(a), __float_as_uint(b), false, false); return __uint_as_float(r[0]) + __uint_as_float(r[1]); }
__device__ __forceinline__ float xsum32(float a, float b) { const auto r = __builtin_amdgcn_permlane32_swap(__float_as_uint(a), __float_as_uint(b), false, false); return __uint_as_float(r[0]) + __uint_as_float(r[1]); }
__device__ __forceinline__ float xmax16(float a) { const auto r = __builtin_amdgcn_permlane16_swap(__float_as_uint(a), __float_as_uint(a), false, false); return fmaxf(__uint_as_float(r[0]), __uint_as_float(r[1])); }
__device__ __forceinline__ float xmax32(float a) { const auto r = __builtin_amdgcn_permlane32_swap(__float_as_uint(a), __float_as_uint(a), false, false); return fmaxf(__uint_as_float(r[0]), __uint_as_float(r[1])); }
__device__ __forceinline__ float sum16(float v) { v += dppf<DPP_X1>(v); v += dppf<DPP_X2>(v); v += dppf<DPP_HMIR>(v); v += dppf<DPP_MIR>(v); return v; }
__device__ __forceinline__ float wave_sum(float v) { v = sum16(v); v = xsum16(v, v); return xsum32(v, v); }
__device__ __forceinline__ float wave_max(float v) {
    v = fmaxf(v, dppf<DPP_X1>(v)); v = fmaxf(v, dppf<DPP_X2>(v)); v = fmaxf(v, dppf<DPP_HMIR>(v)); v = fmaxf(v, dppf<DPP_MIR>(v)); v = xmax16(v); return xmax32(v);
}
__device__ __forceinline__ int cond_of(int t) { return t < NCTX ? 0 : 1 + ((t - NCTX) >> 11); }
__device__ __forceinline__ unsigned hash_u(unsigned x) { x ^= x >> 16; x *= 0x7feb352dU; x ^= x >> 15; x *= 0x846ca68bU; x ^= x >> 16; return x; }

#define XB_TMO      128
#define XB_XCNT(j)  (256  + 64 * (j))
#define XB_XSUB(j)  (1280 + 64 * (j))
#define XB_XGEN(j)  (2304 + 64 * (j))
#define XB_TOP      3328
#define XB_TOPGEN   3392
#define XCD_BAR_WORDS 3456
#define XB_SPIN_CAP (1u << 18)
__device__ __forceinline__ unsigned xb_ld(unsigned* p)              { return __hip_atomic_load(p, __ATOMIC_RELAXED, __HIP_MEMORY_SCOPE_AGENT); }
__device__ __forceinline__ unsigned xb_add(unsigned* p, unsigned v) { return __hip_atomic_fetch_add(p, v, __ATOMIC_RELAXED, __HIP_MEMORY_SCOPE_AGENT); }
__device__ __forceinline__ unsigned xb_xcc_id() { return (unsigned)__builtin_amdgcn_s_getreg((3 << 11) | 20) & 0xFu; }
#define XB_SPIN(cond, bar) do { unsigned _sp = 0; while (cond) { __builtin_amdgcn_s_sleep(1); \
    if ((++_sp & 255u) == 0u) { if (xb_ld(&(bar)[XB_TMO])) break; if (_sp > XB_SPIN_CAP) { atomicAdd(&(bar)[XB_TMO], 1u); break; } } } } while (0)
struct XcdBarrier { unsigned* bar; unsigned x; volatile LAS unsigned* st; };
__device__ __forceinline__ XcdBarrier xcd_barrier_post(unsigned* bar, volatile LAS unsigned* st) {
    XcdBarrier b; b.bar = bar; b.x = xb_xcc_id(); b.st = st;
    if (threadIdx.x == 0) (void)xb_add(&bar[XB_XCNT(b.x)], 1u);
    return b;
}
__device__ __forceinline__ void xcd_barrier_complete(unsigned* bar, unsigned x, unsigned& nloc, unsigned& nx) {
    const unsigned G = gridDim.x * gridDim.y * gridDim.z;
    unsigned sum, cnt, mine, sp = 0u;
    for (;;) {
        sum = 0u; cnt = 0u; mine = 0u;
#pragma unroll
        for (unsigned j = 0; j < 16; ++j) { const unsigned c = xb_ld(&bar[XB_XCNT(j)]); sum += c; cnt += (c > 0u) ? 1u : 0u; mine = (j == x) ? c : mine; }
        if (sum == G) break;
        __builtin_amdgcn_s_sleep(1);
        if ((++sp & 255u) == 0u) { if (xb_ld(&bar[XB_TMO])) break; if (sp > XB_SPIN_CAP) { atomicAdd(&bar[XB_TMO], 1u); break; } }
    }
    nloc = mine > 0u ? mine : 1u; nx = cnt > 0u ? cnt : 1u;
}
__device__ __forceinline__ void xcd_barrier(const XcdBarrier& b) {
    asm volatile("s_waitcnt vmcnt(0)" ::: "memory");
    __syncthreads();
    if (threadIdx.x == 0) {
        unsigned* bar = b.bar;
        __builtin_amdgcn_s_waitcnt(0);
        unsigned nloc = b.st[0], nx = b.st[1];
        if (nloc == 0u) { xcd_barrier_complete(bar, b.x, nloc, nx); b.st[0] = nloc; b.st[1] = nx; }
        const unsigned old = xb_add(&bar[XB_XSUB(b.x)], 1u);
        const unsigned gen = old / nloc;
        if (old + 1u == (gen + 1u) * nloc) {
            __builtin_amdgcn_fence(__ATOMIC_RELEASE, "agent");
            asm volatile("s_waitcnt vmcnt(0)" ::: "memory");
            const unsigned og = xb_add(&bar[XB_TOP], 1u);
            const unsigned tg = og / nx;
            if (og + 1u == (tg + 1u) * nx) xb_add(&bar[XB_TOPGEN], 1u);
            else XB_SPIN(xb_ld(&bar[XB_TOPGEN]) == tg, bar);
            __builtin_amdgcn_fence(__ATOMIC_ACQUIRE, "agent");
            xb_add(&bar[XB_XGEN(b.x)], 1u);
            asm volatile("s_waitcnt vmcnt(0)" ::: "memory");
        } else {
            XB_SPIN(xb_ld(&bar[XB_XGEN(b.x)]) == gen, bar);
            __builtin_amdgcn_fence(__ATOMIC_ACQUIRE, "agent");
            asm volatile("s_waitcnt vmcnt(0)" ::: "memory");
        }
    }
    __syncthreads();
}

struct Args { const float* in[29]; float* out; unsigned char* ws; int ph_lo, ph_hi; };
struct Frame {
    LAS unsigned char* lds;
    unsigned char* ws; float* out; unsigned* ctl;
    int tid, lane, wave, G, bid, gw, NGW;
};
#if MK_CHECK
#define CHK_FAIL(F, id) do { unsigned _e = 0u; __hip_atomic_compare_exchange_strong((F).ctl + CW_ERR, &_e, (unsigned)(id), __ATOMIC_RELAXED, __ATOMIC_RELAXED, __HIP_MEMORY_SCOPE_AGENT); } while (0)
#endif
__device__ __forceinline__ bool close_enough(float a, float b, float rel, float abs_) { const float d = fabsf(a - b); return d <= rel * fabsf(b) + abs_ && a == a; }

namespace pg8 {
#define PG8_LAS __attribute__((address_space(3)))
typedef unsigned short bf16_t;
typedef short bf16x8 __attribute__((ext_vector_type(8)));
typedef float f32x4 __attribute__((ext_vector_type(4)));
constexpr int BM = 256, BK = 64, HALF = 128, HTB = HALF * BK * 2  , STAGE_BYTES = 8 * HTB, NXCD = 8, WGM = 8;

__host__ __device__ __forceinline__ int lds_byte(int r, int c, int XM = 32) { const int st = (r >> 4) * 2 + (c >> 5), rr = r & 15, cc = c & 31, ob = rr * 64 + cc * 2; return st * 1024 + (ob ^ (((ob >> 9) & 1) * XM)); }
__host__ __device__ __forceinline__ void stage_rc(int b, int& R, int& C, int XM = 32) { const int st = b / 1024, sb = b % 1024, swz = sb ^ (((sb >> 9) & 1) * XM); R = (st >> 1) * 16 + swz / 64; C = (st & 1) * 32 + (swz % 64) / 2; }
__host__ __device__ __forceinline__ int perm32(int rho) { const int n = rho >> 4, i = rho & 15; return 8 * (i >> 2) + 4 * n + (i & 3); }
struct Unit { int pm, pn, kb; int kt = 0; };
struct Gemm { const bf16_t* A; const bf16_t* Bt; int K, ld; const int* aidx; };
template <class Epi, class Sched, bool ALIGN_EPI = false, bool SP2 = false, bool GATHER = false, bool F8 = false>
__device__ __forceinline__ void gemm_phase(PG8_LAS unsigned char* lds, const Gemm g, const Sched& S, const Epi& E) {
    int tid_ = threadIdx.x; asm volatile("" : "+v"(tid_));
    const int tid = tid_, wid = __builtin_amdgcn_readfirstlane(tid >> 6), lane = tid & 63, wr = wid >> 2, wc = wid & 3, fr = lane & 15, fq = lane >> 4;
    const int K = g.K, LD = g.ld, nt = K / BK;
    unsigned voffA[2], voffB[2]; int RA[2]; unsigned CA2[2];
#pragma unroll
    for (int i = 0; i < 2; ++i) { int R, C; stage_rc(tid * 16 + i * 8192, R, C, F8 ? 48 : 32); const int Rb = Epi::PERM ? ((R & ~31) + perm32(R & 31)) : R;
        voffA[i] = (unsigned)(R * LD + C) * 2u; voffB[i] = (unsigned)(Rb * LD + C) * 2u; RA[i] = R; CA2[i] = (unsigned)C * 2u; }
    const size_t kstep = (size_t)(BK * 2);
    const size_t hstep = (size_t)HALF * LD * 2;
    const size_t tstep = 2 * hstep;
    const unsigned ldsw = (unsigned)wid * 1024u;
    const int aoff = lds_byte(wr * 64 + fr, F8 ? fq * 16 : fq * 8, F8 ? 48 : 32), boff = lds_byte(wc * 32 + fr, F8 ? fq * 16 : fq * 8, F8 ? 48 : 32);
    const int aoffh = aoff ^ 16, boffh = boff ^ 16;
    typedef int i32x8_t __attribute__((ext_vector_type(8)));
#define PG8_SA(b, h) (((b) * 2 + (h)) * HTB)
#define PG8_SB(b, h) ((4 + (b) * 2 + (h)) * HTB)
#define PG8_STAGE(bufoff, gbase, voff) do { _Pragma("unroll") for (int _i = 0; _i < 2; ++_i) \
        __builtin_amdgcn_global_load_lds((const unsigned*)((const char*)(gbase) + (voff)[_i]), (PG8_LAS unsigned*)(lds + (bufoff) + ldsw + _i * 8192), 16, 0, 0); } while (0)
#define PG8_GOFF(dst, unit) do { _Pragma("unroll") for (int _h = 0; _h < 2; ++_h) _Pragma("unroll") for (int _i = 0; _i < 2; ++_i) dst[_h][_i] = (unsigned)g.aidx[(unit).pm * 256 + _h * 128 + RA[_i]] * (unsigned)(LD * 2) + CA2[_i]; } while (0)
#define PG8_STAGE_A(bufoff, gbase, h, nx) do { if constexpr (GATHER) { unsigned _o[2] = {(nx) ? oN[h][0] : oC[h][0], (nx) ? oN[h][1] : oC[h][1]}; PG8_STAGE(bufoff, gbase, _o); } else { PG8_STAGE(bufoff, (gbase) + (h) * hstep, voffA); } } while (0)
#define PG8_LDA16(dst, b, h) do { _Pragma("unroll") for (int m = 0; m < 4; ++m) _Pragma("unroll") for (int k = 0; k < 2; ++k) dst[m][k] = *(const PG8_LAS bf16x8*)(lds + PG8_SA(b, h) + aoff + m * 2048 + k * 1024); } while (0)
#define PG8_LDB16(dst, b, h) do { _Pragma("unroll") for (int n = 0; n < 2; ++n) _Pragma("unroll") for (int k = 0; k < 2; ++k) dst[n][k] = *(const PG8_LAS bf16x8*)(lds + PG8_SB(b, h) + boff + n * 2048 + k * 1024); } while (0)
#define PG8_MMA16(ai, bj, At, Bt) do { __builtin_amdgcn_s_setprio(1); _Pragma("unroll") for (int m = 0; m < 4; ++m) _Pragma("unroll") for (int n = 0; n < 2; ++n) _Pragma("unroll") for (int k = 0; k < 2; ++k) \
        acc[ai][bj][m][n] = __builtin_amdgcn_mfma_f32_16x16x32_bf16(Bt[n][k], At[m][k], acc[ai][bj][m][n], 0, 0, 0); __builtin_amdgcn_s_setprio(0); } while (0)
#define PG8_LD32(p, lo, hi) __builtin_bit_cast(i32x8_t, __builtin_shufflevector(*(const PG8_LAS bf16x8*)((p) + (lo)), *(const PG8_LAS bf16x8*)((p) + (hi)), 0, 1, 2, 3, 4, 5, 6, 7, 8, 9, 10, 11, 12, 13, 14, 15))
#define PG8_LDA(dst, b, h) do { if constexpr (F8) { _Pragma("unroll") for (int m = 0; m < 4; ++m) dst##8[m] = PG8_LD32(lds + PG8_SA(b, h) + m * 2048, aoff, aoffh); } else { PG8_LDA16(dst, b, h); } } while (0)
#define PG8_LDB(dst, b, h) do { if constexpr (F8) { _Pragma("unroll") for (int n = 0; n < 2; ++n) dst##8[n] = PG8_LD32(lds + PG8_SB(b, h) + n * 2048, boff, boffh); } else { PG8_LDB16(dst, b, h); } } while (0)
#define PG8_MMA(ai, bj, At, Bt) do { if constexpr (F8) { __builtin_amdgcn_s_setprio(1); _Pragma("unroll") for (int m = 0; m < 4; ++m) _Pragma("unroll") for (int n = 0; n < 2; ++n) \
        asm volatile("v_mfma_f32_16x16x128_f8f6f4 %0, %1, %2, %0" : "+v"(acc[ai][bj][m][n]) : "v"(Bt##8[n]), "v"(At##8[m])); __builtin_amdgcn_s_setprio(0); } else { PG8_MMA16(ai, bj, At, Bt); } } while (0)
#define PG8_WAIT_V(n) asm volatile("s_waitcnt vmcnt(" #n ")" ::: "memory")
#define PG8_WAIT_L(n) asm volatile("s_waitcnt lgkmcnt(" #n ")" ::: "memory")
#define PG8_BAR __builtin_amdgcn_s_barrier()
#define PG8_SCHED __builtin_amdgcn_sched_barrier(0)
    Unit cur, nxt; int ui = 0;
    if (!S.next(0, cur)) return;
    unsigned oC[2][2] = {{0u, 0u}, {0u, 0u}}, oN[2][2] = {{0u, 0u}, {0u, 0u}};
    if constexpr (GATHER) PG8_GOFF(oC, cur);
    f32x4 acc[2][2][4][2];
#pragma unroll
    for (int a = 0; a < 2; ++a)
#pragma unroll
        for (int b = 0; b < 2; ++b)
#pragma unroll
            for (int m = 0; m < 4; ++m)
#pragma unroll
                for (int n = 0; n < 2; ++n) acc[a][b][m][n] = (f32x4){0.f, 0.f, 0.f, 0.f};
    bf16x8 At[4][2], B0[2][2], B1[2][2]; i32x8_t At8[4], B08[2], B18[2];
    const char* cA = GATHER ? (const char*)g.A + cur.kb : (const char*)g.A + (size_t)cur.pm * tstep + cur.kb; const char* cB = (const char*)g.Bt + (size_t)cur.pn * tstep + cur.kb;
    S.a_ready(cur);
    if constexpr (SP2) {
        PG8_STAGE(PG8_SB(0, 0), cB, voffB); PG8_STAGE(PG8_SB(0, 1), cB + hstep, voffB); PG8_STAGE_A(PG8_SA(0, 0), cA, 0, false); PG8_STAGE_A(PG8_SA(0, 1), cA, 1, false);
        if (wr == 1) PG8_BAR;
        PG8_WAIT_V(2); PG8_BAR;
        PG8_STAGE(PG8_SB(1, 0), cB + kstep, voffB); PG8_STAGE_A(PG8_SA(1, 0), cA + kstep, 0, false); PG8_STAGE(PG8_SB(1, 1), cB + hstep + kstep, voffB);
        PG8_WAIT_V(6); PG8_BAR;
    } else {
        PG8_STAGE(PG8_SB(0, 0), cB, voffB); PG8_STAGE_A(PG8_SA(0, 0), cA, 0, false); PG8_STAGE(PG8_SB(0, 1), cB + hstep, voffB); PG8_STAGE_A(PG8_SA(0, 1), cA, 1, false);
        if (wr == 1) PG8_BAR;
        PG8_WAIT_V(4); PG8_BAR;
        PG8_STAGE(PG8_SB(1, 0), cB + kstep, voffB); PG8_STAGE_A(PG8_SA(1, 0), cA + kstep, 0, false); PG8_STAGE(PG8_SB(1, 1), cB + hstep + kstep, voffB);
        PG8_WAIT_V(6); PG8_BAR;
    }
    for (;;) {
        const bool has_next = S.next(ui + 1, nxt);
        const char* nA = has_next ? (GATHER ? (const char*)g.A + nxt.kb : (const char*)g.A + (size_t)nxt.pm * tstep + nxt.kb) : cA;
        if constexpr (GATHER) { if (has_next) PG8_GOFF(oN, nxt); } const char* nB = has_next ? (const char*)g.Bt + (size_t)nxt.pn * tstep + nxt.kb : cB;
        const int unt = cur.kt ? cur.kt : nt;
        for (int t = 0; t < unt; t += 2) {
            const bool last = (t == unt - 2); const bool lastn = last && has_next;
            const char* a1 = cA + (size_t)(t + 1) * kstep;
            const char* a2 = last ? nA : cA + (size_t)(t + 2) * kstep; const char* b2 = last ? nB : cB + (size_t)(t + 2) * kstep;
            const char* a3 = a2 + kstep; const char* b3 = b2 + kstep;
            if (last && has_next) S.a_ready(nxt);
            if constexpr (SP2) {
            PG8_LDB(B0, 0, 0); PG8_LDB(B1, 0, 1); PG8_SCHED; PG8_LDA(At, 0, 0); PG8_STAGE_A(PG8_SA(1, 1), a1, 1, false);
            PG8_WAIT_V(8); PG8_WAIT_L(0); PG8_BAR; PG8_MMA(0, 0, At, B0); PG8_MMA(0, 1, At, B1); PG8_BAR; PG8_SCHED;
            PG8_LDA(At, 0, 1); PG8_STAGE(PG8_SB(0, 0), b2, voffB); PG8_STAGE(PG8_SB(0, 1), b2 + hstep, voffB); PG8_STAGE_A(PG8_SA(0, 0), a2, 0, lastn);
            PG8_WAIT_V(8); PG8_WAIT_L(0); PG8_BAR; PG8_MMA(1, 0, At, B0); PG8_MMA(1, 1, At, B1); PG8_BAR; PG8_SCHED;
            PG8_LDB(B0, 1, 0); PG8_LDB(B1, 1, 1); PG8_SCHED; PG8_LDA(At, 1, 0); PG8_STAGE_A(PG8_SA(0, 1), a2, 1, lastn);
            PG8_WAIT_V(8); PG8_WAIT_L(0); PG8_BAR; PG8_MMA(0, 0, At, B0); PG8_MMA(0, 1, At, B1); PG8_BAR; PG8_SCHED;
            PG8_LDA(At, 1, 1); PG8_STAGE(PG8_SB(1, 0), b3, voffB); PG8_STAGE(PG8_SB(1, 1), b3 + hstep, voffB); PG8_STAGE_A(PG8_SA(1, 0), a3, 0, lastn);
            PG8_WAIT_V(8); PG8_WAIT_L(0); PG8_BAR; PG8_MMA(1, 0, At, B0); PG8_MMA(1, 1, At, B1); PG8_BAR; PG8_SCHED;
            } else {
            PG8_LDB(B0, 0, 0); PG8_SCHED; PG8_LDA(At, 0, 0); PG8_STAGE_A(PG8_SA(1, 1), a1, 1, false);
            PG8_WAIT_L(8); PG8_BAR; PG8_WAIT_L(0); PG8_MMA(0, 0, At, B0); PG8_BAR; PG8_SCHED;
            PG8_LDB(B1, 0, 1); PG8_STAGE(PG8_SB(0, 0), b2, voffB);
            PG8_BAR; PG8_WAIT_L(0); PG8_MMA(0, 1, At, B1); PG8_BAR;
            PG8_LDA(At, 0, 1); PG8_STAGE_A(PG8_SA(0, 0), a2, 0, lastn);
            PG8_BAR; PG8_WAIT_L(0); PG8_MMA(1, 0, At, B0); PG8_BAR; PG8_SCHED;
            PG8_STAGE(PG8_SB(0, 1), b2 + hstep, voffB);
            PG8_WAIT_V(6); PG8_BAR; PG8_MMA(1, 1, At, B1); PG8_BAR;
            PG8_LDB(B0, 1, 0); PG8_SCHED; PG8_LDA(At, 1, 0); PG8_STAGE_A(PG8_SA(0, 1), a2, 1, lastn);
            PG8_WAIT_L(8); PG8_BAR; PG8_WAIT_L(0); PG8_MMA(0, 0, At, B0); PG8_BAR; PG8_SCHED;
            PG8_LDB(B1, 1, 1); PG8_STAGE(PG8_SB(1, 0), b3, voffB);
            PG8_BAR; PG8_WAIT_L(0); PG8_MMA(0, 1, At, B1); PG8_BAR;
            PG8_LDA(At, 1, 1); PG8_STAGE_A(PG8_SA(1, 0), a3, 0, lastn);
            PG8_BAR; PG8_WAIT_L(0); PG8_MMA(1, 0, At, B0); PG8_BAR; PG8_SCHED;
            PG8_STAGE(PG8_SB(1, 1), b3 + hstep, voffB);
            PG8_WAIT_V(6); PG8_BAR; PG8_MMA(1, 1, At, B1); PG8_BAR;
            }
        }
        if constexpr (ALIGN_EPI) { if (wr == 0) PG8_BAR; }
        if constexpr (F8) {
#pragma unroll
            for (int a = 0; a < 2; ++a)
#pragma unroll
                for (int b = 0; b < 2; ++b)
                    asm volatile("s_nop 15\n\ts_nop 7" : "+v"(acc[a][b][0][0]), "+v"(acc[a][b][0][1]), "+v"(acc[a][b][1][0]), "+v"(acc[a][b][1][1]), "+v"(acc[a][b][2][0]), "+v"(acc[a][b][2][1]), "+v"(acc[a][b][3][0]), "+v"(acc[a][b][3][1])); }
        if constexpr (!Epi::AFTER_DRAIN) { E(acc, cur, wr, wc, fr, fq); S.done(cur); }
        if (!has_next) break;
#pragma unroll
        for (int a = 0; a < 2; ++a)
#pragma unroll
            for (int b = 0; b < 2; ++b)
#pragma unroll
                for (int m = 0; m < 4; ++m)
#pragma unroll
                    for (int n = 0; n < 2; ++n) acc[a][b][m][n] = (f32x4){0.f, 0.f, 0.f, 0.f};
        cur = nxt; cA = nA; cB = nB; ++ui;
        if constexpr (GATHER) { oC[0][0] = oN[0][0]; oC[0][1] = oN[0][1]; oC[1][0] = oN[1][0]; oC[1][1] = oN[1][1]; }
        if constexpr (ALIGN_EPI) { if (wr == 1) PG8_BAR; }
    }
    PG8_WAIT_V(0);
    if constexpr (!ALIGN_EPI) { if (wr == 0) PG8_BAR; }
    PG8_BAR;
    if constexpr (Epi::AFTER_DRAIN) { E.fused(acc, cur, wr, wc, fr, fq, lds, wid, lane); S.done(cur); }
#undef PG8_SA
#undef PG8_SB
#undef PG8_STAGE
#undef PG8_STAGE_A
#undef PG8_GOFF
#undef PG8_LDA
#undef PG8_LDA16
#undef PG8_LD32
#undef PG8_LDB16
#undef PG8_MMA16
#undef PG8_LDB
#undef PG8_MMA
#undef PG8_WAIT_V
#undef PG8_WAIT_L
#undef PG8_BAR
#undef PG8_SCHED
}
}
using pg8::Unit; using pg8::Gemm;
struct ChunkMap { int x, loc, nx, chunk;
    __device__ void init(int G, int bid) { if (G % 8 == 0) { nx = 8; chunk = G / 8; x = bid % 8; loc = bid / 8; } else { nx = 1; chunk = G; x = 0; loc = bid; } }
    __device__ __forceinline__ int lin(int i) const { return (i * nx + x) * chunk + loc; } };
struct PlainOrder {
    int nN, total; ChunkMap cm;
    __device__ bool next(int i, Unit& u) const { const int L = cm.lin(i); if (L >= total) return false; u.pm = L / nN; u.pn = L % nN; u.kb = 0; return true; }
    __device__ __forceinline__ void a_ready(const Unit&) const {}
    __device__ __forceinline__ void done(const Unit&) const {}
};
struct QkvOrder { ChunkMap cm;
    __device__ bool next(int i, Unit& u) const { const int L = cm.lin(i); if (L >= 288) return false;
        if (L >= 32 && L < 128) { const int r = L - 32; u.pm = r >> 1; u.pn = 4 + (r & 1); } else { const int r = L < 32 ? L : L - 96; u.pm = r >> 2; u.pn = r & 3; }
        u.kb = 0; return true; }
    __device__ __forceinline__ void a_ready(const Unit&) const {}
    __device__ __forceinline__ void done(const Unit&) const {}
};
struct SplitKOrder {
    int nN, ks, kbytes, total; ChunkMap cm;
    __device__ bool next(int i, Unit& u) const { const int L = cm.lin(i); if (L >= total) return false; const int t = L / ks; u.pm = t / nN; u.pn = t % nN; u.kb = (L % ks) * kbytes; return true; }
    __device__ __forceinline__ void a_ready(const Unit&) const {}
    __device__ __forceinline__ void done(const Unit&) const {}
};
struct GroupedOrder {
    int mt, nt, ks, kbytes; ChunkMap cm;
    __device__ bool next(int i, Unit& u) const { const int L = cm.lin(i), per = mt * nt * ks; if (L >= NE * per) return false; const int e = L / per, r = L % per, m = r / (nt * ks), q = r % (nt * ks);
        u.pm = e * mt + m; u.pn = e * nt + q / ks; u.kb = (q % ks) * kbytes; return true; }
    __device__ __forceinline__ void a_ready(const Unit&) const {}
    __device__ __forceinline__ void done(const Unit&) const {}
};
constexpr int DOWN_FULL_PANELS = 64;
struct DownOrder { ChunkMap cm;
    __device__ bool next(int i, Unit& u) const { const int L = cm.lin(i >> 1); if (L >= 256) return false; const int half = i & 1; const int T = half ? 256 + (L >> 1) : L;
        u.pm = T >> 2; u.pn = (u.pm / 6) * 4 + (T & 3); u.kb = half ? (L & 1) * 1024 : 0; u.kt = half ? 8 : 16; return true; }
    __device__ __forceinline__ void a_ready(const Unit&) const {}
    __device__ __forceinline__ void done(const Unit&) const {}
};
struct EpiF32 { float* C; int ldc; size_t kstride; static constexpr bool PERM = false, AFTER_DRAIN = false;
    __device__ __forceinline__ void operator()(const f32x4 (&acc)[2][2][4][2], const Unit& u, int wr, int wc, int fr, int fq) const {
#pragma unroll
        for (int ai = 0; ai < 2; ++ai)
#pragma unroll
            for (int m = 0; m < 4; ++m) { float* rp = C + (u.kb ? kstride : (size_t)0) + (size_t)(u.pm * 256 + ai * 128 + wr * 64 + m * 16 + fr) * ldc + u.pn * 256 + wc * 32 + 4 * fq;
#pragma unroll
                for (int bj = 0; bj < 2; ++bj)
#pragma unroll
                    for (int n = 0; n < 2; ++n) *(f32x4*)(rp + bj * 128 + n * 16) = acc[ai][bj][m][n]; }
    }
};
struct EpiBf16P { bf16* C; int ldc; static constexpr bool PERM = true, AFTER_DRAIN = false;
    __device__ __forceinline__ void operator()(const f32x4 (&acc)[2][2][4][2], const Unit& u, int wr, int wc, int fr, int fq) const {
#pragma unroll
        for (int ai = 0; ai < 2; ++ai)
#pragma unroll
            for (int m = 0; m < 4; ++m) { bf16* rp = C + (size_t)(u.pm * 256 + ai * 128 + wr * 64 + m * 16 + fr) * ldc + u.pn * 256 + wc * 32 + 8 * fq;
#pragma unroll
                for (int bj = 0; bj < 2; ++bj) { const f32x4 v0 = acc[ai][bj][m][0], v1 = acc[ai][bj][m][1]; u32x4 w; w.x = cvtpk(v0[0], v0[1]); w.y = cvtpk(v0[2], v0[3]); w.z = cvtpk(v1[0], v1[1]); w.w = cvtpk(v1[2], v1[3]);
                    *(u32x4*)(rp + bj * 128) = w; } }
    }
};
__device__ __forceinline__ float silu_f(float x) { return x * __builtin_amdgcn_rcpf(1.f + __builtin_amdgcn_exp2f(-x * LOG2E)); }
struct EpiSwiglu { unsigned char* HID; static constexpr bool PERM = true, AFTER_DRAIN = false;
    __device__ __forceinline__ void operator()(const f32x4 (&acc)[2][2][4][2], const Unit& u, int wr, int wc, int fr, int fq) const {
        const int cb = (u.pn & 15) * 128 + wc * 32 + 8 * fq; constexpr float IS = 1.f / W8_SCALE;
#pragma unroll
        for (int ai = 0; ai < 2; ++ai)
#pragma unroll
            for (int m = 0; m < 4; ++m) { unsigned char* rp = HID + (size_t)(u.pm * 256 + ai * 128 + wr * 64 + m * 16 + fr) * FF + cb; u32x2 w;
#pragma unroll
                for (int n = 0; n < 2; ++n) { const f32x4 g = acc[ai][0][m][n] * IS, up = acc[ai][1][m][n] * (IS * H8_SCALE);
                    const unsigned pk = pk4_fp8(silu_f(g[0]) * up[0], silu_f(g[1]) * up[1], silu_f(g[2]) * up[2], silu_f(g[3]) * up[3]); if (n == 0) w.x = pk; else w.y = pk; }
                *(u32x2*)rp = w; asm volatile("" ::: "memory"); }
    }
};
struct EpiDown { unsigned char* YE; const float* gate; static constexpr bool PERM = true, AFTER_DRAIN = false;
    __device__ __forceinline__ void operator()(const f32x4 (&acc)[2][2][4][2], const Unit& u, int wr, int wc, int fr, int fq) const {
        const int cb = (u.pn & 3) * 256 + wc * 32 + 8 * fq;
#pragma unroll
        for (int ai = 0; ai < 2; ++ai)
#pragma unroll
            for (int m = 0; m < 4; ++m) { const int row = u.pm * 256 + ai * 128 + wr * 64 + m * 16 + fr; const float gv = gate[row] * (YE8_SCALE / (W8_SCALE * H8_SCALE)); unsigned char* rp = YE + (size_t)(u.kb ? NSLOTS : 0) * D + (size_t)row * D + cb;
#pragma unroll
                for (int bj = 0; bj < 2; ++bj) { const f32x4 v0 = acc[ai][bj][m][0] * gv, v1 = acc[ai][bj][m][1] * gv; u32x2 w;
                    w.x = pk4_fp8(clamp8(v0[0]), clamp8(v0[1]), clamp8(v0[2]), clamp8(v0[3])); w.y = pk4_fp8(clamp8(v1[0]), clamp8(v1[1]), clamp8(v1[2]), clamp8(v1[3])); *(u32x2*)(rp + bj * 128) = w; } }
    }
};

#if MK_CHECK
__device__ __forceinline__ float fp8f(const unsigned char* p, int i) { const int w = ((const int*)p)[i >> 2]; const int b = i & 3; return b == 0 ? __builtin_amdgcn_cvt_f32_fp8(w, 0) : b == 1 ? __builtin_amdgcn_cvt_f32_fp8(w, 1) : b == 2 ? __builtin_amdgcn_cvt_f32_fp8(w, 2) : __builtin_amdgcn_cvt_f32_fp8(w, 3); }
__device__ __forceinline__ float dot_fp8(const unsigned char* a, const unsigned char* b, int K, int lane) { float s = 0.f; for (int k = lane; k < K; k += 64) s += fp8f(a, k) * fp8f(b, k); return wave_sum(s); }
__device__ __forceinline__ float dot_bf16(const bf16* a, const bf16* b, int K, int lane) {
    float s = 0.f; for (int k = lane; k < K; k += 64) s += bf2f(a[k]) * bf2f(b[k]); return wave_sum(s);
}
#endif

__constant__ double INVF[16] = {1.0, 0.5623413251903491, 0.31622776601683794, 0.1778279410038923, 0.1, 0.05623413251903491, 0.03162277660168379, 0.01778279410038923,
                                0.01, 0.005623413251903491, 0.0031622776601683794, 0.0017782794100389228, 0.001, 0.0005623413251903491, 0.00031622776601683794, 0.00017782794100389227};
__device__ __forceinline__ void sincos_d(double a, float& s, float& c) {
    const double k = __builtin_rint(a * 0.6366197723675814), r = a - k * 1.5707963267948966, r2 = r * r;
    const double sr = r * (1.0 + r2 * (-1.0 / 6 + r2 * (1.0 / 120 + r2 * (-1.0 / 5040 + r2 * (1.0 / 362880 + r2 * (-1.0 / 39916800 + r2 * (1.0 / 6227020800.0)))))));
    const double cr = 1.0 + r2 * (-0.5 + r2 * (1.0 / 24 + r2 * (-1.0 / 720 + r2 * (1.0 / 40320 + r2 * (-1.0 / 3628800 + r2 * (1.0 / 479001600.0))))));
    const int q = ((int)k) & 3;
    const double ss = (q == 0) ? sr : (q == 1) ? cr : (q == 2) ? -sr : -cr;
    const double cc = (q == 0) ? cr : (q == 1) ? -sr : (q == 2) ? -cr : sr;
    s = (float)ss; c = (float)cc;
}
__device__ __forceinline__ void conv_load(f32x4 (&v)[16], const float* W, int N, int k0, int n0, int lane) {
    const int r4 = lane >> 4, c16 = lane & 15, n = n0 + 4 * c16;
    if (n >= N) return;
    const float* src = W + (size_t)(k0 + 16 * r4) * N + n;
#pragma unroll
    for (int i = 0; i < 16; ++i) v[i] = *(const f32x4*)(src + (size_t)i * N);
}
__device__ __forceinline__ void conv_store(const f32x4 (&v)[16], int N, bf16* WT, size_t rowbase, int ldk, int k0, int n0, int lane) {
    const int r4 = lane >> 4, c16 = lane & 15, n = n0 + 4 * c16;
    if (n >= N) return;
    bf16* dst = WT + (rowbase + 4 * c16) * (size_t)ldk + k0 + 16 * r4;
#pragma unroll
    for (int e = 0; e < 4; ++e) {
        u32x4 lo, hi;
        lo.x = cvtpk(v[0][e], v[1][e]); lo.y = cvtpk(v[2][e], v[3][e]); lo.z = cvtpk(v[4][e], v[5][e]); lo.w = cvtpk(v[6][e], v[7][e]);
        hi.x = cvtpk(v[8][e], v[9][e]); hi.y = cvtpk(v[10][e], v[11][e]); hi.z = cvtpk(v[12][e], v[13][e]); hi.w = cvtpk(v[14][e], v[15][e]);
        *(u32x4*)(dst + (size_t)e * ldk) = lo; *(u32x4*)(dst + (size_t)e * ldk + 8) = hi;
    }
}
__device__ __forceinline__ void conv_item(const float* W, int N, bf16* WT, size_t rowbase, int ldk, int k0, int n0, int lane) {
    f32x4 v[16]; conv_load(v, W, N, k0, n0, lane); conv_store(v, N, WT, rowbase, ldk, k0, n0, lane);
}
__device__ __forceinline__ void glds16(const void* gsrc, unsigned lds_dst) { unsigned keep;
    asm volatile("s_mov_b32 %0, m0\n\ts_mov_b32 m0, %2\n\ts_nop 0\n\tglobal_load_lds_dwordx4 %1, off\n\ts_mov_b32 m0, %0" : "=&s"(keep) : "v"(gsrc), "s"(lds_dst) : "memory"); }
__device__ __forceinline__ void glds16_nt(const void* gsrc, unsigned lds_dst) { unsigned keep;
    asm volatile("s_mov_b32 %0, m0\n\ts_mov_b32 m0, %2\n\ts_nop 0\n\tglobal_load_lds_dwordx4 %1, off nt\n\ts_mov_b32 m0, %0" : "=&s"(keep) : "v"(gsrc), "s"(lds_dst) : "memory"); }
__device__ __forceinline__ void conv_issue8(unsigned lds_scr, const float* W, int N, int k0, int n0, int lane) {
    const float* src = W + (size_t)(k0 + 8 * (lane >> 4)) * N + n0 + 4 * (lane & 15);
#pragma unroll
    for (int i = 0; i < 8; ++i) glds16_nt(src + (size_t)i * N, (unsigned)__builtin_amdgcn_readfirstlane(lds_scr + i * 1024));
}
__device__ __forceinline__ void conv_fetch8(f32x4 (&v)[8], const LAS unsigned char* scr, int lane) {
#pragma unroll
    for (int i = 0; i < 8; ++i) v[i] = *(const LAS f32x4*)(scr + i * 1024 + lane * 16);
}
__device__ __forceinline__ void conv_load8(f32x4 (&v)[8], const float* W, int N, int k0, int n0, int lane) {
    const float* src = W + (size_t)(k0 + 8 * (lane >> 4)) * N + n0 + 4 * (lane & 15);
#pragma unroll
    for (int i = 0; i < 8; ++i) v[i] = __builtin_nontemporal_load((const f32x4*)(src + (size_t)i * N));
}
__device__ __forceinline__ void conv_store8(const f32x4 (&v)[8], unsigned char* WT, size_t rowbase, int ldk, int k0, int lane) {
    unsigned char* dst = WT + (rowbase + 4 * (lane & 15)) * (size_t)ldk + k0 + 8 * (lane >> 4);
#pragma unroll
    for (int e = 0; e < 4; ++e) { u32x2 w; w.x = pk4_fp8(v[0][e] * W8_SCALE, v[1][e] * W8_SCALE, v[2][e] * W8_SCALE, v[3][e] * W8_SCALE); w.y = pk4_fp8(v[4][e] * W8_SCALE, v[5][e] * W8_SCALE, v[6][e] * W8_SCALE, v[7][e] * W8_SCALE);
        *(u32x2*)(dst + (size_t)e * ldk) = w; }
}
struct ConvJob { const float* gate; const float* up; const float* down; unsigned char* wgu; unsigned char* wd; };
constexpr int CV_PER_LAYER = 3 * 16 * 1024, CV_TOTAL = 4 * CV_PER_LAYER;
struct ConvItem { const float* W; unsigned char* WT; size_t rowbase; int N, ldk, k0, n0; };
__device__ __forceinline__ ConvItem cv_decode(const ConvJob& J, int it) {
    ConvItem c; const int L = it / CV_PER_LAYER, r0 = it % CV_PER_LAYER, fam = r0 >> 14, r = r0 & 16383, e = L * 16 + (r >> 10), q = r & 1023;
    if (fam < 2) { c.W = (fam ? J.up : J.gate) + (size_t)e * 1024 * 2048; c.N = 2048; c.k0 = (q >> 5) * 32; c.n0 = (q & 31) * 64; c.WT = J.wgu; c.ldk = 1024; c.rowbase = (size_t)e * 4096 + (c.n0 >> 7) * 256 + (c.n0 & 127) + (fam ? 128 : 0); }
    else { c.W = J.down + (size_t)e * 2048 * 1024; c.N = 1024; c.k0 = (q >> 4) * 32; c.n0 = (q & 15) * 64; c.WT = J.wd; c.ldk = 2048; c.rowbase = (size_t)e * 1024 + c.n0; }
    return c;
}
template <class RowBase>
__device__ __forceinline__ void conv_family(const Frame& F, const float* W, int K, int N, int nmat, bf16* WT, const RowBase& rb, int& base) {
    const int nblk = (N + 63) / 64, per = (K / 64) * nblk, total = per * nmat;
    const int gwr = F.G > 192 ? (F.gw + F.NGW - 192 * 8) % F.NGW : F.gw;
    const int first = (gwr + F.NGW - base % F.NGW) % F.NGW; base += total;
    for (int it = first; it < total; it += F.NGW) {
        const int mi = it / per, r = it % per, kb = r / nblk, nb = r % nblk;
        conv_item(W + (size_t)mi * K * N, N, WT, rb(mi, nb * 64), K, kb * 64, nb * 64, F.lane);
    }
}

__device__ __forceinline__ void ada_direct(const Frame& F, const Args& a, int l, int b0) {
    const int cg = F.bid - b0; if (cg < 0 || cg >= 192) return;
    LAS float* sc = (LAS float*)F.lds;
    LAS float* red = (LAS float*)(F.lds + 20480);
    for (int i = F.tid; i < 5 * D; i += 512) { const int c = i >> 10, k = i & 1023; const float x = (c == 0) ? a.in[7][k] : a.in[6][(c - 1) * D + k]; sc[i] = x / (1.f + __expf(-x)); }
    __syncthreads();
    const int col = F.tid & 31, kg = F.tid >> 5, n = cg * 32 + col;
    const float* w = a.in[8] + ((size_t)l * D + kg * 64) * 6144 + n;
    float acc[5] = {0.f, 0.f, 0.f, 0.f, 0.f};
#pragma unroll 16
    for (int k = 0; k < 64; ++k) { const float wv = w[(size_t)k * 6144];
#pragma unroll
        for (int c = 0; c < 5; ++c) acc[c] += sc[c * D + kg * 64 + k] * wv; }
#pragma unroll
    for (int c = 0; c < 5; ++c) red[(kg * 5 + c) * 32 + col] = acc[c];
    __syncthreads();
    if (F.tid < 160) { const int c = F.tid >> 5; float s = a.in[9][l * 6144 + n];
#pragma unroll
        for (int g = 0; g < 16; ++g) s += red[(g * 5 + c) * 32 + col];
        ((float*)(F.ws + WS_ADA))[(size_t)(l * 5 + c) * 6144 + n] = s; }
    __syncthreads();
}
__device__ __forceinline__ void phase_prologue(const Frame& F, const Args& a) {
    ada_direct(F, a, 0, 0);
    {
        float* R64 = (float*)(F.ws + WS_ROPE64); float* R32 = (float*)(F.ws + WS_ROPE32);
        for (int i = F.bid * 512 + F.tid; i < 2048 * 32; i += F.G * 512) { const int pos = i >> 5, j = i & 31; const double ang = (j < 16) ? (double)(pos >> 6) * INVF[j] : (double)(pos & 63) * INVF[j - 16];
            float s, c; sincos_d(ang, s, c); R64[i] = c; R64[2048 * 32 + i] = s; }
        for (int i = F.bid * 512 + F.tid; i < 2048 * 16; i += F.G * 512) { const int pos = i >> 4, j = i & 15; const double ang = (j < 8) ? (double)(pos >> 6) * INVF[2 * j] : (double)(pos & 63) * INVF[2 * (j - 8)];
            float s, c; sincos_d(ang, s, c); R32[i] = c; R32[2048 * 16 + i] = s; }
    }
    __syncthreads();
    for (int rep = 0; rep < MK_REP_CONV; ++rep) {
    bf16* WQKV = (bf16*)(F.ws + WS_WQKV); bf16* WO = (bf16*)(F.ws + WS_WO);
    int cvb = 0;
    conv_family(F, a.in[12], 1024, 1536, 2, WQKV, [](int mi, int n0) { return (size_t)(mi == 0 ? 0 : 2) * 1536 + n0; }, cvb);
    conv_family(F, a.in[16], 1024, 1536, 1, WQKV, [](int mi, int n0) { return (size_t)1536 + n0; }, cvb);
    conv_family(F, a.in[15], 1024, 1024, 2, WO, [](int mi, int n0) { return (size_t)(mi == 0 ? 0 : 3) * 1024 + n0; }, cvb);
    conv_family(F, a.in[18], 1024, 1024, 1, WO, [](int mi, int n0) { return (size_t)1024 + n0; }, cvb);
    conv_family(F, a.in[24], 1024, 1024, 1, WO, [](int mi, int n0) { return (size_t)2048 + n0; }, cvb);
    conv_family(F, a.in[19], 1024, 416, 1, (bf16*)(F.ws + WS_WDN), [](int mi, int n0) { return (size_t)n0; }, cvb);
    conv_family(F, a.in[21], 256, 1536, 1, (bf16*)(F.ws + WS_WUQ), [](int mi, int n0) { return (size_t)n0; }, cvb);
    conv_family(F, a.in[23], 128, 2048, 1, (bf16*)(F.ws + WS_WUKV), [](int mi, int n0) { return (size_t)n0; }, cvb);
    }
    { u32x4* z = (u32x4*)((bf16*)(F.ws + WS_WDN) + 416 * 1024); for (int i = F.bid * 512 + F.tid; i < 96 * 1024 / 8; i += F.G * 512) z[i] = (u32x4){0u, 0u, 0u, 0u}; }
}
__device__ __forceinline__ void phase_ada_reduce(const Frame& F, const Args& a) {
    const float* ADAP = (const float*)(F.ws + WS_ADAP); float* ADA = (float*)(F.ws + WS_ADA);
    for (int i = F.bid * 512 + F.tid; i < 4 * 5 * 6144; i += F.G * 512) {
        const int l = i / 30720, r = i % 30720, c = r / 6144, n = r % 6144;
        float s = a.in[9][l * 6144 + n];
        for (int kc = 0; kc < 16; ++kc) s += ADAP[((size_t)(kc * 4 + l) * 5 + c) * 6144 + n];
        ADA[i] = s;
    }
}
__device__ __forceinline__ const float* ada_vec(const Frame& F, int l, int c, int k) { return (const float*)(F.ws + WS_ADA) + ((size_t)(l * 5 + c) * 6 + k) * D; }

__device__ __forceinline__ void phase_mod0(const Frame& F, const Args& a) {
    bf16* X = (bf16*)(F.ws + WS_X); bf16* H = (bf16*)(F.ws + WS_H);
    const int RPW = (NTOK + F.NGW - 1) / F.NGW, rbeg = F.gw * RPW, rend = (rbeg + RPW < NTOK) ? rbeg + RPW : NTOK; int ccur = -1;
    f32x4 shv[4], scv[4];
#pragma unroll
    for (int j = 0; j < 4; ++j) { shv[j] = (f32x4){0.f, 0.f, 0.f, 0.f}; scv[j] = shv[j]; }
    for (int row = rbeg; row < rend; ++row) {
        const int c = cond_of(row);
        if (c != ccur) { ccur = c; const f32x4* sh = (const f32x4*)ada_vec(F, 0, c, 0); const f32x4* sc = (const f32x4*)ada_vec(F, 0, c, 1);
#pragma unroll
            for (int j = 0; j < 4; ++j) { shv[j] = sh[F.lane + 64 * j]; scv[j] = sc[F.lane + 64 * j] + 1.f; } }
        const f32x4* xi = (const f32x4*)((row < NCTX) ? a.in[0] + (size_t)row * D : a.in[1] + (size_t)(row - NCTX) * D);
#pragma unroll
        for (int j = 0; j < 4; ++j) { const int q = F.lane + 64 * j; const f32x4 x = xi[q]; ((u32x2*)(X + (size_t)row * D))[q] = pk4(x); ((u32x2*)(H + (size_t)row * D))[q] = pk4(x * scv[j] + shv[j]); }
    }
}

__device__ __forceinline__ size_t kb_off(int HK, int DK, bool lat, int b, int hk) { return lat ? (size_t)16 * HK * 256 * DK + ((size_t)(b * HK + hk) * 2560) * DK : ((size_t)(b * HK + hk) * 256) * DK; }
__device__ __forceinline__ size_t vt_off(int HK, bool lat, int b, int hk) { return lat ? (size_t)16 * HK * 64 * 256 + ((size_t)(b * HK + hk) * 64) * 2560 : ((size_t)(b * HK + hk) * 64) * 256; }
__device__ __forceinline__ int swap23(int k) { return (k & ~12) | ((k & 4) << 1) | ((k & 8) >> 1); }
__device__ __forceinline__ void vt_store(bf16* dst, const float (&vr)[64]) {
#pragma unroll
    for (int q = 0; q < 8; ++q) { const int b = 16 * (q >> 1) + 4 * (q & 1); u32x4 w; w.x = cvtpk(vr[b], vr[b + 1]); w.y = cvtpk(vr[b + 2], vr[b + 3]); w.z = cvtpk(vr[b + 8], vr[b + 9]); w.w = cvtpk(vr[b + 10], vr[b + 11]); ((u32x4*)dst)[q] = w; }
}

__device__ __forceinline__ void phase_kv_post(const Frame& F, const Args& a, int kind, int j, int slot, int gw, int NGW) {
    const bf16* QKV = (const bf16*)(F.ws + WS_QKV); bf16* Kb = (bf16*)(F.ws + WS_KB); bf16* Vt = (bf16*)(F.ws + WS_VT);
    const float* R64 = (const float*)(F.ws + WS_ROPE64);
    int lane_ = F.lane; asm volatile("" : "+v"(lane_)); const int lane = lane_, l16 = lane & 15, hk = lane >> 4;
    for (int it = gw * 64 + lane; it < 16 * 8192; it += NGW * 64) {
        const int bh = it >> 13, q = it & 8191, b = bh >> 2, hc = bh & 3;
        const f32x4 v = *(const f32x4*)(a.in[2] + ((size_t)((b * 3 + slot) * 4 + hc) * 512) * 64 + 4 * q);
        u32x2 w; w.x = cvtpk(v[0], v[1]); w.y = cvtpk(v[2], v[3]);
        *(u32x2*)(Kb + kb_off(4, 64, true, b, hc) + (size_t)2048 * 64 + 4 * q) = w;
    }
    for (int it = gw; it < 4 * 4 * 8; it += NGW) {
        const int b = it >> 5, hv = (it >> 3) & 3, tl = it & 7;
        float vr[64];
#pragma unroll
        for (int i = 0; i < 64; ++i) vr[i] = a.in[3][((size_t)((b * 3 + slot) * 4 + hv) * 512 + tl * 64 + i) * 64 + lane];
        vt_store(Vt + vt_off(4, true, b, hv) + (size_t)lane * 2560 + 2048 + tl * 64, vr);
    }
    f32x4 kn = (f32x4){1.f, 1.f, 1.f, 1.f}; if (kind == 0) kn = *(const f32x4*)(a.in[14] + j * 64 + 4 * l16);
    {
        const int RPW = (NTOK + NGW - 1) / NGW, rbeg = gw * RPW, rend = (rbeg + RPW < NTOK) ? rbeg + RPW : NTOK;
        u32x2 wqn = (u32x2){0u, 0u}; f32x4 cn = (f32x4){0.f, 0.f, 0.f, 0.f}, snn = cn;
        if (rbeg < rend) { wqn = *(const u32x2*)(QKV + (size_t)rbeg * 1536 + 1024 + 4 * lane);
            if (rbeg >= NCTX) { const int s0 = (rbeg - NCTX) & 2047; cn = *(const f32x4*)(R64 + s0 * 32 + 4 * (lane & 7)); snn = *(const f32x4*)(R64 + 2048 * 32 + s0 * 32 + 4 * (lane & 7)); } }
        for (int t = rbeg; t < rend; ++t) {
            const bool lat = t >= NCTX; const int b = lat ? (t - NCTX) >> 11 : t >> 8, s = lat ? (t - NCTX) & 2047 : t & 255;
            const u32x2 wq = wqn; const f32x4 c = cn, sn = snn;
            if (t + 1 < rend) { wqn = *(const u32x2*)(QKV + (size_t)(t + 1) * 1536 + 1024 + 4 * lane);
                if (t + 1 >= NCTX) { const int s1 = (t + 1 - NCTX) & 2047; cn = *(const f32x4*)(R64 + s1 * 32 + 4 * (lane & 7)); snn = *(const f32x4*)(R64 + 2048 * 32 + s1 * 32 + 4 * (lane & 7)); } }
            f32x4 v = bf4(wq);
            if (kind == 0) { float ss = (v[0] * v[0] + v[1] * v[1]) + (v[2] * v[2] + v[3] * v[3]); ss = sum16(ss);
                v = v * (__builtin_amdgcn_rsqf(ss * (1.f / 64.f) + 1e-6f)) * kn; }
            if (lat) { f32x4 p; p[0] = dppf<DPP_X8>(v[0]); p[1] = dppf<DPP_X8>(v[1]); p[2] = dppf<DPP_X8>(v[2]); p[3] = dppf<DPP_X8>(v[3]);
                v = (lane & 8) ? v * c + p * sn : v * c - p * sn; }
            *(u32x2*)(Kb + kb_off(4, 64, lat, b, hk) + (size_t)s * 64 + 4 * l16) = pk4(v);
            if (!lat) *(f32x4*)(F.out + OFF_NK + ((size_t)((b * 3 + slot) * 4 + hk) * 256 + s) * 64 + 4 * l16) = v;
        }
    }
    for (int it = gw; it < (NTOK / 64) * 4; it += NGW) {
        const int tt = it >> 2, hv = it & 3, t0 = tt * 64; const bool lat = t0 >= NCTX; const int b = lat ? (t0 - NCTX) >> 11 : t0 >> 8, s0 = lat ? (t0 - NCTX) & 2047 : t0 & 255;
        float vr[64];
#pragma unroll
        for (int i = 0; i < 64; ++i) vr[i] = bf2f(QKV[(size_t)(t0 + i) * 1536 + 1280 + hv * 64 + lane]);
        vt_store(Vt + vt_off(4, lat, b, hv) + (size_t)lane * (lat ? 2560 : 256) + s0, vr);
        if (!lat) {
#pragma unroll
            for (int i = 0; i < 64; ++i) F.out[OFF_NV + ((size_t)((b * 3 + slot) * 4 + hv) * 256 + s0 + i) * 64 + lane] = vr[i]; }
    }
}

__device__ __forceinline__ void phase_mla_post1(const Frame& F, const Args& a) {
    const float* DWN = (const float*)(F.ws + WS_QKV); bf16* QA = (bf16*)(F.ws + WS_QA); bf16* CKVA = (bf16*)(F.ws + WS_CKVA); bf16* Kb = (bf16*)(F.ws + WS_KB);
    const float* R32 = (const float*)(F.ws + WS_ROPE32);
    int lane_ = F.lane; asm volatile("" : "+v"(lane_)); const int lane = lane_;
    const f32x4 qn = ((const f32x4*)a.in[20])[lane]; const f32x4 kvn = ((const f32x4*)a.in[22])[lane & 31];
    for (int t = F.gw; t < NTOK + 2048; t += F.NGW) {
        if (t < NTOK) {
            const bool lat = t >= NCTX; const int b = lat ? (t - NCTX) >> 11 : t >> 8, s = lat ? (t - NCTX) & 2047 : t & 255;
            const float* row = DWN + (size_t)t * 512;
            { const f32x4 v = ((const f32x4*)row)[lane] + ((const f32x4*)(row + DWN_PART))[lane]; const float ss = wave_sum(v[0] * v[0] + v[1] * v[1] + v[2] * v[2] + v[3] * v[3]); const float r = __builtin_amdgcn_rsqf(ss * (1.f / 256.f) + 1e-6f);
              const f32x4 o = v * r * qn; u32x2 w; w.x = cvtpk(o[0], o[1]); w.y = cvtpk(o[2], o[3]); ((u32x2*)(QA + (size_t)t * 256))[lane] = w; }
            { f32x4 v = (f32x4){0.f, 0.f, 0.f, 0.f}; if (lane < 32) v = ((const f32x4*)(row + 256))[lane] + ((const f32x4*)(row + DWN_PART + 256))[lane];
              const float ss = wave_sum(v[0] * v[0] + v[1] * v[1] + v[2] * v[2] + v[3] * v[3]); const float r = __builtin_amdgcn_rsqf(ss * (1.f / 128.f) + 1e-6f);
              const f32x4 o = v * r * kvn;
              if (lane < 32) { u32x2 w; w.x = cvtpk(o[0], o[1]); w.y = cvtpk(o[2], o[3]); ((u32x2*)(CKVA + (size_t)t * 128))[lane] = w; if (!lat) ((f32x4*)(F.out + OFF_CKV + (size_t)t * 128))[lane] = o; } }
            { float x = (lane < 32) ? row[384 + lane] + row[DWN_PART + 384 + lane] : 0.f;
              if (!lat && lane < 32) F.out[OFF_KPE + (size_t)t * 32 + lane] = x;
              if (lat) { const float p = __shfl_xor(x, 16); const int i = lane & 15; const float c = R32[s * 16 + i], sn = R32[2048 * 16 + s * 16 + i]; x = ((lane & 31) < 16) ? x * c - p * sn : x * c + p * sn; }
              const bf16 xb = f2bf(x);
              if (lane < 32) { for (int h = 0; h < 16; ++h) Kb[kb_off(16, 96, lat, b, h) + (size_t)s * 96 + 64 + lane] = xb; } }
        } else {
            const int r = t - NTOK, b = r >> 9, s = r & 511;
            if (lane < 32) { const f32x4 v = ((const f32x4*)(a.in[4] + (size_t)r * 128))[lane]; u32x2 w; w.x = cvtpk(v[0], v[1]); w.y = cvtpk(v[2], v[3]); ((u32x2*)(CKVA + (size_t)t * 128))[lane] = w;
                const bf16 xb = f2bf(a.in[5][(size_t)r * 32 + lane]);
                for (int h = 0; h < 16; ++h) Kb[kb_off(16, 96, true, b, h) + (size_t)(2048 + s) * 96 + 64 + lane] = xb; }
        }
    }
}
__device__ __forceinline__ void mla_row(int row, bool& lat, int& b, int& s) {
    if (row < NCTX) { lat = false; b = row >> 8; s = row & 255; } else if (row < NTOK) { lat = true; b = (row - NCTX) >> 11; s = (row - NCTX) & 2047; } else { lat = true; b = (row - NTOK) >> 9; s = 2048 + ((row - NTOK) & 511); }
}
struct EpiUkv { bf16* Kb; bf16* VRAW; static constexpr bool PERM = false, AFTER_DRAIN = false;
    __device__ __forceinline__ void operator()(const f32x4 (&acc)[2][2][4][2], const Unit& u, int wr, int wc, int fr, int fq) const {
#pragma unroll
        for (int ai = 0; ai < 2; ++ai)
#pragma unroll
            for (int m = 0; m < 4; ++m) { const int row = u.pm * 256 + ai * 128 + wr * 64 + m * 16 + fr; bool lat; int b, s; mla_row(row, lat, b, s);
#pragma unroll
                for (int bj = 0; bj < 2; ++bj) { const int h = 2 * u.pn + bj;
                    if (wc < 2) { bf16* kp = Kb + kb_off(16, 96, lat, b, h) + (size_t)s * 96 + wc * 32 + 4 * fq;
#pragma unroll
                        for (int n = 0; n < 2; ++n) { const f32x4 v = acc[ai][bj][m][n]; u32x2 w; w.x = cvtpk(v[0], v[1]); w.y = cvtpk(v[2], v[3]); *(u32x2*)(kp + n * 16) = w; } }
                    else { bf16* vp = VRAW + (size_t)row * 1024 + h * 64 + (wc - 2) * 32 + 4 * fq;
#pragma unroll
                        for (int n = 0; n < 2; ++n) { const f32x4 v = acc[ai][bj][m][n]; u32x2 w; w.x = cvtpk(v[0], v[1]); w.y = cvtpk(v[2], v[3]); *(u32x2*)(vp + n * 16) = w; } } } }
    }
};
__device__ __forceinline__ void phase_mla_post2(const Frame& F, const Args& a) {
    const bf16* VRAW = (const bf16*)(F.ws + WS_KVRAW); bf16* Vt = (bf16*)(F.ws + WS_VT);
    int lane_ = F.lane; asm volatile("" : "+v"(lane_)); const int lane = lane_;
    for (int it = F.gw; it < 224 * 16; it += F.NGW) {
        const int tile = it >> 4, h = it & 15, row0 = tile * 64; bool lat; int b, s0; mla_row(row0, lat, b, s0);
        float vr[64];
#pragma unroll
        for (int i = 0; i < 64; ++i) vr[i] = bf2f(VRAW[(size_t)(row0 + i) * 1024 + h * 64 + lane]);
        vt_store(Vt + vt_off(16, lat, b, h) + (size_t)lane * (lat ? 2560 : 256) + s0, vr);
    }
}

__device__ __forceinline__ int crow(int r, int hi) { return (r & 3) + 8 * (r >> 2) + 4 * hi; }
__device__ __forceinline__ float max3f(float a, float b, float c) { float r; asm("v_max3_f32 %0, %1, %2, %3" : "=v"(r) : "v"(a), "v"(b), "v"(c)); return r; }
constexpr float THRL = 5.f;
template <int DK, int KIND>
__device__ __forceinline__ void attn_phase(const Frame& F, const Args& a, int j, const ConvJob& J, int& cv_it, int cv_need, int cv_cap) {
    constexpr int HK = (DK == 96) ? 16 : 4, CH = (DK == 96) ? 64 : 128, KPB = (DK + 8) * 2, VPB = (CH + 8) * 2, NDS = DK / 16, KCH = DK / 8;
    constexpr int NKC = CH * KCH, NKI = (NKC + 511) / 512, NVI = 64 * (CH / 8) / 512, NSUB = CH / 64;
    constexpr float QS = (DK == 96) ? MLA_QS : GQA_QS;
    const bf16* QRAW = (const bf16*)(F.ws + WS_QKV); const bf16* Kb = (const bf16*)(F.ws + WS_KB); const bf16* Vt = (const bf16*)(F.ws + WS_VT); bf16* O = (bf16*)(F.ws + WS_O);
    LAS unsigned char* Ks = F.lds; LAS unsigned char* Vs = F.lds + 2 * CH * KPB;
    LAS unsigned char* cvs = F.lds + 2 * CH * KPB + 2 * 64 * VPB + F.wave * 8192;
    const unsigned cvs_addr = (unsigned)(uintptr_t)cvs;
    int tid_ = F.tid; asm volatile("" : "+v"(tid_));
    const int tid = tid_, lane = tid & 63, wid = F.wave, r32 = lane & 31, hi = lane >> 5;
    constexpr bool CVP = true;
    int itc = 0;
    for (int un = F.bid; un < 768; un += F.G) {
        bool lat; int b, hq, q0, S, tok0;
        if (un < 512) { lat = true; b = un >> 7; hq = (un >> 3) & 15; q0 = (un & 7) * 256; S = 2560; tok0 = NCTX + b * 2048 + q0; }
        else { const int v = un - 512; lat = false; b = v >> 4; hq = v & 15; q0 = 0; S = 256; tok0 = b * 256; }
        const int hk = (HK == 4) ? (hq >> 2) : hq;
        const bf16* Kg = Kb + kb_off(HK, DK, lat, b, hk); const bf16* Vg = Vt + vt_off(HK, lat, b, hk);
        const int n2 = lat ? 512 / CH : 0; int lo = 0, hiK = lat ? 2048 : 256;
        const bool masked = (KIND == 1) && lat;
        if (masked) { lo = q0 - 128; lo = lo < 0 ? 0 : (lo > 1536 ? 1536 : lo); hiK = lo + 512; }
        const int nch = n2 + (hiK - lo) / CH;
        bf16x8 qf[NDS];
        {
            const bf16* qrow = QRAW + (size_t)(tok0 + wid * 32 + r32) * 1536 + hq * DK + 8 * hi;
            f32x4 v[NDS][2];
#pragma unroll
            for (int ds = 0; ds < NDS; ++ds) { const u32x4 wq = *(const u32x4*)(qrow + 16 * ds);
                v[ds][0] = (f32x4){__uint_as_float(wq.x << 16), __uint_as_float(wq.x & 0xffff0000u), __uint_as_float(wq.y << 16), __uint_as_float(wq.y & 0xffff0000u)};
                v[ds][1] = (f32x4){__uint_as_float(wq.z << 16), __uint_as_float(wq.z & 0xffff0000u), __uint_as_float(wq.w << 16), __uint_as_float(wq.w & 0xffff0000u)}; }
            if (KIND == 0) {
                float ss = 0.f;
#pragma unroll
                for (int ds = 0; ds < NDS; ++ds)
#pragma unroll
                    for (int h2 = 0; h2 < 2; ++h2) ss += (v[ds][h2][0] * v[ds][h2][0] + v[ds][h2][1] * v[ds][h2][1]) + (v[ds][h2][2] * v[ds][h2][2] + v[ds][h2][3] * v[ds][h2][3]);
                ss += __shfl_xor(ss, 32);
                const float r = __builtin_amdgcn_rsqf(ss * (1.f / 64.f) + 1e-6f);
                const float* qn = a.in[13] + j * 64 + 8 * hi;
#pragma unroll
                for (int ds = 0; ds < NDS; ++ds) { v[ds][0] = v[ds][0] * r * *(const f32x4*)(qn + 16 * ds); v[ds][1] = v[ds][1] * r * *(const f32x4*)(qn + 16 * ds + 4); }
            }
            if (lat) {
                const int s = q0 + wid * 32 + r32;
                if (DK == 64) {
                    const float* R64 = (const float*)(F.ws + WS_ROPE64);
#pragma unroll
                    for (int ds = 0; ds < 2; ++ds)
#pragma unroll
                        for (int h2 = 0; h2 < 2; ++h2) { const int idx = s * 32 + 16 * ds + 8 * hi + 4 * h2; const f32x4 c = *(const f32x4*)(R64 + idx), sn = *(const f32x4*)(R64 + 2048 * 32 + idx);
                            const f32x4 xa = v[ds][h2], xb = v[ds + 2][h2]; v[ds][h2] = xa * c - xb * sn; v[ds + 2][h2] = xb * c + xa * sn; }
                } else {
                    const float* R32 = (const float*)(F.ws + WS_ROPE32);
#pragma unroll
                    for (int h2 = 0; h2 < 2; ++h2) { const int idx = s * 16 + 8 * hi + 4 * h2; const f32x4 c = *(const f32x4*)(R32 + idx), sn = *(const f32x4*)(R32 + 2048 * 16 + idx);
                        const f32x4 xa = v[NDS - 2][h2], xb = v[NDS - 1][h2]; v[NDS - 2][h2] = xa * c - xb * sn; v[NDS - 1][h2] = xb * c + xa * sn; }
                }
            }
#pragma unroll
            for (int ds = 0; ds < NDS; ++ds) { u32x4 w; w.x = cvtpk(v[ds][0][0] * QS, v[ds][0][1] * QS); w.y = cvtpk(v[ds][0][2] * QS, v[ds][0][3] * QS); w.z = cvtpk(v[ds][1][0] * QS, v[ds][1][1] * QS); w.w = cvtpk(v[ds][1][2] * QS, v[ds][1][3] * QS);
                qf[ds] = __builtin_bit_cast(bf16x8, w); }
        }
        const int qw0 = q0 + wid * 32, qpos = qw0 + r32;
        float mhat = 0.f, l_run = 0.f; bool first = true; f32x16 o0, o1, negm;
#pragma unroll
        for (int r = 0; r < 16; ++r) { o0[r] = 0.f; o1[r] = 0.f; negm[r] = 0.f; }
        u32x4 kreg[NKI], vreg[NVI];
#define ATT_KEY0(c) ((c) < n2 ? 2048 + CH * (c) : lo + CH * ((c) - n2))
#define ATT_LOAD(c) do { const int k0_ = ATT_KEY0(c); \
            _Pragma("unroll") for (int i_ = 0; i_ < NKI; ++i_) { const int cc_ = tid + 512 * i_; if (NKC % 512 == 0 || cc_ < NKC) kreg[i_] = *(const u32x4*)(Kg + (size_t)(k0_ + cc_ / KCH) * DK + (cc_ % KCH) * 8); } \
            _Pragma("unroll") for (int i_ = 0; i_ < NVI; ++i_) { const int cc_ = tid + 512 * i_; vreg[i_] = *(const u32x4*)(Vg + (size_t)(cc_ / (CH / 8)) * S + k0_ + (cc_ % (CH / 8)) * 8); } } while (0)
#define ATT_STORE(buf) do { \
            _Pragma("unroll") for (int i_ = 0; i_ < NKI; ++i_) { const int cc_ = tid + 512 * i_; if (NKC % 512 == 0 || cc_ < NKC) *(LAS u32x4*)(Ks + (buf) * CH * KPB + (cc_ / KCH) * KPB + (cc_ % KCH) * 16) = kreg[i_]; } \
            _Pragma("unroll") for (int i_ = 0; i_ < NVI; ++i_) { const int cc_ = tid + 512 * i_; *(LAS u32x4*)(Vs + (buf) * 64 * VPB + (cc_ / (CH / 8)) * VPB + (cc_ % (CH / 8)) * 16) = vreg[i_]; } } while (0)
        ATT_LOAD(0);
        __syncthreads();
        ATT_STORE(0);
        __syncthreads();
        for (int c = 0; c < nch; ++c) {
            const int cur = c & 1;
            if (c + 1 < nch) ATT_LOAD(c + 1);
            const bool cv = CVP && ((CH == 128) || ((itc++ & 1) == 0)) && cv_it < cv_cap;
            if (cv) { const ConvItem ci = cv_decode(J, cv_it); conv_issue8(cvs_addr, ci.W, ci.N, ci.k0, ci.n0, lane); }
            const int key0c = ATT_KEY0(c);
            for (int sub = 0; sub < NSUB; ++sub) {
                const int key0 = key0c + 64 * sub;
                if (masked && c >= n2 && (key0 > qw0 + 159 || key0 + 63 < qw0 - 128)) continue;
                f32x16 p0, p1;
                const LAS unsigned char* kb_ = Ks + cur * CH * KPB + (sub * 64 + r32) * KPB + hi * 16;
                const LAS unsigned char* vb_ = Vs + cur * 64 * VPB + r32 * VPB + sub * 128 + hi * 16;
                bf16x8 kf[2 * NDS], vf[8];
#pragma unroll
                for (int ds = 0; ds < NDS; ++ds) { kf[2 * ds] = *(const LAS bf16x8*)(kb_ + ds * 32); kf[2 * ds + 1] = *(const LAS bf16x8*)(kb_ + 32 * KPB + ds * 32); }
#pragma unroll
                for (int s = 0; s < 4; ++s) { vf[2 * s] = *(const LAS bf16x8*)(vb_ + s * 32); vf[2 * s + 1] = *(const LAS bf16x8*)(vb_ + 32 * VPB + s * 32); }
                __builtin_amdgcn_sched_barrier(0);
#pragma unroll
                for (int ds = 0; ds < NDS; ++ds) {
                    if (ds == 0) { p0 = __builtin_amdgcn_mfma_f32_32x32x16_bf16(kf[0], qf[0], negm, 0, 0, 0); p1 = __builtin_amdgcn_mfma_f32_32x32x16_bf16(kf[1], qf[0], negm, 0, 0, 0); }
                    else { p0 = __builtin_amdgcn_mfma_f32_32x32x16_bf16(kf[2 * ds], qf[ds], p0, 0, 0, 0); p1 = __builtin_amdgcn_mfma_f32_32x32x16_bf16(kf[2 * ds + 1], qf[ds], p1, 0, 0, 0); }
                }
                if (masked && c >= n2) {
                    const int kbase = key0 - qpos;
#pragma unroll
                    for (int r = 0; r < 16; ++r) { const int d0 = kbase + crow(r, hi), d1 = d0 + 32;
                        if (d0 > 128 || d0 < -128) p0[r] = -INFINITY;
                        if (d1 > 128 || d1 < -128) p1[r] = -INFINITY; }
                }
                float rm;
                { float ma = max3f(p0[0], p0[1], p1[0]), mb = max3f(p0[2], p0[3], p1[1]); ma = max3f(ma, p1[2], p1[3]);
#pragma unroll
                  for (int r = 4; r < 16; r += 4) { ma = max3f(ma, p0[r], p0[r + 1]); mb = max3f(mb, p0[r + 2], p0[r + 3]); ma = max3f(ma, p1[r], p1[r + 1]); mb = max3f(mb, p1[r + 2], p1[r + 3]); }
                  const float m2 = max3f(ma, mb, mb);
                  auto rr = __builtin_amdgcn_permlane32_swap(__float_as_uint(m2), __float_as_uint(m2), false, false);
                  rm = max3f(__uint_as_float(rr[0]), __uint_as_float(rr[1]), m2); }
                if (first || __any(rm > THRL)) {
                    const float dl = first ? rm : fmaxf(rm, 0.f);
                    mhat += dl;
#pragma unroll
                    for (int r = 0; r < 16; ++r) { p0[r] -= dl; p1[r] -= dl; }
                    if (!first) { const float sc = __builtin_amdgcn_exp2f(-dl); l_run *= sc;
#pragma unroll
                        for (int r = 0; r < 16; ++r) { o0[r] *= sc; o1[r] *= sc; } }
#pragma unroll
                    for (int r = 0; r < 16; ++r) negm[r] = -mhat;
                    first = false;
                }
                float ls0 = 0.f, ls1 = 0.f;
#pragma unroll
                for (int r = 0; r < 16; ++r) { p0[r] = __builtin_amdgcn_exp2f(p0[r]); p1[r] = __builtin_amdgcn_exp2f(p1[r]); ls0 += p0[r]; ls1 += p1[r]; }
                l_run += ls0 + ls1;
                bf16x8 pb[4];
#pragma unroll
                for (int s = 0; s < 4; ++s) { u32x4 w;
                    if (s < 2) { w.x = cvtpk(p0[8 * s], p0[8 * s + 1]); w.y = cvtpk(p0[8 * s + 2], p0[8 * s + 3]); w.z = cvtpk(p0[8 * s + 4], p0[8 * s + 5]); w.w = cvtpk(p0[8 * s + 6], p0[8 * s + 7]); }
                    else { const int q = s - 2; w.x = cvtpk(p1[8 * q], p1[8 * q + 1]); w.y = cvtpk(p1[8 * q + 2], p1[8 * q + 3]); w.z = cvtpk(p1[8 * q + 4], p1[8 * q + 5]); w.w = cvtpk(p1[8 * q + 6], p1[8 * q + 7]); }
                    pb[s] = __builtin_bit_cast(bf16x8, w); }
#pragma unroll
                for (int s = 0; s < 4; ++s) {
                    o0 = __builtin_amdgcn_mfma_f32_32x32x16_bf16(vf[2 * s], pb[s], o0, 0, 0, 0);
                    o1 = __builtin_amdgcn_mfma_f32_32x32x16_bf16(vf[2 * s + 1], pb[s], o1, 0, 0, 0);
                }
            }
            if (c + 1 < nch) ATT_STORE(cur ^ 1);
            if (cv) { asm volatile("s_waitcnt vmcnt(0)" ::: "memory"); f32x4 cvv[8]; conv_fetch8(cvv, cvs, lane); const ConvItem ci = cv_decode(J, cv_it); conv_store8(cvv, ci.WT, ci.rowbase, ci.ldk, ci.k0, lane); cv_it += F.NGW; }
            __syncthreads();
        }
#undef ATT_KEY0
#undef ATT_LOAD
#undef ATT_STORE
        float l = l_run + __shfl_xor(l_run, 32);
        if (KIND == 1) l += __builtin_amdgcn_exp2f(a.in[17][hq] * LOG2E - mhat);
        const float inv = 1.f / l;
        bf16* op = O + (size_t)(tok0 + wid * 32 + r32) * 1024 + hq * 64 + 4 * hi;
#pragma unroll
        for (int g = 0; g < 4; ++g) {
            u32x2 w0, w1; w0.x = cvtpk(o0[4 * g] * inv, o0[4 * g + 1] * inv); w0.y = cvtpk(o0[4 * g + 2] * inv, o0[4 * g + 3] * inv);
            w1.x = cvtpk(o1[4 * g] * inv, o1[4 * g + 1] * inv); w1.y = cvtpk(o1[4 * g + 2] * inv, o1[4 * g + 3] * inv);
            *(u32x2*)(op + 8 * g) = w0; *(u32x2*)(op + 32 + 8 * g) = w1;
        }
    }
    for (; cv_it < cv_need; cv_it += 2 * F.NGW) {
        f32x4 v0[8], v1[8]; const ConvItem c0 = cv_decode(J, cv_it); conv_load8(v0, c0.W, c0.N, c0.k0, c0.n0, lane);
        const bool two = cv_it + F.NGW < CV_TOTAL; ConvItem c1 = c0; if (two) { c1 = cv_decode(J, cv_it + F.NGW); conv_load8(v1, c1.W, c1.N, c1.k0, c1.n0, lane); }
        conv_store8(v0, c0.WT, c0.rowbase, c0.ldk, c0.k0, lane); if (two) conv_store8(v1, c1.WT, c1.rowbase, c1.ldk, c1.k0, lane); }
}
#if MK_CHECK
template <int DK, int KIND>
__device__ __forceinline__ void check_attn(const Frame& F, const Args& a, int j, int id) {
    constexpr int HK = (DK == 96) ? 16 : 4; constexpr float QS = (DK == 96) ? MLA_QS : GQA_QS;
    const bf16* QRAW = (const bf16*)(F.ws + WS_QKV); const bf16* Kb = (const bf16*)(F.ws + WS_KB); const bf16* Vt = (const bf16*)(F.ws + WS_VT); const bf16* O = (const bf16*)(F.ws + WS_O);
    LAS float* scs = (LAS float*)(F.lds + F.wave * 12288); LAS float* qs = scs + 2560;
    const int lane = F.lane;
    const unsigned hsh = hash_u(F.gw * 2654435761u + id);
    const int t = (F.gw & 1) ? (hsh % NCTX) : NCTX + (hsh % NLAT), hq = (hsh >> 16) & 15;
    const bool lat = t >= NCTX; const int b = lat ? (t - NCTX) >> 11 : t >> 8, s = lat ? (t - NCTX) & 2047 : t & 255, S = lat ? 2560 : 256;
    const int hk = (HK == 4) ? (hq >> 2) : hq;
    const bf16* Kg = Kb + kb_off(HK, DK, lat, b, hk); const bf16* Vg = Vt + vt_off(HK, lat, b, hk); const bf16* q = QRAW + (size_t)t * 1536 + hq * DK;
    {
        float x = bf2f(q[lane]);
        if (KIND == 0) { const float ss = wave_sum(x * x); x = x * __builtin_amdgcn_rsqf(ss * (1.f / 64.f) + 1e-6f) * a.in[13][j * 64 + lane]; }
        if (DK == 64 && lat) { const float* R64 = (const float*)(F.ws + WS_ROPE64); const float p = __shfl_xor(x, 32); const int i = lane & 31; const float c = R64[s * 32 + i], sn = R64[2048 * 32 + s * 32 + i]; x = (lane < 32) ? x * c - p * sn : x * c + p * sn; }
        qs[lane] = bf2f(f2bf(x * QS));
        if (DK == 96) { float y = (lane < 32) ? bf2f(q[64 + lane]) : 0.f;
            if (lat) { const float* R32 = (const float*)(F.ws + WS_ROPE32); const float p = __shfl_xor(y, 16); const int i = lane & 15; const float c = R32[s * 16 + i], sn = R32[2048 * 16 + s * 16 + i]; y = ((lane & 31) < 16) ? y * c - p * sn : y * c + p * sn; }
            if (lane < 32) qs[64 + lane] = bf2f(f2bf(y * QS)); }
        asm volatile("s_waitcnt lgkmcnt(0)" ::: "memory");
    }
    float mx = -1e30f;
    for (int jk = lane; jk < S; jk += 64) {
        float sc = 0.f; for (int d = 0; d < DK; ++d) sc += qs[d] * bf2f(Kg[(size_t)jk * DK + d]);
        if (KIND == 1 && lat && jk < 2048 && (jk - s > 128 || jk - s < -128)) sc = -INFINITY;
        scs[jk] = sc; mx = fmaxf(mx, sc);
    }
    mx = wave_max(mx);
    asm volatile("s_waitcnt lgkmcnt(0)" ::: "memory");
    float l = 0.f, o = 0.f;
    for (int jk = 0; jk < S; ++jk) { const float p = __builtin_amdgcn_exp2f(scs[jk] - mx); l += p; o += bf2f(f2bf(p)) * bf2f(Vg[(size_t)lane * S + swap23(jk)]); }
    if (KIND == 1) l += __builtin_amdgcn_exp2f(a.in[17][hq] * LOG2E - mx);
    o /= l;
    const float got = bf2f(O[(size_t)t * 1024 + hq * 64 + lane]);
    if (!close_enough(got, o, 0.03f, 0.01f)) CHK_FAIL(F, id);
    asm volatile("s_waitcnt lgkmcnt(0)" ::: "memory");
}
template <class Fn>
__device__ __forceinline__ void check_gemm_f32(const Frame& F, const bf16* A, const bf16* Bt, int M, int N, int K, const float* C, int ldc, int id) {
    for (int sidx = 0; sidx < 2; ++sidx) {
        const unsigned h = hash_u((F.gw * 2 + sidx) * 2654435761u + id * 97u);
        const int row = h % M, col = (h >> 12) % N;
        const float ref = dot_bf16(A + (size_t)row * K, Bt + (size_t)col * K, K, F.lane);
        if (!close_enough(C[(size_t)row * ldc + col], ref, 0.01f, 0.01f)) CHK_FAIL(F, id);
    }
}
template <class Fn>
__device__ __forceinline__ void check_gemm_bf16(const Frame& F, const bf16* A, const bf16* Bt, int M, int N, int K, const bf16* C, int ldc, int id) {
    for (int sidx = 0; sidx < 2; ++sidx) {
        const unsigned h = hash_u((F.gw * 2 + sidx) * 2654435761u + id * 97u);
        const int row = h % M, col = (h >> 12) % N;
        const float ref = dot_bf16(A + (size_t)row * K, Bt + (size_t)col * K, K, F.lane);
        if (!close_enough(bf2f(C[(size_t)row * ldc + col]), ref, 0.02f, 0.02f)) CHK_FAIL(F, id);
    }
}
#endif

__device__ __forceinline__ void phase_ln1_router(const Frame& F, const Args& a, int l) {
    const bf16* X = (const bf16*)(F.ws + WS_X); bf16* X1 = (bf16*)(F.ws + WS_X1); const bf16* AO = (const bf16*)(F.ws + WS_AO); unsigned char* H8 = F.ws + WS_XE; float* AFF = (float*)(F.ws + WS_AFF);
    constexpr int RP = 1032, RB = 6;
    LAS bf16* Wb = (LAS bf16*)F.lds;
    LAS bf16* Hs = (LAS bf16*)(F.lds + 16 * RP * 2) + F.wave * (RB * RP);
    const float* wr = a.in[25] + (size_t)l * D * NE;
    int lane_ = F.lane; asm volatile("" : "+v"(lane_)); const int lane = lane_;
    const f32x4* lg = (const f32x4*)(a.in[10] + (size_t)(l * 2 + 0) * D); const f32x4* lb = (const f32x4*)(a.in[11] + (size_t)(l * 2 + 0) * D);
    const int RPW = (NTOK + F.NGW - 1) / F.NGW, rbeg = F.gw * RPW, rend = (rbeg + RPW < NTOK) ? rbeg + RPW : NTOK;
    f32x4 lgv[4], lbv[4], g1v[4], sh2v[4], sc2v[4]; int ccur = -1;
#pragma unroll
    for (int j = 0; j < 4; ++j) { lgv[j] = lg[lane + 64 * j]; lbv[j] = lb[lane + 64 * j]; g1v[j] = lgv[j]; sh2v[j] = lgv[j]; sc2v[j] = lgv[j]; }
    u32x2 xc[4], ac[4], xd[4], ad[4];
    { const int r0 = rbeg < rend ? rbeg : NTOK - 1, r1 = rbeg + 1 < rend ? rbeg + 1 : r0;
#pragma unroll
      for (int j = 0; j < 4; ++j) { xc[j] = ((const u32x2*)(X + (size_t)r0 * D))[lane + 64 * j]; ac[j] = ((const u32x2*)(AO + (size_t)r0 * D))[lane + 64 * j];
          xd[j] = ((const u32x2*)(X + (size_t)r1 * D))[lane + 64 * j]; ad[j] = ((const u32x2*)(AO + (size_t)r1 * D))[lane + 64 * j]; } }
    for (int i = F.tid; i < D * NE; i += 512) Wb[(i & 15) * RP + (i >> 4)] = f2bf(wr[i]);
    __syncthreads();
    for (int row = rbeg; row < rend; ++row) {
        const int c = cond_of(row);
        if (c != ccur) { ccur = c; const f32x4* g1 = (const f32x4*)ada_vec(F, l, c, 2); const f32x4* sh2 = (const f32x4*)ada_vec(F, l, c, 3); const f32x4* sc2 = (const f32x4*)ada_vec(F, l, c, 4);
#pragma unroll
            for (int j = 0; j < 4; ++j) { g1v[j] = g1[lane + 64 * j]; sh2v[j] = sh2[lane + 64 * j]; sc2v[j] = sc2[lane + 64 * j] + 1.f; } }
        f32x4 y[4]; float s = 0.f, s2 = 0.f;
#pragma unroll
        for (int j = 0; j < 4; ++j) { const f32x4 av = (f32x4){__uint_as_float(ac[j].x << 16), __uint_as_float(ac[j].x & 0xffff0000u), __uint_as_float(ac[j].y << 16), __uint_as_float(ac[j].y & 0xffff0000u)}; y[j] = bf4(xc[j]) * ALPHA + g1v[j] * av; s += (y[j][0] + y[j][1]) + (y[j][2] + y[j][3]); s2 += (y[j][0] * y[j][0] + y[j][1] * y[j][1]) + (y[j][2] * y[j][2] + y[j][3] * y[j][3]); }
        { const int nr = row + 2 < rend ? row + 2 : row;
#pragma unroll
          for (int j = 0; j < 4; ++j) { xc[j] = xd[j]; ac[j] = ad[j]; xd[j] = ((const u32x2*)(X + (size_t)nr * D))[lane + 64 * j]; ad[j] = ((const u32x2*)(AO + (size_t)nr * D))[lane + 64 * j]; } }
        s = wave_sum(s); s2 = wave_sum(s2);
        const float mean = s * (1.f / D), var = fmaxf(s2 * (1.f / D) - mean * mean, 0.f);
        const float rstd = 1.f / sqrtf(var + 1e-5f);
        f32x4 h[4];
#pragma unroll
        for (int j = 0; j < 4; ++j) { const int q = lane + 64 * j; const f32x4 xn = (y[j] - mean) * rstd * lgv[j] + lbv[j]; ((u32x2*)(X1 + (size_t)row * D))[q] = pk4(xn);
            h[j] = xn * sc2v[j] + sh2v[j]; ((unsigned*)(H8 + (size_t)row * D))[q] = pk4_fp8(h[j][0], h[j][1], h[j][2], h[j][3]); }
        const int br = (row - rbeg) % RB;
#pragma unroll
        for (int j = 0; j < 4; ++j) { u32x2 w; w.x = cvtpk(h[j][0], h[j][1]); w.y = cvtpk(h[j][2], h[j][3]); *(LAS u32x2*)(Hs + br * RP + 4 * (lane + 64 * j)) = w; }
        if (br == RB - 1 || row == rend - 1) {
            const int nrows = br + 1, row0 = row - br, n = lane & 15, kq = lane >> 4, nn = n < nrows ? n : 0;
            const LAS bf16* wp = Wb + n * RP + 8 * kq; const LAS bf16* hp = Hs + nn * RP + 8 * kq;
            f32x4 l0 = (f32x4){0.f, 0.f, 0.f, 0.f}, l1 = l0;
#pragma unroll 4
            for (int st = 0; st < 32; st += 2) {
                l0 = __builtin_amdgcn_mfma_f32_16x16x32_bf16(*(const LAS bf16x8*)(wp + 32 * st), *(const LAS bf16x8*)(hp + 32 * st), l0, 0, 0, 0);
                l1 = __builtin_amdgcn_mfma_f32_16x16x32_bf16(*(const LAS bf16x8*)(wp + 32 * st + 32), *(const LAS bf16x8*)(hp + 32 * st + 32), l1, 0, 0, 0); }
            const f32x4 lg4 = l0 + l1;
            float mx = fmaxf(fmaxf(lg4[0], lg4[1]), fmaxf(lg4[2], lg4[3])); mx = xmax16(mx); mx = xmax32(mx);
            f32x4 ex; ex[0] = __expf(lg4[0] - mx); ex[1] = __expf(lg4[1] - mx); ex[2] = __expf(lg4[2] - mx); ex[3] = __expf(lg4[3] - mx);
            float den = (ex[0] + ex[1]) + (ex[2] + ex[3]); den = xsum16(den, den); den = xsum32(den, den);
            const float inv = 1.f / den;
            if (n < nrows) {
#pragma unroll
                for (int i = 0; i < 4; ++i) AFF[(size_t)(4 * kq + i) * NTOK + row0 + n] = ex[i] * inv; }
        }
    }
    __syncthreads();
}

__device__ __forceinline__ int block_excl_scan(int v, LAS int* wsum, int lane, int wid, int& total) {
    int inc = v;
#pragma unroll
    for (int o = 1; o < 64; o <<= 1) { const int t = __shfl_up(inc, o); if (lane >= o) inc += t; }
    if (lane == 63) wsum[wid] = inc;
    __syncthreads();
    int off = 0, tot = 0;
#pragma unroll
    for (int w = 0; w < 8; ++w) { const int s = wsum[w]; if (w < wid) off += s; tot += s; }
    __syncthreads();
    total = tot; return off + inc - v;
}
__device__ __forceinline__ void phase_topk(const Frame& F) {
    const float* AFFT = (const float*)(F.ws + WS_AFF); int* IDX = (int*)(F.ws + WS_IDX); float* GATEV = (float*)(F.ws + WS_GATEV); int* SLOTMAP = (int*)(F.ws + WS_SLOTMAP);
    LAS int* hist = (LAS int*)F.lds;
    LAS int* wsum = (LAS int*)(F.lds + 1024);
    LAS unsigned* shv = (LAS unsigned*)(F.lds + 1024 + 64);
    const int tid = F.tid, lane = F.lane;
    for (int pr = F.bid; pr < 32; pr += F.G) {
        const int stream = pr >> 4, e = pr & 15, tok0 = stream ? NCTX : 0, cap = stream ? CAPL : CAPC, sbase = e * ESLOTS + (stream ? CAPC : 0);
        const int C = stream ? 16 : 8, i0 = tid * C;
        unsigned k[16];
        { const u32x4* src = (const u32x4*)(AFFT + (size_t)e * NTOK + tok0 + i0);
#pragma unroll
          for (int q = 0; q < 4; ++q) { u32x4 v = (u32x4){0u, 0u, 0u, 0u}; if (q * 4 < C) v = src[q]; k[4 * q] = v.x; k[4 * q + 1] = v.y; k[4 * q + 2] = v.z; k[4 * q + 3] = v.w; } }
        unsigned prefix = 0u; int remaining = cap;
        __syncthreads();
        for (int pass = 0; pass < 4; ++pass) {
            const int shift = 24 - 8 * pass;
            if (tid < 256) hist[tid] = 0;
            __syncthreads();
#pragma unroll
            for (int i = 0; i < 16; ++i) if (i < C) { const unsigned kk = k[i]; if (pass == 0 || (kk >> (shift + 8)) == prefix) __hip_atomic_fetch_add(&hist[(kk >> shift) & 255u], 1, __ATOMIC_RELAXED, __HIP_MEMORY_SCOPE_WORKGROUP); }
            __syncthreads();
            if (tid < 64) {
                const int h0 = hist[4 * lane], h1 = hist[4 * lane + 1], h2 = hist[4 * lane + 2], h3 = hist[4 * lane + 3], c = h0 + h1 + h2 + h3;
                int inc = c;
#pragma unroll
                for (int o = 1; o < 64; o <<= 1) { const int t = __shfl_down(inc, o); if (lane + o < 64) inc += t; }
                const int above = inc - c;
                if (above < remaining && remaining <= inc) {
                    int cum = above, sel;
                    if (cum + h3 >= remaining) sel = 3; else { cum += h3; if (cum + h2 >= remaining) sel = 2; else { cum += h2; if (cum + h1 >= remaining) sel = 1; else { cum += h1; sel = 0; } } }
                    shv[0] = (prefix << 8) | (unsigned)(4 * lane + sel); shv[1] = (unsigned)(remaining - cum);
                }
            }
            __syncthreads();
            prefix = shv[0]; remaining = (int)shv[1];
        }
        const unsigned thr = prefix; const int need = remaining;
        int ceq = 0;
#pragma unroll
        for (int i = 0; i < 16; ++i) if (i < C) ceq += (k[i] == thr) ? 1 : 0;
        int tot; const int eq_rank = block_excl_scan(ceq, wsum, F.lane, F.wave, tot);
        int csel = 0; { int er = eq_rank;
#pragma unroll
            for (int i = 0; i < 16; ++i) if (i < C) { if (k[i] > thr) ++csel; else if (k[i] == thr) { if (er < need) ++csel; ++er; } } }
        int slot = block_excl_scan(csel, wsum, F.lane, F.wave, tot);
#if MK_CHECK
        if (tid == 0 && tot != cap) CHK_FAIL(F, 60);
#endif
        { int er = eq_rank; int sm[16];
#pragma unroll
            for (int i = 0; i < 16; ++i) { sm[i] = -1; if (i < C) { bool sel = false; if (k[i] > thr) sel = true; else if (k[i] == thr) { sel = er < need; ++er; }
                const int tok = tok0 + i0 + i;
                if (sel) { const int r = sbase + slot; IDX[r] = tok; GATEV[r] = __uint_as_float(k[i]); sm[i] = r; ++slot; } } }
            u32x4* dst = (u32x4*)(SLOTMAP + (size_t)e * NTOK + tok0 + i0);
#pragma unroll
            for (int q = 0; q < 4; ++q) if (q * 4 < C) dst[q] = (u32x4){(unsigned)sm[4 * q], (unsigned)sm[4 * q + 1], (unsigned)sm[4 * q + 2], (unsigned)sm[4 * q + 3]}; }
    }
    __syncthreads();
}
__device__ __forceinline__ void phase_gather(const Frame& F) {
    const int* IDX = (const int*)(F.ws + WS_IDX);
#if MK_CHECK
    {
        const int* SLOTMAP = (const int*)(F.ws + WS_SLOTMAP); const float* GATEV = (const float*)(F.ws + WS_GATEV); const float* AFF = (const float*)(F.ws + WS_AFF);
        for (int r = F.gw * 64 + F.lane; r < NSLOTS; r += F.NGW * 64) { const int tok = IDX[r], e = r / ESLOTS; const bool latslot = (r % ESLOTS) >= CAPC;
            bool ok = tok >= 0 && tok < NTOK && ((tok >= NCTX) == latslot);
            if (ok) ok = SLOTMAP[(size_t)e * NTOK + tok] == r && GATEV[r] == AFF[(size_t)e * NTOK + tok];
            if (ok) { const unsigned h = hash_u(r * 7919u + 13u); const int t2 = latslot ? NCTX + (h % NLAT) : (h % NCTX); if (SLOTMAP[(size_t)e * NTOK + t2] < 0 && AFF[(size_t)e * NTOK + t2] > GATEV[r]) ok = false; }
            if (!ok) CHK_FAIL(F, 61); }
    }
#endif
}

__device__ __forceinline__ void ye_acc(f32x4& f, unsigned w) {
    const auto lo = __builtin_amdgcn_cvt_pk_f32_fp8((int)w, false), hi = __builtin_amdgcn_cvt_pk_f32_fp8((int)w, true); f[0] += lo[0]; f[1] += lo[1]; f[2] += hi[0]; f[3] += hi[1];
}
__device__ __forceinline__ void ye_add(f32x4 (&f)[4], const unsigned char* YE, int r, int lane) {
    const bool two = (r >> 8) >= DOWN_FULL_PANELS;
    unsigned w[4], w2[4];
#pragma unroll
    for (int j = 0; j < 4; ++j) { w[j] = ((const unsigned*)(YE + (size_t)r * D))[lane + 64 * j]; w2[j] = 0u; if (two) w2[j] = ((const unsigned*)(YE + (size_t)(NSLOTS + r) * D))[lane + 64 * j]; }
#pragma unroll
    for (int j = 0; j < 4; ++j) { ye_acc(f[j], w[j]); ye_acc(f[j], w2[j]); }
}
__device__ __forceinline__ void ye_add2(f32x4 (&f)[4], const unsigned char* YE, int r, int rb, int lane) {
    const bool two = (r >> 8) >= DOWN_FULL_PANELS, twob = (rb >> 8) >= DOWN_FULL_PANELS;
    unsigned w[4], w2[4], v[4], v2[4];
#pragma unroll
    for (int j = 0; j < 4; ++j) { w[j] = ((const unsigned*)(YE + (size_t)r * D))[lane + 64 * j]; w2[j] = 0u; if (two) w2[j] = ((const unsigned*)(YE + (size_t)(NSLOTS + r) * D))[lane + 64 * j];
        v[j] = ((const unsigned*)(YE + (size_t)rb * D))[lane + 64 * j]; v2[j] = 0u; if (twob) v2[j] = ((const unsigned*)(YE + (size_t)(NSLOTS + rb) * D))[lane + 64 * j]; }
#pragma unroll
    for (int j = 0; j < 4; ++j) { ye_acc(f[j], w[j]); ye_acc(f[j], w2[j]); ye_acc(f[j], v[j]); ye_acc(f[j], v2[j]); }
}
__device__ __forceinline__ void phase_combine(const Frame& F, const Args& a, int l) {
    bf16* X = (bf16*)(F.ws + WS_X); const bf16* X1 = (const bf16*)(F.ws + WS_X1); bf16* H = (bf16*)(F.ws + WS_H); const unsigned char* YE = F.ws + WS_YE; const int* SLOTMAP = (const int*)(F.ws + WS_SLOTMAP);
    int lane_ = F.lane; asm volatile("" : "+v"(lane_)); const int lane = lane_;
    const f32x4* lg = (const f32x4*)(a.in[10] + (size_t)(l * 2 + 1) * D); const f32x4* lb = (const f32x4*)(a.in[11] + (size_t)(l * 2 + 1) * D);
#if MK_CHECK
    const unsigned err = __hip_atomic_load(F.ctl + CW_ERR, __ATOMIC_RELAXED, __HIP_MEMORY_SCOPE_AGENT);
    const unsigned tmo = __hip_atomic_load(F.ctl + CW_BAR + XB_TMO, __ATOMIC_RELAXED, __HIP_MEMORY_SCOPE_AGENT);
#endif
    const int RPW = (NTOK + F.NGW - 1) / F.NGW, rbeg = F.gw * RPW, rend = (rbeg + RPW < NTOK) ? rbeg + RPW : NTOK;
    f32x4 lgv[4], lbv[4], g2v[4], shv[4], scv[4]; int ccur = -1;
#pragma unroll
    for (int j = 0; j < 4; ++j) { lgv[j] = lg[lane + 64 * j]; lbv[j] = lb[lane + 64 * j]; g2v[j] = lgv[j]; shv[j] = lgv[j]; scv[j] = lgv[j]; }
    auto ld_sm = [&](int r) { int v = -1; if (r < rend && lane < 16) v = SLOTMAP[(size_t)lane * NTOK + r]; return v; };
    u32x2 x1n[4]; unsigned pw[4], pw2[4], pv[4], pv2[4]; unsigned restn = 0u; int smn_keep = -1;
    auto issue = [&](int r, int smv) {
        unsigned mask = (unsigned)__ballot(smv >= 0) & 0xffffu; int r0 = -1, r1 = -1;
        if (mask) { const int e0 = __builtin_ctz(mask); mask &= mask - 1; r0 = __builtin_amdgcn_readlane(smv, e0); }
        if (mask) { const int e1 = __builtin_ctz(mask); mask &= mask - 1; r1 = __builtin_amdgcn_readlane(smv, e1); }
        restn = mask; smn_keep = smv;
        const int rr = r < rend ? r : rend - 1;
#pragma unroll
        for (int j = 0; j < 4; ++j) { x1n[j] = ((const u32x2*)(X1 + (size_t)rr * D))[lane + 64 * j]; pw[j] = 0u; pw2[j] = 0u; pv[j] = 0u; pv2[j] = 0u; }
        if (r0 >= 0) {
#pragma unroll
            for (int j = 0; j < 4; ++j) { pw[j] = ((const unsigned*)(YE + (size_t)r0 * D))[lane + 64 * j]; if ((r0 >> 8) >= DOWN_FULL_PANELS) pw2[j] = ((const unsigned*)(YE + (size_t)(NSLOTS + r0) * D))[lane + 64 * j]; } }
        if (r1 >= 0) {
#pragma unroll
            for (int j = 0; j < 4; ++j) { pv[j] = ((const unsigned*)(YE + (size_t)r1 * D))[lane + 64 * j]; if ((r1 >> 8) >= DOWN_FULL_PANELS) pv2[j] = ((const unsigned*)(YE + (size_t)(NSLOTS + r1) * D))[lane + 64 * j]; } }
    };
    int sm1 = ld_sm(rbeg + 1);
    if (rbeg < rend) issue(rbeg, ld_sm(rbeg));
    for (int row = rbeg; row < rend; ++row) {
        const int c = cond_of(row);
        if (c != ccur) { ccur = c; const f32x4* g2 = (const f32x4*)ada_vec(F, l, c, 5);
#pragma unroll
            for (int j = 0; j < 4; ++j) g2v[j] = g2[lane + 64 * j];
            if (l < 3) { const f32x4* sh = (const f32x4*)ada_vec(F, l + 1, c, 0); const f32x4* sc = (const f32x4*)ada_vec(F, l + 1, c, 1);
#pragma unroll
                for (int j = 0; j < 4; ++j) { shv[j] = sh[lane + 64 * j]; scv[j] = sc[lane + 64 * j] + 1.f; } } }
        f32x4 x1[4], f[4]; unsigned mask = restn; const int smc = smn_keep;
#pragma unroll
        for (int j = 0; j < 4; ++j) { x1[j] = bf4(x1n[j]); f[j] = (f32x4){0.f, 0.f, 0.f, 0.f}; ye_acc(f[j], pw[j]); ye_acc(f[j], pw2[j]); ye_acc(f[j], pv[j]); ye_acc(f[j], pv2[j]); }
        if (row + 1 < rend) { const int smv = sm1; sm1 = ld_sm(row + 2); issue(row + 1, smv); }
        while (mask) {
            const int e0 = __builtin_ctz(mask); mask &= mask - 1; const int r0 = __builtin_amdgcn_readlane(smc, e0);
            if (mask) { const int e1 = __builtin_ctz(mask); mask &= mask - 1; const int r1 = __builtin_amdgcn_readlane(smc, e1); ye_add2(f, YE, r0, r1, lane); }
            else ye_add(f, YE, r0, lane);
        }
        f32x4 y[4]; float s = 0.f, s2 = 0.f;
#pragma unroll
        for (int j = 0; j < 4; ++j) { y[j] = x1[j] * ALPHA + g2v[j] * f[j] * (1.f / YE8_SCALE); s += (y[j][0] + y[j][1]) + (y[j][2] + y[j][3]); s2 += (y[j][0] * y[j][0] + y[j][1] * y[j][1]) + (y[j][2] * y[j][2] + y[j][3] * y[j][3]); }
        s = wave_sum(s); s2 = wave_sum(s2);
        const float mean = s * (1.f / D), var = fmaxf(s2 * (1.f / D) - mean * mean, 0.f);
        const float rstd = 1.f / sqrtf(var + 1e-5f);
        if (l < 3) {
#pragma unroll
            for (int j = 0; j < 4; ++j) { const int q = lane + 64 * j; const f32x4 xn = (y[j] - mean) * rstd * lgv[j] + lbv[j]; ((u32x2*)(X + (size_t)row * D))[q] = pk4(xn);
                const f32x4 h = xn * scv[j] + shv[j]; u32x2 w; w.x = cvtpk(h[0], h[1]); w.y = cvtpk(h[2], h[3]); ((u32x2*)(H + (size_t)row * D))[q] = w; }
        } else {
#pragma unroll
            for (int j = 0; j < 4; ++j) { const int q = lane + 64 * j; f32x4 xn = (y[j] - mean) * rstd * lgv[j] + lbv[j];
#if MK_CHECK
                if (row == 0 && q == 0) { if (err) xn[0] = 100.f * (float)err; else if (tmo) xn[0] = 9900.f; }
#endif
                ((f32x4*)(F.out + (size_t)row * D))[q] = xn; }
        }
    }
}

#if !MK_SPLIT
#define GRID_BAR() xcd_barrier(bar)
#else
#define GRID_BAR() do { } while (0)
#endif
#define IN(k) (lo <= (k) && (k) < hi)
#define GEMM_PHASE(EPI, SCHED) do { for (int rep_ = 0; rep_ < MK_REP_GEMM; ++rep_) pg8::gemm_phase<EPI, SCHED, true, true>(F.lds, g, S, E); } while (0)
template <int KIND>
__device__ __forceinline__ void run_mixer(const Frame& F, const Args& a, const XcdBarrier& bar, int lo, int hi, int l, int j, int slot, int& cv_it) {
    const int base = 3 + 12 * l;
    const bf16* Hb = (const bf16*)(F.ws + WS_H);
    ChunkMap cm; cm.init(F.G, F.bid);
    const ConvJob J{a.in[26], a.in[27], a.in[28], F.ws + WS_WGU, F.ws + WS_WD};
    const int cv_cap = (l == 0 ? 32 : l == 1 ? 48 : l == 2 ? 82 : 96) * (CV_PER_LAYER / 24);
    if (KIND != 2) {
        const bf16* Wq = (const bf16*)(F.ws + WS_WQKV) + (size_t)slot * 1536 * 1024;
        if (IN(base + 0)) {
            unsigned* cnt = F.ctl + CW_KV + 16 * l;
            Gemm g{Hb, Wq, 1024, 1024}; QkvOrder S{cm}; EpiBf16P E{(bf16*)(F.ws + WS_QKV), 1536};
            GEMM_PHASE(EpiBf16P, QkvOrder);
            int nkv = 0; { Unit u; for (int i = 0; S.next(i, u); ++i) nkv += (u.pn >= 4) ? 1 : 0; }
            if (nkv && F.tid == 0) { __builtin_amdgcn_fence(__ATOMIC_RELEASE, "agent"); (void)__hip_atomic_fetch_add(cnt, (unsigned)nkv, __ATOMIC_RELAXED, __HIP_MEMORY_SCOPE_AGENT); }
            const int idx = cm.x * cm.chunk + cm.loc; int skip = 288 - F.G; if (skip < 0 || skip >= F.G) skip = 0;
            if (idx >= skip) {
                if (F.tid == 0) { while (__hip_atomic_load(cnt, __ATOMIC_RELAXED, __HIP_MEMORY_SCOPE_AGENT) < 96u) __builtin_amdgcn_s_sleep(2); __builtin_amdgcn_fence(__ATOMIC_ACQUIRE, "agent"); }
                __syncthreads();
                for (int rep = 0; rep < MK_REP_POST; ++rep) phase_kv_post(F, a, KIND, j, slot, (idx - skip) * 8 + F.wave, (F.G - skip) * 8);
            }
            GRID_BAR();
        }
#if MK_CHECK
        if (IN(base + 3)) check_gemm_bf16<int>(F, Hb, Wq, NTOK, 1536, 1024, (const bf16*)(F.ws + WS_QKV), 1536, 10 + l);
#endif
        if (IN(base + 4)) {
            for (int rep = 0; rep < MK_REP_ATTN; ++rep) { if (KIND == 0) attn_phase<64, 0>(F, a, j, J, cv_it, (l + 1) * CV_PER_LAYER, cv_cap); else attn_phase<64, 1>(F, a, j, J, cv_it, (l + 1) * CV_PER_LAYER, cv_cap); }
            GRID_BAR();
        }
    } else {
        if (IN(base + 0)) {
            Gemm g{Hb, (const bf16*)(F.ws + WS_WDN), 512, 1024}; SplitKOrder S{2, 2, 1024, 48 * 2 * 2, cm}; EpiF32 E{(float*)(F.ws + WS_QKV), 512, DWN_PART};
            GEMM_PHASE(EpiF32, SplitKOrder); GRID_BAR();
        }
        if (IN(base + 1)) {
#if MK_CHECK
            for (int sidx = 0; sidx < 2; ++sidx) { const unsigned h = hash_u((F.gw * 2 + sidx) * 2654435761u + (10 + l) * 97u); const int row = h % NTOK, col = (h >> 12) % 512;
                const float ref = dot_bf16(Hb + (size_t)row * 1024, (const bf16*)(F.ws + WS_WDN) + (size_t)col * 1024, 1024, F.lane); const float* dq = (const float*)(F.ws + WS_QKV) + (size_t)row * 512 + col;
                if (!close_enough(dq[0] + dq[DWN_PART], ref, 0.01f, 0.01f)) CHK_FAIL(F, 10 + l); }
#endif
            phase_mla_post1(F, a); GRID_BAR();
        }
        if (IN(base + 2)) {
            { Gemm g{(const bf16*)(F.ws + WS_QA), (const bf16*)(F.ws + WS_WUQ), 256, 256}; PlainOrder S{6, 48 * 6, cm}; EpiBf16P E{(bf16*)(F.ws + WS_QKV), 1536}; GEMM_PHASE(EpiBf16P, PlainOrder); }
            { Gemm g{(const bf16*)(F.ws + WS_CKVA), (const bf16*)(F.ws + WS_WUKV), 128, 128}; ChunkMap cmr = cm; cmr.x = cm.nx - 1 - cm.x; PlainOrder S{8, 56 * 8, cmr};     EpiUkv E{(bf16*)(F.ws + WS_KB), (bf16*)(F.ws + WS_KVRAW)}; GEMM_PHASE(EpiUkv, PlainOrder); }
            GRID_BAR();
        }
        if (IN(base + 3)) {
#if MK_CHECK
            check_gemm_bf16<int>(F, (const bf16*)(F.ws + WS_QA), (const bf16*)(F.ws + WS_WUQ), NTOK, 1536, 256, (const bf16*)(F.ws + WS_QKV), 1536, 14);
            for (int sidx = 0; sidx < 2; ++sidx) {
                const unsigned h = hash_u((F.gw * 2 + sidx) * 2654435761u + 15u * 97u); const int row = h % 14336, col = (h >> 12) % 2048, hh = col >> 7, ii = col & 127;
                const float ref = dot_bf16((const bf16*)(F.ws + WS_CKVA) + (size_t)row * 128, (const bf16*)(F.ws + WS_WUKV) + (size_t)col * 128, 128, F.lane);
                bool lat; int b, s; mla_row(row, lat, b, s);
                const float got = (ii < 64) ? bf2f(((const bf16*)(F.ws + WS_KB))[kb_off(16, 96, lat, b, hh) + (size_t)s * 96 + ii]) : bf2f(((const bf16*)(F.ws + WS_KVRAW))[(size_t)row * 1024 + hh * 64 + ii - 64]);
                if (!close_enough(got, ref, 0.02f, 0.02f)) CHK_FAIL(F, 15);
            }
#endif
            for (int rep = 0; rep < MK_REP_POST; ++rep) phase_mla_post2(F, a); GRID_BAR();
        }
        if (IN(base + 4)) { for (int rep = 0; rep < MK_REP_ATTN; ++rep) attn_phase<96, 2>(F, a, j, J, cv_it, (l + 1) * CV_PER_LAYER, cv_cap); GRID_BAR(); }
    }
}
__device__ __forceinline__ void run_moe(const Frame& F, const Args& a, const XcdBarrier& bar, int lo, int hi, int l, int kind) {
    const int base = 3 + 12 * l;
    ChunkMap cm; cm.init(F.G, F.bid);
    const bf16* Wo = (const bf16*)(F.ws + WS_WO) + (size_t)l * 1024 * 1024;
    if (IN(base + 5)) {
#if MK_CHECK
        if (kind == 0) check_attn<64, 0>(F, a, l / 3, 20 + l); else if (kind == 1) check_attn<64, 1>(F, a, 0, 20 + l); else check_attn<96, 2>(F, a, 0, 20 + l);
        __syncthreads();
#endif
        Gemm g{(const bf16*)(F.ws + WS_O), Wo, 1024, 1024}; PlainOrder S{4, 48 * 4, cm}; EpiBf16P E{(bf16*)(F.ws + WS_AO), 1024};
        GEMM_PHASE(EpiBf16P, PlainOrder); GRID_BAR();
    }
    if (IN(base + 6)) {
#if MK_CHECK
        check_gemm_bf16<int>(F, (const bf16*)(F.ws + WS_O), Wo, NTOK, 1024, 1024, (const bf16*)(F.ws + WS_AO), 1024, 30 + l);
#endif
        for (int rep = 0; rep < MK_REP_LN1; ++rep) phase_ln1_router(F, a, l); GRID_BAR();
    }
#if MK_CHECK
    if (IN(base + 7)) {
        const unsigned hsh = hash_u(F.gw * 2654435761u + 991u * l + 17u); const int row = hsh % NTOK, c = cond_of(row);
        const bf16* X1c = (const bf16*)(F.ws + WS_X1); const float* sh2 = ada_vec(F, l, c, 3); const float* sc2 = ada_vec(F, l, c, 4); const float* wrc = a.in[25] + (size_t)l * D * NE; const float* AFFc = (const float*)(F.ws + WS_AFF);
        float lgt[16];
#pragma unroll
        for (int e = 0; e < 16; ++e) { float sacc = 0.f; for (int k = F.lane; k < D; k += 64) { const float hh = bf2f(X1c[(size_t)row * D + k]) * (sc2[k] + 1.f) + sh2[k]; sacc += hh * wrc[k * NE + e]; } lgt[e] = wave_sum(sacc); }
        float mxc = lgt[0];
#pragma unroll
        for (int e = 1; e < 16; ++e) mxc = fmaxf(mxc, lgt[e]);
        float denc = 0.f;
#pragma unroll
        for (int e = 0; e < 16; ++e) denc += __expf(lgt[e] - mxc);
#pragma unroll
        for (int e = 0; e < 16; ++e) { const float ref = __expf(lgt[e] - mxc) / denc, got = AFFc[(size_t)e * NTOK + row]; if (!close_enough(got, ref, 0.03f, 2e-4f)) CHK_FAIL(F, 62); }
    }
#endif
    if (IN(base + 7)) { for (int rep = 0; rep < MK_REP_TOPK; ++rep) phase_topk(F); if (l < 3) ada_direct(F, a, l + 1, 32); GRID_BAR(); }
#if MK_CHECK
    if (IN(base + 8)) { phase_gather(F); GRID_BAR(); }
#endif
    const unsigned char* Wgu = F.ws + WS_WGU + (size_t)l * 16 * 4096 * 1024; const unsigned char* Wd = F.ws + WS_WD + (size_t)l * 16 * 1024 * 2048;
    if (IN(base + 9)) {
#if MK_CHECK
        for (int sidx = 0; sidx < 16; ++sidx) {
            const unsigned h = hash_u((F.gw * 16 + sidx) * 2654435761u + 71u * l + 3u); const int idx = h & 63, e = (h >> 6) & 15, kk = (h >> 10) & 1023, nn = (h >> 20) & 2047;
            const int k = kk + ((idx & 1) ? 1024 * ((h >> 31) & 1) : 0);
            float src, got;
            if (idx & 1) { const int n = nn & 1023; src = a.in[28][((size_t)(l * 16 + e) * 2048 + k) * 1024 + n]; got = fp8f(Wd + ((size_t)e * 1024 + n) * 2048, k); }
            else { const bool up = (idx & 2) != 0; src = (up ? a.in[27] : a.in[26])[((size_t)(l * 16 + e) * 1024 + kk) * 2048 + nn]; got = fp8f(Wgu + ((size_t)e * 4096 + (nn >> 7) * 256 + (up ? 128 : 0) + (nn & 127)) * 1024, kk); }
            { const unsigned pk = pk4_fp8(src * W8_SCALE, 0.f, 0.f, 0.f); if (F.lane == 0 && got != __builtin_amdgcn_cvt_f32_fp8((int)pk, 0)) CHK_FAIL(F, 70 + l); }
        }
#endif
        Gemm g{(const bf16*)(F.ws + WS_XE), (const bf16*)Wgu, 512, 512, (const int*)(F.ws + WS_IDX)}; GroupedOrder S{6, 16, 1, 0, cm}; EpiSwiglu E{F.ws + WS_HID};
        pg8::gemm_phase<EpiSwiglu, GroupedOrder, true, true, true, true>(F.lds, g, S, E); GRID_BAR();
    }
    if (IN(base + 10)) {
#if MK_CHECK
        for (int sidx = 0; sidx < 2; ++sidx) {
            const unsigned h = hash_u((F.gw * 2 + sidx) * 2654435761u + 977u * l); const int row = h % NSLOTS, cc = (h >> 12) % FF, e = row / ESLOTS;
            const unsigned char* xr = F.ws + WS_XE + (size_t)((const int*)(F.ws + WS_IDX))[row] * D; const unsigned char* wg = Wgu + ((size_t)e * 4096 + (cc >> 7) * 256 + (cc & 127)) * 1024;
            const float gd = dot_fp8(xr, wg, 1024, F.lane) * (1.f / W8_SCALE), ud = dot_fp8(xr, wg + 128 * 1024, 1024, F.lane) * (1.f / W8_SCALE);
            const float ref = gd / (1.f + __expf(-gd)) * ud, got = fp8f(F.ws + WS_HID + (size_t)row * FF, cc) * (1.f / H8_SCALE);
            if (!close_enough(got, ref, 0.08f, 0.01f)) CHK_FAIL(F, 40 + l);
        }
#endif
        EpiDown E{F.ws + WS_YE, (const float*)(F.ws + WS_GATEV)};
        { Gemm g{(const bf16*)(F.ws + WS_HID), (const bf16*)Wd, 1024, 1024, nullptr}; DownOrder S{cm}; pg8::gemm_phase<EpiDown, DownOrder, true, true, false, true>(F.lds, g, S, E); }
        GRID_BAR();
    }
    if (IN(base + 11)) {
#if MK_CHECK
        for (int sidx = 0; sidx < 2; ++sidx) {
            const unsigned h = hash_u((F.gw * 2 + sidx) * 2654435761u + 577u * l + 5u); const int row = h % NSLOTS, cc = (h >> 12) % D, e = row / ESLOTS;
            const float dd = dot_fp8(F.ws + WS_HID + (size_t)row * FF, Wd + ((size_t)e * 1024 + cc) * 2048, 2048, F.lane) * (1.f / (W8_SCALE * H8_SCALE));
            const float ref = dd * ((const float*)(F.ws + WS_GATEV))[row], p1 = fp8f(F.ws + WS_YE + (size_t)row * D, cc) * (1.f / YE8_SCALE), p2 = ((row >> 8) >= DOWN_FULL_PANELS) ? fp8f(F.ws + WS_YE + (size_t)(NSLOTS + row) * D, cc) * (1.f / YE8_SCALE) : 0.f;
            if (!(fabsf(p1 + p2 - ref) <= 0.07f * (fabsf(p1) + fabsf(p2)) + 0.0005f)) CHK_FAIL(F, 50 + l);
        }
#endif
        for (int rep = 0; rep < MK_REP_COMB; ++rep) phase_combine(F, a, l); if (l < 3) GRID_BAR();
    }
}
#undef IN

constexpr int N_PHASES = 3 + 4 * 12;
__global__ void __launch_bounds__(512, 2) mk_fwd(Args a) {
    extern __shared__ __attribute__((aligned(16))) unsigned char lds_raw[];
    LAS unsigned char* lds0 = (LAS unsigned char*)lds_raw;
    Frame F;
    F.lds = lds0 + LDS_PH; F.ws = a.ws; F.out = a.out; F.ctl = (unsigned*)(a.ws + WS_CTL);
    F.tid = threadIdx.x; F.lane = F.tid & 63; F.wave = __builtin_amdgcn_readfirstlane(F.tid >> 6); F.G = gridDim.x; F.bid = blockIdx.x; F.gw = F.bid * 8 + F.wave; F.NGW = F.G * 8;
    if (F.tid < LDS_PH / 4) ((LAS unsigned*)lds0)[F.tid] = 0u;
    __syncthreads();
#if !MK_SPLIT
    XcdBarrier bar = xcd_barrier_post(F.ctl + CW_BAR, (volatile LAS unsigned*)lds0);
#else
    XcdBarrier bar; bar.bar = F.ctl + CW_BAR; bar.x = 0; bar.st = (volatile LAS unsigned*)lds0;
#endif
    const int lo = a.ph_lo, hi = a.ph_hi;
#define IN(k) (lo <= (k) && (k) < hi)
    if (IN(0)) { phase_prologue(F, a); GRID_BAR(); }
    if (IN(2)) { phase_mod0(F, a); GRID_BAR(); }
    int cv_it = F.gw;
    run_mixer<0>(F, a, bar, lo, hi, 0, 0, 0, cv_it);
    run_moe(F, a, bar, lo, hi, 0, 0);
    run_mixer<1>(F, a, bar, lo, hi, 1, 0, 1, cv_it);
    run_moe(F, a, bar, lo, hi, 1, 1);
    run_mixer<2>(F, a, bar, lo, hi, 2, 0, 0, cv_it);
    run_moe(F, a, bar, lo, hi, 2, 2);
    run_mixer<0>(F, a, bar, lo, hi, 3, 1, 2, cv_it);
    run_moe(F, a, bar, lo, hi, 3, 0);
#undef IN
}

extern "C" void kernel_launch(void* const* d_in, const int* in_sizes, int n_in, void* d_out, int out_size, void* d_ws, size_t ws_size, hipStream_t stream) {
    static int grid = 0;
    if (grid == 0) {
        if (n_in != 29 || out_size != 19529728 || ws_size < WS_END) { fprintf(stderr, "kernel_launch: unexpected sizes n_in %d out %d ws %zu\n", n_in, out_size, ws_size); grid = -1; return; }
        int dev = 0, cus = 0, per_cu = 0;
        if (hipGetDevice(&dev) != hipSuccess || hipDeviceGetAttribute(&cus, hipDeviceAttributeMultiprocessorCount, dev) != hipSuccess) { grid = -1; return; }
        if (hipFuncSetAttribute((const void*)mk_fwd, hipFuncAttributeMaxDynamicSharedMemorySize, LDS_BYTES) != hipSuccess) { fprintf(stderr, "kernel_launch: hipFuncSetAttribute failed\n"); grid = -1; return; }
        if (hipOccupancyMaxActiveBlocksPerMultiprocessor(&per_cu, (const void*)mk_fwd, 512, LDS_BYTES) != hipSuccess || per_cu < 1) fprintf(stderr, "kernel_launch: occupancy query says %d\n", per_cu);
        (void)hipGetLastError();
        grid = cus;
    }
    if (grid < 0) return;
    (void)hipMemsetAsync((char*)d_ws + WS_CTL, 0, CTL_BYTES, stream);
    Args a{};
    for (int i = 0; i < 29; ++i) a.in[i] = (const float*)d_in[i];
    a.out = (float*)d_out; a.ws = (unsigned char*)d_ws;
#if MK_SPLIT
    for (int p = 0; p < N_PHASES; ++p) {
        const int r = (p - 3) % 12, l = (p - 3) / 12;
        if (p >= 3) { const bool mla = (l % 3) == 2; if (!mla && (r == 1 || r == 2)) continue; }
        a.ph_lo = p; a.ph_hi = p + 1;
        hipLaunchKernelGGL(mk_fwd, dim3(grid), dim3(512), LDS_BYTES, stream, a);
    }
#else
    a.ph_lo = 0; a.ph_hi = N_PHASES;
    hipLaunchKernelGGL(mk_fwd, dim3(grid), dim3(512), LDS_BYTES, stream, a);
#endif
}
```
